# Optimizing an MI355X kernel written in HIP

```python
import jax, jax.numpy as jnp
from jax import lax
import numpy as np

D_MODEL = 2048
BATCH = 8
SEQ = 4096
DEPTH = 4

CHUNK = 64
Q_BLOCK = 128
HEAD_DIM = 128
MEM_TOKENS = 256
MEM_HEADS = 4
MEM_W = MEM_HEADS * HEAD_DIM
MIX_W = D_MODEL
MAIN_W = MIX_W - MEM_W
GLA_HEADS = 4
GLA_KEY = MAIN_W // 2
GLA_HK = GLA_KEY // GLA_HEADS
GLA_HV = MAIN_W // GLA_HEADS
GLA_GATE_RANK = 16
GLA_GATE_NORMALIZER = 16.0
FOX_HEADS = MAIN_W // HEAD_DIM
D_FF = 256 * ((8 * D_MODEL // 3 + 255) // 256)
A_IN = 2 * GLA_KEY + MAIN_W + GLA_GATE_RANK + MAIN_W + MEM_W
B_IN = 2 * MAIN_W + MEM_W
KV_SHARED = 2 * MAIN_W + FOX_HEADS
EPS = 1e-6

kernel_name = "yoco_gla_fox_macaron_memory_trunk"


def _rmsnorm(x, g):
    xf = x.astype(jnp.float32)
    y = xf * lax.rsqrt(jnp.mean(xf * xf, axis=-1, keepdims=True) + EPS)
    return (y * g.astype(jnp.float32)).astype(x.dtype)


def _swiglu(h, w1, w3, w2):
    return (jax.nn.silu(h @ w1) * (h @ w3)) @ w2


def _gla_chunk_causal(q, k, v, log_a):
    b, s, h, dk = q.shape
    dv = v.shape[-1]
    n = s // CHUNK

    def to_chunks(t):
        return jnp.moveaxis(t.reshape(b, n, CHUNK, h, t.shape[-1]), 1, 0)

    qc, kc, vc = to_chunks(q), to_chunks(k), to_chunks(v)
    cum = jnp.cumsum(to_chunks(log_a), axis=2)
    total = cum[:, :, -1:]
    k_dec = (kc.astype(jnp.float32) * jnp.exp(total - cum)).astype(k.dtype)
    a_chunk = jnp.exp(total[:, :, 0])

    def step(state, inp):
        q_c, k_c, v_c, a_c = inp
        state = a_c[..., None] * state + jnp.einsum(
            'bchk,bchv->bhkv', k_c, v_c, preferred_element_type=jnp.float32)
        out = jnp.einsum('bchk,bhkv->bchv', q_c.astype(jnp.float32), state)
        return state, out.astype(v_c.dtype)

    state0 = jnp.zeros((b, h, dk, dv), jnp.float32)
    _, o = lax.scan(step, state0, (qc, k_dec, vc, a_chunk))
    return jnp.moveaxis(o, 0, 1).reshape(b, s, h, dv)


def _forgetting_attention(q, k, v, cum_log_f):
    b, s, h, d = q.shape
    scale = d ** -0.5
    outs = []
    for i in range(s // Q_BLOCK):
        q0 = i * Q_BLOCK
        q1 = q0 + Q_BLOCK
        logits = jnp.einsum('bqhd,bkhd->bhqk', q[:, q0:q1], k[:, :q1],
                            preferred_element_type=jnp.float32) * scale
        logits = logits + cum_log_f[:, :, q0:q1, None] - cum_log_f[:, :, None, :q1]
        causal = (q0 + jnp.arange(Q_BLOCK))[:, None] >= jnp.arange(q1)[None, :]
        p = jax.nn.softmax(jnp.where(causal, logits, -jnp.inf), axis=-1)
        outs.append(jnp.einsum('bhqk,bkhd->bqhd', p.astype(v.dtype), v[:, :q1]))
    return jnp.concatenate(outs, axis=1)


def _memory_attention(qm, mk, mv):
    logits = jnp.einsum('bshd,bmhd->bhsm', qm, mk,
                        preferred_element_type=jnp.float32) * (qm.shape[-1] ** -0.5)
    p = jax.nn.softmax(logits, axis=-1)
    return jnp.einsum('bhsm,bmhd->bshd', p.astype(mv.dtype), mv)


def setup_inputs(seed: int = 0) -> dict:
    key = jax.random.key(seed)
    ks = jax.random.split(key, 32)
    f32 = jnp.float32
    n_a = DEPTH // 2
    n_b = DEPTH - n_a

    def w(k, shape, fan_in, scale=1.0):
        return jax.random.normal(k, shape, f32) * (scale * fan_in ** -0.5)

    def gain(k, shape):
        return 1.0 + 0.05 * jax.random.normal(k, shape, f32)

    return {
        "x": jax.random.normal(ks[0], (BATCH, SEQ, D_MODEL), f32),
        "mem": jax.random.normal(ks[1], (BATCH, MEM_TOKENS, D_MODEL), f32),
        "ffn_norm": gain(ks[2], (DEPTH, 2, D_MODEL)),
        "ffn_w1": w(ks[3], (DEPTH, 2, D_MODEL, D_FF), D_MODEL),
        "ffn_w3": w(ks[4], (DEPTH, 2, D_MODEL, D_FF), D_MODEL),
        "ffn_w2": w(ks[5], (DEPTH, 2, D_FF, D_MODEL), D_FF),
        "mix_norm": gain(ks[6], (DEPTH, D_MODEL)),
        "mem_norm": gain(ks[7], (DEPTH, D_MODEL)),
        "w_mem_kv": w(ks[8], (DEPTH, D_MODEL, 2 * MEM_W), D_MODEL),
        "mem_q_norm": gain(ks[9], (DEPTH, HEAD_DIM)),
        "mem_k_norm": gain(ks[10], (DEPTH, HEAD_DIM)),
        "w_out": w(ks[11], (DEPTH, MIX_W, D_MODEL), MIX_W),
        "a_w_in": w(ks[12], (n_a, D_MODEL, A_IN), D_MODEL),
        "a_w_gate_up": w(ks[13], (n_a, GLA_GATE_RANK, GLA_KEY), GLA_GATE_RANK),
        "a_b_gate": 0.1 * jax.random.normal(ks[14], (n_a, GLA_KEY), f32),
        "a_out_norm": gain(ks[15], (n_a, GLA_HV)),
        "b_w_in": w(ks[16], (n_b, D_MODEL, B_IN), D_MODEL),
        "b_q_norm": gain(ks[17], (n_b, HEAD_DIM)),
        "kv_norm": gain(ks[18], (D_MODEL,)),
        "w_kv": w(ks[19], (D_MODEL, KV_SHARED), D_MODEL),
        "b_f": jax.random.uniform(ks[20], (FOX_HEADS,), f32, 1.0, 5.0),
        "k_norm": gain(ks[21], (HEAD_DIM,)),
    }


def reference(x, mem, ffn_norm, ffn_w1, ffn_w3, ffn_w2, mix_norm, mem_norm,
              w_mem_kv, mem_q_norm, mem_k_norm, w_out, a_w_in, a_w_gate_up,
              a_b_gate, a_out_norm, b_w_in, b_q_norm, kv_norm, w_kv, b_f, k_norm):
    bsz, seq, _ = x.shape
    n_a = a_w_in.shape[0]
    a_split = list(np.cumsum([GLA_KEY, GLA_KEY, MAIN_W, GLA_GATE_RANK, MAIN_W]))
    b_split = [MAIN_W, 2 * MAIN_W]
    ks_shared = vs_shared = cum_shared = None

    for l in range(DEPTH):
        if l == n_a:
            hs = _rmsnorm(x, kv_norm)
            k_s, v_s, f_s = jnp.split(hs @ w_kv, b_split, axis=-1)
            ks_shared = _rmsnorm(k_s.reshape(bsz, seq, FOX_HEADS, HEAD_DIM), k_norm)
            vs_shared = v_s.reshape(bsz, seq, FOX_HEADS, HEAD_DIM)
            log_f = jax.nn.log_sigmoid((f_s + b_f).astype(jnp.float32))
            cum_shared = jnp.moveaxis(jnp.cumsum(log_f, axis=1), 1, 2)

        x = x + 0.5 * _swiglu(_rmsnorm(x, ffn_norm[l, 0]), ffn_w1[l, 0],
                              ffn_w3[l, 0], ffn_w2[l, 0])

        h = _rmsnorm(x, mix_norm[l])
        if l < n_a:
            q, k, v, lr, g, qm = jnp.split(h @ a_w_in[l], a_split, axis=-1)
            q = q.reshape(bsz, seq, GLA_HEADS, GLA_HK) * (GLA_HK ** -0.5)
            k = k.reshape(bsz, seq, GLA_HEADS, GLA_HK)
            v = v.reshape(bsz, seq, GLA_HEADS, GLA_HV)
            log_a = jax.nn.log_sigmoid(
                (lr @ a_w_gate_up[l] + a_b_gate[l]).astype(jnp.float32)) / GLA_GATE_NORMALIZER
            log_a = log_a.reshape(bsz, seq, GLA_HEADS, GLA_HK)
            o = _gla_chunk_causal(q, k, v, log_a)
            o = _rmsnorm(o, a_out_norm[l]) * jax.nn.silu(g.reshape(bsz, seq, GLA_HEADS, GLA_HV))
        else:
            j = l - n_a
            q, g, qm = jnp.split(h @ b_w_in[j], b_split, axis=-1)
            q = _rmsnorm(q.reshape(bsz, seq, FOX_HEADS, HEAD_DIM), b_q_norm[j])
            o = _forgetting_attention(q, ks_shared, vs_shared, cum_shared)
            o = o * jax.nn.sigmoid(g.reshape(bsz, seq, FOX_HEADS, HEAD_DIM))
        o = o.reshape(bsz, seq, MAIN_W)

        mh = _rmsnorm(mem, mem_norm[l])
        mkv = (mh @ w_mem_kv[l]).reshape(bsz, mem.shape[1], 2, MEM_HEADS, HEAD_DIM)
        mk = _rmsnorm(mkv[:, :, 0], mem_k_norm[l])
        mv = mkv[:, :, 1]
        qm = _rmsnorm(qm.reshape(bsz, seq, MEM_HEADS, HEAD_DIM), mem_q_norm[l])
        mo = _memory_attention(qm, mk, mv).reshape(bsz, seq, MEM_W)

        x = x + jnp.concatenate([o, mo], axis=-1) @ w_out[l]

        x = x + 0.5 * _swiglu(_rmsnorm(x, ffn_norm[l, 1]), ffn_w1[l, 1],
                              ffn_w3[l, 1], ffn_w2[l, 1])
    return x
```

```cpp
#include <hip/hip_runtime.h>
#include <cstdio>
#include <cstdint>
__device__ __forceinline__ int lane_id_v() { int l; asm volatile("v_mbcnt_lo_u32_b32 %0, -1, 0\n\tv_mbcnt_hi_u32_b32 %0, -1, %0" : "=v"(l)); return l; }
namespace pg8 {
#define PG8_LAS __attribute__((address_space(3)))
typedef unsigned short bf16_t;
typedef short bf16x8 __attribute__((ext_vector_type(8)));
typedef float f32x4 __attribute__((ext_vector_type(4)));
typedef unsigned u32x4 __attribute__((ext_vector_type(4)));
constexpr int BM = 256, BK = 64, HALF = 128, HTB = HALF * BK * 2  , STAGE_BYTES = 8 * HTB, NXCD = 8, WGM = 8;

__host__ __device__ __forceinline__ int lds_byte(int r, int c) { const int st = (r >> 4) * 2 + (c >> 5), rr = r & 15, cc = c & 31, ob = rr * 64 + cc * 2; return st * 1024 + (ob ^ (((ob >> 9) & 1) << 5)); }
__host__ __device__ __forceinline__ void stage_rc(int b, int& R, int& C) { const int st = b / 1024, sb = b % 1024, swz = sb ^ (((sb >> 9) & 1) << 5); R = (st >> 1) * 16 + swz / 64; C = (st & 1) * 32 + (swz % 64) / 2; }
__host__ __device__ __forceinline__ int perm32(int rho) { const int n = rho >> 4, i = rho & 15; return 8 * (i >> 2) + 4 * n + (i & 3); }

struct Unit { int pm, pn; };
struct Gemm { const bf16_t* A; const bf16_t* Bt; int M, N, K; };

struct StaticOrder {
    int nM, nN, nwg, G, c;
    __host__ __device__ void init(int M, int N, int G_, int c_) { nM = M / BM; nN = N / BM; nwg = nM * nN; G = G_; c = c_; }
    __host__ __device__ bool next(int i, Unit& u) const {
        const long L = (long)i * G + c; if (L >= nwg) return false;
        int wgid = (int)L; { const int q = nwg / NXCD, r = nwg % NXCD, xcd = wgid % NXCD, off = wgid / NXCD; wgid = (xcd < r ? xcd * (q + 1) : r * (q + 1) + (xcd - r) * q) + off; }
        const int nig = WGM * nN, gid = wgid / nig, fm = gid * WGM, gsz = (nM - fm) < WGM ? (nM - fm) : WGM;
        u.pm = fm + ((wgid % nig) % gsz); u.pn = (wgid % nig) / gsz; return true;
    }
    __device__ __forceinline__ void a_ready(const Unit&) const {}
    __device__ __forceinline__ void done(const Unit&) const {}
};

__device__ __forceinline__ unsigned cvt_pk_bf16(float lo, float hi) { unsigned r; asm volatile("v_cvt_pk_bf16_f32 %0, %1, %2" : "=v"(r) : "v"(lo), "v"(hi)); return r; }
typedef float f32x2 __attribute__((ext_vector_type(2)));
__device__ __forceinline__ f32x2 gelu_pk(f32x2 v) {
    const f32x2 av = __builtin_elementwise_abs(v), d = av * 0.2316418882f + 1.0f;
    f32x2 t; t.x = __builtin_amdgcn_rcpf(d.x); t.y = __builtin_amdgcn_rcpf(d.y);
    f32x2 q = t * 0.5307027145f + (-0.7265760135f); q = q * t + 0.7107068705f; q = q * t + (-0.142248368f); q = q * t + 0.127414796f; q = q * t;
    const f32x2 s = (v * v) * (-0.72134752044f);
    f32x2 e; e.x = __builtin_amdgcn_exp2f(s.x); e.y = __builtin_amdgcn_exp2f(s.y);
    const f32x2 m = v * (q * e), r = v - m;
    f32x2 o; o.x = v.x < 0.f ? m.x : r.x; o.y = v.y < 0.f ? m.y : r.y; return o;
}

template <int ACT  > struct EpiBf16 {
    static constexpr bool PERM = true, AFTER_DRAIN = false; static_assert(ACT == 0 || ACT == 1, "EpiBf16: ACT is 0 (none) or 1 (gelu_pk)");
    bf16_t* O; int ldc; const float* bias; int split_cols; size_t split_stride; float scale0;
    __device__ __forceinline__ void operator()(const f32x4 (&acc)[2][2][4][2], const Unit& u, int wr, int wc, int fr, int fq) const {
        const int row0 = u.pm * BM + wr * 64 + fr; int colt = u.pn * BM; bf16_t* base = O;
        float sc = 1.f; if (split_cols) { const int t = colt / split_cols; base += (size_t)t * split_stride; colt -= t * split_cols; if (t == 0) sc = scale0; }
        const int col0 = colt + wc * 32 + 8 * fq, bcol0 = u.pn * BM + wc * 32 + 8 * fq;
        f32x4 bv[2][2];
#pragma unroll
        for (int bj = 0; bj < 2; ++bj)
#pragma unroll
            for (int n = 0; n < 2; ++n) bv[bj][n] = bias ? *(const f32x4*)(bias + bcol0 + bj * HALF + 4 * n) : (f32x4){0.f, 0.f, 0.f, 0.f};
#pragma unroll
        for (int ai = 0; ai < 2; ++ai)
#pragma unroll
            for (int m = 0; m < 4; ++m) { bf16_t* rowp = base + (size_t)(row0 + ai * HALF + m * 16) * ldc + col0;
#pragma unroll
                for (int bj = 0; bj < 2; ++bj) { f32x4 v0 = acc[ai][bj][m][0] + bv[bj][0], v1 = acc[ai][bj][m][1] + bv[bj][1];
                    if (ACT == 1) { f32x2 a = gelu_pk((f32x2){v0[0], v0[1]}), b = gelu_pk((f32x2){v0[2], v0[3]}), c = gelu_pk((f32x2){v1[0], v1[1]}), d = gelu_pk((f32x2){v1[2], v1[3]});
                        v0 = (f32x4){a.x, a.y, b.x, b.y}; v1 = (f32x4){c.x, c.y, d.x, d.y}; }
                    v0 = v0 * sc; v1 = v1 * sc; u32x4 w; w.x = cvt_pk_bf16(v0[0], v0[1]); w.y = cvt_pk_bf16(v0[2], v0[3]); w.z = cvt_pk_bf16(v1[0], v1[1]); w.w = cvt_pk_bf16(v1[2], v1[3]);
                    *(u32x4*)(rowp + bj * HALF) = w; } }
    }
};

__device__ __forceinline__ unsigned pkbf(float lo, float hi) {
    typedef __bf16 bf2_t __attribute__((ext_vector_type(2))); typedef float fl2_t __attribute__((ext_vector_type(2)));
    fl2_t v = {lo, hi}; bf2_t r = __builtin_convertvector(v, bf2_t); return __builtin_bit_cast(unsigned, r);
}
__device__ __forceinline__ float silu_f(float x) { return x * __builtin_amdgcn_rcpf(1.0f + __builtin_amdgcn_exp2f(-1.4426950408889634f * x)); }

struct EpiSwiGLU {
    static constexpr bool PERM = true, AFTER_DRAIN = false;
    bf16_t* O; int ldc;
    __device__ __forceinline__ void operator()(const f32x4 (&acc)[2][2][4][2], const Unit& u, int wr, int wc, int fr, int fq) const {
        const int row0 = u.pm * BM + wr * 64 + fr, col0 = u.pn * HALF + wc * 32 + 8 * fq;
#pragma unroll
        for (int ai = 0; ai < 2; ++ai)
#pragma unroll
            for (int m = 0; m < 4; ++m) { bf16_t* rowp = O + (size_t)(row0 + ai * HALF + m * 16) * ldc + col0;
                const f32x4 g0 = acc[ai][0][m][0], g1 = acc[ai][0][m][1], u0 = acc[ai][1][m][0], u1 = acc[ai][1][m][1];
                u32x4 w;
                w.x = pkbf(silu_f(g0[0]) * u0[0], silu_f(g0[1]) * u0[1]); w.y = pkbf(silu_f(g0[2]) * u0[2], silu_f(g0[3]) * u0[3]);
                w.z = pkbf(silu_f(g1[0]) * u1[0], silu_f(g1[1]) * u1[1]); w.w = pkbf(silu_f(g1[2]) * u1[2], silu_f(g1[3]) * u1[3]);
                *(u32x4*)rowp = w; }
    }
};
struct EpiResAdd {
    static constexpr bool PERM = false, AFTER_DRAIN = false;
    const float* base; float* out; int ldc; float scale;
    __device__ __forceinline__ void operator()(const f32x4 (&acc)[2][2][4][2], const Unit& u, int wr, int wc, int fr, int fq) const {
        const int row0 = u.pm * BM + wr * 64 + fr, col0 = u.pn * BM + wc * 32 + 4 * fq;
#pragma unroll
        for (int ai = 0; ai < 2; ++ai) {
            f32x4 b[4][2][2];
#pragma unroll
            for (int m = 0; m < 4; ++m) { const size_t off = (size_t)(row0 + ai * HALF + m * 16) * ldc + col0;
#pragma unroll
                for (int bj = 0; bj < 2; ++bj)
#pragma unroll
                    for (int n = 0; n < 2; ++n) b[m][bj][n] = *(const f32x4*)(base + off + bj * HALF + n * 16); }
#pragma unroll
            for (int m = 0; m < 4; ++m) { const size_t off = (size_t)(row0 + ai * HALF + m * 16) * ldc + col0;
#pragma unroll
                for (int bj = 0; bj < 2; ++bj)
#pragma unroll
                    for (int n = 0; n < 2; ++n) *(f32x4*)(out + off + bj * HALF + n * 16) = b[m][bj][n] + acc[ai][bj][m][n] * scale; }
            asm volatile("" ::: "memory"); }
    }
};
struct EpiF32 {
    static constexpr bool PERM = false, AFTER_DRAIN = false;
    float* C; int ldc;
    __device__ __forceinline__ void operator()(const f32x4 (&acc)[2][2][4][2], const Unit& u, int wr, int wc, int fr, int fq) const {
        const int row0 = u.pm * BM + wr * 64 + fr, col0 = u.pn * BM + wc * 32 + 4 * fq;
#pragma unroll
        for (int ai = 0; ai < 2; ++ai)
#pragma unroll
            for (int m = 0; m < 4; ++m) { float* rowp = C + (size_t)(row0 + ai * HALF + m * 16) * ldc + col0;
#pragma unroll
                for (int bj = 0; bj < 2; ++bj)
#pragma unroll
                    for (int n = 0; n < 2; ++n) *(f32x4*)(rowp + bj * HALF + n * 16) = acc[ai][bj][m][n]; }
    }
};
struct EpiB16 {
    static constexpr bool PERM = true, AFTER_DRAIN = false;
    bf16_t* O; int ldc;
    __device__ __forceinline__ void operator()(const f32x4 (&acc)[2][2][4][2], const Unit& u, int wr, int wc, int fr, int fq) const {
        const int row0 = u.pm * BM + wr * 64 + fr, col0 = u.pn * BM + wc * 32 + 8 * fq;
#pragma unroll
        for (int ai = 0; ai < 2; ++ai)
#pragma unroll
            for (int m = 0; m < 4; ++m) { bf16_t* rowp = O + (size_t)(row0 + ai * HALF + m * 16) * ldc + col0;
#pragma unroll
                for (int bj = 0; bj < 2; ++bj) { const f32x4 v0 = acc[ai][bj][m][0], v1 = acc[ai][bj][m][1];
                    u32x4 w; w.x = pkbf(v0[0], v0[1]); w.y = pkbf(v0[2], v0[3]); w.z = pkbf(v1[0], v1[1]); w.w = pkbf(v1[2], v1[3]);
                    *(u32x4*)(rowp + bj * HALF) = w; } }
    }
};
struct EpiKV {
    static constexpr bool PERM = true, AFTER_DRAIN = false;
    bf16_t* O; int ldc; float* F;
    __device__ __forceinline__ void operator()(const f32x4 (&acc)[2][2][4][2], const Unit& u, int wr, int wc, int fr, int fq) const {
        const int row0 = u.pm * BM + wr * 64 + fr;
        if (u.pn < 12) {
            const int col0 = u.pn * BM + wc * 32 + 8 * fq;
#pragma unroll
            for (int ai = 0; ai < 2; ++ai)
#pragma unroll
                for (int m = 0; m < 4; ++m) { bf16_t* rowp = O + (size_t)(row0 + ai * HALF + m * 16) * ldc + col0;
#pragma unroll
                    for (int bj = 0; bj < 2; ++bj) { const f32x4 v0 = acc[ai][bj][m][0], v1 = acc[ai][bj][m][1];
                        u32x4 w; w.x = pkbf(v0[0], v0[1]); w.y = pkbf(v0[2], v0[3]); w.z = pkbf(v1[0], v1[1]); w.w = pkbf(v1[2], v1[3]);
                        *(u32x4*)(rowp + bj * HALF) = w; } }
        } else if (wc == 0 && fq < 2) {
#pragma unroll
            for (int ai = 0; ai < 2; ++ai)
#pragma unroll
                for (int m = 0; m < 4; ++m) { float* rowp = F + (size_t)(row0 + ai * HALF + m * 16) * 16 + 8 * fq;
                    *(f32x4*)(rowp) = acc[ai][0][m][0]; *(f32x4*)(rowp + 4) = acc[ai][0][m][1]; }
        }
    }
};
template <class Epi, class Sched, bool ALIGN_EPI = false, bool SP2 = false>
__device__ __forceinline__ void gemm_phase(PG8_LAS unsigned char* lds, const Gemm g, const Sched& S, const Epi& E, const int wave_in) {
    const int tid_l = wave_in * 64 + lane_id_v();
    const int tid = tid_l, wid = wave_in, lane = tid & 63, wr = wid >> 2, wc = wid & 3, fr = lane & 15, fq = lane >> 4;
    const int K = g.K, nt = K / BK;
    unsigned voffA[2], voffB[2];
#pragma unroll
    for (int i = 0; i < 2; ++i) { int R, C; stage_rc(tid * 16 + i * 8192, R, C); const int Rb = Epi::PERM ? ((R & ~31) + perm32(R & 31)) : R;
        voffA[i] = (unsigned)(R * K + C) * 2u; voffB[i] = (unsigned)(Rb * K + C) * 2u; }
    const size_t kstep = (size_t)(BK * 2);
    const size_t hstep = (size_t)HALF * K * 2;
    const size_t tstep = 2 * hstep;
    const unsigned ldsw = (unsigned)wid * 1024u;
    const int aoff = lds_byte(wr * 64 + fr, fq * 8), boff = lds_byte(wc * 32 + fr, fq * 8);
#define PG8_SA(b, h) (((b) * 2 + (h)) * HTB)
#define PG8_SB(b, h) ((4 + (b) * 2 + (h)) * HTB)
#define PG8_STAGE(bufoff, gbase, voff) do { _Pragma("unroll") for (int _i = 0; _i < 2; ++_i) \
        __builtin_amdgcn_global_load_lds((const unsigned*)((const char*)(gbase) + (voff)[_i]), (PG8_LAS unsigned*)(lds + (bufoff) + ldsw + _i * 8192), 16, 0, 0); } while (0)
#define PG8_LDA(dst, b, h) do { _Pragma("unroll") for (int m = 0; m < 4; ++m) _Pragma("unroll") for (int k = 0; k < 2; ++k) dst[m][k] = *(const PG8_LAS bf16x8*)(lds + PG8_SA(b, h) + aoff + m * 2048 + k * 1024); } while (0)
#define PG8_LDB(dst, b, h) do { _Pragma("unroll") for (int n = 0; n < 2; ++n) _Pragma("unroll") for (int k = 0; k < 2; ++k) dst[n][k] = *(const PG8_LAS bf16x8*)(lds + PG8_SB(b, h) + boff + n * 2048 + k * 1024); } while (0)
#define PG8_MMA(ai, bj, At, Bt) do { __builtin_amdgcn_s_setprio(1); _Pragma("unroll") for (int m = 0; m < 4; ++m) _Pragma("unroll") for (int n = 0; n < 2; ++n) _Pragma("unroll") for (int k = 0; k < 2; ++k) \
        acc[ai][bj][m][n] = __builtin_amdgcn_mfma_f32_16x16x32_bf16(Bt[n][k], At[m][k], acc[ai][bj][m][n], 0, 0, 0); __builtin_amdgcn_s_setprio(0); } while (0)
#define PG8_WAIT_V(n) asm volatile("s_waitcnt vmcnt(" #n ")" ::: "memory")
#define PG8_WAIT_L(n) asm volatile("s_waitcnt lgkmcnt(" #n ")" ::: "memory")
#define PG8_BAR __builtin_amdgcn_s_barrier()
#define PG8_SCHED __builtin_amdgcn_sched_barrier(0)
    Unit cur, nxt; int ui = 0;
    if (!S.next(0, cur)) return;
    f32x4 acc[2][2][4][2];
#pragma unroll
    for (int a = 0; a < 2; ++a)
#pragma unroll
        for (int b = 0; b < 2; ++b)
#pragma unroll
            for (int m = 0; m < 4; ++m)
#pragma unroll
                for (int n = 0; n < 2; ++n) acc[a][b][m][n] = (f32x4){0.f, 0.f, 0.f, 0.f};
    bf16x8 At[4][2], B0[2][2], B1[2][2];
    const char* cA = (const char*)g.A + (size_t)cur.pm * tstep; const char* cB = (const char*)g.Bt + (size_t)cur.pn * tstep;
    S.a_ready(cur);
    if constexpr (SP2) {
        PG8_STAGE(PG8_SB(0, 0), cB, voffB); PG8_STAGE(PG8_SB(0, 1), cB + hstep, voffB); PG8_STAGE(PG8_SA(0, 0), cA, voffA); PG8_STAGE(PG8_SA(0, 1), cA + hstep, voffA);
        if (wr == 1) PG8_BAR;
        PG8_WAIT_V(2); PG8_BAR;
        PG8_STAGE(PG8_SB(1, 0), cB + kstep, voffB); PG8_STAGE(PG8_SA(1, 0), cA + kstep, voffA); PG8_STAGE(PG8_SB(1, 1), cB + hstep + kstep, voffB);
        PG8_WAIT_V(6); PG8_BAR;
    } else {
        PG8_STAGE(PG8_SB(0, 0), cB, voffB); PG8_STAGE(PG8_SA(0, 0), cA, voffA); PG8_STAGE(PG8_SB(0, 1), cB + hstep, voffB); PG8_STAGE(PG8_SA(0, 1), cA + hstep, voffA);
        if (wr == 1) PG8_BAR;
        PG8_WAIT_V(4); PG8_BAR;
        PG8_STAGE(PG8_SB(1, 0), cB + kstep, voffB); PG8_STAGE(PG8_SA(1, 0), cA + kstep, voffA); PG8_STAGE(PG8_SB(1, 1), cB + hstep + kstep, voffB);
        PG8_WAIT_V(6); PG8_BAR;
    }
    for (;;) {
        const bool has_next = S.next(ui + 1, nxt);
        const char* nA = has_next ? (const char*)g.A + (size_t)nxt.pm * tstep : cA; const char* nB = has_next ? (const char*)g.Bt + (size_t)nxt.pn * tstep : cB;
        for (int t = 0; t < nt; t += 2) {
            const bool last = (t == nt - 2);
            const char* a1 = cA + (size_t)(t + 1) * kstep;
            const char* a2 = last ? nA : cA + (size_t)(t + 2) * kstep; const char* b2 = last ? nB : cB + (size_t)(t + 2) * kstep;
            const char* a3 = a2 + kstep; const char* b3 = b2 + kstep;
            if (last && has_next) S.a_ready(nxt);
            if constexpr (SP2) {
            PG8_LDB(B0, 0, 0); PG8_LDB(B1, 0, 1); PG8_SCHED; PG8_LDA(At, 0, 0); PG8_STAGE(PG8_SA(1, 1), a1 + hstep, voffA);
            PG8_WAIT_V(8); PG8_WAIT_L(0); PG8_BAR; PG8_MMA(0, 0, At, B0); PG8_MMA(0, 1, At, B1); PG8_BAR; PG8_SCHED;
            PG8_LDA(At, 0, 1); PG8_STAGE(PG8_SB(0, 0), b2, voffB); PG8_STAGE(PG8_SB(0, 1), b2 + hstep, voffB); PG8_STAGE(PG8_SA(0, 0), a2, voffA);
            PG8_WAIT_V(8); PG8_WAIT_L(0); PG8_BAR; PG8_MMA(1, 0, At, B0); PG8_MMA(1, 1, At, B1); PG8_BAR; PG8_SCHED;
            PG8_LDB(B0, 1, 0); PG8_LDB(B1, 1, 1); PG8_SCHED; PG8_LDA(At, 1, 0); PG8_STAGE(PG8_SA(0, 1), a2 + hstep, voffA);
            PG8_WAIT_V(8); PG8_WAIT_L(0); PG8_BAR; PG8_MMA(0, 0, At, B0); PG8_MMA(0, 1, At, B1); PG8_BAR; PG8_SCHED;
            PG8_LDA(At, 1, 1); PG8_STAGE(PG8_SB(1, 0), b3, voffB); PG8_STAGE(PG8_SB(1, 1), b3 + hstep, voffB); PG8_STAGE(PG8_SA(1, 0), a3, voffA);
            PG8_WAIT_V(8); PG8_WAIT_L(0); PG8_BAR; PG8_MMA(1, 0, At, B0); PG8_MMA(1, 1, At, B1); PG8_BAR; PG8_SCHED;
            } else {
            PG8_LDB(B0, 0, 0); PG8_SCHED; PG8_LDA(At, 0, 0); PG8_STAGE(PG8_SA(1, 1), a1 + hstep, voffA);
            PG8_WAIT_L(8); PG8_BAR; PG8_WAIT_L(0); PG8_MMA(0, 0, At, B0); PG8_BAR; PG8_SCHED;
            PG8_LDB(B1, 0, 1); PG8_STAGE(PG8_SB(0, 0), b2, voffB);
            PG8_BAR; PG8_WAIT_L(0); PG8_MMA(0, 1, At, B1); PG8_BAR;
            PG8_LDA(At, 0, 1); PG8_STAGE(PG8_SA(0, 0), a2, voffA);
            PG8_BAR; PG8_WAIT_L(0); PG8_MMA(1, 0, At, B0); PG8_BAR; PG8_SCHED;
            PG8_STAGE(PG8_SB(0, 1), b2 + hstep, voffB);
            PG8_WAIT_V(6); PG8_BAR; PG8_MMA(1, 1, At, B1); PG8_BAR;
            PG8_LDB(B0, 1, 0); PG8_SCHED; PG8_LDA(At, 1, 0); PG8_STAGE(PG8_SA(0, 1), a2 + hstep, voffA);
            PG8_WAIT_L(8); PG8_BAR; PG8_WAIT_L(0); PG8_MMA(0, 0, At, B0); PG8_BAR; PG8_SCHED;
            PG8_LDB(B1, 1, 1); PG8_STAGE(PG8_SB(1, 0), b3, voffB);
            PG8_BAR; PG8_WAIT_L(0); PG8_MMA(0, 1, At, B1); PG8_BAR;
            PG8_LDA(At, 1, 1); PG8_STAGE(PG8_SA(1, 0), a3, voffA);
            PG8_BAR; PG8_WAIT_L(0); PG8_MMA(1, 0, At, B0); PG8_BAR; PG8_SCHED;
            PG8_STAGE(PG8_SB(1, 1), b3 + hstep, voffB);
            PG8_WAIT_V(6); PG8_BAR; PG8_MMA(1, 1, At, B1); PG8_BAR;
            }
        }
        if constexpr (ALIGN_EPI) { if (wr == 0) PG8_BAR; }
        if constexpr (!Epi::AFTER_DRAIN) { E(acc, cur, wr, wc, fr, fq); S.done(cur); }
        if (!has_next) break;
#pragma unroll
        for (int a = 0; a < 2; ++a)
#pragma unroll
            for (int b = 0; b < 2; ++b)
#pragma unroll
                for (int m = 0; m < 4; ++m)
#pragma unroll
                    for (int n = 0; n < 2; ++n) acc[a][b][m][n] = (f32x4){0.f, 0.f, 0.f, 0.f};
        cur = nxt; cA = nA; cB = nB; ++ui;
        if constexpr (ALIGN_EPI) { if (wr == 1) PG8_BAR; }
    }
    PG8_WAIT_V(0);
    if constexpr (!ALIGN_EPI) { if (wr == 0) PG8_BAR; }
    PG8_BAR;
    if constexpr (Epi::AFTER_DRAIN) { E.fused(acc, cur, wr, wc, fr, fq, lds, wid, lane); S.done(cur); }
#undef PG8_SA
#undef PG8_SB
#undef PG8_STAGE
#undef PG8_LDA
#undef PG8_LDB
#undef PG8_MMA
#undef PG8_WAIT_V
#undef PG8_WAIT_L
#undef PG8_BAR
#undef PG8_SCHED
}
}

namespace fa {
constexpr float SCALE = 0.08838834764831845f;
constexpr int D = 128, NW = 8, QBLK = 32, KVBLK = 64, QB = NW * QBLK;
constexpr int SHM_V = KVBLK * D * 2, SHM_K = KVBLK * D * 2;
constexpr int LDS_BYTES = 2 * SHM_V + 2 * SHM_K + NW * 64 * 4;
constexpr float THR = 8.f;
constexpr int OP = 2048;
typedef unsigned short bf16;
typedef short bf16x8 __attribute__((ext_vector_type(8)));
typedef short s16x4 __attribute__((ext_vector_type(4)));
typedef float f32x16 __attribute__((ext_vector_type(16)));
typedef float f32x4 __attribute__((ext_vector_type(4)));
typedef unsigned u32x4 __attribute__((ext_vector_type(4)));

#define KSWZ(row, colB) ((row) * 256 + ((colB) ^ (((row) & 7) << 4)))
#define SBAR() __builtin_amdgcn_sched_barrier(0)
__device__ __forceinline__ int v_st(int k, int c) { const int kk = (k & ~0xC) | ((k & 4) << 1) | ((k & 8) >> 1); return ((kk >> 3) * 4 + (c >> 5)) * 512 + ((kk & 7) * 32 + (c & 31)) * 2; }
__device__ __forceinline__ int v_rd_base(int lane) { return ((lane & 3) << 3) | (((lane >> 2) & 3) << 6) | (((lane >> 4) & 1) << 5) | (((lane >> 5) & 1) << 8); }
constexpr int v_rd_off(int d0, int ks, int half) { return d0 * 512 + ks * 4096 + half * 2048; }
__device__ __forceinline__ int crow(int r, int hi) { return (r & 3) + 8 * (r >> 2) + 4 * hi; }
__device__ __forceinline__ unsigned cvtpk(float lo, float hi) {
    unsigned r; asm volatile("v_cvt_pk_bf16_f32 %0, %1, %2" : "=v"(r) : "v"(lo), "v"(hi)); return r;
}
__device__ __forceinline__ bf16x8 load8(const bf16* p) { return *reinterpret_cast<const bf16x8*>(p); }
__device__ __forceinline__ bf16x8 cb_frag(float c, int hi) {
    const unsigned u1 = __float_as_uint(c) & 0xffff0000u; const float r1 = c - __uint_as_float(u1);
    const unsigned v1 = __float_as_uint(r1) & 0xffff0000u; const float r2 = r1 - __uint_as_float(v1);
    const unsigned w1 = __float_as_uint(r2) & 0xffff0000u;
    u32x4 w = {hi ? 0u : ((u1 >> 16) | v1), hi ? 0u : (w1 >> 16), 0u, 0u};
    return *reinterpret_cast<bf16x8*>(&w);
}
__device__ __forceinline__ int hi_opaque() { return lane_id_v() >> 5; }
__device__ __forceinline__ bf16x8 ones_frag(int hi) { u32x4 w = {hi ? 0u : 0x3F803F80u, hi ? 0u : 0x00003F80u, 0u, 0u}; return *reinterpret_cast<bf16x8*>(&w); }
__device__ __forceinline__ void mask_tile(f32x16& p0, f32x16& p1, int dq, unsigned W) {
    const float NEG = -__builtin_inff();
#pragma unroll
    for (int r = 0; r < 16; ++r) {
        const int c = (r & 3) + 8 * (r >> 2);
        if ((unsigned)(dq - c) >= W) p0[r] = NEG;
        if ((unsigned)(dq - c - 32) >= W) p1[r] = NEG;
    }
}
__device__ __forceinline__ void partialSM(f32x16& p0, f32x16& p1, float& m_reg, float& mn, float& alpha) {
    float pmax = p0[0]; for (int r = 1; r < 16; ++r) pmax = fmaxf(pmax, p0[r]); for (int r = 0; r < 16; ++r) pmax = fmaxf(pmax, p1[r]);
    { auto rr = __builtin_amdgcn_permlane32_swap(__float_as_uint(pmax), __float_as_uint(pmax), false, false);
      pmax = fmaxf(__uint_as_float(rr[0]), __uint_as_float(rr[1])); }
    constexpr float C2 = 1.4426950408889634f * SCALE;
    if (__builtin_expect(__all((pmax - m_reg) * SCALE <= THR), 1)) { mn = m_reg; alpha = 1.f; }
    else { mn = fmaxf(m_reg, pmax); alpha = __builtin_amdgcn_exp2f((m_reg - mn) * C2); m_reg = mn; }
    const float mnL = -mn * C2;
    for (int r = 0; r < 16; ++r) p0[r] = fmaf(p0[r], C2, mnL); for (int r = 0; r < 16; ++r) p1[r] = fmaf(p1[r], C2, mnL);
    for (int r = 0; r < 16; ++r) p0[r] = __builtin_amdgcn_exp2f(p0[r]);
}
__device__ __forceinline__ void finishSM(f32x16& p0, f32x16& p1, float alpha, float& l_reg, bf16x8& pa0, bf16x8& pa1, bf16x8& pa2, bf16x8& pa3) {
    for (int r = 0; r < 16; ++r) p1[r] = __builtin_amdgcn_exp2f(p1[r]);
    float ps = 0; for (int r = 0; r < 16; ++r) ps += p0[r]; for (int r = 0; r < 16; ++r) ps += p1[r];
    { auto rr = __builtin_amdgcn_permlane32_swap(__float_as_uint(ps), __float_as_uint(ps), false, false);
      ps = __uint_as_float(rr[0]) + __uint_as_float(rr[1]); }
    l_reg = l_reg * alpha + ps;
#define PK4(P, B_, OUT) do { unsigned a0 = cvtpk(P[B_+0], P[B_+1]), a1 = cvtpk(P[B_+2], P[B_+3]);                          \
        unsigned b0 = cvtpk(P[B_+4], P[B_+5]), b1 = cvtpk(P[B_+6], P[B_+7]);                                             \
        auto r0 = __builtin_amdgcn_permlane32_swap(a0, b0, false, false); auto r1 = __builtin_amdgcn_permlane32_swap(a1, b1, false, false); \
        u32x4 w = {r0[0], r1[0], r0[1], r1[1]}; OUT = *reinterpret_cast<bf16x8*>(&w); } while (0)
    PK4(p0, 0, pa0); PK4(p0, 8, pa1); PK4(p1, 0, pa2); PK4(p1, 8, pa3);
#undef PK4
}
template <int KB>
__device__ __forceinline__ void qkt(f32x16& p0, f32x16& p1, const char* K_lds, int r32, int hi, const bf16x8* qr, bf16x8 kx0, bf16x8 kx1, bf16x8 qx) {
    p0 = __builtin_amdgcn_mfma_f32_32x32x16_bf16(kx0, qx, f32x16{}, 0, 0, 0);
    p1 = __builtin_amdgcn_mfma_f32_32x32x16_bf16(kx1, qx, f32x16{}, 0, 0, 0);
    const char* kb[4];
#pragma unroll
    for (int dd = 0; dd < 4; ++dd) kb[dd] = K_lds + KB * SHM_K + KSWZ(r32, (dd * 16 + hi * 8) * 2);
#pragma unroll
    for (int d0 = 0; d0 < 8; ++d0) { const char* a = kb[d0 & 3] + (d0 >> 2) * 128;
        bf16x8 b0 = *reinterpret_cast<const bf16x8*>(a);
        bf16x8 b1 = *reinterpret_cast<const bf16x8*>(a + 32 * 256);
        p0 = __builtin_amdgcn_mfma_f32_32x32x16_bf16(b0, qr[d0], p0, 0, 0, 0);
        p1 = __builtin_amdgcn_mfma_f32_32x32x16_bf16(b1, qr[d0], p1, 0, 0, 0); }
}
template <int VB>
__device__ __forceinline__ void pv_tile(f32x16* o, int vb0, bf16x8 pa0, bf16x8 pa1, bf16x8 pa2, bf16x8 pa3) {
#define TRRD(dst, off) asm volatile("ds_read_b64_tr_b16 %0, %1 offset:%2" : "=&v"(dst) : "v"(vb0), "i"(off) : "memory")
#define PV_D0(d0) do { s16x4 l0, l1, l2, l3, h0, h1, h2, h3; constexpr int b_ = VB * SHM_V + v_rd_off(d0, 0, 0);     \
        TRRD(l0, b_); TRRD(h0, b_ + 2048); TRRD(l1, b_ + 4096); TRRD(h1, b_ + 6144); TRRD(l2, b_ + 8192); TRRD(h2, b_ + 10240); TRRD(l3, b_ + 12288); TRRD(h3, b_ + 14336); \
        asm volatile("s_waitcnt lgkmcnt(0)" ::: "memory"); SBAR();                 \
        o[d0] = __builtin_amdgcn_mfma_f32_32x32x16_bf16(pa0, (bf16x8){l0[0], l0[1], l0[2], l0[3], h0[0], h0[1], h0[2], h0[3]}, o[d0], 0, 0, 0);   \
        o[d0] = __builtin_amdgcn_mfma_f32_32x32x16_bf16(pa1, (bf16x8){l1[0], l1[1], l1[2], l1[3], h1[0], h1[1], h1[2], h1[3]}, o[d0], 0, 0, 0);   \
        o[d0] = __builtin_amdgcn_mfma_f32_32x32x16_bf16(pa2, (bf16x8){l2[0], l2[1], l2[2], l2[3], h2[0], h2[1], h2[2], h2[3]}, o[d0], 0, 0, 0);   \
        o[d0] = __builtin_amdgcn_mfma_f32_32x32x16_bf16(pa3, (bf16x8){l3[0], l3[1], l3[2], l3[3], h3[0], h3[1], h3[2], h3[3]}, o[d0], 0, 0, 0); } while (0)
    PV_D0(0); PV_D0(1); PV_D0(2); PV_D0(3);
#undef PV_D0
#undef TRRD
}

struct BlockRef { const bf16* Q; const bf16* K; const bf16* V; bf16* O; const bf16* G; const float* CB; int P0, skv, qp, kp; };
struct Seam { bf16x8 qr[8]; bf16x8 st_v0, st_v1, st_k0, st_k1; float cb0, cb1; };
#define ROWP(p, k0, rr, pitch) ((p) + (size_t)(k0) * (pitch) + (unsigned)((rr) * (pitch) + sc))
#define VMW() asm volatile("s_waitcnt vmcnt(0)" ::: "memory")
#define VMWN(n) asm volatile("s_waitcnt vmcnt(%0)" :: "i"(n) : "memory")
#define SLOAD_H(Kp, Vp, Cp, k0, pitch) do { S.st_v0 = load8(ROWP(Vp, k0, sr, pitch)); S.st_v1 = load8(ROWP(Vp, k0, 32 + sr, pitch));              \
                         S.st_k0 = load8(ROWP(Kp, k0, sr, pitch)); S.st_k1 = load8(ROWP(Kp, k0, 32 + sr, pitch));                                    \
                         S.cb0 = (Cp) ? (Cp)[(k0) + r32] : 0.f; S.cb1 = (Cp) ? (Cp)[(k0) + 32 + r32] : 0.f; } while (0)
#define SWRITE_HK(bf) do { *(bf16x8*)(K_lds + (bf) * SHM_K + kws) = S.st_k0; *(bf16x8*)(K_lds + (bf) * SHM_K + kws + 32 * 256) = S.st_k1; } while (0)
#define SWRITE_HV(bf) do { *(bf16x8*)(V_lds + (bf) * SHM_V + vst0) = S.st_v0; *(bf16x8*)(V_lds + (bf) * SHM_V + vst1) = S.st_v1; } while (0)
#define SWRITE_H(bf) do { SWRITE_HV(bf); SWRITE_HK(bf); } while (0)
__device__ __forceinline__ void attn_prime(const BlockRef& cur, char* lds, Seam& S, const int wave_in) {
    const int tid = wave_in * 64 + lane_id_v(), wid = wave_in, lane = tid & 63, r32 = lane & 31, hi = lane >> 5;
    const int sr = tid >> 4, sc = (tid & 15) * 8, kws = KSWZ(sr, sc * 2); char* K_lds = lds + 2 * SHM_V;
#pragma unroll
    for (int d0 = 0; d0 < 8; ++d0) S.qr[d0] = load8(cur.Q + (size_t)(wid * QBLK + r32) * cur.qp + d0 * 16 + hi * 8);
    SLOAD_H(cur.K, cur.V, cur.CB, 0, cur.kp); VMW(); SWRITE_HK(0);
    __syncthreads();
}
__device__ __forceinline__ void attn_block(const BlockRef& cur, const BlockRef& nxt, char* lds, Seam& S, const int wave_in) {
    const int tid = wave_in * 64 + lane_id_v(), wid = wave_in, lane = tid & 63, r32 = lane & 31, hi = lane >> 5;
    constexpr int W = 1 << 30;
    int j_hi = (cur.P0 + QB - 1) / KVBLK + 1; if (j_hi > cur.skv / KVBLK) j_hi = cur.skv / KVBLK;
    const int NT = j_hi;
    const int qlo = cur.P0 + wid * QBLK, qm = qlo + r32 - 4 * hi;
    char* V_lds = lds; char* K_lds = lds + 2 * SHM_V;
    float* ws = (float*)(lds + 2 * SHM_V + 2 * SHM_K) + wid * 64; float* li_l = ws, * al_l = ws + 32;
    float m_reg = -1e30f, l_reg = 0; f32x16 o[4] = {};
    const int sr = tid >> 4, sc = (tid & 15) * 8, vst0 = v_st(sr, sc), vst1 = v_st(32 + sr, sc), kws = KSWZ(sr, sc * 2);
    const int vb0 = (int)(uintptr_t)V_lds + v_rd_base(lane);
    const bf16* Kh = cur.K; const bf16* Vh = cur.V; const float* Ch = cur.CB; const int KP = cur.kp;
#define QX() ones_frag(hi_opaque())
#define RESC(a) do { if (__any((a) < 1.f)) { if (hi == 0) al_l[r32] = (a); asm volatile("s_waitcnt lgkmcnt(0)" ::: "memory");              \
                     for (int d_ = 0; d_ < 4; ++d_) for (int r = 0; r < 16; ++r) o[d_][r] *= al_l[crow(r, hi)]; } } while (0)
#define KBASE(t) ((t) * KVBLK)
#define MASKT(P0_, P1_, t) do { const int kb_ = KBASE(t); if (kb_ + KVBLK - 1 > qlo) mask_tile(P0_, P1_, qm - kb_, (unsigned)W); } while (0)
#define SEAM_K0() do { VMWN(8); SWRITE_HK(0); SBAR(); } while (0)
    f32x16 pA0, pA1, pB0, pB1; float mnA, mnB, alA, alB; bf16x8 pa0, pa1, pa2, pa3; bf16x8 kx0, kx1;
    SWRITE_HV(0); SBAR();
    kx0 = cb_frag(S.cb0, hi); kx1 = cb_frag(S.cb1, hi);
    if (NT > 1) SLOAD_H(Kh, Vh, Ch, KBASE(1), KP);
    SBAR(); qkt<0>(pA0, pA1, K_lds, r32, hi, S.qr, kx0, kx1, QX());
    MASKT(pA0, pA1, 0); partialSM(pA0, pA1, m_reg, mnA, alA);
    if (NT > 1) { VMW(); SWRITE_H(1); }
    __syncthreads();
#define HALF_STEP(PX0, PX1, mnX, alX, PY0, PY1, alY, t, KB, VB, SB) do {                                                      \
        SBAR(); kx0 = cb_frag(S.cb0, hi); kx1 = cb_frag(S.cb1, hi);                                                           \
        qkt<KB>(PX0, PX1, K_lds, r32, hi, S.qr, kx0, kx1, QX());                                                                \
        finishSM(PY0, PY1, alY, l_reg, pa0, pa1, pa2, pa3); SBAR();                                                           \
        if ((t) + 1 < NT) { SLOAD_H(Kh, Vh, Ch, KBASE((t) + 1), KP); SBAR(); }                                                \
        pv_tile<VB>(o, vb0, pa0, pa1, pa2, pa3); MASKT(PX0, PX1, (t)); partialSM(PX0, PX1, m_reg, mnX, alX);                  \
        __syncthreads();                                                                                                      \
        if ((t) + 1 < NT) { VMW(); SWRITE_H(SB); }                                                                            \
        RESC(alX); __syncthreads(); } while (0)
    for (int t = 1; t + 1 < NT; t += 2) {
        HALF_STEP(pB0, pB1, mnB, alB, pA0, pA1, alA, t, 1, 0, 0);
        HALF_STEP(pA0, pA1, mnA, alA, pB0, pB1, alB, t + 1, 0, 1, 1);
    }
    const bool even = (NT & 1) == 0;
    if (even) { SBAR(); kx0 = cb_frag(S.cb0, hi); kx1 = cb_frag(S.cb1, hi); qkt<1>(pB0, pB1, K_lds, r32, hi, S.qr, kx0, kx1, QX()); SBAR(); }
    SLOAD_H(nxt.K, nxt.V, nxt.CB, 0, nxt.kp); SBAR();
#pragma unroll
    for (int d0 = 0; d0 < 8; ++d0) S.qr[d0] = load8(nxt.Q + (size_t)(wid * QBLK + r32) * nxt.qp + d0 * 16 + hi * 8);
    SBAR();
    finishSM(pA0, pA1, alA, l_reg, pa0, pa1, pa2, pa3); SBAR();
    pv_tile<0>(o, vb0, pa0, pa1, pa2, pa3);
    if (even) { MASKT(pB0, pB1, NT - 1); partialSM(pB0, pB1, m_reg, mnB, alB); __syncthreads(); RESC(alB);
        finishSM(pB0, pB1, alB, l_reg, pa0, pa1, pa2, pa3); SBAR(); pv_tile<1>(o, vb0, pa0, pa1, pa2, pa3); }
    SBAR(); SEAM_K0();
    if (hi == 0) li_l[r32] = l_reg; asm volatile("s_waitcnt lgkmcnt(0)" ::: "memory");
    float rli[16];
#pragma unroll
    for (int r = 0; r < 16; ++r) rli[r] = __builtin_amdgcn_rcpf(li_l[crow(r, hi)]);
    bf16* Ow = cur.O + (size_t)(wid * QBLK) * OP;
    const bf16* Gw = cur.G ? cur.G + (size_t)(wid * QBLK) * cur.qp : nullptr; const int GP = cur.qp;
#pragma unroll
    for (int r = 0; r < 16; ++r) { const int orow = crow(r, hi);
#pragma unroll
        for (int d0 = 0; d0 < 4; ++d0) { float v = o[d0][r] * rli[r];
            if (Gw) { const float g = __uint_as_float(((unsigned)Gw[(size_t)orow * GP + d0 * 32 + r32]) << 16);
                      v *= __builtin_amdgcn_rcpf(1.0f + __builtin_amdgcn_exp2f(-1.4426950408889634f * g)); }
            const float vn = __uint_as_float((unsigned)__builtin_amdgcn_update_dpp(0, (int)__float_as_uint(v), 0xB1, 0xF, 0xF, true));
            if ((r32 & 1) == 0) *(unsigned*)(Ow + (size_t)orow * OP + d0 * 32 + r32) = cvtpk(v, vn); } }
    __syncthreads();
#undef QX
#undef RESC
#undef KBASE
#undef MASKT
#undef SEAM_K0
#undef HALF_STEP
}
#undef ROWP
#undef VMW
#undef VMWN
#undef SLOAD_H
#undef SWRITE_HK
#undef SWRITE_HV
#undef SWRITE_H
#undef KSWZ
#undef SBAR
}

constexpr int NWAVES = 8;
#ifndef MK_PER_PHASE
#define MK_PER_PHASE 1
#endif
#ifndef MK_STOP_PC
#define MK_STOP_PC 1000
#endif
constexpr int NPH = 50;

constexpr int BATCH = 8, SEQ = 4096, DM = 2048, M = BATCH * SEQ, FF = 5632, NUP = 2 * FF, DEPTH = 4;
constexpr int NA = 5888, NB = 3584, NKV = 3328, NMEMW = 4096;
constexpr int A_Q = 0, A_K = 768, A_V = 1536, A_G = 3072, A_QM = 4608, A_GATE = 5120;
constexpr int B_Q = 0, B_G = 1536, B_QM = 3072;
constexpr int MEMT = 256, MROWS = BATCH * MEMT;
constexpr float EPS = 1e-6f;

constexpr size_t MiB = 1u << 20;
constexpr size_t WS_CTL = 0, CTL_ZERO_BYTES = 1 * MiB;
constexpr size_t WS_CB = 1 * MiB, WS_F = 3 * MiB, WS_ACH = 5 * MiB, WS_MEMB = 8 * MiB, WS_MKVF = 16 * MiB, WS_MK = 48 * MiB, WS_MV = 56 * MiB;
constexpr size_t WS_WUP = 64 * MiB, WS_WDN = 416 * MiB, WS_WAIN = 592 * MiB, WS_WBIN = 638 * MiB, WS_WOUT = 666 * MiB, WS_WKV = 698 * MiB, WS_WMEM = 711 * MiB;
constexpr size_t WS_HMIX = 728 * MiB, WS_ACT = 856 * MiB, WS_KDT = 1224 * MiB, WS_VT = 1272 * MiB, WS_OG = 1368 * MiB, WS_KSVS = 1224 * MiB, WS_END = 1464 * MiB;
static_assert(WS_WUP + 8 * (size_t)NUP * DM * 2 <= WS_WDN && WS_WDN + 8 * (size_t)DM * FF * 2 <= WS_WAIN && WS_WAIN + 2 * (size_t)NA * DM * 2 <= WS_WBIN && WS_WBIN + 2 * (size_t)NB * DM * 2 <= WS_WOUT &&
              WS_WOUT + 4 * (size_t)DM * DM * 2 <= WS_WKV && WS_WKV + (size_t)NKV * DM * 2 <= WS_WMEM && WS_WMEM + (size_t)NMEMW * DM * 2 <= WS_HMIX && WS_HMIX + (size_t)M * DM * 2 <= WS_ACT &&
              WS_ACT + (size_t)M * NA * 2 <= WS_KDT && WS_KDT + (size_t)2048 * 192 * 64 * 2 <= WS_VT && WS_VT + (size_t)2048 * 384 * 64 * 2 <= WS_OG && WS_OG + (size_t)M * 1536 * 2 <= WS_END &&
              WS_KSVS + (size_t)M * 3072 * 2 <= WS_END && WS_MKVF + (size_t)MROWS * NMEMW * 4 <= WS_MK && WS_MEMB + (size_t)MROWS * DM * 2 <= WS_MKVF, "d_ws map");
constexpr int CW_TMO = 0, CW_BAR = 4096;
constexpr int RING_BYTES = 131072, LDSCTL_OFF = RING_BYTES, MISC_OFF = LDSCTL_OFF + 320, LDS_BYTES = 147456;

#define GAS __attribute__((address_space(1)))
#define LAS __attribute__((address_space(3)))
typedef unsigned short bf16;
typedef unsigned v4u __attribute__((ext_vector_type(4)));
typedef float f32x4 __attribute__((ext_vector_type(4)));
typedef float f32x16 __attribute__((ext_vector_type(16)));
typedef short bf16x8 __attribute__((ext_vector_type(8)));
typedef GAS unsigned gu32;
#define RLX_AGENT __ATOMIC_RELAXED, __HIP_MEMORY_SCOPE_AGENT
#define LDS_WAIT() asm volatile("s_waitcnt lgkmcnt(0)" ::: "memory")
using pg8::pkbf;
__device__ __forceinline__ float bf_lo(unsigned w) { return __uint_as_float(w << 16); }
__device__ __forceinline__ float bf_hi(unsigned w) { return __uint_as_float(w & 0xffff0000u); }
__device__ __forceinline__ float bf2f(bf16 b) { return __uint_as_float(((unsigned)b) << 16); }
__device__ __forceinline__ float logsig(float x) { return fminf(x, 0.f) - __logf(1.0f + __expf(-fabsf(x))); }
#define XCH1(v)  __uint_as_float((unsigned)__builtin_amdgcn_update_dpp(0, (int)__float_as_uint(v), 0xB1, 0xF, 0xF, true))
#define XCH2(v)  __uint_as_float((unsigned)__builtin_amdgcn_update_dpp(0, (int)__float_as_uint(v), 0x4E, 0xF, 0xF, true))
#define XCH4(v)  __uint_as_float((unsigned)__builtin_amdgcn_ds_swizzle((int)__float_as_uint(v), (4 << 10) | 0x1f))
#define XCH8(v)  __uint_as_float((unsigned)__builtin_amdgcn_ds_swizzle((int)__float_as_uint(v), (8 << 10) | 0x1f))
#define XCH16(v) __uint_as_float((unsigned)__builtin_amdgcn_ds_swizzle((int)__float_as_uint(v), (16 << 10) | 0x1f))
__device__ __forceinline__ float wave_sum(float v) {
    v += XCH1(v); v += XCH2(v); v += XCH4(v); v += XCH8(v); v += XCH16(v);
    const auto rr = __builtin_amdgcn_permlane32_swap(__float_as_uint(v), __float_as_uint(v), false, false);
    return __uint_as_float(rr[0]) + __uint_as_float(rr[1]);
}
__device__ __forceinline__ int launder_s(int v) { asm volatile("" : "+s"(v)); return v; }

#define XB_TMO      128
#define XB_XCNT(j)  (256  + 64 * (j))
#define XB_XSUB(j)  (1280 + 64 * (j))
#define XB_XGEN(j)  (2304 + 64 * (j))
#define XB_TOP      3328
#define XB_TOPGEN   3392
#define XCD_BAR_WORDS 3456
#define XB_SPIN_CAP (1u << 18)
__device__ __forceinline__ unsigned xb_ld(unsigned* p)              { return __hip_atomic_load(p, __ATOMIC_RELAXED, __HIP_MEMORY_SCOPE_AGENT); }
__device__ __forceinline__ unsigned xb_add(unsigned* p, unsigned v) { return __hip_atomic_fetch_add(p, v, __ATOMIC_RELAXED, __HIP_MEMORY_SCOPE_AGENT); }
__device__ __forceinline__ unsigned xb_xcc_id() { return (unsigned)__builtin_amdgcn_s_getreg((3 << 11) | 20) & 0xFu; }
#define XB_SPIN(cond, bar) do { unsigned _sp = 0; while (cond) { __builtin_amdgcn_s_sleep(1); \
    if ((++_sp & 255u) == 0u) { if (xb_ld(&(bar)[XB_TMO])) break; if (_sp > XB_SPIN_CAP) { atomicAdd(&(bar)[XB_TMO], 1u); break; } } } } while (0)
struct XcdBarrier { unsigned* bar; unsigned x; volatile LAS unsigned* st; int wave; };
__device__ __forceinline__ XcdBarrier xcd_barrier_post(unsigned* bar, volatile LAS unsigned* st, int wave) {
    XcdBarrier b; b.bar = bar; b.x = xb_xcc_id(); b.st = st; b.wave = wave;
    if (threadIdx.x == 0) (void)xb_add(&bar[XB_XCNT(b.x)], 1u);
    return b;
}
__device__ __forceinline__ void xcd_barrier_complete(unsigned* bar, unsigned x, unsigned& nloc, unsigned& nx) {
    const unsigned G = gridDim.x * gridDim.y * gridDim.z;
    unsigned sum, cnt, mine, sp = 0u;
    for (;;) {
        sum = 0u; cnt = 0u; mine = 0u;
#pragma unroll
        for (unsigned j = 0; j < 16; ++j) { const unsigned c = xb_ld(&bar[XB_XCNT(j)]); sum += c; cnt += (c > 0u) ? 1u : 0u; mine = (j == x) ? c : mine; }
        if (sum == G) break;
        __builtin_amdgcn_s_sleep(1);
        if ((++sp & 255u) == 0u) { if (xb_ld(&bar[XB_TMO])) break; if (sp > XB_SPIN_CAP) { atomicAdd(&bar[XB_TMO], 1u); break; } }
    }
    nloc = mine > 0u ? mine : 1u; nx = cnt > 0u ? cnt : 1u;
}
__device__ __forceinline__ void xcd_barrier(const XcdBarrier& b) {
    asm volatile("s_waitcnt vmcnt(0)" ::: "memory");
    __syncthreads();
    if (b.wave == 0 && lane_id_v() == 0) {
        unsigned* bar = b.bar;
        __builtin_amdgcn_s_waitcnt(0);
        unsigned nloc = b.st[0], nx = b.st[1];
        if (nloc == 0u) { xcd_barrier_complete(bar, b.x, nloc, nx); b.st[0] = nloc; b.st[1] = nx; }
        const unsigned old = xb_add(&bar[XB_XSUB(b.x)], 1u);
        const unsigned gen = old / nloc;
        if (old + 1u == (gen + 1u) * nloc) {
            __builtin_amdgcn_fence(__ATOMIC_RELEASE, "agent");
            asm volatile("s_waitcnt vmcnt(0)" ::: "memory");
            const unsigned og = xb_add(&bar[XB_TOP], 1u);
            const unsigned tg = og / nx;
            if (og + 1u == (tg + 1u) * nx) xb_add(&bar[XB_TOPGEN], 1u);
            else XB_SPIN(xb_ld(&bar[XB_TOPGEN]) == tg, bar);
            __builtin_amdgcn_fence(__ATOMIC_ACQUIRE, "agent");
            xb_add(&bar[XB_XGEN(b.x)], 1u);
            asm volatile("s_waitcnt vmcnt(0)" ::: "memory");
        } else {
            XB_SPIN(xb_ld(&bar[XB_XGEN(b.x)]) == gen, bar);
            __builtin_amdgcn_fence(__ATOMIC_ACQUIRE, "agent");
            asm volatile("s_waitcnt vmcnt(0)" ::: "memory");
        }
    }
    __syncthreads();
}

__device__ __forceinline__ const float* ldp(volatile LAS unsigned* T, int k) { const unsigned lo = __builtin_amdgcn_readfirstlane(T[2 * k]), hi = __builtin_amdgcn_readfirstlane(T[2 * k + 1]); return (const float*)(const GAS float*)(((unsigned long long)hi << 32) | lo); }
__device__ __forceinline__ int launder(int v) { asm volatile("" : "+v"(v)); return v; }
__device__ __forceinline__ int lane_id() { return lane_id_v(); }
__device__ __forceinline__ void cvt_item(const float* W, int ldw, int srccol, const float* gain, float scale, bf16* Bt, int K, int dstrow, int k0, LAS float* scr, int lane) {
#pragma unroll 8
    for (int i = 0; i < 32; ++i) { const int kk = 2 * i + (lane >> 5); const float g = gain ? gain[k0 + kk] * scale : scale;
        scr[kk * 33 + (lane & 31)] = W[(size_t)(k0 + kk) * ldw + srccol + (lane & 31)] * g; }
    LDS_WAIT();
    const int c = lane & 7;
#pragma unroll
    for (int j = 0; j < 4; ++j) { const int n = (lane >> 3) + 8 * j; const LAS float* s = scr + (8 * c) * 33 + n;
        v4u o; o.x = pkbf(s[0 * 33], s[1 * 33]); o.y = pkbf(s[2 * 33], s[3 * 33]); o.z = pkbf(s[4 * 33], s[5 * 33]); o.w = pkbf(s[6 * 33], s[7 * 33]);
        *(v4u*)(Bt + (size_t)(dstrow + n) * K + k0 + 8 * c) = o; }
    LDS_WAIT();
}
__device__ __forceinline__ void rms_row_to_bf16(const float* xrow, bf16* orow, int lane) {
    const f32x4* xr = (const f32x4*)xrow + lane;
    f32x4 v[8]; float s = 0.f;
#pragma unroll
    for (int j = 0; j < 8; ++j) { v[j] = xr[64 * j]; s += (v[j].x * v[j].x + v[j].y * v[j].y) + (v[j].z * v[j].z + v[j].w * v[j].w); }
    const float rinv = 1.0f / sqrtf(wave_sum(s) * (1.0f / DM) + EPS);
    unsigned long long* o8 = (unsigned long long*)orow + lane;
#pragma unroll
    for (int j = 0; j < 8; ++j) o8[64 * j] = (unsigned long long)pkbf(v[j].x * rinv, v[j].y * rinv) | ((unsigned long long)pkbf(v[j].z * rinv, v[j].w * rinv) << 32);
}
struct InPtrs { const float *x, *mem, *ffn_norm, *w1, *w3, *w2, *mix_norm, *mem_norm, *w_mem_kv, *mem_q_norm, *mem_k_norm, *w_out, *a_w_in, *a_w_gate_up, *a_b_gate, *a_out_norm, *b_w_in, *b_q_norm, *kv_norm, *w_kv, *b_f, *k_norm; };

__device__ __forceinline__ void convert_phase(volatile LAS unsigned* PT, unsigned char* ws, LAS unsigned char* lds, int gw, int NGW, int lane, int wave) {
    InPtrs I;
    I.x = ldp(PT, 0); I.mem = ldp(PT, 1); I.ffn_norm = ldp(PT, 2); I.w1 = ldp(PT, 3); I.w3 = ldp(PT, 4); I.w2 = ldp(PT, 5); I.mix_norm = ldp(PT, 6); I.mem_norm = ldp(PT, 7);
    I.w_mem_kv = ldp(PT, 8); I.mem_q_norm = ldp(PT, 9); I.mem_k_norm = ldp(PT, 10); I.w_out = ldp(PT, 11); I.a_w_in = ldp(PT, 12); I.a_w_gate_up = ldp(PT, 13); I.a_b_gate = ldp(PT, 14);
    I.a_out_norm = ldp(PT, 15); I.b_w_in = ldp(PT, 16); I.b_q_norm = ldp(PT, 17); I.kv_norm = ldp(PT, 18); I.w_kv = ldp(PT, 19); I.b_f = ldp(PT, 20); I.k_norm = ldp(PT, 21);
    LAS float* scr = (LAS float*)(lds + wave * 16384);
    bf16* WUP = (bf16*)(ws + WS_WUP); bf16* WDN = (bf16*)(ws + WS_WDN); bf16* WAIN = (bf16*)(ws + WS_WAIN); bf16* WBIN = (bf16*)(ws + WS_WBIN);
    bf16* WOUT = (bf16*)(ws + WS_WOUT); bf16* WKV = (bf16*)(ws + WS_WKV); bf16* WMEM = (bf16*)(ws + WS_WMEM);
    constexpr int IT_W1 = 8 * 32 * 176, IT_W2 = 8 * 88 * 64, IT_A = 2 * 32 * 160, IT_B = 2 * 32 * 112, IT_O = 4 * 32 * 64, IT_KV = 32 * 96, IT_MEM = 4 * 32 * 32;
    constexpr int IT_TOTAL = 2 * IT_W1 + IT_W2 + IT_A + IT_B + IT_O + IT_KV + IT_MEM;
    for (int it = gw; it < IT_TOTAL; it += NGW) {
        int r = it;
        if (r < 2 * IT_W1) { const int which = r / IT_W1; r -= which * IT_W1; const int mat = r / (32 * 176); r -= mat * (32 * 176); const int kb = r / 176, nb = r % 176; const int j0 = 32 * nb;
            cvt_item((which ? I.w3 : I.w1) + (size_t)mat * DM * FF, FF, j0, I.ffn_norm + mat * DM, 1.f, WUP + (size_t)mat * NUP * DM, DM, 256 * (j0 / 128) + which * 128 + (j0 % 128), 64 * kb, scr, lane); continue; }
        r -= 2 * IT_W1;
        if (r < IT_W2) { const int mat = r / (88 * 64); r -= mat * (88 * 64); const int kb = r / 64, nb = r % 64;
            cvt_item(I.w2 + (size_t)mat * FF * DM, DM, 32 * nb, nullptr, 1.f, WDN + (size_t)mat * DM * FF, FF, 32 * nb, 64 * kb, scr, lane); continue; }
        r -= IT_W2;
        if (r < IT_A) { const int l = r / (32 * 160); r -= l * (32 * 160); const int kb = r / 160, nb = r % 160; const int n0 = 32 * nb;
            cvt_item(I.a_w_in + (size_t)l * DM * 5136, 5136, n0 < 3072 ? n0 : n0 + 16, I.mix_norm + l * DM, n0 < 768 ? 0.07216878364870322f : 1.f, WAIN + (size_t)l * NA * DM, DM, n0, 64 * kb, scr, lane); continue; }
        r -= IT_A;
        if (r < IT_B) { const int j = r / (32 * 112); r -= j * (32 * 112); const int kb = r / 112, nb = r % 112;
            cvt_item(I.b_w_in + (size_t)j * DM * NB, NB, 32 * nb, I.mix_norm + (2 + j) * DM, 1.f, WBIN + (size_t)j * NB * DM, DM, 32 * nb, 64 * kb, scr, lane); continue; }
        r -= IT_B;
        if (r < IT_O) { const int l = r / (32 * 64); r -= l * (32 * 64); const int kb = r / 64, nb = r % 64;
            cvt_item(I.w_out + (size_t)l * DM * DM, DM, 32 * nb, nullptr, 1.f, WOUT + (size_t)l * DM * DM, DM, 32 * nb, 64 * kb, scr, lane); continue; }
        r -= IT_O;
        if (r < IT_KV) { const int kb = r / 96, nb = r % 96;
            cvt_item(I.w_kv, 3084, 32 * nb, I.kv_norm, 1.f, WKV, DM, 32 * nb, 64 * kb, scr, lane); continue; }
        r -= IT_KV;
        { const int l = r / (32 * 32); r -= l * (32 * 32); const int kb = r / 32, nb = r % 32;
            cvt_item(I.w_mem_kv + (size_t)l * DM * 1024, 1024, 32 * nb, I.mem_norm + l * DM, 1.f, WMEM, DM, l * 1024 + 32 * nb, 64 * kb, scr, lane); }
    }
    const int gtid = gw * 64 + lane, NT = NGW * 64;
    for (int idx = gtid; idx < 2 * 768 * 256; idx += NT) { const int l = idx / (768 * 256); const int rem = idx - l * (768 * 256); const int n = rem >> 8, k0 = (rem & 255) * 8;
        float a[8];
#pragma unroll
        for (int j = 0; j < 8; ++j) a[j] = 0.f;
        const float* win = I.a_w_in + (size_t)l * DM * 5136 + (size_t)k0 * 5136 + 3072; const float* wg = I.a_w_gate_up + (size_t)l * 16 * 768 + n;
#pragma unroll
        for (int rr = 0; rr < 16; ++rr) { const float g = wg[rr * 768];
#pragma unroll
            for (int j = 0; j < 8; ++j) a[j] += win[(size_t)j * 5136 + rr] * g; }
        const float* gn = I.mix_norm + l * DM + k0;
        v4u o; o.x = pkbf(a[0] * gn[0], a[1] * gn[1]); o.y = pkbf(a[2] * gn[2], a[3] * gn[3]); o.z = pkbf(a[4] * gn[4], a[5] * gn[5]); o.w = pkbf(a[6] * gn[6], a[7] * gn[7]);
        *(v4u*)(WAIN + (size_t)l * NA * DM + (size_t)(A_GATE + n) * DM + k0) = o; }
    for (int idx = gtid; idx < 256 * 256; idx += NT) { const int n = idx >> 8, k0 = (idx & 255) * 8;
        float a[8];
#pragma unroll
        for (int j = 0; j < 8; ++j) a[j] = (n < 12) ? I.w_kv[(size_t)(k0 + j) * 3084 + 3072 + n] * I.kv_norm[k0 + j] : 0.f;
        v4u o; o.x = pkbf(a[0], a[1]); o.y = pkbf(a[2], a[3]); o.z = pkbf(a[4], a[5]); o.w = pkbf(a[6], a[7]);
        *(v4u*)(WKV + (size_t)(3072 + n) * DM + k0) = o; }
    for (int m = gw; m < MROWS; m += NGW) rms_row_to_bf16(I.mem + (size_t)m * DM, (bf16*)(ws + WS_MEMB) + (size_t)m * DM, lane);
}
__device__ __forceinline__ void hn_pass(bf16* buf, int pitch, int col0, int nheads, const float* gain, int gw, int NGW, int lane) {
    const int l16 = lane & 15; const int ntask4 = M * nheads / 4;
    f32x4 g0 = *(const f32x4*)(gain + 8 * l16), g1 = *(const f32x4*)(gain + 8 * l16 + 4);
    for (int t4 = gw; t4 < ntask4; t4 += NGW) { const int t = t4 * 4 + (lane >> 4); const int row = t / nheads, hh = t - row * nheads;
        bf16* p = buf + (size_t)row * pitch + col0 + hh * 128 + 8 * l16;
        const v4u w = *(const v4u*)p;
        float x[8] = {bf_lo(w.x), bf_hi(w.x), bf_lo(w.y), bf_hi(w.y), bf_lo(w.z), bf_hi(w.z), bf_lo(w.w), bf_hi(w.w)};
        float ss = 0.f;
#pragma unroll
        for (int e = 0; e < 8; ++e) ss += x[e] * x[e];
        ss += XCH1(ss); ss += XCH2(ss); ss += XCH4(ss); ss += XCH8(ss);
        const float rinv = 1.0f / sqrtf(ss * (1.0f / 128.f) + EPS);
        v4u o; o.x = pkbf(x[0] * rinv * g0[0], x[1] * rinv * g0[1]); o.y = pkbf(x[2] * rinv * g0[2], x[3] * rinv * g0[3]);
        o.z = pkbf(x[4] * rinv * g1[0], x[5] * rinv * g1[1]); o.w = pkbf(x[6] * rinv * g1[2], x[7] * rinv * g1[3]);
        *(v4u*)p = o; }
}
__device__ __forceinline__ void mkmv_pass(const float* MKVF, bf16* MK, bf16* MV, const float* mem_k_norm, int gw, int NGW, int lane) {
    const int l16 = lane & 15;
    for (int t4 = gw; t4 < MROWS * 32 / 4; t4 += NGW) { const int t = t4 * 4 + (lane >> 4); const int row = t >> 5, rem = t & 31; const int l = rem >> 3, kv = (rem >> 2) & 1, hh = rem & 3;
        const float* src = MKVF + (size_t)row * NMEMW + l * 1024 + kv * 512 + hh * 128 + 8 * l16;
        const f32x4 a = *(const f32x4*)src, b = *(const f32x4*)(src + 4);
        float ss = (a.x * a.x + a.y * a.y) + (a.z * a.z + a.w * a.w) + (b.x * b.x + b.y * b.y) + (b.z * b.z + b.w * b.w);
        ss += XCH1(ss); ss += XCH2(ss); ss += XCH4(ss); ss += XCH8(ss);
        const float rinv = kv ? 1.0f : 1.0f / sqrtf(ss * (1.0f / 128.f) + EPS);
        f32x4 g0 = {1.f, 1.f, 1.f, 1.f}, g1 = {1.f, 1.f, 1.f, 1.f};
        if (!kv) { g0 = *(const f32x4*)(mem_k_norm + l * 128 + 8 * l16); g1 = *(const f32x4*)(mem_k_norm + l * 128 + 8 * l16 + 4); }
        v4u o; o.x = pkbf(a.x * rinv * g0[0], a.y * rinv * g0[1]); o.y = pkbf(a.z * rinv * g0[2], a.w * rinv * g0[3]);
        o.z = pkbf(b.x * rinv * g1[0], b.y * rinv * g1[1]); o.w = pkbf(b.z * rinv * g1[2], b.w * rinv * g1[3]);
        *(v4u*)((kv ? MV : MK) + ((size_t)l * MROWS + row) * 512 + hh * 128 + 8 * l16) = o; }
}
__device__ __forceinline__ void gla_prep(const bf16* PROJ, const float* b_gate  , bf16* KDT, bf16* VT, float* ACH, int gw, int NGW, int lane) {
    for (int t = gw; t < 2048; t += NGW) {
        const int b = t >> 8, c = (t >> 2) & 63, h = t & 3; const int ci = (b * 4 + h) * 64 + c;
        const bf16* P = PROJ + ((size_t)b * SEQ + c * 64) * NA;
        for (int cg = 0; cg < 3; ++cg) { const int d = cg * 64 + lane;
            const float bias = b_gate[h * 192 + d];
            const bf16* pg = P + A_GATE + h * 192 + d; const bf16* pk = P + A_K + h * 192 + d;
            float cum[64]; float run = 0.f;
#pragma unroll
            for (int j = 0; j < 64; ++j) { const float gp = bf2f(pg[(size_t)j * NA]) + bias; run += logsig(gp) * (1.0f / 16.0f); cum[j] = run; }
            ACH[ci * 192 + d] = __expf(run);
            bf16* dst = KDT + ((size_t)ci * 192 + d) * 64;
#pragma unroll
            for (int j8 = 0; j8 < 8; ++j8) { float kd[8];
#pragma unroll
                for (int e = 0; e < 8; ++e) { const int j = 8 * j8 + e; kd[e] = bf2f(pk[(size_t)j * NA]) * __expf(run - cum[j]); }
                v4u o; o.x = pkbf(kd[0], kd[1]); o.y = pkbf(kd[2], kd[3]); o.z = pkbf(kd[4], kd[5]); o.w = pkbf(kd[6], kd[7]);
                *(v4u*)(dst + 8 * j8) = o; } }
        for (int cg = 0; cg < 6; ++cg) { const int dv = cg * 64 + lane; const bf16* pv = P + A_V + h * 384 + dv; bf16* dst = VT + ((size_t)ci * 384 + dv) * 64;
#pragma unroll
            for (int j8 = 0; j8 < 8; ++j8) { unsigned r[8];
#pragma unroll
                for (int e = 0; e < 8; ++e) r[e] = pv[(size_t)(8 * j8 + e) * NA];
                v4u o; o.x = r[0] | (r[1] << 16); o.y = r[2] | (r[3] << 16); o.z = r[4] | (r[5] << 16); o.w = r[6] | (r[7] << 16);
                *(v4u*)(dst + 8 * j8) = o; } }
    }
}
__device__ __forceinline__ void gla_scan(const bf16* PROJ, const bf16* KDT, const bf16* VT, const float* ACH, bf16* OG, int vcu, int G, int wave, int lane) {
    const int r = lane & 31, hi = lane >> 5;
    for (int u = wave * G + vcu; u < 384; u += NWAVES * G) {
        const int bh = u / 12, n32 = u - bh * 12, b = bh >> 2, h = bh & 3;
        f32x16 S[6];
#pragma unroll
        for (int mt = 0; mt < 6; ++mt)
#pragma unroll
            for (int i = 0; i < 16; ++i) S[mt][i] = 0.f;
        for (int c = 0; c < 64; ++c) { const int ci = bh * 64 + c; const size_t t0 = (size_t)b * SEQ + c * 64;
            const bf16* kd = KDT + (size_t)ci * 192 * 64; const bf16* vt = VT + ((size_t)ci * 384 + n32 * 32) * 64; const float* ac = ACH + ci * 192;
            bf16x8 vb[4];
#pragma unroll
            for (int s = 0; s < 4; ++s) vb[s] = *(const bf16x8*)(vt + (size_t)r * 64 + 16 * s + 8 * hi);
#pragma unroll
            for (int mt = 0; mt < 6; ++mt) {
#pragma unroll
                for (int i4 = 0; i4 < 4; ++i4) { const f32x4 a4 = *(const f32x4*)(ac + 32 * mt + 8 * i4 + 4 * hi);
#pragma unroll
                    for (int e = 0; e < 4; ++e) S[mt][4 * i4 + e] *= a4[e]; }
#pragma unroll
                for (int s = 0; s < 4; ++s) { const bf16x8 ka = *(const bf16x8*)(kd + (size_t)(32 * mt + r) * 64 + 16 * s + 8 * hi);
                    S[mt] = __builtin_amdgcn_mfma_f32_32x32x16_bf16(ka, vb[s], S[mt], 0, 0, 0); } }
            f32x16 o0, o1;
#pragma unroll
            for (int i = 0; i < 16; ++i) { o0[i] = 0.f; o1[i] = 0.f; }
            const bf16* q0 = PROJ + (t0 + r) * NA + A_Q + h * 192; const bf16* q1 = q0 + (size_t)32 * NA;
#pragma unroll
            for (int mt = 0; mt < 6; ++mt)
#pragma unroll
                for (int s = 0; s < 2; ++s) {
                    v4u xw; xw.x = pkbf(S[mt][8 * s + 0], S[mt][8 * s + 1]); xw.y = pkbf(S[mt][8 * s + 2], S[mt][8 * s + 3]); xw.z = pkbf(S[mt][8 * s + 4], S[mt][8 * s + 5]); xw.w = pkbf(S[mt][8 * s + 6], S[mt][8 * s + 7]);
                    const bf16x8 xs = __builtin_bit_cast(bf16x8, xw);
                    const int dk0 = 32 * mt + 16 * s + 4 * hi;
                    const uint2 a0 = *(const uint2*)(q0 + dk0), a1 = *(const uint2*)(q0 + dk0 + 8), c0 = *(const uint2*)(q1 + dk0), c1 = *(const uint2*)(q1 + dk0 + 8);
                    v4u qa = {a0.x, a0.y, a1.x, a1.y}, qc = {c0.x, c0.y, c1.x, c1.y};
                    o0 = __builtin_amdgcn_mfma_f32_32x32x16_bf16(__builtin_bit_cast(bf16x8, qa), xs, o0, 0, 0, 0);
                    o1 = __builtin_amdgcn_mfma_f32_32x32x16_bf16(__builtin_bit_cast(bf16x8, qc), xs, o1, 0, 0, 0); }
            bf16* og = OG + t0 * 1536 + h * 384 + n32 * 32 + r;
#pragma unroll
            for (int i = 0; i < 16; ++i) { const int row = (i & 3) + 8 * (i >> 2) + 4 * hi;
                const float v0 = o0[i], v1 = o1[i]; const float n0 = XCH1(v0), n1 = XCH1(v1);
                if ((r & 1) == 0) { *(unsigned*)(og + (size_t)row * 1536) = pkbf(v0, n0); *(unsigned*)(og + (size_t)(32 + row) * 1536) = pkbf(v1, n1); } }
        }
    }
}
__device__ __forceinline__ void gla_post(const bf16* OG, const bf16* PROJ, const float* onorm  , bf16* MIX, int gw, int NGW, int lane) {
    const int la = lane < 48 ? lane : 0;
    const f32x4 g0 = *(const f32x4*)(onorm + 8 * la), g1 = *(const f32x4*)(onorm + 8 * la + 4);
    for (int t = gw; t < M * 4; t += NGW) { const int row = t >> 2, h = t & 3;
        v4u w = {0u, 0u, 0u, 0u}, gw4 = {0u, 0u, 0u, 0u};
        if (lane < 48) { w = *(const v4u*)(OG + (size_t)row * 1536 + h * 384 + 8 * lane); gw4 = *(const v4u*)(PROJ + (size_t)row * NA + A_G + h * 384 + 8 * lane); }
        float x[8] = {bf_lo(w.x), bf_hi(w.x), bf_lo(w.y), bf_hi(w.y), bf_lo(w.z), bf_hi(w.z), bf_lo(w.w), bf_hi(w.w)};
        float g[8] = {bf_lo(gw4.x), bf_hi(gw4.x), bf_lo(gw4.y), bf_hi(gw4.y), bf_lo(gw4.z), bf_hi(gw4.z), bf_lo(gw4.w), bf_hi(gw4.w)};
        float ss = 0.f;
#pragma unroll
        for (int e = 0; e < 8; ++e) ss += x[e] * x[e];
        const float rinv = 1.0f / sqrtf(wave_sum(ss) * (1.0f / 384.f) + EPS);
        float y[8];
#pragma unroll
        for (int e = 0; e < 8; ++e) y[e] = x[e] * rinv * (e < 4 ? g0[e] : g1[e - 4]) * pg8::silu_f(g[e]);
        if (lane < 48) { v4u o; o.x = pkbf(y[0], y[1]); o.y = pkbf(y[2], y[3]); o.z = pkbf(y[4], y[5]); o.w = pkbf(y[6], y[7]);
            *(v4u*)(MIX + (size_t)row * DM + h * 384 + 8 * lane) = o; } }
}
__device__ __forceinline__ void fox_cumsum(const float* F, const float* b_f, float* CB, int gw, int NGW, int lane) {
    for (int t = gw; t < BATCH * 12; t += NGW) { const int b = t / 12, h = t - b * 12; const float bf = b_f[h];
        const float* src = F + ((size_t)b * SEQ + lane * 64) * 16 + h;
        float v[64]; float run = 0.f;
#pragma unroll
        for (int j = 0; j < 64; ++j) { run += logsig(src[(size_t)j * 16] + bf); v[j] = run; }
        float incl = run;
#pragma unroll
        for (int o = 1; o < 64; o <<= 1) { const float y = __uint_as_float((unsigned)__builtin_amdgcn_ds_bpermute((lane - o) << 2, (int)__float_as_uint(incl))); if (lane >= o) incl += y; }
        const float excl = incl - run;
        float* dst = CB + (size_t)t * SEQ + lane * 64;
#pragma unroll
        for (int j = 0; j < 64; ++j) dst[j] = -(excl + v[j]) * 11.313708498984761f; }
}
struct AttCfg { const bf16* PROJ; const bf16* KSVS; const float* CB; const bf16* MK; const bf16* MV; bf16* MIX; int np, qmcol, fox, vcu, G; };
__device__ __forceinline__ fa::BlockRef att_ref(const AttCfg& c, int idx, int nf) {
    fa::BlockRef r;
    if (idx < nf) { const int L = c.vcu + c.G * (idx >> 1); const int bh = L >> 3, x = L & 7; const int qb = (idx & 1) ? 15 - x : x; const int b = bh / 12, h = bh - b * 12;
        const size_t row0 = (size_t)b * SEQ + qb * 256;
        r.Q = c.PROJ + row0 * c.np + B_Q + h * 128; r.G = c.PROJ + row0 * c.np + B_G + h * 128; r.K = c.KSVS + (size_t)b * SEQ * 3072 + h * 128; r.V = r.K + 1536; r.O = c.MIX + row0 * DM + h * 128;
        r.CB = c.CB + (size_t)bh * SEQ; r.P0 = qb * 256; r.skv = SEQ; r.qp = c.np; r.kp = 3072; }
    else { const int mb = c.vcu + c.G * (idx - nf); const int rb = mb >> 2, mh = mb & 3; const int b = rb >> 4; const size_t row0 = (size_t)rb * 256;
        r.Q = c.PROJ + row0 * c.np + c.qmcol + mh * 128; r.G = nullptr; r.K = c.MK + (size_t)b * MEMT * 512 + mh * 128; r.V = c.MV + (size_t)b * MEMT * 512 + mh * 128; r.O = c.MIX + row0 * DM + 1536 + mh * 128;
        r.CB = nullptr; r.P0 = 256; r.skv = MEMT; r.qp = c.np; r.kp = 512; }
    return r;
}
__device__ __forceinline__ void att_phase(const AttCfg& c, char* lds, int wave) {
    const int nfi = (c.fox && c.vcu < 768) ? (768 - c.vcu + c.G - 1) / c.G : 0, nf = 2 * nfi;
    const int nm = c.vcu < 512 ? (512 - c.vcu + c.G - 1) / c.G : 0;
    const int nblk = nf + nm;
    if (nblk == 0) return;
    fa::BlockRef cur = att_ref(c, 0, nf); fa::Seam S;
    fa::attn_prime(cur, lds, S, wave);
    for (int i = 0; i < nblk; ++i) {
        const fa::BlockRef nxt = (i + 1 < nblk) ? att_ref(c, i + 1, nf) : cur;
        fa::attn_block(cur, nxt, lds, S, wave);
        cur = nxt;
    }
}

struct Args { const float* in[22]; float* out; unsigned char* ws; int lo, hi; };
constexpr int PT_OUT = 22, PT_WS = 23;
#define PTR(k) ldp(PT, (k))
__global__ void __launch_bounds__(NWAVES * 64, 2) mega_fwd(Args args) {
    extern __shared__ __attribute__((aligned(16))) unsigned char lds_raw[];
    LAS unsigned char* lds = (LAS unsigned char*)lds_raw;
    volatile LAS unsigned* MISC = (volatile LAS unsigned*)(lds + MISC_OFF);
    volatile LAS unsigned* PT = (volatile LAS unsigned*)(lds + MISC_OFF + 128);
    const int wave = __builtin_amdgcn_readfirstlane((int)threadIdx.x >> 6);
    const int G = gridDim.x; const int bx = blockIdx.x; const int vcu = (G % 8 == 0) ? (bx % 8) * (G / 8) + bx / 8 : bx;
    const int gw = vcu * NWAVES + wave, NGW = G * NWAVES;
    for (int u = threadIdx.x; u < (LDS_BYTES - LDSCTL_OFF) / 4; u += NWAVES * 64) ((LAS unsigned*)(lds + LDSCTL_OFF))[u] = 0u;
    __syncthreads();
    if (threadIdx.x == 0) {
#pragma unroll
        for (int k = 0; k < 22; ++k) { const unsigned long long p = (unsigned long long)args.in[k]; PT[2 * k] = (unsigned)p; PT[2 * k + 1] = (unsigned)(p >> 32); }
        { const unsigned long long p = (unsigned long long)args.out; PT[2 * PT_OUT] = (unsigned)p; PT[2 * PT_OUT + 1] = (unsigned)(p >> 32); }
        { const unsigned long long p = (unsigned long long)args.ws; PT[2 * PT_WS] = (unsigned)p; PT[2 * PT_WS + 1] = (unsigned)(p >> 32); }
    }
    __syncthreads();
    const int lo = args.lo, hi = args.hi < MK_STOP_PC ? args.hi : MK_STOP_PC;
    const bool use_bar = (args.hi - args.lo) > 1;
    XcdBarrier bar; bar.bar = (unsigned*)((unsigned char*)PTR(PT_WS) + WS_CTL) + CW_BAR; bar.x = 0; bar.st = MISC + 8; bar.wave = wave;
    if (use_bar) bar = xcd_barrier_post(bar.bar, MISC + 8, wave);

    int pc = 0;
#define PH_ON (pc >= lo && pc < hi)
#define PH_END do { if (use_bar && pc >= lo && pc + 1 < hi) { XcdBarrier bb; bb.bar = (unsigned*)((unsigned char*)PTR(PT_WS) + WS_CTL) + CW_BAR; bb.x = bar.x; bb.st = MISC + 8; bb.wave = wave; xcd_barrier(bb); } ++pc; } while (0)
#define WSP ((unsigned char*)PTR(PT_WS))
#define PH_BEGIN if (PH_ON) { const int lane = lane_id(); const int gwp = launder_s(gw), vcup = launder_s(vcu), bxp = launder_s(bx), wavep = launder_s(wave); unsigned char* ws = WSP; (void)lane; (void)gwp; (void)vcup; (void)bxp; (void)wavep;
#define XOUT ((float*)PTR(PT_OUT))

    PH_BEGIN
#ifndef DBG_NO_CVT
        convert_phase(PT, ws, lds, gwp, NGW, lane, wavep);
#endif
    }
    PH_END;
    PH_BEGIN pg8::Gemm g{(const bf16*)(ws + WS_MEMB), (const bf16*)(ws + WS_WMEM), MROWS, NMEMW, DM}; pg8::StaticOrder S; S.init(MROWS, NMEMW, G, bxp);
        pg8::EpiF32 E{(float*)(ws + WS_MKVF), NMEMW};
        pg8::gemm_phase<pg8::EpiF32, pg8::StaticOrder, true, true>(lds, g, S, E, wavep); }
    PH_END;

    for (int l = 0; l < DEPTH; ++l) {
        for (int sub = 0; sub < 2; ++sub) {
            const int mat = l * 2 + sub;
            PH_BEGIN const float* xin = (l == 0 && sub == 0) ? PTR(0) : (const float*)XOUT; bf16* HMIX = (bf16*)(ws + WS_HMIX);
                for (int m = gwp; m < M; m += NGW) rms_row_to_bf16(xin + (size_t)m * DM, HMIX + (size_t)m * DM, lane);
                if (l == 0 && sub == 0) mkmv_pass((const float*)(ws + WS_MKVF), (bf16*)(ws + WS_MK), (bf16*)(ws + WS_MV), PTR(10), gwp, NGW, lane); }
            PH_END;
            if (l == 2 && sub == 0) {
                PH_BEGIN pg8::Gemm g{(const bf16*)(ws + WS_HMIX), (const bf16*)(ws + WS_WKV), M, NKV, DM}; pg8::StaticOrder S; S.init(M, NKV, G, bxp);
                    pg8::EpiKV E{(bf16*)(ws + WS_KSVS), 3072, (float*)(ws + WS_F)};
                    pg8::gemm_phase<pg8::EpiKV, pg8::StaticOrder, true, true>(lds, g, S, E, wavep); }
                PH_END;
                PH_BEGIN hn_pass((bf16*)(ws + WS_KSVS), 3072, 0, 12, PTR(21), gwp, NGW, lane);
#ifndef DBG_NO_CUM
                    fox_cumsum((const float*)(ws + WS_F), PTR(20), (float*)(ws + WS_CB), gwp, NGW, lane);
#endif
                    }
                PH_END;
            }
            PH_BEGIN pg8::Gemm g{(const bf16*)(ws + WS_HMIX), (const bf16*)(ws + WS_WUP) + (size_t)mat * NUP * DM, M, NUP, DM}; pg8::StaticOrder S; S.init(M, NUP, G, bxp);
                pg8::EpiSwiGLU E{(bf16*)(ws + WS_ACT), FF};
                pg8::gemm_phase<pg8::EpiSwiGLU, pg8::StaticOrder, true, true>(lds, g, S, E, wavep); }
            PH_END;
            PH_BEGIN pg8::Gemm g{(const bf16*)(ws + WS_ACT), (const bf16*)(ws + WS_WDN) + (size_t)mat * DM * FF, M, DM, FF}; pg8::StaticOrder S; S.init(M, DM, G, bxp);
                float* X = XOUT; const float* xin = (l == 0 && sub == 0) ? PTR(0) : (const float*)X;
                pg8::EpiResAdd E{xin, X, DM, 0.5f};
                pg8::gemm_phase<pg8::EpiResAdd, pg8::StaticOrder, true, true>(lds, g, S, E, wavep); }
            PH_END;
            if (sub == 0) {
                const int np = l < 2 ? NA : NB;
                PH_BEGIN const float* X = XOUT; bf16* HMIX = (bf16*)(ws + WS_HMIX);
                    for (int m = gwp; m < M; m += NGW) rms_row_to_bf16(X + (size_t)m * DM, HMIX + (size_t)m * DM, lane); }
                PH_END;
                PH_BEGIN const bf16* wt = l < 2 ? (const bf16*)(ws + WS_WAIN) + (size_t)l * NA * DM : (const bf16*)(ws + WS_WBIN) + (size_t)(l - 2) * NB * DM;
                    pg8::Gemm g{(const bf16*)(ws + WS_HMIX), wt, M, np, DM}; pg8::StaticOrder S; S.init(M, np, G, bxp);
                    pg8::EpiB16 E{(bf16*)(ws + WS_ACT), np};
                    pg8::gemm_phase<pg8::EpiB16, pg8::StaticOrder, true, true>(lds, g, S, E, wavep); }
                PH_END;
                if (l < 2) {
                    PH_BEGIN
#ifndef DBG_NO_PREP
                        gla_prep((const bf16*)(ws + WS_ACT), PTR(14) + l * 768, (bf16*)(ws + WS_KDT), (bf16*)(ws + WS_VT), (float*)(ws + WS_ACH), gwp, NGW, lane);
#endif
                        hn_pass((bf16*)(ws + WS_ACT), NA, A_QM, 4, PTR(9) + l * 128, gwp, NGW, lane); }
                    PH_END;
                    PH_BEGIN
#ifndef DBG_NO_SCAN
                        gla_scan((const bf16*)(ws + WS_ACT), (const bf16*)(ws + WS_KDT), (const bf16*)(ws + WS_VT), (const float*)(ws + WS_ACH), (bf16*)(ws + WS_OG), vcup, G, wavep, lane);
#endif
                    }
                    PH_END;
                } else {
                    PH_BEGIN
                        hn_pass((bf16*)(ws + WS_ACT), NB, B_Q, 12, PTR(17) + (l - 2) * 128, gwp, NGW, lane); hn_pass((bf16*)(ws + WS_ACT), NB, B_QM, 4, PTR(9) + l * 128, gwp, NGW, lane); }
                    PH_END;
                }
                PH_BEGIN
                    if (l < 2) gla_post((const bf16*)(ws + WS_OG), (const bf16*)(ws + WS_ACT), PTR(15) + l * 384, (bf16*)(ws + WS_HMIX), gwp, NGW, lane);
                    AttCfg c; c.PROJ = (const bf16*)(ws + WS_ACT); c.KSVS = (const bf16*)(ws + WS_KSVS); c.CB = (const float*)(ws + WS_CB); c.MK = (const bf16*)(ws + WS_MK) + (size_t)l * MROWS * 512; c.MV = (const bf16*)(ws + WS_MV) + (size_t)l * MROWS * 512;
                    c.MIX = (bf16*)(ws + WS_HMIX); c.np = np; c.qmcol = l < 2 ? A_QM : B_QM; c.fox = l >= 2; c.vcu = vcup; c.G = G;
                    __syncthreads();
#ifndef DBG_NO_ATT
                    att_phase(c, (char*)lds_raw, wavep);
#endif
                    }
                PH_END;
                PH_BEGIN pg8::Gemm g{(const bf16*)(ws + WS_HMIX), (const bf16*)(ws + WS_WOUT) + (size_t)l * DM * DM, M, DM, DM}; pg8::StaticOrder S; S.init(M, DM, G, bxp);
                    float* X = XOUT;
                    pg8::EpiResAdd E{X, X, DM, 1.0f};
                    pg8::gemm_phase<pg8::EpiResAdd, pg8::StaticOrder, true, true>(lds, g, S, E, wavep); }
                PH_END;
            }
        }
    }
#undef PH_ON
#undef PH_END
#undef WSP
#undef PH_BEGIN
#undef XOUT
}

extern "C" void kernel_launch(void* const* d_in, const int* in_sizes, int n_in, void* d_out, int out_size, void* d_ws, size_t ws_size, hipStream_t stream) {
    static int grid = 0;
    if (grid == 0) {
        if (n_in != 22 || in_sizes[0] != M * DM || out_size != M * DM || ws_size < WS_END) { fprintf(stderr, "kernel_launch: unexpected shapes (n_in %d, in0 %d, out %d, ws %zu < %zu); nothing launched\n", n_in, n_in > 0 ? in_sizes[0] : -1, out_size, ws_size, (size_t)WS_END); grid = -1; return; }
        int dev = 0, cus = 0, per_cu = 0;
        if (hipGetDevice(&dev) != hipSuccess || hipDeviceGetAttribute(&cus, hipDeviceAttributeMultiprocessorCount, dev) != hipSuccess) { fprintf(stderr, "kernel_launch: device query failed\n"); grid = -1; return; }
        if (hipFuncSetAttribute((const void*)mega_fwd, hipFuncAttributeMaxDynamicSharedMemorySize, LDS_BYTES) != hipSuccess) { fprintf(stderr, "kernel_launch: hipFuncSetAttribute failed\n"); grid = -1; return; }
        if (hipOccupancyMaxActiveBlocksPerMultiprocessor(&per_cu, (const void*)mega_fwd, NWAVES * 64, LDS_BYTES) != hipSuccess || per_cu < 1)
            fprintf(stderr, "kernel_launch: note: occupancy query reports %d workgroups per CU\n", per_cu);
        (void)hipGetLastError();
        grid = cus;
    }
    if (grid < 0) return;
    (void)hipMemsetAsync((char*)d_ws + WS_CTL, 0, CTL_ZERO_BYTES, stream);
    Args a{};
    for (int i = 0; i < 22; ++i) a.in[i] = (const float*)d_in[i];
    a.out = (float*)d_out; a.ws = (unsigned char*)d_ws;
#if MK_PER_PHASE
    for (int p = 0; p < NPH && p < MK_STOP_PC; ++p) { a.lo = p; a.hi = p + 1; hipLaunchKernelGGL(mega_fwd, dim3(grid), dim3(NWAVES * 64), LDS_BYTES, stream, a); }
#else
    a.lo = 0; a.hi = NPH; hipLaunchKernelGGL(mega_fwd, dim3(grid), dim3(NWAVES * 64), LDS_BYTES, stream, a);
#endif
}
```

```cpp
#include <hip/hip_runtime.h>
#include <cstdio>
#include <cstdint>
__device__ __forceinline__ int lane_id_v() { int l; asm volatile("v_mbcnt_lo_u32_b32 %0, -1, 0\n\tv_mbcnt_hi_u32_b32 %0, -1, %0" : "=v"(l)); return l; }
namespace pg8 {
#define PG8_LAS __attribute__((address_space(3)))
typedef unsigned short bf16_t;
typedef short bf16x8 __attribute__((ext_vector_type(8)));
typedef float f32x4 __attribute__((ext_vector_type(4)));
typedef unsigned u32x4 __attribute__((ext_vector_type(4)));
constexpr int BM = 256, BK = 64, HALF = 128, HTB = HALF * BK * 2  , STAGE_BYTES = 8 * HTB, NXCD = 8, WGM = 8;

__host__ __device__ __forceinline__ int lds_byte(int r, int c) { const int st = (r >> 4) * 2 + (c >> 5), rr = r & 15, cc = c & 31, ob = rr * 64 + cc * 2; return st * 1024 + (ob ^ (((ob >> 9) & 1) << 5)); }
__host__ __device__ __forceinline__ void stage_rc(int b, int& R, int& C) { const int st = b / 1024, sb = b % 1024, swz = sb ^ (((sb >> 9) & 1) << 5); R = (st >> 1) * 16 + swz / 64; C = (st & 1) * 32 + (swz % 64) / 2; }
__host__ __device__ __forceinline__ int perm32(int rho) { const int n = rho >> 4, i = rho & 15; return 8 * (i >> 2) + 4 * n + (i & 3); }

struct Unit { int pm, pn; };
struct Gemm { const bf16_t* A; const bf16_t* Bt; int M, N, K; };

struct StaticOrder {
    int nM, nN, nwg, G, c;
    __host__ __device__ void init(int M, int N, int G_, int c_) { nM = M / BM; nN = N / BM; nwg = nM * nN; G = G_; c = c_; }
    __host__ __device__ bool next(int i, Unit& u) const {
        const long L = (long)i * G + c; if (L >= nwg) return false;
        int wgid = (int)L; { const int q = nwg / NXCD, r = nwg % NXCD, xcd = wgid % NXCD, off = wgid / NXCD; wgid = (xcd < r ? xcd * (q + 1) : r * (q + 1) + (xcd - r) * q) + off; }
        const int nig = WGM * nN, gid = wgid / nig, fm = gid * WGM, gsz = (nM - fm) < WGM ? (nM - fm) : WGM;
        u.pm = fm + ((wgid % nig) % gsz); u.pn = (wgid % nig) / gsz; return true;
    }
    __device__ __forceinline__ void a_ready(const Unit&) const {}
    __device__ __forceinline__ void done(const Unit&) const {}
};

__device__ __forceinline__ unsigned cvt_pk_bf16(float lo, float hi) { unsigned r; asm volatile("v_cvt_pk_bf16_f32 %0, %1, %2" : "=v"(r) : "v"(lo), "v"(hi)); return r; }
typedef float f32x2 __attribute__((ext_vector_type(2)));
__device__ __forceinline__ f32x2 gelu_pk(f32x2 v) {
    const f32x2 av = __builtin_elementwise_abs(v), d = av * 0.2316418882f + 1.0f;
    f32x2 t; t.x = __builtin_amdgcn_rcpf(d.x); t.y = __builtin_amdgcn_rcpf(d.y);
    f32x2 q = t * 0.5307027145f + (-0.7265760135f); q = q * t + 0.7107068705f; q = q * t + (-0.142248368f); q = q * t + 0.127414796f; q = q * t;
    const f32x2 s = (v * v) * (-0.72134752044f);
    f32x2 e; e.x = __builtin_amdgcn_exp2f(s.x); e.y = __builtin_amdgcn_exp2f(s.y);
    const f32x2 m = v * (q * e), r = v - m;
    f32x2 o; o.x = v.x < 0.f ? m.x : r.x; o.y = v.y < 0.f ? m.y : r.y; return o;
}

template <int ACT  > struct EpiBf16 {
    static constexpr bool PERM = true, AFTER_DRAIN = false; static_assert(ACT == 0 || ACT == 1, "EpiBf16: ACT is 0 (none) or 1 (gelu_pk)");
    bf16_t* O; int ldc; const float* bias; int split_cols; size_t split_stride; float scale0;
    __device__ __forceinline__ void operator()(const f32x4 (&acc)[2][2][4][2], const Unit& u, int wr, int wc, int fr, int fq) const {
        const int row0 = u.pm * BM + wr * 64 + fr; int colt = u.pn * BM; bf16_t* base = O;
        float sc = 1.f; if (split_cols) { const int t = colt / split_cols; base += (size_t)t * split_stride; colt -= t * split_cols; if (t == 0) sc = scale0; }
        const int col0 = colt + wc * 32 + 8 * fq, bcol0 = u.pn * BM + wc * 32 + 8 * fq;
        f32x4 bv[2][2];
#pragma unroll
        for (int bj = 0; bj < 2; ++bj)
#pragma unroll
            for (int n = 0; n < 2; ++n) bv[bj][n] = bias ? *(const f32x4*)(bias + bcol0 + bj * HALF + 4 * n) : (f32x4){0.f, 0.f, 0.f, 0.f};
#pragma unroll
        for (int ai = 0; ai < 2; ++ai)
#pragma unroll
            for (int m = 0; m < 4; ++m) { bf16_t* rowp = base + (size_t)(row0 + ai * HALF + m * 16) * ldc + col0;
#pragma unroll
                for (int bj = 0; bj < 2; ++bj) { f32x4 v0 = acc[ai][bj][m][0] + bv[bj][0], v1 = acc[ai][bj][m][1] + bv[bj][1];
                    if (ACT == 1) { f32x2 a = gelu_pk((f32x2){v0[0], v0[1]}), b = gelu_pk((f32x2){v0[2], v0[3]}), c = gelu_pk((f32x2){v1[0], v1[1]}), d = gelu_pk((f32x2){v1[2], v1[3]});
                        v0 = (f32x4){a.x, a.y, b.x, b.y}; v1 = (f32x4){c.x, c.y, d.x, d.y}; }
                    v0 = v0 * sc; v1 = v1 * sc; u32x4 w; w.x = cvt_pk_bf16(v0[0], v0[1]); w.y = cvt_pk_bf16(v0[2], v0[3]); w.z = cvt_pk_bf16(v1[0], v1[1]); w.w = cvt_pk_bf16(v1[2], v1[3]);
                    *(u32x4*)(rowp + bj * HALF) = w; } }
    }
};

__device__ __forceinline__ unsigned pkbf(float lo, float hi) {
    typedef __bf16 bf2_t __attribute__((ext_vector_type(2))); typedef float fl2_t __attribute__((ext_vector_type(2)));
    fl2_t v = {lo, hi}; bf2_t r = __builtin_convertvector(v, bf2_t); return __builtin_bit_cast(unsigned, r);
}
__device__ __forceinline__ float silu_f(float x) { return x * __builtin_amdgcn_rcpf(1.0f + __builtin_amdgcn_exp2f(-1.4426950408889634f * x)); }

struct EpiSwiGLU {
    static constexpr bool PERM = true, AFTER_DRAIN = false;
    bf16_t* O; int ldc;
    __device__ __forceinline__ void operator()(const f32x4 (&acc)[2][2][4][2], const Unit& u, int wr, int wc, int fr, int fq) const {
        const int row0 = u.pm * BM + wr * 64 + fr, col0 = u.pn * HALF + wc * 32 + 8 * fq;
#pragma unroll
        for (int ai = 0; ai < 2; ++ai)
#pragma unroll
            for (int m = 0; m < 4; ++m) { bf16_t* rowp = O + (size_t)(row0 + ai * HALF + m * 16) * ldc + col0;
                const f32x4 g0 = acc[ai][0][m][0], g1 = acc[ai][0][m][1], u0 = acc[ai][1][m][0], u1 = acc[ai][1][m][1];
                u32x4 w;
                w.x = pkbf(silu_f(g0[0]) * u0[0], silu_f(g0[1]) * u0[1]); w.y = pkbf(silu_f(g0[2]) * u0[2], silu_f(g0[3]) * u0[3]);
                w.z = pkbf(silu_f(g1[0]) * u1[0], silu_f(g1[1]) * u1[1]); w.w = pkbf(silu_f(g1[2]) * u1[2], silu_f(g1[3]) * u1[3]);
                *(u32x4*)rowp = w; }
    }
};
struct EpiResAdd {
    static constexpr bool PERM = false, AFTER_DRAIN = false;
    const float* base; float* out; int ldc; float scale;
    __device__ __forceinline__ void operator()(const f32x4 (&acc)[2][2][4][2], const Unit& u, int wr, int wc, int fr, int fq) const {
        const int row0 = u.pm * BM + wr * 64 + fr, col0 = u.pn * BM + wc * 32 + 4 * fq;
#pragma unroll
        for (int ai = 0; ai < 2; ++ai) {
            f32x4 b[4][2][2];
#pragma unroll
            for (int m = 0; m < 4; ++m) { const size_t off = (size_t)(row0 + ai * HALF + m * 16) * ldc + col0;
#pragma unroll
                for (int bj = 0; bj < 2; ++bj)
#pragma unroll
                    for (int n = 0; n < 2; ++n) b[m][bj][n] = *(const f32x4*)(base + off + bj * HALF + n * 16); }
#pragma unroll
            for (int m = 0; m < 4; ++m) { const size_t off = (size_t)(row0 + ai * HALF + m * 16) * ldc + col0;
#pragma unroll
                for (int bj = 0; bj < 2; ++bj)
#pragma unroll
                    for (int n = 0; n < 2; ++n) *(f32x4*)(out + off + bj * HALF + n * 16) = b[m][bj][n] + acc[ai][bj][m][n] * scale; }
            asm volatile("" ::: "memory"); }
    }
};
struct EpiF32 {
    static constexpr bool PERM = false, AFTER_DRAIN = false;
    float* C; int ldc;
    __device__ __forceinline__ void operator()(const f32x4 (&acc)[2][2][4][2], const Unit& u, int wr, int wc, int fr, int fq) const {
        const int row0 = u.pm * BM + wr * 64 + fr, col0 = u.pn * BM + wc * 32 + 4 * fq;
#pragma unroll
        for (int ai = 0; ai < 2; ++ai)
#pragma unroll
            for (int m = 0; m < 4; ++m) { float* rowp = C + (size_t)(row0 + ai * HALF + m * 16) * ldc + col0;
#pragma unroll
                for (int bj = 0; bj < 2; ++bj)
#pragma unroll
                    for (int n = 0; n < 2; ++n) *(f32x4*)(rowp + bj * HALF + n * 16) = acc[ai][bj][m][n]; }
    }
};
struct EpiB16 {
    static constexpr bool PERM = true, AFTER_DRAIN = false;
    bf16_t* O; int ldc;
    __device__ __forceinline__ void operator()(const f32x4 (&acc)[2][2][4][2], const Unit& u, int wr, int wc, int fr, int fq) const {
        const int row0 = u.pm * BM + wr * 64 + fr, col0 = u.pn * BM + wc * 32 + 8 * fq;
#pragma unroll
        for (int ai = 0; ai < 2; ++ai)
#pragma unroll
            for (int m = 0; m < 4; ++m) { bf16_t* rowp = O + (size_t)(row0 + ai * HALF + m * 16) * ldc + col0;
#pragma unroll
                for (int bj = 0; bj < 2; ++bj) { const f32x4 v0 = acc[ai][bj][m][0], v1 = acc[ai][bj][m][1];
                    u32x4 w; w.x = pkbf(v0[0], v0[1]); w.y = pkbf(v0[2], v0[3]); w.z = pkbf(v1[0], v1[1]); w.w = pkbf(v1[2], v1[3]);
                    *(u32x4*)(rowp + bj * HALF) = w; } }
    }
};
struct EpiKV {
    static constexpr bool PERM = true, AFTER_DRAIN = false;
    bf16_t* O; int ldc; float* F;
    __device__ __forceinline__ void operator()(const f32x4 (&acc)[2][2][4][2], const Unit& u, int wr, int wc, int fr, int fq) const {
        const int row0 = u.pm * BM + wr * 64 + fr;
        if (u.pn < 12) {
            const int col0 = u.pn * BM + wc * 32 + 8 * fq;
#pragma unroll
            for (int ai = 0; ai < 2; ++ai)
#pragma unroll
                for (int m = 0; m < 4; ++m) { bf16_t* rowp = O + (size_t)(row0 + ai * HALF + m * 16) * ldc + col0;
#pragma unroll
                    for (int bj = 0; bj < 2; ++bj) { const f32x4 v0 = acc[ai][bj][m][0], v1 = acc[ai][bj][m][1];
                        u32x4 w; w.x = pkbf(v0[0], v0[1]); w.y = pkbf(v0[2], v0[3]); w.z = pkbf(v1[0], v1[1]); w.w = pkbf(v1[2], v1[3]);
                        *(u32x4*)(rowp + bj * HALF) = w; } }
        } else if (wc == 0 && fq < 2) {
#pragma unroll
            for (int ai = 0; ai < 2; ++ai)
#pragma unroll
                for (int m = 0; m < 4; ++m) { float* rowp = F + (size_t)(row0 + ai * HALF + m * 16) * 16 + 8 * fq;
                    *(f32x4*)(rowp) = acc[ai][0][m][0]; *(f32x4*)(rowp + 4) = acc[ai][0][m][1]; }
        }
    }
};
template <class Epi, class Sched, bool ALIGN_EPI = false, bool SP2 = false>
__device__ __forceinline__ void gemm_phase(PG8_LAS unsigned char* lds, const Gemm g, const Sched& S, const Epi& E, const int wave_in) {
    const int tid_l = wave_in * 64 + lane_id_v();
    const int tid = tid_l, wid = wave_in, lane = tid & 63, wr = wid >> 2, wc = wid & 3, fr = lane & 15, fq = lane >> 4;
    const int K = g.K, nt = K / BK;
    unsigned voffA[2], voffB[2];
#pragma unroll
    for (int i = 0; i < 2; ++i) { int R, C; stage_rc(tid * 16 + i * 8192, R, C); const int Rb = Epi::PERM ? ((R & ~31) + perm32(R & 31)) : R;
        voffA[i] = (unsigned)(R * K + C) * 2u; voffB[i] = (unsigned)(Rb * K + C) * 2u; }
    const size_t kstep = (size_t)(BK * 2);
    const size_t hstep = (size_t)HALF * K * 2;
    const size_t tstep = 2 * hstep;
    const unsigned ldsw = (unsigned)wid * 1024u;
    const int aoff = lds_byte(wr * 64 + fr, fq * 8), boff = lds_byte(wc * 32 + fr, fq * 8);
#define PG8_SA(b, h) (((b) * 2 + (h)) * HTB)
#define PG8_SB(b, h) ((4 + (b) * 2 + (h)) * HTB)
#define PG8_STAGE(bufoff, gbase, voff) do { _Pragma("unroll") for (int _i = 0; _i < 2; ++_i) \
        __builtin_amdgcn_global_load_lds((const unsigned*)((const char*)(gbase) + (voff)[_i]), (PG8_LAS unsigned*)(lds + (bufoff) + ldsw + _i * 8192), 16, 0, 0); } while (0)
#define PG8_LDA(dst, b, h) do { _Pragma("unroll") for (int m = 0; m < 4; ++m) _Pragma("unroll") for (int k = 0; k < 2; ++k) dst[m][k] = *(const PG8_LAS bf16x8*)(lds + PG8_SA(b, h) + aoff + m * 2048 + k * 1024); } while (0)
#define PG8_LDB(dst, b, h) do { _Pragma("unroll") for (int n = 0; n < 2; ++n) _Pragma("unroll") for (int k = 0; k < 2; ++k) dst[n][k] = *(const PG8_LAS bf16x8*)(lds + PG8_SB(b, h) + boff + n * 2048 + k * 1024); } while (0)
#define PG8_MMA(ai, bj, At, Bt) do { __builtin_amdgcn_s_setprio(1); _Pragma("unroll") for (int m = 0; m < 4; ++m) _Pragma("unroll") for (int n = 0; n < 2; ++n) _Pragma("unroll") for (int k = 0; k < 2; ++k) \
        acc[ai][bj][m][n] = __builtin_amdgcn_mfma_f32_16x16x32_bf16(Bt[n][k], At[m][k], acc[ai][bj][m][n], 0, 0, 0); __builtin_amdgcn_s_setprio(0); } while (0)
#define PG8_WAIT_V(n) asm volatile("s_waitcnt vmcnt(" #n ")" ::: "memory")
#define PG8_WAIT_L(n) asm volatile("s_waitcnt lgkmcnt(" #n ")" ::: "memory")
#define PG8_BAR __builtin_amdgcn_s_barrier()
#define PG8_SCHED __builtin_amdgcn_sched_barrier(0)
    Unit cur, nxt; int ui = 0;
    if (!S.next(0, cur)) return;
    f32x4 acc[2][2][4][2];
#pragma unroll
    for (int a = 0; a < 2; ++a)
#pragma unroll
        for (int b = 0; b < 2; ++b)
#pragma unroll
            for (int m = 0; m < 4; ++m)
#pragma unroll
                for (int n = 0; n < 2; ++n) acc[a][b][m][n] = (f32x4){0.f, 0.f, 0.f, 0.f};
    bf16x8 At[4][2], B0[2][2], B1[2][2];
    const char* cA = (const char*)g.A + (size_t)cur.pm * tstep; const char* cB = (const char*)g.Bt + (size_t)cur.pn * tstep;
    S.a_ready(cur);
    if constexpr (SP2) {
        PG8_STAGE(PG8_SB(0, 0), cB, voffB); PG8_STAGE(PG8_SB(0, 1), cB + hstep, voffB); PG8_STAGE(PG8_SA(0, 0), cA, voffA); PG8_STAGE(PG8_SA(0, 1), cA + hstep, voffA);
        if (wr == 1) PG8_BAR;
        PG8_WAIT_V(2); PG8_BAR;
        PG8_STAGE(PG8_SB(1, 0), cB + kstep, voffB); PG8_STAGE(PG8_SA(1, 0), cA + kstep, voffA); PG8_STAGE(PG8_SB(1, 1), cB + hstep + kstep, voffB);
        PG8_WAIT_V(6); PG8_BAR;
    } else {
        PG8_STAGE(PG8_SB(0, 0), cB, voffB); PG8_STAGE(PG8_SA(0, 0), cA, voffA); PG8_STAGE(PG8_SB(0, 1), cB + hstep, voffB); PG8_STAGE(PG8_SA(0, 1), cA + hstep, voffA);
        if (wr == 1) PG8_BAR;
        PG8_WAIT_V(4); PG8_BAR;
        PG8_STAGE(PG8_SB(1, 0), cB + kstep, voffB); PG8_STAGE(PG8_SA(1, 0), cA + kstep, voffA); PG8_STAGE(PG8_SB(1, 1), cB + hstep + kstep, voffB);
        PG8_WAIT_V(6); PG8_BAR;
    }
    for (;;) {
        const bool has_next = S.next(ui + 1, nxt);
        const char* nA = has_next ? (const char*)g.A + (size_t)nxt.pm * tstep : cA; const char* nB = has_next ? (const char*)g.Bt + (size_t)nxt.pn * tstep : cB;
        for (int t = 0; t < nt; t += 2) {
            const bool last = (t == nt - 2);
            const char* a1 = cA + (size_t)(t + 1) * kstep;
            const char* a2 = last ? nA : cA + (size_t)(t + 2) * kstep; const char* b2 = last ? nB : cB + (size_t)(t + 2) * kstep;
            const char* a3 = a2 + kstep; const char* b3 = b2 + kstep;
            if (last && has_next) S.a_ready(nxt);
            if constexpr (SP2) {
            PG8_LDB(B0, 0, 0); PG8_LDB(B1, 0, 1); PG8_SCHED; PG8_LDA(At, 0, 0); PG8_STAGE(PG8_SA(1, 1), a1 + hstep, voffA);
            PG8_WAIT_V(8); PG8_WAIT_L(0); PG8_BAR; PG8_MMA(0, 0, At, B0); PG8_MMA(0, 1, At, B1); PG8_BAR; PG8_SCHED;
            PG8_LDA(At, 0, 1); PG8_STAGE(PG8_SB(0, 0), b2, voffB); PG8_STAGE(PG8_SB(0, 1), b2 + hstep, voffB); PG8_STAGE(PG8_SA(0, 0), a2, voffA);
            PG8_WAIT_V(8); PG8_WAIT_L(0); PG8_BAR; PG8_MMA(1, 0, At, B0); PG8_MMA(1, 1, At, B1); PG8_BAR; PG8_SCHED;
            PG8_LDB(B0, 1, 0); PG8_LDB(B1, 1, 1); PG8_SCHED; PG8_LDA(At, 1, 0); PG8_STAGE(PG8_SA(0, 1), a2 + hstep, voffA);
            PG8_WAIT_V(8); PG8_WAIT_L(0); PG8_BAR; PG8_MMA(0, 0, At, B0); PG8_MMA(0, 1, At, B1); PG8_BAR; PG8_SCHED;
            PG8_LDA(At, 1, 1); PG8_STAGE(PG8_SB(1, 0), b3, voffB); PG8_STAGE(PG8_SB(1, 1), b3 + hstep, voffB); PG8_STAGE(PG8_SA(1, 0), a3, voffA);
            PG8_WAIT_V(8); PG8_WAIT_L(0); PG8_BAR; PG8_MMA(1, 0, At, B0); PG8_MMA(1, 1, At, B1); PG8_BAR; PG8_SCHED;
            } else {
            PG8_LDB(B0, 0, 0); PG8_SCHED; PG8_LDA(At, 0, 0); PG8_STAGE(PG8_SA(1, 1), a1 + hstep, voffA);
            PG8_WAIT_L(8); PG8_BAR; PG8_WAIT_L(0); PG8_MMA(0, 0, At, B0); PG8_BAR; PG8_SCHED;
            PG8_LDB(B1, 0, 1); PG8_STAGE(PG8_SB(0, 0), b2, voffB);
            PG8_BAR; PG8_WAIT_L(0); PG8_MMA(0, 1, At, B1); PG8_BAR;
            PG8_LDA(At, 0, 1); PG8_STAGE(PG8_SA(0, 0), a2, voffA);
            PG8_BAR; PG8_WAIT_L(0); PG8_MMA(1, 0, At, B0); PG8_BAR; PG8_SCHED;
            PG8_STAGE(PG8_SB(0, 1), b2 + hstep, voffB);
            PG8_WAIT_V(6); PG8_BAR; PG8_MMA(1, 1, At, B1); PG8_BAR;
            PG8_LDB(B0, 1, 0); PG8_SCHED; PG8_LDA(At, 1, 0); PG8_STAGE(PG8_SA(0, 1), a2 + hstep, voffA);
            PG8_WAIT_L(8); PG8_BAR; PG8_WAIT_L(0); PG8_MMA(0, 0, At, B0); PG8_BAR; PG8_SCHED;
            PG8_LDB(B1, 1, 1); PG8_STAGE(PG8_SB(1, 0), b3, voffB);
            PG8_BAR; PG8_WAIT_L(0); PG8_MMA(0, 1, At, B1); PG8_BAR;
            PG8_LDA(At, 1, 1); PG8_STAGE(PG8_SA(1, 0), a3, voffA);
            PG8_BAR; PG8_WAIT_L(0); PG8_MMA(1, 0, At, B0); PG8_BAR; PG8_SCHED;
            PG8_STAGE(PG8_SB(1, 1), b3 + hstep, voffB);
            PG8_WAIT_V(6); PG8_BAR; PG8_MMA(1, 1, At, B1); PG8_BAR;
            }
        }
        if constexpr (ALIGN_EPI) { if (wr == 0) PG8_BAR; }
        if constexpr (!Epi::AFTER_DRAIN) { E(acc, cur, wr, wc, fr, fq); S.done(cur); }
        if (!has_next) break;
#pragma unroll
        for (int a = 0; a < 2; ++a)
#pragma unroll
            for (int b = 0; b < 2; ++b)
#pragma unroll
                for (int m = 0; m < 4; ++m)
#pragma unroll
                    for (int n = 0; n < 2; ++n) acc[a][b][m][n] = (f32x4){0.f, 0.f, 0.f, 0.f};
        cur = nxt; cA = nA; cB = nB; ++ui;
        if constexpr (ALIGN_EPI) { if (wr == 1) PG8_BAR; }
    }
    PG8_WAIT_V(0);
    if constexpr (!ALIGN_EPI) { if (wr == 0) PG8_BAR; }
    PG8_BAR;
    if constexpr (Epi::AFTER_DRAIN) { E.fused(acc, cur, wr, wc, fr, fq, lds, wid, lane); S.done(cur); }
#undef PG8_SA
#undef PG8_SB
#undef PG8_STAGE
#undef PG8_LDA
#undef PG8_LDB
#undef PG8_MMA
#undef PG8_WAIT_V
#undef PG8_WAIT_L
#undef PG8_BAR
#undef PG8_SCHED
}
}

namespace fa {
constexpr float SCALE = 0.08838834764831845f;
constexpr int D = 128, NW = 8, QBLK = 32, KVBLK = 64, QB = NW * QBLK;
constexpr int SHM_V = KVBLK * D * 2, SHM_K = KVBLK * D * 2;
constexpr int LDS_BYTES = 2 * SHM_V + 2 * SHM_K + NW * 64 * 4;
constexpr float THR = 8.f;
constexpr int OP = 2048;
typedef unsigned short bf16;
typedef short bf16x8 __attribute__((ext_vector_type(8)));
typedef short s16x4 __attribute__((ext_vector_type(4)));
typedef float f32x16 __attribute__((ext_vector_type(16)));
typedef float f32x4 __attribute__((ext_vector_type(4)));
typedef unsigned u32x4 __attribute__((ext_vector_type(4)));

#define KSWZ(row, colB) ((row) * 256 + ((colB) ^ (((row) & 7) << 4)))
#define SBAR() __builtin_amdgcn_sched_barrier(0)
__device__ __forceinline__ int v_st(int k, int c) { const int kk = (k & ~0xC) | ((k & 4) << 1) | ((k & 8) >> 1); return ((kk >> 3) * 4 + (c >> 5)) * 512 + ((kk & 7) * 32 + (c & 31)) * 2; }
__device__ __forceinline__ int v_rd_base(int lane) { return ((lane & 3) << 3) | (((lane >> 2) & 3) << 6) | (((lane >> 4) & 1) << 5) | (((lane >> 5) & 1) << 8); }
constexpr int v_rd_off(int d0, int ks, int half) { return d0 * 512 + ks * 4096 + half * 2048; }
__device__ __forceinline__ int crow(int r, int hi) { return (r & 3) + 8 * (r >> 2) + 4 * hi; }
__device__ __forceinline__ unsigned cvtpk(float lo, float hi) {
    unsigned r; asm volatile("v_cvt_pk_bf16_f32 %0, %1, %2" : "=v"(r) : "v"(lo), "v"(hi)); return r;
}
__device__ __forceinline__ bf16x8 load8(const bf16* p) { return *reinterpret_cast<const bf16x8*>(p); }
__device__ __forceinline__ bf16x8 cb_frag(float c, int hi) {
    const unsigned u1 = __float_as_uint(c) & 0xffff0000u; const float r1 = c - __uint_as_float(u1);
    const unsigned v1 = __float_as_uint(r1) & 0xffff0000u; const float r2 = r1 - __uint_as_float(v1);
    const unsigned w1 = __float_as_uint(r2) & 0xffff0000u;
    u32x4 w = {hi ? 0u : ((u1 >> 16) | v1), hi ? 0u : (w1 >> 16), 0u, 0u};
    return *reinterpret_cast<bf16x8*>(&w);
}
__device__ __forceinline__ int hi_opaque() { return lane_id_v() >> 5; }
__device__ __forceinline__ bf16x8 ones_frag(int hi) { u32x4 w = {hi ? 0u : 0x3F803F80u, hi ? 0u : 0x00003F80u, 0u, 0u}; return *reinterpret_cast<bf16x8*>(&w); }
__device__ __forceinline__ void mask_tile(f32x16& p0, f32x16& p1, int dq, unsigned W) {
    const float NEG = -__builtin_inff();
#pragma unroll
    for (int r = 0; r < 16; ++r) {
        const int c = (r & 3) + 8 * (r >> 2);
        if ((unsigned)(dq - c) >= W) p0[r] = NEG;
        if ((unsigned)(dq - c - 32) >= W) p1[r] = NEG;
    }
}
__device__ __forceinline__ void partialSM(f32x16& p0, f32x16& p1, float& m_reg, float& mn, float& alpha) {
    float pmax = p0[0]; for (int r = 1; r < 16; ++r) pmax = fmaxf(pmax, p0[r]); for (int r = 0; r < 16; ++r) pmax = fmaxf(pmax, p1[r]);
    { auto rr = __builtin_amdgcn_permlane32_swap(__float_as_uint(pmax), __float_as_uint(pmax), false, false);
      pmax = fmaxf(__uint_as_float(rr[0]), __uint_as_float(rr[1])); }
    constexpr float C2 = 1.4426950408889634f * SCALE;
    if (__builtin_expect(__all((pmax - m_reg) * SCALE <= THR), 1)) { mn = m_reg; alpha = 1.f; }
    else { mn = fmaxf(m_reg, pmax); alpha = __builtin_amdgcn_exp2f((m_reg - mn) * C2); m_reg = mn; }
    const float mnL = -mn * C2;
    for (int r = 0; r < 16; ++r) p0[r] = fmaf(p0[r], C2, mnL); for (int r = 0; r < 16; ++r) p1[r] = fmaf(p1[r], C2, mnL);
    for (int r = 0; r < 16; ++r) p0[r] = __builtin_amdgcn_exp2f(p0[r]);
}
__device__ __forceinline__ void finishSM(f32x16& p0, f32x16& p1, float alpha, float& l_reg, bf16x8& pa0, bf16x8& pa1, bf16x8& pa2, bf16x8& pa3) {
    for (int r = 0; r < 16; ++r) p1[r] = __builtin_amdgcn_exp2f(p1[r]);
    float ps = 0; for (int r = 0; r < 16; ++r) ps += p0[r]; for (int r = 0; r < 16; ++r) ps += p1[r];
    { auto rr = __builtin_amdgcn_permlane32_swap(__float_as_uint(ps), __float_as_uint(ps), false, false);
      ps = __uint_as_float(rr[0]) + __uint_as_float(rr[1]); }
    l_reg = l_reg * alpha + ps;
#define PK4(P, B_, OUT) do { unsigned a0 = cvtpk(P[B_+0], P[B_+1]), a1 = cvtpk(P[B_+2], P[B_+3]);                          \
        unsigned b0 = cvtpk(P[B_+4], P[B_+5]), b1 = cvtpk(P[B_+6], P[B_+7]);                                             \
        auto r0 = __builtin_amdgcn_permlane32_swap(a0, b0, false, false); auto r1 = __builtin_amdgcn_permlane32_swap(a1, b1, false, false); \
        u32x4 w = {r0[0], r1[0], r0[1], r1[1]}; OUT = *reinterpret_cast<bf16x8*>(&w); } while (0)
    PK4(p0, 0, pa0); PK4(p0, 8, pa1); PK4(p1, 0, pa2); PK4(p1, 8, pa3);
#undef PK4
}
template <int KB>
__device__ __forceinline__ void qkt(f32x16& p0, f32x16& p1, const char* K_lds, int r32, int hi, const bf16x8* qr, bf16x8 kx0, bf16x8 kx1, bf16x8 qx) {
    p0 = __builtin_amdgcn_mfma_f32_32x32x16_bf16(kx0, qx, f32x16{}, 0, 0, 0);
    p1 = __builtin_amdgcn_mfma_f32_32x32x16_bf16(kx1, qx, f32x16{}, 0, 0, 0);
    const char* kb[4];
#pragma unroll
    for (int dd = 0; dd < 4; ++dd) kb[dd] = K_lds + KB * SHM_K + KSWZ(r32, (dd * 16 + hi * 8) * 2);
#pragma unroll
    for (int d0 = 0; d0 < 8; ++d0) { const char* a = kb[d0 & 3] + (d0 >> 2) * 128;
        bf16x8 b0 = *reinterpret_cast<const bf16x8*>(a);
        bf16x8 b1 = *reinterpret_cast<const bf16x8*>(a + 32 * 256);
        p0 = __builtin_amdgcn_mfma_f32_32x32x16_bf16(b0, qr[d0], p0, 0, 0, 0);
        p1 = __builtin_amdgcn_mfma_f32_32x32x16_bf16(b1, qr[d0], p1, 0, 0, 0); }
}
template <int VB>
__device__ __forceinline__ void pv_tile(f32x16* o, int vb0, bf16x8 pa0, bf16x8 pa1, bf16x8 pa2, bf16x8 pa3) {
#define TRRD(dst, off) asm volatile("ds_read_b64_tr_b16 %0, %1 offset:%2" : "=&v"(dst) : "v"(vb0), "i"(off) : "memory")
#define PV_D0(d0) do { s16x4 l0, l1, l2, l3, h0, h1, h2, h3; constexpr int b_ = VB * SHM_V + v_rd_off(d0, 0, 0);     \
        TRRD(l0, b_); TRRD(h0, b_ + 2048); TRRD(l1, b_ + 4096); TRRD(h1, b_ + 6144); TRRD(l2, b_ + 8192); TRRD(h2, b_ + 10240); TRRD(l3, b_ + 12288); TRRD(h3, b_ + 14336); \
        asm volatile("s_waitcnt lgkmcnt(0)" ::: "memory"); SBAR();                 \
        o[d0] = __builtin_amdgcn_mfma_f32_32x32x16_bf16(pa0, (bf16x8){l0[0], l0[1], l0[2], l0[3], h0[0], h0[1], h0[2], h0[3]}, o[d0], 0, 0, 0);   \
        o[d0] = __builtin_amdgcn_mfma_f32_32x32x16_bf16(pa1, (bf16x8){l1[0], l1[1], l1[2], l1[3], h1[0], h1[1], h1[2], h1[3]}, o[d0], 0, 0, 0);   \
        o[d0] = __builtin_amdgcn_mfma_f32_32x32x16_bf16(pa2, (bf16x8){l2[0], l2[1], l2[2], l2[3], h2[0], h2[1], h2[2], h2[3]}, o[d0], 0, 0, 0);   \
        o[d0] = __builtin_amdgcn_mfma_f32_32x32x16_bf16(pa3, (bf16x8){l3[0], l3[1], l3[2], l3[3], h3[0], h3[1], h3[2], h3[3]}, o[d0], 0, 0, 0); } while (0)
    PV_D0(0); PV_D0(1); PV_D0(2); PV_D0(3);
#undef PV_D0
#undef TRRD
}

struct BlockRef { const bf16* Q; const bf16* K; const bf16* V; bf16* O; const bf16* G; const float* CB; int P0, skv, qp, kp; };
struct Seam { bf16x8 qr[8]; bf16x8 st_v0, st_v1, st_k0, st_k1; float cb0, cb1; };
#define ROWP(p, k0, rr, pitch) ((p) + (size_t)(k0) * (pitch) + (unsigned)((rr) * (pitch) + sc))
#define VMW() asm volatile("s_waitcnt vmcnt(0)" ::: "memory")
#define VMWN(n) asm volatile("s_waitcnt vmcnt(%0)" :: "i"(n) : "memory")
#define SLOAD_H(Kp, Vp, Cp, k0, pitch) do { S.st_v0 = load8(ROWP(Vp, k0, sr, pitch)); S.st_v1 = load8(ROWP(Vp, k0, 32 + sr, pitch));              \
                         S.st_k0 = load8(ROWP(Kp, k0, sr, pitch)); S.st_k1 = load8(ROWP(Kp, k0, 32 + sr, pitch));                                    \
                         S.cb0 = (Cp) ? (Cp)[(k0) + r32] : 0.f; S.cb1 = (Cp) ? (Cp)[(k0) + 32 + r32] : 0.f; } while (0)
#define SWRITE_HK(bf) do { *(bf16x8*)(K_lds + (bf) * SHM_K + kws) = S.st_k0; *(bf16x8*)(K_lds + (bf) * SHM_K + kws + 32 * 256) = S.st_k1; } while (0)
#define SWRITE_HV(bf) do { *(bf16x8*)(V_lds + (bf) * SHM_V + vst0) = S.st_v0; *(bf16x8*)(V_lds + (bf) * SHM_V + vst1) = S.st_v1; } while (0)
#define SWRITE_H(bf) do { SWRITE_HV(bf); SWRITE_HK(bf); } while (0)
__device__ __forceinline__ void attn_prime(const BlockRef& cur, char* lds, Seam& S, const int wave_in) {
    const int tid = wave_in * 64 + lane_id_v(), wid = wave_in, lane = tid & 63, r32 = lane & 31, hi = lane >> 5;
    const int sr = tid >> 4, sc = (tid & 15) * 8, kws = KSWZ(sr, sc * 2); char* K_lds = lds + 2 * SHM_V;
#pragma unroll
    for (int d0 = 0; d0 < 8; ++d0) S.qr[d0] = load8(cur.Q + (size_t)(wid * QBLK + r32) * cur.qp + d0 * 16 + hi * 8);
    SLOAD_H(cur.K, cur.V, cur.CB, 0, cur.kp); VMW(); SWRITE_HK(0);
    __syncthreads();
}
__device__ __forceinline__ void attn_block(const BlockRef& cur, const BlockRef& nxt, char* lds, Seam& S, const int wave_in) {
    const int tid = wave_in * 64 + lane_id_v(), wid = wave_in, lane = tid & 63, r32 = lane & 31, hi = lane >> 5;
    constexpr int W = 1 << 30;
    int j_hi = (cur.P0 + QB - 1) / KVBLK + 1; if (j_hi > cur.skv / KVBLK) j_hi = cur.skv / KVBLK;
    const int NT = j_hi;
    const int qlo = cur.P0 + wid * QBLK, qm = qlo + r32 - 4 * hi;
    char* V_lds = lds; char* K_lds = lds + 2 * SHM_V;
    float* ws = (float*)(lds + 2 * SHM_V + 2 * SHM_K) + wid * 64; float* li_l = ws, * al_l = ws + 32;
    float m_reg = -1e30f, l_reg = 0; f32x16 o[4] = {};
    const int sr = tid >> 4, sc = (tid & 15) * 8, vst0 = v_st(sr, sc), vst1 = v_st(32 + sr, sc), kws = KSWZ(sr, sc * 2);
    const int vb0 = (int)(uintptr_t)V_lds + v_rd_base(lane);
    const bf16* Kh = cur.K; const bf16* Vh = cur.V; const float* Ch = cur.CB; const int KP = cur.kp;
#define QX() ones_frag(hi_opaque())
#define RESC(a) do { if (__any((a) < 1.f)) { if (hi == 0) al_l[r32] = (a); asm volatile("s_waitcnt lgkmcnt(0)" ::: "memory");              \
                     for (int d_ = 0; d_ < 4; ++d_) for (int r = 0; r < 16; ++r) o[d_][r] *= al_l[crow(r, hi)]; } } while (0)
#define KBASE(t) ((t) * KVBLK)
#define MASKT(P0_, P1_, t) do { const int kb_ = KBASE(t); if (kb_ + KVBLK - 1 > qlo) mask_tile(P0_, P1_, qm - kb_, (unsigned)W); } while (0)
#define SEAM_K0() do { VMWN(8); SWRITE_HK(0); SBAR(); } while (0)
    f32x16 pA0, pA1, pB0, pB1; float mnA, mnB, alA, alB; bf16x8 pa0, pa1, pa2, pa3; bf16x8 kx0, kx1;
    SWRITE_HV(0); SBAR();
    kx0 = cb_frag(S.cb0, hi); kx1 = cb_frag(S.cb1, hi);
    if (NT > 1) SLOAD_H(Kh, Vh, Ch, KBASE(1), KP);
    SBAR(); qkt<0>(pA0, pA1, K_lds, r32, hi, S.qr, kx0, kx1, QX());
    MASKT(pA0, pA1, 0); partialSM(pA0, pA1, m_reg, mnA, alA);
    if (NT > 1) { VMW(); SWRITE_H(1); }
    __syncthreads();
#define HALF_STEP(PX0, PX1, mnX, alX, PY0, PY1, alY, t, KB, VB, SB) do {                                                      \
        SBAR(); kx0 = cb_frag(S.cb0, hi); kx1 = cb_frag(S.cb1, hi);                                                           \
        qkt<KB>(PX0, PX1, K_lds, r32, hi, S.qr, kx0, kx1, QX());                                                                \
        finishSM(PY0, PY1, alY, l_reg, pa0, pa1, pa2, pa3); SBAR();                                                           \
        if ((t) + 1 < NT) { SLOAD_H(Kh, Vh, Ch, KBASE((t) + 1), KP); SBAR(); }                                                \
        pv_tile<VB>(o, vb0, pa0, pa1, pa2, pa3); MASKT(PX0, PX1, (t)); partialSM(PX0, PX1, m_reg, mnX, alX);                  \
        __syncthreads();                                                                                                      \
        if ((t) + 1 < NT) { VMW(); SWRITE_H(SB); }                                                                            \
        RESC(alX); __syncthreads(); } while (0)
    for (int t = 1; t + 1 < NT; t += 2) {
        HALF_STEP(pB0, pB1, mnB, alB, pA0, pA1, alA, t, 1, 0, 0);
        HALF_STEP(pA0, pA1, mnA, alA, pB0, pB1, alB, t + 1, 0, 1, 1);
    }
    const bool even = (NT & 1) == 0;
    if (even) { SBAR(); kx0 = cb_frag(S.cb0, hi); kx1 = cb_frag(S.cb1, hi); qkt<1>(pB0, pB1, K_lds, r32, hi, S.qr, kx0, kx1, QX()); SBAR(); }
    SLOAD_H(nxt.K, nxt.V, nxt.CB, 0, nxt.kp); SBAR();
#pragma unroll
    for (int d0 = 0; d0 < 8; ++d0) S.qr[d0] = load8(nxt.Q + (size_t)(wid * QBLK + r32) * nxt.qp + d0 * 16 + hi * 8);
    SBAR();
    finishSM(pA0, pA1, alA, l_reg, pa0, pa1, pa2, pa3); SBAR();
    pv_tile<0>(o, vb0, pa0, pa1, pa2, pa3);
    if (even) { MASKT(pB0, pB1, NT - 1); partialSM(pB0, pB1, m_reg, mnB, alB); __syncthreads(); RESC(alB);
        finishSM(pB0, pB1, alB, l_reg, pa0, pa1, pa2, pa3); SBAR(); pv_tile<1>(o, vb0, pa0, pa1, pa2, pa3); }
    SBAR(); SEAM_K0();
    if (hi == 0) li_l[r32] = l_reg; asm volatile("s_waitcnt lgkmcnt(0)" ::: "memory");
    float rli[16];
#pragma unroll
    for (int r = 0; r < 16; ++r) rli[r] = __builtin_amdgcn_rcpf(li_l[crow(r, hi)]);
    bf16* Ow = cur.O + (size_t)(wid * QBLK) * OP;
    const bf16* Gw = cur.G ? cur.G + (size_t)(wid * QBLK) * cur.qp : nullptr; const int GP = cur.qp;
#pragma unroll
    for (int r = 0; r < 16; ++r) { const int orow = crow(r, hi);
#pragma unroll
        for (int d0 = 0; d0 < 4; ++d0) { float v = o[d0][r] * rli[r];
            if (Gw) { const float g = __uint_as_float(((unsigned)Gw[(size_t)orow * GP + d0 * 32 + r32]) << 16);
                      v *= __builtin_amdgcn_rcpf(1.0f + __builtin_amdgcn_exp2f(-1.4426950408889634f * g)); }
            const float vn = __uint_as_float((unsigned)__builtin_amdgcn_update_dpp(0, (int)__float_as_uint(v), 0xB1, 0xF, 0xF, true));
            if ((r32 & 1) == 0) *(unsigned*)(Ow + (size_t)orow * OP + d0 * 32 + r32) = cvtpk(v, vn); } }
    __syncthreads();
#undef QX
#undef RESC
#undef KBASE
#undef MASKT
#undef SEAM_K0
#undef HALF_STEP
}
#undef ROWP
#undef VMW
#undef VMWN
#undef SLOAD_H
#undef SWRITE_HK
#undef SWRITE_HV
#undef SWRITE_H
#undef KSWZ
#undef SBAR
}

constexpr int NWAVES = 8;
#ifndef MK_PER_PHASE
#define MK_PER_PHASE 0
#endif
#ifndef MK_STOP_PC
#define MK_STOP_PC 1000
#endif
constexpr int NPH = 50;

constexpr int BATCH = 8, SEQ = 4096, DM = 2048, M = BATCH * SEQ, FF = 5632, NUP = 2 * FF, DEPTH = 4;
constexpr int NA = 5888, NB = 3584, NKV = 3328, NMEMW = 4096;
constexpr int A_Q = 0, A_K = 768, A_V = 1536, A_G = 3072, A_QM = 4608, A_GATE = 5120;
constexpr int B_Q = 0, B_G = 1536, B_QM = 3072;
constexpr int MEMT = 256, MROWS = BATCH * MEMT;
constexpr float EPS = 1e-6f;

constexpr size_t MiB = 1u << 20;
constexpr size_t WS_CTL = 0, CTL_ZERO_BYTES = 1 * MiB;
constexpr size_t WS_CB = 1 * MiB, WS_F = 3 * MiB, WS_ACH = 5 * MiB, WS_MEMB = 8 * MiB, WS_MKVF = 16 * MiB, WS_MK = 48 * MiB, WS_MV = 56 * MiB;
constexpr size_t WS_WUP = 64 * MiB, WS_WDN = 416 * MiB, WS_WAIN = 592 * MiB, WS_WBIN = 638 * MiB, WS_WOUT = 666 * MiB, WS_WKV = 698 * MiB, WS_WMEM = 711 * MiB;
constexpr size_t WS_HMIX = 728 * MiB, WS_ACT = 856 * MiB, WS_KDT = 1224 * MiB, WS_VT = 1272 * MiB, WS_OG = 1368 * MiB, WS_KSVS = 1224 * MiB, WS_END = 1464 * MiB;
static_assert(WS_WUP + 8 * (size_t)NUP * DM * 2 <= WS_WDN && WS_WDN + 8 * (size_t)DM * FF * 2 <= WS_WAIN && WS_WAIN + 2 * (size_t)NA * DM * 2 <= WS_WBIN && WS_WBIN + 2 * (size_t)NB * DM * 2 <= WS_WOUT &&
              WS_WOUT + 4 * (size_t)DM * DM * 2 <= WS_WKV && WS_WKV + (size_t)NKV * DM * 2 <= WS_WMEM && WS_WMEM + (size_t)NMEMW * DM * 2 <= WS_HMIX && WS_HMIX + (size_t)M * DM * 2 <= WS_ACT &&
              WS_ACT + (size_t)M * NA * 2 <= WS_KDT && WS_KDT + (size_t)2048 * 192 * 64 * 2 <= WS_VT && WS_VT + (size_t)2048 * 384 * 64 * 2 <= WS_OG && WS_OG + (size_t)M * 1536 * 2 <= WS_END &&
              WS_KSVS + (size_t)M * 3072 * 2 <= WS_END && WS_MKVF + (size_t)MROWS * NMEMW * 4 <= WS_MK && WS_MEMB + (size_t)MROWS * DM * 2 <= WS_MKVF, "d_ws map");
constexpr int CW_TMO = 0, CW_BAR = 4096;
constexpr int RING_BYTES = 131072, LDSCTL_OFF = RING_BYTES, MISC_OFF = LDSCTL_OFF + 320, LDS_BYTES = 147456;

#define GAS __attribute__((address_space(1)))
#define LAS __attribute__((address_space(3)))
typedef unsigned short bf16;
typedef unsigned v4u __attribute__((ext_vector_type(4)));
typedef float f32x4 __attribute__((ext_vector_type(4)));
typedef float f32x16 __attribute__((ext_vector_type(16)));
typedef short bf16x8 __attribute__((ext_vector_type(8)));
typedef GAS unsigned gu32;
#define RLX_AGENT __ATOMIC_RELAXED, __HIP_MEMORY_SCOPE_AGENT
#define LDS_WAIT() asm volatile("s_waitcnt lgkmcnt(0)" ::: "memory")
using pg8::pkbf;
__device__ __forceinline__ float bf_lo(unsigned w) { return __uint_as_float(w << 16); }
__device__ __forceinline__ float bf_hi(unsigned w) { return __uint_as_float(w & 0xffff0000u); }
__device__ __forceinline__ float bf2f(bf16 b) { return __uint_as_float(((unsigned)b) << 16); }
__device__ __forceinline__ float logsig(float x) { return fminf(x, 0.f) - __logf(1.0f + __expf(-fabsf(x))); }
#define XCH1(v)  __uint_as_float((unsigned)__builtin_amdgcn_update_dpp(0, (int)__float_as_uint(v), 0xB1, 0xF, 0xF, true))
#define XCH2(v)  __uint_as_float((unsigned)__builtin_amdgcn_update_dpp(0, (int)__float_as_uint(v), 0x4E, 0xF, 0xF, true))
#define XCH4(v)  __uint_as_float((unsigned)__builtin_amdgcn_ds_swizzle((int)__float_as_uint(v), (4 << 10) | 0x1f))
#define XCH8(v)  __uint_as_float((unsigned)__builtin_amdgcn_ds_swizzle((int)__float_as_uint(v), (8 << 10) | 0x1f))
#define XCH16(v) __uint_as_float((unsigned)__builtin_amdgcn_ds_swizzle((int)__float_as_uint(v), (16 << 10) | 0x1f))
__device__ __forceinline__ float wave_sum(float v) {
    v += XCH1(v); v += XCH2(v); v += XCH4(v); v += XCH8(v); v += XCH16(v);
    const auto rr = __builtin_amdgcn_permlane32_swap(__float_as_uint(v), __float_as_uint(v), false, false);
    return __uint_as_float(rr[0]) + __uint_as_float(rr[1]);
}
__device__ __forceinline__ int launder_s(int v) { asm volatile("" : "+s"(v)); return v; }

#define XB_TMO      128
#define XB_XCNT(j)  (256  + 64 * (j))
#define XB_XSUB(j)  (1280 + 64 * (j))
#define XB_XGEN(j)  (2304 + 64 * (j))
#define XB_TOP      3328
#define XB_TOPGEN   3392
#define XCD_BAR_WORDS 3456
#define XB_SPIN_CAP (1u << 18)
__device__ __forceinline__ unsigned xb_ld(unsigned* p)              { return __hip_atomic_load(p, __ATOMIC_RELAXED, __HIP_MEMORY_SCOPE_AGENT); }
__device__ __forceinline__ unsigned xb_add(unsigned* p, unsigned v) { return __hip_atomic_fetch_add(p, v, __ATOMIC_RELAXED, __HIP_MEMORY_SCOPE_AGENT); }
__device__ __forceinline__ unsigned xb_xcc_id() { return (unsigned)__builtin_amdgcn_s_getreg((3 << 11) | 20) & 0xFu; }
#define XB_SPIN(cond, bar) do { unsigned _sp = 0; while (cond) { __builtin_amdgcn_s_sleep(1); \
    if ((++_sp & 255u) == 0u) { if (xb_ld(&(bar)[XB_TMO])) break; if (_sp > XB_SPIN_CAP) { atomicAdd(&(bar)[XB_TMO], 1u); break; } } } } while (0)
struct XcdBarrier { unsigned* bar; unsigned x; volatile LAS unsigned* st; int wave; };
__device__ __forceinline__ XcdBarrier xcd_barrier_post(unsigned* bar, volatile LAS unsigned* st, int wave) {
    XcdBarrier b; b.bar = bar; b.x = xb_xcc_id(); b.st = st; b.wave = wave;
    if (threadIdx.x == 0) (void)xb_add(&bar[XB_XCNT(b.x)], 1u);
    return b;
}
__device__ __forceinline__ void xcd_barrier_complete(unsigned* bar, unsigned x, unsigned& nloc, unsigned& nx) {
    const unsigned G = gridDim.x * gridDim.y * gridDim.z;
    unsigned sum, cnt, mine, sp = 0u;
    for (;;) {
        sum = 0u; cnt = 0u; mine = 0u;
#pragma unroll
        for (unsigned j = 0; j < 16; ++j) { const unsigned c = xb_ld(&bar[XB_XCNT(j)]); sum += c; cnt += (c > 0u) ? 1u : 0u; mine = (j == x) ? c : mine; }
        if (sum == G) break;
        __builtin_amdgcn_s_sleep(1);
        if ((++sp & 255u) == 0u) { if (xb_ld(&bar[XB_TMO])) break; if (sp > XB_SPIN_CAP) { atomicAdd(&bar[XB_TMO], 1u); break; } }
    }
    nloc = mine > 0u ? mine : 1u; nx = cnt > 0u ? cnt : 1u;
}
__device__ __forceinline__ void xcd_barrier(const XcdBarrier& b) {
    asm volatile("s_waitcnt vmcnt(0)" ::: "memory");
    __syncthreads();
    if (b.wave == 0 && lane_id_v() == 0) {
        unsigned* bar = b.bar;
        __builtin_amdgcn_s_waitcnt(0);
        unsigned nloc = b.st[0], nx = b.st[1];
        if (nloc == 0u) { xcd_barrier_complete(bar, b.x, nloc, nx); b.st[0] = nloc; b.st[1] = nx; }
        const unsigned old = xb_add(&bar[XB_XSUB(b.x)], 1u);
        const unsigned gen = old / nloc;
        if (old + 1u == (gen + 1u) * nloc) {
            __builtin_amdgcn_fence(__ATOMIC_RELEASE, "agent");
            asm volatile("s_waitcnt vmcnt(0)" ::: "memory");
            const unsigned og = xb_add(&bar[XB_TOP], 1u);
            const unsigned tg = og / nx;
            if (og + 1u == (tg + 1u) * nx) xb_add(&bar[XB_TOPGEN], 1u);
            else XB_SPIN(xb_ld(&bar[XB_TOPGEN]) == tg, bar);
            __builtin_amdgcn_fence(__ATOMIC_ACQUIRE, "agent");
            xb_add(&bar[XB_XGEN(b.x)], 1u);
            asm volatile("s_waitcnt vmcnt(0)" ::: "memory");
        } else {
            XB_SPIN(xb_ld(&bar[XB_XGEN(b.x)]) == gen, bar);
            __builtin_amdgcn_fence(__ATOMIC_ACQUIRE, "agent");
            asm volatile("s_waitcnt vmcnt(0)" ::: "memory");
        }
    }
    __syncthreads();
}

__device__ __forceinline__ const float* ldp(volatile LAS unsigned* T, int k) { const unsigned lo = __builtin_amdgcn_readfirstlane(T[2 * k]), hi = __builtin_amdgcn_readfirstlane(T[2 * k + 1]); return (const float*)(const GAS float*)(((unsigned long long)hi << 32) | lo); }
__device__ __forceinline__ int launder(int v) { asm volatile("" : "+v"(v)); return v; }
__device__ __forceinline__ int lane_id() { return lane_id_v(); }
__device__ __forceinline__ void cvt_item(const float* W, int ldw, int srccol, const float* gain, float scale, bf16* Bt, int K, int dstrow, int k0, LAS float* scr, int lane) {
#pragma unroll 8
    for (int i = 0; i < 32; ++i) { const int kk = 2 * i + (lane >> 5); const float g = gain ? gain[k0 + kk] * scale : scale;
        scr[kk * 33 + (lane & 31)] = W[(size_t)(k0 + kk) * ldw + srccol + (lane & 31)] * g; }
    LDS_WAIT();
    const int c = lane & 7;
#pragma unroll
    for (int j = 0; j < 4; ++j) { const int n = (lane >> 3) + 8 * j; const LAS float* s = scr + (8 * c) * 33 + n;
        v4u o; o.x = pkbf(s[0 * 33], s[1 * 33]); o.y = pkbf(s[2 * 33], s[3 * 33]); o.z = pkbf(s[4 * 33], s[5 * 33]); o.w = pkbf(s[6 * 33], s[7 * 33]);
        *(v4u*)(Bt + (size_t)(dstrow + n) * K + k0 + 8 * c) = o; }
    LDS_WAIT();
}
__device__ __forceinline__ void rms_row_to_bf16(const float* xrow, bf16* orow, int lane) {
    const f32x4* xr = (const f32x4*)xrow + lane;
    f32x4 v[8]; float s = 0.f;
#pragma unroll
    for (int j = 0; j < 8; ++j) { v[j] = xr[64 * j]; s += (v[j].x * v[j].x + v[j].y * v[j].y) + (v[j].z * v[j].z + v[j].w * v[j].w); }
    const float rinv = 1.0f / sqrtf(wave_sum(s) * (1.0f / DM) + EPS);
    unsigned long long* o8 = (unsigned long long*)orow + lane;
#pragma unroll
    for (int j = 0; j < 8; ++j) o8[64 * j] = (unsigned long long)pkbf(v[j].x * rinv, v[j].y * rinv) | ((unsigned long long)pkbf(v[j].z * rinv, v[j].w * rinv) << 32);
}
struct InPtrs { const float *x, *mem, *ffn_norm, *w1, *w3, *w2, *mix_norm, *mem_norm, *w_mem_kv, *mem_q_norm, *mem_k_norm, *w_out, *a_w_in, *a_w_gate_up, *a_b_gate, *a_out_norm, *b_w_in, *b_q_norm, *kv_norm, *w_kv, *b_f, *k_norm; };

__device__ __forceinline__ void convert_phase(volatile LAS unsigned* PT, unsigned char* ws, LAS unsigned char* lds, int gw, int NGW, int lane, int wave) {
    InPtrs I;
    I.x = ldp(PT, 0); I.mem = ldp(PT, 1); I.ffn_norm = ldp(PT, 2); I.w1 = ldp(PT, 3); I.w3 = ldp(PT, 4); I.w2 = ldp(PT, 5); I.mix_norm = ldp(PT, 6); I.mem_norm = ldp(PT, 7);
    I.w_mem_kv = ldp(PT, 8); I.mem_q_norm = ldp(PT, 9); I.mem_k_norm = ldp(PT, 10); I.w_out = ldp(PT, 11); I.a_w_in = ldp(PT, 12); I.a_w_gate_up = ldp(PT, 13); I.a_b_gate = ldp(PT, 14);
    I.a_out_norm = ldp(PT, 15); I.b_w_in = ldp(PT, 16); I.b_q_norm = ldp(PT, 17); I.kv_norm = ldp(PT, 18); I.w_kv = ldp(PT, 19); I.b_f = ldp(PT, 20); I.k_norm = ldp(PT, 21);
    LAS float* scr = (LAS float*)(lds + wave * 16384);
    bf16* WUP = (bf16*)(ws + WS_WUP); bf16* WDN = (bf16*)(ws + WS_WDN); bf16* WAIN = (bf16*)(ws + WS_WAIN); bf16* WBIN = (bf16*)(ws + WS_WBIN);
    bf16* WOUT = (bf16*)(ws + WS_WOUT); bf16* WKV = (bf16*)(ws + WS_WKV); bf16* WMEM = (bf16*)(ws + WS_WMEM);
    constexpr int IT_W1 = 8 * 32 * 176, IT_W2 = 8 * 88 * 64, IT_A = 2 * 32 * 160, IT_B = 2 * 32 * 112, IT_O = 4 * 32 * 64, IT_KV = 32 * 96, IT_MEM = 4 * 32 * 32;
    constexpr int IT_TOTAL = 2 * IT_W1 + IT_W2 + IT_A + IT_B + IT_O + IT_KV + IT_MEM;
    for (int it = gw; it < IT_TOTAL; it += NGW) {
        int r = it;
        if (r < 2 * IT_W1) { const int which = r / IT_W1; r -= which * IT_W1; const int mat = r / (32 * 176); r -= mat * (32 * 176); const int kb = r / 176, nb = r % 176; const int j0 = 32 * nb;
            cvt_item((which ? I.w3 : I.w1) + (size_t)mat * DM * FF, FF, j0, I.ffn_norm + mat * DM, 1.f, WUP + (size_t)mat * NUP * DM, DM, 256 * (j0 / 128) + which * 128 + (j0 % 128), 64 * kb, scr, lane); continue; }
        r -= 2 * IT_W1;
        if (r < IT_W2) { const int mat = r / (88 * 64); r -= mat * (88 * 64); const int kb = r / 64, nb = r % 64;
            cvt_item(I.w2 + (size_t)mat * FF * DM, DM, 32 * nb, nullptr, 1.f, WDN + (size_t)mat * DM * FF, FF, 32 * nb, 64 * kb, scr, lane); continue; }
        r -= IT_W2;
        if (r < IT_A) { const int l = r / (32 * 160); r -= l * (32 * 160); const int kb = r / 160, nb = r % 160; const int n0 = 32 * nb;
            cvt_item(I.a_w_in + (size_t)l * DM * 5136, 5136, n0 < 3072 ? n0 : n0 + 16, I.mix_norm + l * DM, n0 < 768 ? 0.07216878364870322f : 1.f, WAIN + (size_t)l * NA * DM, DM, n0, 64 * kb, scr, lane); continue; }
        r -= IT_A;
        if (r < IT_B) { const int j = r / (32 * 112); r -= j * (32 * 112); const int kb = r / 112, nb = r % 112;
            cvt_item(I.b_w_in + (size_t)j * DM * NB, NB, 32 * nb, I.mix_norm + (2 + j) * DM, 1.f, WBIN + (size_t)j * NB * DM, DM, 32 * nb, 64 * kb, scr, lane); continue; }
        r -= IT_B;
        if (r < IT_O) { const int l = r / (32 * 64); r -= l * (32 * 64); const int kb = r / 64, nb = r % 64;
            cvt_item(I.w_out + (size_t)l * DM * DM, DM, 32 * nb, nullptr, 1.f, WOUT + (size_t)l * DM * DM, DM, 32 * nb, 64 * kb, scr, lane); continue; }
        r -= IT_O;
        if (r < IT_KV) { const int kb = r / 96, nb = r % 96;
            cvt_item(I.w_kv, 3084, 32 * nb, I.kv_norm, 1.f, WKV, DM, 32 * nb, 64 * kb, scr, lane); continue; }
        r -= IT_KV;
        { const int l = r / (32 * 32); r -= l * (32 * 32); const int kb = r / 32, nb = r % 32;
            cvt_item(I.w_mem_kv + (size_t)l * DM * 1024, 1024, 32 * nb, I.mem_norm + l * DM, 1.f, WMEM, DM, l * 1024 + 32 * nb, 64 * kb, scr, lane); }
    }
    const int gtid = gw * 64 + lane, NT = NGW * 64;
    for (int idx = gtid; idx < 2 * 768 * 256; idx += NT) { const int l = idx / (768 * 256); const int rem = idx - l * (768 * 256); const int n = rem >> 8, k0 = (rem & 255) * 8;
        float a[8];
#pragma unroll
        for (int j = 0; j < 8; ++j) a[j] = 0.f;
        const float* win = I.a_w_in + (size_t)l * DM * 5136 + (size_t)k0 * 5136 + 3072; const float* wg = I.a_w_gate_up + (size_t)l * 16 * 768 + n;
#pragma unroll
        for (int rr = 0; rr < 16; ++rr) { const float g = wg[rr * 768];
#pragma unroll
            for (int j = 0; j < 8; ++j) a[j] += win[(size_t)j * 5136 + rr] * g; }
        const float* gn = I.mix_norm + l * DM + k0;
        v4u o; o.x = pkbf(a[0] * gn[0], a[1] * gn[1]); o.y = pkbf(a[2] * gn[2], a[3] * gn[3]); o.z = pkbf(a[4] * gn[4], a[5] * gn[5]); o.w = pkbf(a[6] * gn[6], a[7] * gn[7]);
        *(v4u*)(WAIN + (size_t)l * NA * DM + (size_t)(A_GATE + n) * DM + k0) = o; }
    for (int idx = gtid; idx < 256 * 256; idx += NT) { const int n = idx >> 8, k0 = (idx & 255) * 8;
        float a[8];
#pragma unroll
        for (int j = 0; j < 8; ++j) a[j] = (n < 12) ? I.w_kv[(size_t)(k0 + j) * 3084 + 3072 + n] * I.kv_norm[k0 + j] : 0.f;
        v4u o; o.x = pkbf(a[0], a[1]); o.y = pkbf(a[2], a[3]); o.z = pkbf(a[4], a[5]); o.w = pkbf(a[6], a[7]);
        *(v4u*)(WKV + (size_t)(3072 + n) * DM + k0) = o; }
    for (int m = gw; m < MROWS; m += NGW) rms_row_to_bf16(I.mem + (size_t)m * DM, (bf16*)(ws + WS_MEMB) + (size_t)m * DM, lane);
}
__device__ __forceinline__ void hn_pass(bf16* buf, int pitch, int col0, int nheads, const float* gain, int gw, int NGW, int lane) {
    const int l16 = lane & 15; const int ntask4 = M * nheads / 4;
    f32x4 g0 = *(const f32x4*)(gain + 8 * l16), g1 = *(const f32x4*)(gain + 8 * l16 + 4);
    for (int t4 = gw; t4 < ntask4; t4 += NGW) { const int t = t4 * 4 + (lane >> 4); const int row = t / nheads, hh = t - row * nheads;
        bf16* p = buf + (size_t)row * pitch + col0 + hh * 128 + 8 * l16;
        const v4u w = *(const v4u*)p;
        float x[8] = {bf_lo(w.x), bf_hi(w.x), bf_lo(w.y), bf_hi(w.y), bf_lo(w.z), bf_hi(w.z), bf_lo(w.w), bf_hi(w.w)};
        float ss = 0.f;
#pragma unroll
        for (int e = 0; e < 8; ++e) ss += x[e] * x[e];
        ss += XCH1(ss); ss += XCH2(ss); ss += XCH4(ss); ss += XCH8(ss);
        const float rinv = 1.0f / sqrtf(ss * (1.0f / 128.f) + EPS);
        v4u o; o.x = pkbf(x[0] * rinv * g0[0], x[1] * rinv * g0[1]); o.y = pkbf(x[2] * rinv * g0[2], x[3] * rinv * g0[3]);
        o.z = pkbf(x[4] * rinv * g1[0], x[5] * rinv * g1[1]); o.w = pkbf(x[6] * rinv * g1[2], x[7] * rinv * g1[3]);
        *(v4u*)p = o; }
}
__device__ __forceinline__ void mkmv_pass(const float* MKVF, bf16* MK, bf16* MV, const float* mem_k_norm, int gw, int NGW, int lane) {
    const int l16 = lane & 15;
    for (int t4 = gw; t4 < MROWS * 32 / 4; t4 += NGW) { const int t = t4 * 4 + (lane >> 4); const int row = t >> 5, rem = t & 31; const int l = rem >> 3, kv = (rem >> 2) & 1, hh = rem & 3;
        const float* src = MKVF + (size_t)row * NMEMW + l * 1024 + kv * 512 + hh * 128 + 8 * l16;
        const f32x4 a = *(const f32x4*)src, b = *(const f32x4*)(src + 4);
        float ss = (a.x * a.x + a.y * a.y) + (a.z * a.z + a.w * a.w) + (b.x * b.x + b.y * b.y) + (b.z * b.z + b.w * b.w);
        ss += XCH1(ss); ss += XCH2(ss); ss += XCH4(ss); ss += XCH8(ss);
        const float rinv = kv ? 1.0f : 1.0f / sqrtf(ss * (1.0f / 128.f) + EPS);
        f32x4 g0 = {1.f, 1.f, 1.f, 1.f}, g1 = {1.f, 1.f, 1.f, 1.f};
        if (!kv) { g0 = *(const f32x4*)(mem_k_norm + l * 128 + 8 * l16); g1 = *(const f32x4*)(mem_k_norm + l * 128 + 8 * l16 + 4); }
        v4u o; o.x = pkbf(a.x * rinv * g0[0], a.y * rinv * g0[1]); o.y = pkbf(a.z * rinv * g0[2], a.w * rinv * g0[3]);
        o.z = pkbf(b.x * rinv * g1[0], b.y * rinv * g1[1]); o.w = pkbf(b.z * rinv * g1[2], b.w * rinv * g1[3]);
        *(v4u*)((kv ? MV : MK) + ((size_t)l * MROWS + row) * 512 + hh * 128 + 8 * l16) = o; }
}
__device__ __forceinline__ void gla_prep(const bf16* PROJ, const float* b_gate  , bf16* KDT, bf16* VT, float* ACH, int gw, int NGW, int lane) {
    for (int t = gw; t < 2048; t += NGW) {
        const int b = t >> 8, c = (t >> 2) & 63, h = t & 3; const int ci = (b * 4 + h) * 64 + c;
        const bf16* P = PROJ + ((size_t)b * SEQ + c * 64) * NA;
        for (int cg = 0; cg < 3; ++cg) { const int d = cg * 64 + lane;
            const float bias = b_gate[h * 192 + d];
            const bf16* pg = P + A_GATE + h * 192 + d; const bf16* pk = P + A_K + h * 192 + d;
            float cum[64]; float run = 0.f;
#pragma unroll
            for (int j = 0; j < 64; ++j) { const float gp = bf2f(pg[(size_t)j * NA]) + bias; run += logsig(gp) * (1.0f / 16.0f); cum[j] = run; }
            ACH[ci * 192 + d] = __expf(run);
            bf16* dst = KDT + ((size_t)ci * 192 + d) * 64;
#pragma unroll
            for (int j8 = 0; j8 < 8; ++j8) { float kd[8];
#pragma unroll
                for (int e = 0; e < 8; ++e) { const int j = 8 * j8 + e; kd[e] = bf2f(pk[(size_t)j * NA]) * __expf(run - cum[j]); }
                v4u o; o.x = pkbf(kd[0], kd[1]); o.y = pkbf(kd[2], kd[3]); o.z = pkbf(kd[4], kd[5]); o.w = pkbf(kd[6], kd[7]);
                *(v4u*)(dst + 8 * j8) = o; } }
        for (int cg = 0; cg < 6; ++cg) { const int dv = cg * 64 + lane; const bf16* pv = P + A_V + h * 384 + dv; bf16* dst = VT + ((size_t)ci * 384 + dv) * 64;
#pragma unroll
            for (int j8 = 0; j8 < 8; ++j8) { unsigned r[8];
#pragma unroll
                for (int e = 0; e < 8; ++e) r[e] = pv[(size_t)(8 * j8 + e) * NA];
                v4u o; o.x = r[0] | (r[1] << 16); o.y = r[2] | (r[3] << 16); o.z = r[4] | (r[5] << 16); o.w = r[6] | (r[7] << 16);
                *(v4u*)(dst + 8 * j8) = o; } }
    }
}
__device__ __forceinline__ void gla_scan(const bf16* PROJ, const bf16* KDT, const bf16* VT, const float* ACH, bf16* OG, int vcu, int G, int wave, int lane) {
    const int r = lane & 31, hi = lane >> 5;
    for (int u = wave * G + vcu; u < 384; u += NWAVES * G) {
        const int bh = u / 12, n32 = u - bh * 12, b = bh >> 2, h = bh & 3;
        f32x16 S[6];
#pragma unroll
        for (int mt = 0; mt < 6; ++mt)
#pragma unroll
            for (int i = 0; i < 16; ++i) S[mt][i] = 0.f;
        for (int c = 0; c < 64; ++c) { const int ci = bh * 64 + c; const size_t t0 = (size_t)b * SEQ + c * 64;
            const bf16* kd = KDT + (size_t)ci * 192 * 64; const bf16* vt = VT + ((size_t)ci * 384 + n32 * 32) * 64; const float* ac = ACH + ci * 192;
            bf16x8 vb[4];
#pragma unroll
            for (int s = 0; s < 4; ++s) vb[s] = *(const bf16x8*)(vt + (size_t)r * 64 + 16 * s + 8 * hi);
#pragma unroll
            for (int mt = 0; mt < 6; ++mt) {
#pragma unroll
                for (int i4 = 0; i4 < 4; ++i4) { const f32x4 a4 = *(const f32x4*)(ac + 32 * mt + 8 * i4 + 4 * hi);
#pragma unroll
                    for (int e = 0; e < 4; ++e) S[mt][4 * i4 + e] *= a4[e]; }
#pragma unroll
                for (int s = 0; s < 4; ++s) { const bf16x8 ka = *(const bf16x8*)(kd + (size_t)(32 * mt + r) * 64 + 16 * s + 8 * hi);
                    S[mt] = __builtin_amdgcn_mfma_f32_32x32x16_bf16(ka, vb[s], S[mt], 0, 0, 0); } }
            f32x16 o0, o1;
#pragma unroll
            for (int i = 0; i < 16; ++i) { o0[i] = 0.f; o1[i] = 0.f; }
            const bf16* q0 = PROJ + (t0 + r) * NA + A_Q + h * 192; const bf16* q1 = q0 + (size_t)32 * NA;
#pragma unroll
            for (int mt = 0; mt < 6; ++mt)
#pragma unroll
                for (int s = 0; s < 2; ++s) {
                    v4u xw; xw.x = pkbf(S[mt][8 * s + 0], S[mt][8 * s + 1]); xw.y = pkbf(S[mt][8 * s + 2], S[mt][8 * s + 3]); xw.z = pkbf(S[mt][8 * s + 4], S[mt][8 * s + 5]); xw.w = pkbf(S[mt][8 * s + 6], S[mt][8 * s + 7]);
                    const bf16x8 xs = __builtin_bit_cast(bf16x8, xw);
                    const int dk0 = 32 * mt + 16 * s + 4 * hi;
                    const uint2 a0 = *(const uint2*)(q0 + dk0), a1 = *(const uint2*)(q0 + dk0 + 8), c0 = *(const uint2*)(q1 + dk0), c1 = *(const uint2*)(q1 + dk0 + 8);
                    v4u qa = {a0.x, a0.y, a1.x, a1.y}, qc = {c0.x, c0.y, c1.x, c1.y};
                    o0 = __builtin_amdgcn_mfma_f32_32x32x16_bf16(__builtin_bit_cast(bf16x8, qa), xs, o0, 0, 0, 0);
                    o1 = __builtin_amdgcn_mfma_f32_32x32x16_bf16(__builtin_bit_cast(bf16x8, qc), xs, o1, 0, 0, 0); }
            bf16* og = OG + t0 * 1536 + h * 384 + n32 * 32 + r;
#pragma unroll
            for (int i = 0; i < 16; ++i) { const int row = (i & 3) + 8 * (i >> 2) + 4 * hi;
                const float v0 = o0[i], v1 = o1[i]; const float n0 = XCH1(v0), n1 = XCH1(v1);
                if ((r & 1) == 0) { *(unsigned*)(og + (size_t)row * 1536) = pkbf(v0, n0); *(unsigned*)(og + (size_t)(32 + row) * 1536) = pkbf(v1, n1); } }
        }
    }
}
__device__ __forceinline__ void gla_post(const bf16* OG, const bf16* PROJ, const float* onorm  , bf16* MIX, int gw, int NGW, int lane) {
    const int la = lane < 48 ? lane : 0;
    const f32x4 g0 = *(const f32x4*)(onorm + 8 * la), g1 = *(const f32x4*)(onorm + 8 * la + 4);
    for (int t = gw; t < M * 4; t += NGW) { const int row = t >> 2, h = t & 3;
        v4u w = {0u, 0u, 0u, 0u}, gw4 = {0u, 0u, 0u, 0u};
        if (lane < 48) { w = *(const v4u*)(OG + (size_t)row * 1536 + h * 384 + 8 * lane); gw4 = *(const v4u*)(PROJ + (size_t)row * NA + A_G + h * 384 + 8 * lane); }
        float x[8] = {bf_lo(w.x), bf_hi(w.x), bf_lo(w.y), bf_hi(w.y), bf_lo(w.z), bf_hi(w.z), bf_lo(w.w), bf_hi(w.w)};
        float g[8] = {bf_lo(gw4.x), bf_hi(gw4.x), bf_lo(gw4.y), bf_hi(gw4.y), bf_lo(gw4.z), bf_hi(gw4.z), bf_lo(gw4.w), bf_hi(gw4.w)};
        float ss = 0.f;
#pragma unroll
        for (int e = 0; e < 8; ++e) ss += x[e] * x[e];
        const float rinv = 1.0f / sqrtf(wave_sum(ss) * (1.0f / 384.f) + EPS);
        float y[8];
#pragma unroll
        for (int e = 0; e < 8; ++e) y[e] = x[e] * rinv * (e < 4 ? g0[e] : g1[e - 4]) * pg8::silu_f(g[e]);
        if (lane < 48) { v4u o; o.x = pkbf(y[0], y[1]); o.y = pkbf(y[2], y[3]); o.z = pkbf(y[4], y[5]); o.w = pkbf(y[6], y[7]);
            *(v4u*)(MIX + (size_t)row * DM + h * 384 + 8 * lane) = o; } }
}
__device__ __forceinline__ void fox_cumsum(const float* F, const float* b_f, float* CB, int gw, int NGW, int lane) {
    for (int t = gw; t < BATCH * 12; t += NGW) { const int b = t / 12, h = t - b * 12; const float bf = b_f[h];
        const float* src = F + ((size_t)b * SEQ + lane * 64) * 16 + h;
        float v[64]; float run = 0.f;
#pragma unroll
        for (int j = 0; j < 64; ++j) { run += logsig(src[(size_t)j * 16] + bf); v[j] = run; }
        float incl = run;
#pragma unroll
        for (int o = 1; o < 64; o <<= 1) { const float y = __uint_as_float((unsigned)__builtin_amdgcn_ds_bpermute((lane - o) << 2, (int)__float_as_uint(incl))); if (lane >= o) incl += y; }
        const float excl = incl - run;
        float* dst = CB + (size_t)t * SEQ + lane * 64;
#pragma unroll
        for (int j = 0; j < 64; ++j) dst[j] = -(excl + v[j]) * 11.313708498984761f; }
}
struct AttCfg { const bf16* PROJ; const bf16* KSVS; const float* CB; const bf16* MK; const bf16* MV; bf16* MIX; int np, qmcol, fox, vcu, G; };
__device__ __forceinline__ fa::BlockRef att_ref(const AttCfg& c, int idx, int nf) {
    fa::BlockRef r;
    if (idx < nf) { const int L = c.vcu + c.G * (idx >> 1); const int bh = L >> 3, x = L & 7; const int qb = (idx & 1) ? 15 - x : x; const int b = bh / 12, h = bh - b * 12;
        const size_t row0 = (size_t)b * SEQ + qb * 256;
        r.Q = c.PROJ + row0 * c.np + B_Q + h * 128; r.G = c.PROJ + row0 * c.np + B_G + h * 128; r.K = c.KSVS + (size_t)b * SEQ * 3072 + h * 128; r.V = r.K + 1536; r.O = c.MIX + row0 * DM + h * 128;
        r.CB = c.CB + (size_t)bh * SEQ; r.P0 = qb * 256; r.skv = SEQ; r.qp = c.np; r.kp = 3072; }
    else { const int mb = c.vcu + c.G * (idx - nf); const int rb = mb >> 2, mh = mb & 3; const int b = rb >> 4; const size_t row0 = (size_t)rb * 256;
        r.Q = c.PROJ + row0 * c.np + c.qmcol + mh * 128; r.G = nullptr; r.K = c.MK + (size_t)b * MEMT * 512 + mh * 128; r.V = c.MV + (size_t)b * MEMT * 512 + mh * 128; r.O = c.MIX + row0 * DM + 1536 + mh * 128;
        r.CB = nullptr; r.P0 = 256; r.skv = MEMT; r.qp = c.np; r.kp = 512; }
    return r;
}
__device__ __forceinline__ void att_phase(const AttCfg& c, char* lds, int wave) {
    const int nfi = (c.fox && c.vcu < 768) ? (768 - c.vcu + c.G - 1) / c.G : 0, nf = 2 * nfi;
    const int nm = c.vcu < 512 ? (512 - c.vcu + c.G - 1) / c.G : 0;
    const int nblk = nf + nm;
    if (nblk == 0) return;
    fa::BlockRef cur = att_ref(c, 0, nf); fa::Seam S;
    fa::attn_prime(cur, lds, S, wave);
    for (int i = 0; i < nblk; ++i) {
        const fa::BlockRef nxt = (i + 1 < nblk) ? att_ref(c, i + 1, nf) : cur;
        fa::attn_block(cur, nxt, lds, S, wave);
        cur = nxt;
    }
}

struct Args { const float* in[22]; float* out; unsigned char* ws; int lo, hi; };
constexpr int PT_OUT = 22, PT_WS = 23;
#define PTR(k) ldp(PT, (k))
__global__ void __launch_bounds__(NWAVES * 64, 2) mega_fwd(Args args) {
    extern __shared__ __attribute__((aligned(16))) unsigned char lds_raw[];
    LAS unsigned char* lds = (LAS unsigned char*)lds_raw;
    volatile LAS unsigned* MISC = (volatile LAS unsigned*)(lds + MISC_OFF);
    volatile LAS unsigned* PT = (volatile LAS unsigned*)(lds + MISC_OFF + 128);
    const int wave = __builtin_amdgcn_readfirstlane((int)threadIdx.x >> 6);
    const int G = gridDim.x; const int bx = blockIdx.x; const int vcu = (G % 8 == 0) ? (bx % 8) * (G / 8) + bx / 8 : bx;
    const int gw = vcu * NWAVES + wave, NGW = G * NWAVES;
    for (int u = threadIdx.x; u < (LDS_BYTES - LDSCTL_OFF) / 4; u += NWAVES * 64) ((LAS unsigned*)(lds + LDSCTL_OFF))[u] = 0u;
    __syncthreads();
    if (threadIdx.x == 0) {
#pragma unroll
        for (int k = 0; k < 22; ++k) { const unsigned long long p = (unsigned long long)args.in[k]; PT[2 * k] = (unsigned)p; PT[2 * k + 1] = (unsigned)(p >> 32); }
        { const unsigned long long p = (unsigned long long)args.out; PT[2 * PT_OUT] = (unsigned)p; PT[2 * PT_OUT + 1] = (unsigned)(p >> 32); }
        { const unsigned long long p = (unsigned long long)args.ws; PT[2 * PT_WS] = (unsigned)p; PT[2 * PT_WS + 1] = (unsigned)(p >> 32); }
    }
    __syncthreads();
    const int lo = args.lo, hi = args.hi < MK_STOP_PC ? args.hi : MK_STOP_PC;
    const bool use_bar = (args.hi - args.lo) > 1;
    XcdBarrier bar; bar.bar = (unsigned*)((unsigned char*)PTR(PT_WS) + WS_CTL) + CW_BAR; bar.x = 0; bar.st = MISC + 8; bar.wave = wave;
    if (use_bar) bar = xcd_barrier_post(bar.bar, MISC + 8, wave);

    int pc = 0;
#define PH_ON (pc >= lo && pc < hi)
#define PH_END do { if (use_bar && pc >= lo && pc + 1 < hi) { XcdBarrier bb; bb.bar = (unsigned*)((unsigned char*)PTR(PT_WS) + WS_CTL) + CW_BAR; bb.x = bar.x; bb.st = MISC + 8; bb.wave = wave; xcd_barrier(bb); } ++pc; } while (0)
#define WSP ((unsigned char*)PTR(PT_WS))
#define PH_BEGIN if (PH_ON) { const int lane = lane_id(); const int gwp = launder_s(gw), vcup = launder_s(vcu), bxp = launder_s(bx), wavep = launder_s(wave); unsigned char* ws = WSP; (void)lane; (void)gwp; (void)vcup; (void)bxp; (void)wavep;
#define XOUT ((float*)PTR(PT_OUT))

    PH_BEGIN
#ifndef DBG_NO_CVT
        convert_phase(PT, ws, lds, gwp, NGW, lane, wavep);
#endif
    }
    PH_END;
    PH_BEGIN pg8::Gemm g{(const bf16*)(ws + WS_MEMB), (const bf16*)(ws + WS_WMEM), MROWS, NMEMW, DM}; pg8::StaticOrder S; S.init(MROWS, NMEMW, G, bxp);
        pg8::EpiF32 E{(float*)(ws + WS_MKVF), NMEMW};
        pg8::gemm_phase<pg8::EpiF32, pg8::StaticOrder, true, true>(lds, g, S, E, wavep); }
    PH_END;

    for (int l = 0; l < DEPTH; ++l) {
        for (int sub = 0; sub < 2; ++sub) {
            const int mat = l * 2 + sub;
            PH_BEGIN const float* xin = (l == 0 && sub == 0) ? PTR(0) : (const float*)XOUT; bf16* HMIX = (bf16*)(ws + WS_HMIX);
                for (int m = gwp; m < M; m += NGW) rms_row_to_bf16(xin + (size_t)m * DM, HMIX + (size_t)m * DM, lane);
                if (l == 0 && sub == 0) mkmv_pass((const float*)(ws + WS_MKVF), (bf16*)(ws + WS_MK), (bf16*)(ws + WS_MV), PTR(10), gwp, NGW, lane); }
            PH_END;
            if (l == 2 && sub == 0) {
                PH_BEGIN pg8::Gemm g{(const bf16*)(ws + WS_HMIX), (const bf16*)(ws + WS_WKV), M, NKV, DM}; pg8::StaticOrder S; S.init(M, NKV, G, bxp);
                    pg8::EpiKV E{(bf16*)(ws + WS_KSVS), 3072, (float*)(ws + WS_F)};
                    pg8::gemm_phase<pg8::EpiKV, pg8::StaticOrder, true, true>(lds, g, S, E, wavep); }
                PH_END;
                PH_BEGIN hn_pass((bf16*)(ws + WS_KSVS), 3072, 0, 12, PTR(21), gwp, NGW, lane);
#ifndef DBG_NO_CUM
                    fox_cumsum((const float*)(ws + WS_F), PTR(20), (float*)(ws + WS_CB), gwp, NGW, lane);
#endif
                    }
                PH_END;
            }
            PH_BEGIN pg8::Gemm g{(const bf16*)(ws + WS_HMIX), (const bf16*)(ws + WS_WUP) + (size_t)mat * NUP * DM, M, NUP, DM}; pg8::StaticOrder S; S.init(M, NUP, G, bxp);
                pg8::EpiSwiGLU E{(bf16*)(ws + WS_ACT), FF};
                pg8::gemm_phase<pg8::EpiSwiGLU, pg8::StaticOrder, true, true>(lds, g, S, E, wavep); }
            PH_END;
            PH_BEGIN pg8::Gemm g{(const bf16*)(ws + WS_ACT), (const bf16*)(ws + WS_WDN) + (size_t)mat * DM * FF, M, DM, FF}; pg8::StaticOrder S; S.init(M, DM, G, bxp);
                float* X = XOUT; const float* xin = (l == 0 && sub == 0) ? PTR(0) : (const float*)X;
                pg8::EpiResAdd E{xin, X, DM, 0.5f};
                pg8::gemm_phase<pg8::EpiResAdd, pg8::StaticOrder, true, true>(lds, g, S, E, wavep); }
            PH_END;
            if (sub == 0) {
                const int np = l < 2 ? NA : NB;
                PH_BEGIN const float* X = XOUT; bf16* HMIX = (bf16*)(ws + WS_HMIX);
                    for (int m = gwp; m < M; m += NGW) rms_row_to_bf16(X + (size_t)m * DM, HMIX + (size_t)m * DM, lane); }
                PH_END;
                PH_BEGIN const bf16* wt = l < 2 ? (const bf16*)(ws + WS_WAIN) + (size_t)l * NA * DM : (const bf16*)(ws + WS_WBIN) + (size_t)(l - 2) * NB * DM;
                    pg8::Gemm g{(const bf16*)(ws + WS_HMIX), wt, M, np, DM}; pg8::StaticOrder S; S.init(M, np, G, bxp);
                    pg8::EpiB16 E{(bf16*)(ws + WS_ACT), np};
                    pg8::gemm_phase<pg8::EpiB16, pg8::StaticOrder, true, true>(lds, g, S, E, wavep); }
                PH_END;
                if (l < 2) {
                    PH_BEGIN
#ifndef DBG_NO_PREP
                        gla_prep((const bf16*)(ws + WS_ACT), PTR(14) + l * 768, (bf16*)(ws + WS_KDT), (bf16*)(ws + WS_VT), (float*)(ws + WS_ACH), gwp, NGW, lane);
#endif
                        hn_pass((bf16*)(ws + WS_ACT), NA, A_QM, 4, PTR(9) + l * 128, gwp, NGW, lane); }
                    PH_END;
                    PH_BEGIN
#ifndef DBG_NO_SCAN
                        gla_scan((const bf16*)(ws + WS_ACT), (const bf16*)(ws + WS_KDT), (const bf16*)(ws + WS_VT), (const float*)(ws + WS_ACH), (bf16*)(ws + WS_OG), vcup, G, wavep, lane);
#endif
                    }
                    PH_END;
                } else {
                    PH_BEGIN
                        hn_pass((bf16*)(ws + WS_ACT), NB, B_Q, 12, PTR(17) + (l - 2) * 128, gwp, NGW, lane); hn_pass((bf16*)(ws + WS_ACT), NB, B_QM, 4, PTR(9) + l * 128, gwp, NGW, lane); }
                    PH_END;
                }
                PH_BEGIN
                    if (l < 2) gla_post((const bf16*)(ws + WS_OG), (const bf16*)(ws + WS_ACT), PTR(15) + l * 384, (bf16*)(ws + WS_HMIX), gwp, NGW, lane);
                    AttCfg c; c.PROJ = (const bf16*)(ws + WS_ACT); c.KSVS = (const bf16*)(ws + WS_KSVS); c.CB = (const float*)(ws + WS_CB); c.MK = (const bf16*)(ws + WS_MK) + (size_t)l * MROWS * 512; c.MV = (const bf16*)(ws + WS_MV) + (size_t)l * MROWS * 512;
                    c.MIX = (bf16*)(ws + WS_HMIX); c.np = np; c.qmcol = l < 2 ? A_QM : B_QM; c.fox = l >= 2; c.vcu = vcup; c.G = G;
                    __syncthreads();
#ifndef DBG_NO_ATT
                    att_phase(c, (char*)lds_raw, wavep);
#endif
                    }
                PH_END;
                PH_BEGIN pg8::Gemm g{(const bf16*)(ws + WS_HMIX), (const bf16*)(ws + WS_WOUT) + (size_t)l * DM * DM, M, DM, DM}; pg8::StaticOrder S; S.init(M, DM, G, bxp);
                    float* X = XOUT;
                    pg8::EpiResAdd E{X, X, DM, 1.0f};
                    pg8::gemm_phase<pg8::EpiResAdd, pg8::StaticOrder, true, true>(lds, g, S, E, wavep); }
                PH_END;
            }
        }
    }
#undef PH_ON
#undef PH_END
#undef WSP
#undef PH_BEGIN
#undef XOUT
}

extern "C" void kernel_launch(void* const* d_in, const int* in_sizes, int n_in, void* d_out, int out_size, void* d_ws, size_t ws_size, hipStream_t stream) {
    static int grid = 0;
    if (grid == 0) {
        if (n_in != 22 || in_sizes[0] != M * DM || out_size != M * DM || ws_size < WS_END) { fprintf(stderr, "kernel_launch: unexpected shapes (n_in %d, in0 %d, out %d, ws %zu < %zu); nothing launched\n", n_in, n_in > 0 ? in_sizes[0] : -1, out_size, ws_size, (size_t)WS_END); grid = -1; return; }
        int dev = 0, cus = 0, per_cu = 0;
        if (hipGetDevice(&dev) != hipSuccess || hipDeviceGetAttribute(&cus, hipDeviceAttributeMultiprocessorCount, dev) != hipSuccess) { fprintf(stderr, "kernel_launch: device query failed\n"); grid = -1; return; }
        if (hipFuncSetAttribute((const void*)mega_fwd, hipFuncAttributeMaxDynamicSharedMemorySize, LDS_BYTES) != hipSuccess) { fprintf(stderr, "kernel_launch: hipFuncSetAttribute failed\n"); grid = -1; return; }
        if (hipOccupancyMaxActiveBlocksPerMultiprocessor(&per_cu, (const void*)mega_fwd, NWAVES * 64, LDS_BYTES) != hipSuccess || per_cu < 1)
            fprintf(stderr, "kernel_launch: note: occupancy query reports %d workgroups per CU\n", per_cu);
        (void)hipGetLastError();
        grid = cus;
    }
    if (grid < 0) return;
    (void)hipMemsetAsync((char*)d_ws + WS_CTL, 0, CTL_ZERO_BYTES, stream);
    Args a{};
    for (int i = 0; i < 22; ++i) a.in[i] = (const float*)d_in[i];
    a.out = (float*)d_out; a.ws = (unsigned char*)d_ws;
#if MK_PER_PHASE
    for (int p = 0; p < NPH && p < MK_STOP_PC; ++p) { a.lo = p; a.hi = p + 1; hipLaunchKernelGGL(mega_fwd, dim3(grid), dim3(NWAVES * 64), LDS_BYTES, stream, a); }
#else
    a.lo = 0; a.hi = NPH; hipLaunchKernelGGL(mega_fwd, dim3(grid), dim3(NWAVES * 64), LDS_BYTES, stream, a);
#endif
}
```

```cpp
#include <hip/hip_runtime.h>
#include <cstdio>
#include <cstdint>
__device__ __forceinline__ int lane_id_v() { int l; asm volatile("v_mbcnt_lo_u32_b32 %0, -1, 0\n\tv_mbcnt_hi_u32_b32 %0, -1, %0" : "=v"(l)); return l; }
namespace pg8 {
#define PG8_LAS __attribute__((address_space(3)))
typedef unsigned short bf16_t;
typedef short bf16x8 __attribute__((ext_vector_type(8)));
typedef float f32x4 __attribute__((ext_vector_type(4)));
typedef unsigned u32x4 __attribute__((ext_vector_type(4)));
constexpr int BM = 256, BK = 64, HALF = 128, HTB = HALF * BK * 2  , STAGE_BYTES = 8 * HTB, NXCD = 8, WGM = 8;

__host__ __device__ __forceinline__ int lds_byte(int r, int c) { const int st = (r >> 4) * 2 + (c >> 5), rr = r & 15, cc = c & 31, ob = rr * 64 + cc * 2; return st * 1024 + (ob ^ (((ob >> 9) & 1) << 5)); }
__host__ __device__ __forceinline__ void stage_rc(int b, int& R, int& C) { const int st = b / 1024, sb = b % 1024, swz = sb ^ (((sb >> 9) & 1) << 5); R = (st >> 1) * 16 + swz / 64; C = (st & 1) * 32 + (swz % 64) / 2; }
__host__ __device__ __forceinline__ int perm32(int rho) { const int n = rho >> 4, i = rho & 15; return 8 * (i >> 2) + 4 * n + (i & 3); }

struct Unit { int pm, pn; };
struct Gemm { const bf16_t* A; const bf16_t* Bt; int M, N, K; };

struct StaticOrder {
    int nM, nN, nwg, G, c;
    __host__ __device__ void init(int M, int N, int G_, int c_) { nM = M / BM; nN = N / BM; nwg = nM * nN; G = G_; c = c_; }
    __host__ __device__ bool next(int i, Unit& u) const {
        const long L = (long)i * G + c; if (L >= nwg) return false;
        int wgid = (int)L; { const int q = nwg / NXCD, r = nwg % NXCD, xcd = wgid % NXCD, off = wgid / NXCD; wgid = (xcd < r ? xcd * (q + 1) : r * (q + 1) + (xcd - r) * q) + off; }
        const int nig = WGM * nN, gid = wgid / nig, fm = gid * WGM, gsz = (nM - fm) < WGM ? (nM - fm) : WGM;
        u.pm = fm + ((wgid % nig) % gsz); u.pn = (wgid % nig) / gsz; return true;
    }
    __device__ __forceinline__ void a_ready(const Unit&) const {}
    __device__ __forceinline__ void done(const Unit&) const {}
};

__device__ __forceinline__ unsigned cvt_pk_bf16(float lo, float hi) { unsigned r; asm volatile("v_cvt_pk_bf16_f32 %0, %1, %2" : "=v"(r) : "v"(lo), "v"(hi)); return r; }
typedef float f32x2 __attribute__((ext_vector_type(2)));
__device__ __forceinline__ f32x2 gelu_pk(f32x2 v) {
    const f32x2 av = __builtin_elementwise_abs(v), d = av * 0.2316418882f + 1.0f;
    f32x2 t; t.x = __builtin_amdgcn_rcpf(d.x); t.y = __builtin_amdgcn_rcpf(d.y);
    f32x2 q = t * 0.5307027145f + (-0.7265760135f); q = q * t + 0.7107068705f; q = q * t + (-0.142248368f); q = q * t + 0.127414796f; q = q * t;
    const f32x2 s = (v * v) * (-0.72134752044f);
    f32x2 e; e.x = __builtin_amdgcn_exp2f(s.x); e.y = __builtin_amdgcn_exp2f(s.y);
    const f32x2 m = v * (q * e), r = v - m;
    f32x2 o; o.x = v.x < 0.f ? m.x : r.x; o.y = v.y < 0.f ? m.y : r.y; return o;
}

template <int ACT  > struct EpiBf16 {
    static constexpr bool PERM = true, AFTER_DRAIN = false; static_assert(ACT == 0 || ACT == 1, "EpiBf16: ACT is 0 (none) or 1 (gelu_pk)");
    bf16_t* O; int ldc; const float* bias; int split_cols; size_t split_stride; float scale0;
    __device__ __forceinline__ void operator()(const f32x4 (&acc)[2][2][4][2], const Unit& u, int wr, int wc, int fr, int fq) const {
        const int row0 = u.pm * BM + wr * 64 + fr; int colt = u.pn * BM; bf16_t* base = O;
        float sc = 1.f; if (split_cols) { const int t = colt / split_cols; base += (size_t)t * split_stride; colt -= t * split_cols; if (t == 0) sc = scale0; }
        const int col0 = colt + wc * 32 + 8 * fq, bcol0 = u.pn * BM + wc * 32 + 8 * fq;
        f32x4 bv[2][2];
#pragma unroll
        for (int bj = 0; bj < 2; ++bj)
#pragma unroll
            for (int n = 0; n < 2; ++n) bv[bj][n] = bias ? *(const f32x4*)(bias + bcol0 + bj * HALF + 4 * n) : (f32x4){0.f, 0.f, 0.f, 0.f};
#pragma unroll
        for (int ai = 0; ai < 2; ++ai)
#pragma unroll
            for (int m = 0; m < 4; ++m) { bf16_t* rowp = base + (size_t)(row0 + ai * HALF + m * 16) * ldc + col0;
#pragma unroll
                for (int bj = 0; bj < 2; ++bj) { f32x4 v0 = acc[ai][bj][m][0] + bv[bj][0], v1 = acc[ai][bj][m][1] + bv[bj][1];
                    if (ACT == 1) { f32x2 a = gelu_pk((f32x2){v0[0], v0[1]}), b = gelu_pk((f32x2){v0[2], v0[3]}), c = gelu_pk((f32x2){v1[0], v1[1]}), d = gelu_pk((f32x2){v1[2], v1[3]});
                        v0 = (f32x4){a.x, a.y, b.x, b.y}; v1 = (f32x4){c.x, c.y, d.x, d.y}; }
                    v0 = v0 * sc; v1 = v1 * sc; u32x4 w; w.x = cvt_pk_bf16(v0[0], v0[1]); w.y = cvt_pk_bf16(v0[2], v0[3]); w.z = cvt_pk_bf16(v1[0], v1[1]); w.w = cvt_pk_bf16(v1[2], v1[3]);
                    *(u32x4*)(rowp + bj * HALF) = w; } }
    }
};

__device__ __forceinline__ unsigned pkbf(float lo, float hi) {
    typedef __bf16 bf2_t __attribute__((ext_vector_type(2))); typedef float fl2_t __attribute__((ext_vector_type(2)));
    fl2_t v = {lo, hi}; bf2_t r = __builtin_convertvector(v, bf2_t); return __builtin_bit_cast(unsigned, r);
}
__device__ __forceinline__ float silu_f(float x) { return x * __builtin_amdgcn_rcpf(1.0f + __builtin_amdgcn_exp2f(-1.4426950408889634f * x)); }

__device__ __forceinline__ float rinv_of(const float* ss, int row) { const float s = (float)((const unsigned long long*)ss)[row] * (1.0f / 16777216.0f); return 1.0f / sqrtf(s * (1.0f / 2048.f) + 1e-6f); }
struct RinvCache {
    const float* ss; PG8_LAS float* tab; mutable int pm_cached;
    __device__ __forceinline__ void get(float (&ri)[2][4], const Unit& u, int wr, int wc, int fr) const {
        PG8_LAS float* t = tab + (wr * 4 + wc) * 128;
        if (u.pm != pm_cached) { pm_cached = u.pm; const int l = lane_id_v();
            t[l] = rinv_of(ss, u.pm * BM + wr * 64 + l); t[64 + l] = rinv_of(ss, u.pm * BM + HALF + wr * 64 + l);
            asm volatile("s_waitcnt lgkmcnt(0)" ::: "memory"); }
#pragma unroll
        for (int ai = 0; ai < 2; ++ai)
#pragma unroll
            for (int m = 0; m < 4; ++m) ri[ai][m] = t[ai * 64 + m * 16 + fr];
    }
};
struct EpiSwiGLU {
    static constexpr bool PERM = true, AFTER_DRAIN = false;
    bf16_t* O; int ldc; RinvCache rc;
    __device__ __forceinline__ void operator()(const f32x4 (&acc)[2][2][4][2], const Unit& u, int wr, int wc, int fr, int fq) const {
        const int row0 = u.pm * BM + wr * 64 + fr, col0 = u.pn * HALF + wc * 32 + 8 * fq;
        float rit[2][4]; rc.get(rit, u, wr, wc, fr);
#pragma unroll
        for (int ai = 0; ai < 2; ++ai)
#pragma unroll
            for (int m = 0; m < 4; ++m) { bf16_t* rowp = O + (size_t)(row0 + ai * HALF + m * 16) * ldc + col0;
                const float ri = rit[ai][m];
                const f32x4 g0 = acc[ai][0][m][0] * ri, g1 = acc[ai][0][m][1] * ri, u0 = acc[ai][1][m][0] * ri, u1 = acc[ai][1][m][1] * ri;
                u32x4 w;
                w.x = pkbf(silu_f(g0[0]) * u0[0], silu_f(g0[1]) * u0[1]); w.y = pkbf(silu_f(g0[2]) * u0[2], silu_f(g0[3]) * u0[3]);
                w.z = pkbf(silu_f(g1[0]) * u1[0], silu_f(g1[1]) * u1[1]); w.w = pkbf(silu_f(g1[2]) * u1[2], silu_f(g1[3]) * u1[3]);
                *(u32x4*)rowp = w; }
    }
};
typedef unsigned u32x2 __attribute__((ext_vector_type(2)));
struct EpiResAdd {
    static constexpr bool PERM = true, AFTER_DRAIN = false;
    volatile PG8_LAS unsigned* PT; int slot_out, slot_ws; size_t xb_off, ss_off; int ldc; float scale;
    __device__ __forceinline__ void operator()(const f32x4 (&acc)[2][2][4][2], const Unit& u, int wr, int wc, int fr, int fq) const {
        typedef __attribute__((address_space(1))) unsigned char gchar;
        float* out = (float*)(gchar*)(((unsigned long long)__builtin_amdgcn_readfirstlane(PT[2 * slot_out + 1]) << 32) | (unsigned)__builtin_amdgcn_readfirstlane(PT[2 * slot_out]));
        unsigned char* ws = (unsigned char*)(gchar*)(((unsigned long long)__builtin_amdgcn_readfirstlane(PT[2 * slot_ws + 1]) << 32) | (unsigned)__builtin_amdgcn_readfirstlane(PT[2 * slot_ws]));
        const float* base = out; bf16_t* xb = (bf16_t*)(ws + xb_off); float* ss = (float*)(ws + ss_off);
        const int row0 = u.pm * BM + wr * 64 + fr, col0 = u.pn * BM + wc * 32 + 8 * fq;
#pragma unroll
        for (int ai = 0; ai < 2; ++ai) {
            f32x4 b[4][2][2];
#pragma unroll
            for (int m = 0; m < 4; ++m) { const size_t off = (size_t)(row0 + ai * HALF + m * 16) * ldc + col0;
#pragma unroll
                for (int bj = 0; bj < 2; ++bj)
#pragma unroll
                    for (int n = 0; n < 2; ++n) b[m][bj][n] = *(const f32x4*)(base + off + bj * HALF + n * 4); }
#pragma unroll
            for (int m = 0; m < 4; ++m) { const size_t off = (size_t)(row0 + ai * HALF + m * 16) * ldc + col0; float q = 0.f;
#pragma unroll
                for (int bj = 0; bj < 2; ++bj) { const f32x4 x0 = b[m][bj][0] + acc[ai][bj][m][0] * scale, x1 = b[m][bj][1] + acc[ai][bj][m][1] * scale;
                    *(f32x4*)(out + off + bj * HALF) = x0; *(f32x4*)(out + off + bj * HALF + 4) = x1;
                    q += ((x0[0] * x0[0] + x0[1] * x0[1]) + (x0[2] * x0[2] + x0[3] * x0[3])) + ((x1[0] * x1[0] + x1[1] * x1[1]) + (x1[2] * x1[2] + x1[3] * x1[3]));
                    u32x4 w; w.x = pkbf(x0[0], x0[1]); w.y = pkbf(x0[2], x0[3]); w.z = pkbf(x1[0], x1[1]); w.w = pkbf(x1[2], x1[3]); *(u32x4*)(xb + off + bj * HALF) = w; }
                {
                    q += __uint_as_float((unsigned)__builtin_amdgcn_ds_swizzle((int)__float_as_uint(q), (16 << 10) | 0x1f));
                    const auto rr = __builtin_amdgcn_permlane32_swap(__float_as_uint(q), __float_as_uint(q), false, false);
                    q = __uint_as_float(rr[0]) + __uint_as_float(rr[1]);
                    if (fq == 0) atomicAdd((unsigned long long*)ss + row0 + ai * HALF + m * 16, (unsigned long long)(q * 16777216.0f)); } }
            asm volatile("" ::: "memory"); }
    }
};
struct EpiF32 {
    static constexpr bool PERM = false, AFTER_DRAIN = false;
    float* C; int ldc;
    __device__ __forceinline__ void operator()(const f32x4 (&acc)[2][2][4][2], const Unit& u, int wr, int wc, int fr, int fq) const {
        const int row0 = u.pm * BM + wr * 64 + fr, col0 = u.pn * BM + wc * 32 + 4 * fq;
#pragma unroll
        for (int ai = 0; ai < 2; ++ai)
#pragma unroll
            for (int m = 0; m < 4; ++m) { float* rowp = C + (size_t)(row0 + ai * HALF + m * 16) * ldc + col0;
#pragma unroll
                for (int bj = 0; bj < 2; ++bj)
#pragma unroll
                    for (int n = 0; n < 2; ++n) *(f32x4*)(rowp + bj * HALF + n * 16) = acc[ai][bj][m][n]; }
    }
};
struct EpiB16 {
    static constexpr bool PERM = true, AFTER_DRAIN = false;
    bf16_t* O; int ldc; RinvCache rc;
    __device__ __forceinline__ void operator()(const f32x4 (&acc)[2][2][4][2], const Unit& u, int wr, int wc, int fr, int fq) const {
        const int row0 = u.pm * BM + wr * 64 + fr, col0 = u.pn * BM + wc * 32 + 8 * fq;
        float rit[2][4]; rc.get(rit, u, wr, wc, fr);
#pragma unroll
        for (int ai = 0; ai < 2; ++ai)
#pragma unroll
            for (int m = 0; m < 4; ++m) { bf16_t* rowp = O + (size_t)(row0 + ai * HALF + m * 16) * ldc + col0; const float ri = rit[ai][m];
#pragma unroll
                for (int bj = 0; bj < 2; ++bj) { const f32x4 v0 = acc[ai][bj][m][0] * ri, v1 = acc[ai][bj][m][1] * ri;
                    u32x4 w; w.x = pkbf(v0[0], v0[1]); w.y = pkbf(v0[2], v0[3]); w.z = pkbf(v1[0], v1[1]); w.w = pkbf(v1[2], v1[3]);
                    *(u32x4*)(rowp + bj * HALF) = w; } }
    }
};
struct EpiKV {
    static constexpr bool PERM = true, AFTER_DRAIN = false;
    bf16_t* O; int ldc; float* F; RinvCache rc;
    __device__ __forceinline__ void operator()(const f32x4 (&acc)[2][2][4][2], const Unit& u, int wr, int wc, int fr, int fq) const {
        const int row0 = u.pm * BM + wr * 64 + fr;
        float rit[2][4]; rc.get(rit, u, wr, wc, fr);
        if (u.pn < 12) {
            const int col0 = u.pn * BM + wc * 32 + 8 * fq;
#pragma unroll
            for (int ai = 0; ai < 2; ++ai)
#pragma unroll
                for (int m = 0; m < 4; ++m) { bf16_t* rowp = O + (size_t)(row0 + ai * HALF + m * 16) * ldc + col0; const float ri = rit[ai][m];
#pragma unroll
                    for (int bj = 0; bj < 2; ++bj) { const f32x4 v0 = acc[ai][bj][m][0] * ri, v1 = acc[ai][bj][m][1] * ri;
                        u32x4 w; w.x = pkbf(v0[0], v0[1]); w.y = pkbf(v0[2], v0[3]); w.z = pkbf(v1[0], v1[1]); w.w = pkbf(v1[2], v1[3]);
                        *(u32x4*)(rowp + bj * HALF) = w; } }
        } else if (wc == 0 && fq < 2) {
#pragma unroll
            for (int ai = 0; ai < 2; ++ai)
#pragma unroll
                for (int m = 0; m < 4; ++m) { float* rowp = F + (size_t)(row0 + ai * HALF + m * 16) * 16 + 8 * fq; const float ri = rit[ai][m];
                    *(f32x4*)(rowp) = acc[ai][0][m][0] * ri; *(f32x4*)(rowp + 4) = acc[ai][0][m][1] * ri; }
        }
    }
};
template <class Epi, class Sched, bool ALIGN_EPI = false, bool SP2 = false>
__device__ __forceinline__ void gemm_phase(PG8_LAS unsigned char* lds, const Gemm g, const Sched& S, const Epi E, const int wave_in) {
    const int tid_l = wave_in * 64 + lane_id_v();
    const int tid = tid_l, wid = wave_in, lane = tid & 63, wr = wid >> 2, wc = wid & 3, fr = lane & 15, fq = lane >> 4;
    const int K = g.K, nt = K / BK;
    unsigned voffA[2], voffB[2];
#pragma unroll
    for (int i = 0; i < 2; ++i) { int R, C; stage_rc(tid * 16 + i * 8192, R, C); const int Rb = Epi::PERM ? ((R & ~31) + perm32(R & 31)) : R;
        voffA[i] = (unsigned)(R * K + C) * 2u; voffB[i] = (unsigned)(Rb * K + C) * 2u; }
    const size_t kstep = (size_t)(BK * 2);
    const size_t hstep = (size_t)HALF * K * 2;
    const size_t tstep = 2 * hstep;
    const unsigned ldsw = (unsigned)wid * 1024u;
    const int aoff = lds_byte(wr * 64 + fr, fq * 8), boff = lds_byte(wc * 32 + fr, fq * 8);
#define PG8_SA(b, h) (((b) * 2 + (h)) * HTB)
#define PG8_SB(b, h) ((4 + (b) * 2 + (h)) * HTB)
#define PG8_STAGE(bufoff, gbase, voff) do { _Pragma("unroll") for (int _i = 0; _i < 2; ++_i) \
        __builtin_amdgcn_global_load_lds((const unsigned*)((const char*)(gbase) + (voff)[_i]), (PG8_LAS unsigned*)(lds + (bufoff) + ldsw + _i * 8192), 16, 0, 0); } while (0)
#define PG8_LDA(dst, b, h) do { _Pragma("unroll") for (int m = 0; m < 4; ++m) _Pragma("unroll") for (int k = 0; k < 2; ++k) dst[m][k] = *(const PG8_LAS bf16x8*)(lds + PG8_SA(b, h) + aoff + m * 2048 + k * 1024); } while (0)
#define PG8_LDB(dst, b, h) do { _Pragma("unroll") for (int n = 0; n < 2; ++n) _Pragma("unroll") for (int k = 0; k < 2; ++k) dst[n][k] = *(const PG8_LAS bf16x8*)(lds + PG8_SB(b, h) + boff + n * 2048 + k * 1024); } while (0)
#define PG8_MMA(ai, bj, At, Bt) do { __builtin_amdgcn_s_setprio(1); _Pragma("unroll") for (int m = 0; m < 4; ++m) _Pragma("unroll") for (int n = 0; n < 2; ++n) _Pragma("unroll") for (int k = 0; k < 2; ++k) \
        acc[ai][bj][m][n] = __builtin_amdgcn_mfma_f32_16x16x32_bf16(Bt[n][k], At[m][k], acc[ai][bj][m][n], 0, 0, 0); __builtin_amdgcn_s_setprio(0); } while (0)
#define PG8_WAIT_V(n) asm volatile("s_waitcnt vmcnt(" #n ")" ::: "memory")
#define PG8_WAIT_L(n) asm volatile("s_waitcnt lgkmcnt(" #n ")" ::: "memory")
#define PG8_BAR __builtin_amdgcn_s_barrier()
#define PG8_SCHED __builtin_amdgcn_sched_barrier(0)
    Unit cur, nxt; int ui = 0;
    if (!S.next(0, cur)) return;
    f32x4 acc[2][2][4][2];
#pragma unroll
    for (int a = 0; a < 2; ++a)
#pragma unroll
        for (int b = 0; b < 2; ++b)
#pragma unroll
            for (int m = 0; m < 4; ++m)
#pragma unroll
                for (int n = 0; n < 2; ++n) acc[a][b][m][n] = (f32x4){0.f, 0.f, 0.f, 0.f};
    bf16x8 At[4][2], B0[2][2], B1[2][2];
    const char* cA = (const char*)g.A + (size_t)cur.pm * tstep; const char* cB = (const char*)g.Bt + (size_t)cur.pn * tstep;
    S.a_ready(cur);
    if constexpr (SP2) {
        PG8_STAGE(PG8_SB(0, 0), cB, voffB); PG8_STAGE(PG8_SB(0, 1), cB + hstep, voffB); PG8_STAGE(PG8_SA(0, 0), cA, voffA); PG8_STAGE(PG8_SA(0, 1), cA + hstep, voffA);
        if (wr == 1) PG8_BAR;
        PG8_WAIT_V(2); PG8_BAR;
        PG8_STAGE(PG8_SB(1, 0), cB + kstep, voffB); PG8_STAGE(PG8_SA(1, 0), cA + kstep, voffA); PG8_STAGE(PG8_SB(1, 1), cB + hstep + kstep, voffB);
        PG8_WAIT_V(6); PG8_BAR;
    } else {
        PG8_STAGE(PG8_SB(0, 0), cB, voffB); PG8_STAGE(PG8_SA(0, 0), cA, voffA); PG8_STAGE(PG8_SB(0, 1), cB + hstep, voffB); PG8_STAGE(PG8_SA(0, 1), cA + hstep, voffA);
        if (wr == 1) PG8_BAR;
        PG8_WAIT_V(4); PG8_BAR;
        PG8_STAGE(PG8_SB(1, 0), cB + kstep, voffB); PG8_STAGE(PG8_SA(1, 0), cA + kstep, voffA); PG8_STAGE(PG8_SB(1, 1), cB + hstep + kstep, voffB);
        PG8_WAIT_V(6); PG8_BAR;
    }
    for (;;) {
        const bool has_next = S.next(ui + 1, nxt);
        const char* nA = has_next ? (const char*)g.A + (size_t)nxt.pm * tstep : cA; const char* nB = has_next ? (const char*)g.Bt + (size_t)nxt.pn * tstep : cB;
        for (int t = 0; t < nt; t += 2) {
            const bool last = (t == nt - 2);
            const char* a1 = cA + (size_t)(t + 1) * kstep;
            const char* a2 = last ? nA : cA + (size_t)(t + 2) * kstep; const char* b2 = last ? nB : cB + (size_t)(t + 2) * kstep;
            const char* a3 = a2 + kstep; const char* b3 = b2 + kstep;
            if (last && has_next) S.a_ready(nxt);
            if constexpr (SP2) {
            PG8_LDB(B0, 0, 0); PG8_LDB(B1, 0, 1); PG8_SCHED; PG8_LDA(At, 0, 0); PG8_STAGE(PG8_SA(1, 1), a1 + hstep, voffA);
            PG8_WAIT_V(8); PG8_WAIT_L(0); PG8_BAR; PG8_MMA(0, 0, At, B0); PG8_MMA(0, 1, At, B1); PG8_BAR; PG8_SCHED;
            PG8_LDA(At, 0, 1); PG8_STAGE(PG8_SB(0, 0), b2, voffB); PG8_STAGE(PG8_SB(0, 1), b2 + hstep, voffB); PG8_STAGE(PG8_SA(0, 0), a2, voffA);
            PG8_WAIT_V(8); PG8_WAIT_L(0); PG8_BAR; PG8_MMA(1, 0, At, B0); PG8_MMA(1, 1, At, B1); PG8_BAR; PG8_SCHED;
            PG8_LDB(B0, 1, 0); PG8_LDB(B1, 1, 1); PG8_SCHED; PG8_LDA(At, 1, 0); PG8_STAGE(PG8_SA(0, 1), a2 + hstep, voffA);
            PG8_WAIT_V(8); PG8_WAIT_L(0); PG8_BAR; PG8_MMA(0, 0, At, B0); PG8_MMA(0, 1, At, B1); PG8_BAR; PG8_SCHED;
            PG8_LDA(At, 1, 1); PG8_STAGE(PG8_SB(1, 0), b3, voffB); PG8_STAGE(PG8_SB(1, 1), b3 + hstep, voffB); PG8_STAGE(PG8_SA(1, 0), a3, voffA);
            PG8_WAIT_V(8); PG8_WAIT_L(0); PG8_BAR; PG8_MMA(1, 0, At, B0); PG8_MMA(1, 1, At, B1); PG8_BAR; PG8_SCHED;
            } else {
            PG8_LDB(B0, 0, 0); PG8_SCHED; PG8_LDA(At, 0, 0); PG8_STAGE(PG8_SA(1, 1), a1 + hstep, voffA);
            PG8_WAIT_L(8); PG8_BAR; PG8_WAIT_L(0); PG8_MMA(0, 0, At, B0); PG8_BAR; PG8_SCHED;
            PG8_LDB(B1, 0, 1); PG8_STAGE(PG8_SB(0, 0), b2, voffB);
            PG8_BAR; PG8_WAIT_L(0); PG8_MMA(0, 1, At, B1); PG8_BAR;
            PG8_LDA(At, 0, 1); PG8_STAGE(PG8_SA(0, 0), a2, voffA);
            PG8_BAR; PG8_WAIT_L(0); PG8_MMA(1, 0, At, B0); PG8_BAR; PG8_SCHED;
            PG8_STAGE(PG8_SB(0, 1), b2 + hstep, voffB);
            PG8_WAIT_V(6); PG8_BAR; PG8_MMA(1, 1, At, B1); PG8_BAR;
            PG8_LDB(B0, 1, 0); PG8_SCHED; PG8_LDA(At, 1, 0); PG8_STAGE(PG8_SA(0, 1), a2 + hstep, voffA);
            PG8_WAIT_L(8); PG8_BAR; PG8_WAIT_L(0); PG8_MMA(0, 0, At, B0); PG8_BAR; PG8_SCHED;
            PG8_LDB(B1, 1, 1); PG8_STAGE(PG8_SB(1, 0), b3, voffB);
            PG8_BAR; PG8_WAIT_L(0); PG8_MMA(0, 1, At, B1); PG8_BAR;
            PG8_LDA(At, 1, 1); PG8_STAGE(PG8_SA(1, 0), a3, voffA);
            PG8_BAR; PG8_WAIT_L(0); PG8_MMA(1, 0, At, B0); PG8_BAR; PG8_SCHED;
            PG8_STAGE(PG8_SB(1, 1), b3 + hstep, voffB);
            PG8_WAIT_V(6); PG8_BAR; PG8_MMA(1, 1, At, B1); PG8_BAR;
            }
        }
        if constexpr (ALIGN_EPI) { if (wr == 0) PG8_BAR; }
        if constexpr (!Epi::AFTER_DRAIN) { E(acc, cur, wr, wc, fr, fq); S.done(cur); }
        if (!has_next) break;
#pragma unroll
        for (int a = 0; a < 2; ++a)
#pragma unroll
            for (int b = 0; b < 2; ++b)
#pragma unroll
                for (int m = 0; m < 4; ++m)
#pragma unroll
                    for (int n = 0; n < 2; ++n) acc[a][b][m][n] = (f32x4){0.f, 0.f, 0.f, 0.f};
        cur = nxt; cA = nA; cB = nB; ++ui;
        if constexpr (ALIGN_EPI) { if (wr == 1) PG8_BAR; }
    }
    PG8_WAIT_V(0);
    if constexpr (!ALIGN_EPI) { if (wr == 0) PG8_BAR; }
    PG8_BAR;
    if constexpr (Epi::AFTER_DRAIN) { E.fused(acc, cur, wr, wc, fr, fq, lds, wid, lane); S.done(cur); }
#undef PG8_SA
#undef PG8_SB
#undef PG8_STAGE
#undef PG8_LDA
#undef PG8_LDB
#undef PG8_MMA
#undef PG8_WAIT_V
#undef PG8_WAIT_L
#undef PG8_BAR
#undef PG8_SCHED
}
}

namespace fa {
constexpr float SCALE = 0.08838834764831845f;
constexpr int D = 128, NW = 8, QBLK = 32, KVBLK = 64, QB = NW * QBLK;
constexpr int SHM_V = KVBLK * D * 2, SHM_K = KVBLK * D * 2;
constexpr int LDS_BYTES = 2 * SHM_V + 2 * SHM_K + NW * 64 * 4;
constexpr float THR = 8.f;
constexpr int OP = 2048;
typedef unsigned short bf16;
typedef short bf16x8 __attribute__((ext_vector_type(8)));
typedef short s16x4 __attribute__((ext_vector_type(4)));
typedef float f32x16 __attribute__((ext_vector_type(16)));
typedef float f32x4 __attribute__((ext_vector_type(4)));
typedef unsigned u32x4 __attribute__((ext_vector_type(4)));

#define KSWZ(row, colB) ((row) * 256 + ((colB) ^ (((row) & 7) << 4)))
#define SBAR() __builtin_amdgcn_sched_barrier(0)
__device__ __forceinline__ int v_st(int k, int c) { const int kk = (k & ~0xC) | ((k & 4) << 1) | ((k & 8) >> 1); return ((kk >> 3) * 4 + (c >> 5)) * 512 + ((kk & 7) * 32 + (c & 31)) * 2; }
__device__ __forceinline__ int v_rd_base(int lane) { return ((lane & 3) << 3) | (((lane >> 2) & 3) << 6) | (((lane >> 4) & 1) << 5) | (((lane >> 5) & 1) << 8); }
constexpr int v_rd_off(int d0, int ks, int half) { return d0 * 512 + ks * 4096 + half * 2048; }
__device__ __forceinline__ int crow(int r, int hi) { return (r & 3) + 8 * (r >> 2) + 4 * hi; }
__device__ __forceinline__ unsigned cvtpk(float lo, float hi) {
    unsigned r; asm volatile("v_cvt_pk_bf16_f32 %0, %1, %2" : "=v"(r) : "v"(lo), "v"(hi)); return r;
}
__device__ __forceinline__ bf16x8 load8(const bf16* p) { return *reinterpret_cast<const bf16x8*>(p); }
__device__ __forceinline__ bf16x8 cb_frag(float c, int hi) {
    const unsigned u1 = __float_as_uint(c) & 0xffff0000u; const float r1 = c - __uint_as_float(u1);
    const unsigned v1 = __float_as_uint(r1) & 0xffff0000u; const float r2 = r1 - __uint_as_float(v1);
    const unsigned w1 = __float_as_uint(r2) & 0xffff0000u;
    u32x4 w = {hi ? 0u : ((u1 >> 16) | v1), hi ? 0u : (w1 >> 16), 0u, 0u};
    return *reinterpret_cast<bf16x8*>(&w);
}
__device__ __forceinline__ int hi_opaque() { return lane_id_v() >> 5; }
__device__ __forceinline__ bf16x8 ones_frag(int hi) { u32x4 w = {hi ? 0u : 0x3F803F80u, hi ? 0u : 0x00003F80u, 0u, 0u}; return *reinterpret_cast<bf16x8*>(&w); }
__device__ __forceinline__ void mask_tile(f32x16& p0, f32x16& p1, int dq, unsigned W) {
    const float NEG = -__builtin_inff();
#pragma unroll
    for (int r = 0; r < 16; ++r) {
        const int c = (r & 3) + 8 * (r >> 2);
        if ((unsigned)(dq - c) >= W) p0[r] = NEG;
        if ((unsigned)(dq - c - 32) >= W) p1[r] = NEG;
    }
}
__device__ __forceinline__ void partialSM(f32x16& p0, f32x16& p1, float& m_reg, float& mn, float& alpha) {
    float pmax = p0[0]; for (int r = 1; r < 16; ++r) pmax = fmaxf(pmax, p0[r]); for (int r = 0; r < 16; ++r) pmax = fmaxf(pmax, p1[r]);
    { auto rr = __builtin_amdgcn_permlane32_swap(__float_as_uint(pmax), __float_as_uint(pmax), false, false);
      pmax = fmaxf(__uint_as_float(rr[0]), __uint_as_float(rr[1])); }
    constexpr float C2 = 1.4426950408889634f * SCALE;
    if (__builtin_expect(__all((pmax - m_reg) * SCALE <= THR), 1)) { mn = m_reg; alpha = 1.f; }
    else { mn = fmaxf(m_reg, pmax); alpha = __builtin_amdgcn_exp2f((m_reg - mn) * C2); m_reg = mn; }
    const float mnL = -mn * C2;
    for (int r = 0; r < 16; ++r) p0[r] = fmaf(p0[r], C2, mnL); for (int r = 0; r < 16; ++r) p1[r] = fmaf(p1[r], C2, mnL);
    for (int r = 0; r < 16; ++r) p0[r] = __builtin_amdgcn_exp2f(p0[r]);
}
__device__ __forceinline__ void finishSM(f32x16& p0, f32x16& p1, float alpha, float& l_reg, bf16x8& pa0, bf16x8& pa1, bf16x8& pa2, bf16x8& pa3) {
    for (int r = 0; r < 16; ++r) p1[r] = __builtin_amdgcn_exp2f(p1[r]);
    float ps = 0; for (int r = 0; r < 16; ++r) ps += p0[r]; for (int r = 0; r < 16; ++r) ps += p1[r];
    { auto rr = __builtin_amdgcn_permlane32_swap(__float_as_uint(ps), __float_as_uint(ps), false, false);
      ps = __uint_as_float(rr[0]) + __uint_as_float(rr[1]); }
    l_reg = l_reg * alpha + ps;
#define PK4(P, B_, OUT) do { unsigned a0 = cvtpk(P[B_+0], P[B_+1]), a1 = cvtpk(P[B_+2], P[B_+3]);                          \
        unsigned b0 = cvtpk(P[B_+4], P[B_+5]), b1 = cvtpk(P[B_+6], P[B_+7]);                                             \
        auto r0 = __builtin_amdgcn_permlane32_swap(a0, b0, false, false); auto r1 = __builtin_amdgcn_permlane32_swap(a1, b1, false, false); \
        u32x4 w = {r0[0], r1[0], r0[1], r1[1]}; OUT = *reinterpret_cast<bf16x8*>(&w); } while (0)
    PK4(p0, 0, pa0); PK4(p0, 8, pa1); PK4(p1, 0, pa2); PK4(p1, 8, pa3);
#undef PK4
}
template <int KB>
__device__ __forceinline__ void qkt(f32x16& p0, f32x16& p1, const char* K_lds, int r32, int hi, const bf16x8* qr, bf16x8 kx0, bf16x8 kx1, bf16x8 qx) {
    p0 = __builtin_amdgcn_mfma_f32_32x32x16_bf16(kx0, qx, f32x16{}, 0, 0, 0);
    p1 = __builtin_amdgcn_mfma_f32_32x32x16_bf16(kx1, qx, f32x16{}, 0, 0, 0);
    const char* kb[4];
#pragma unroll
    for (int dd = 0; dd < 4; ++dd) kb[dd] = K_lds + KB * SHM_K + KSWZ(r32, (dd * 16 + hi * 8) * 2);
#pragma unroll
    for (int d0 = 0; d0 < 8; ++d0) { const char* a = kb[d0 & 3] + (d0 >> 2) * 128;
        bf16x8 b0 = *reinterpret_cast<const bf16x8*>(a);
        bf16x8 b1 = *reinterpret_cast<const bf16x8*>(a + 32 * 256);
        p0 = __builtin_amdgcn_mfma_f32_32x32x16_bf16(b0, qr[d0], p0, 0, 0, 0);
        p1 = __builtin_amdgcn_mfma_f32_32x32x16_bf16(b1, qr[d0], p1, 0, 0, 0); }
}
template <int VB>
__device__ __forceinline__ void pv_tile(f32x16* o, int vb0, bf16x8 pa0, bf16x8 pa1, bf16x8 pa2, bf16x8 pa3) {
#define TRRD(dst, off) asm volatile("ds_read_b64_tr_b16 %0, %1 offset:%2" : "=&v"(dst) : "v"(vb0), "i"(off) : "memory")
#define PV_D0(d0) do { s16x4 l0, l1, l2, l3, h0, h1, h2, h3; constexpr int b_ = VB * SHM_V + v_rd_off(d0, 0, 0);     \
        TRRD(l0, b_); TRRD(h0, b_ + 2048); TRRD(l1, b_ + 4096); TRRD(h1, b_ + 6144); TRRD(l2, b_ + 8192); TRRD(h2, b_ + 10240); TRRD(l3, b_ + 12288); TRRD(h3, b_ + 14336); \
        asm volatile("s_waitcnt lgkmcnt(0)" ::: "memory"); SBAR();                 \
        o[d0] = __builtin_amdgcn_mfma_f32_32x32x16_bf16(pa0, (bf16x8){l0[0], l0[1], l0[2], l0[3], h0[0], h0[1], h0[2], h0[3]}, o[d0], 0, 0, 0);   \
        o[d0] = __builtin_amdgcn_mfma_f32_32x32x16_bf16(pa1, (bf16x8){l1[0], l1[1], l1[2], l1[3], h1[0], h1[1], h1[2], h1[3]}, o[d0], 0, 0, 0);   \
        o[d0] = __builtin_amdgcn_mfma_f32_32x32x16_bf16(pa2, (bf16x8){l2[0], l2[1], l2[2], l2[3], h2[0], h2[1], h2[2], h2[3]}, o[d0], 0, 0, 0);   \
        o[d0] = __builtin_amdgcn_mfma_f32_32x32x16_bf16(pa3, (bf16x8){l3[0], l3[1], l3[2], l3[3], h3[0], h3[1], h3[2], h3[3]}, o[d0], 0, 0, 0); } while (0)
    PV_D0(0); PV_D0(1); PV_D0(2); PV_D0(3);
#undef PV_D0
#undef TRRD
}

struct BlockRef { const bf16* Q; const bf16* K; const bf16* V; bf16* O; const bf16* G; const float* CB; int P0, skv, qp, kp; };
struct Seam { bf16x8 qr[8]; bf16x8 st_v0, st_v1, st_k0, st_k1; float cb0, cb1; };
#define ROWP(p, k0, rr, pitch) ((p) + (size_t)(k0) * (pitch) + (unsigned)((rr) * (pitch) + sc))
#define VMW() asm volatile("s_waitcnt vmcnt(0)" ::: "memory")
#define VMWN(n) asm volatile("s_waitcnt vmcnt(%0)" :: "i"(n) : "memory")
#define SLOAD_H(Kp, Vp, Cp, k0, pitch) do { S.st_v0 = load8(ROWP(Vp, k0, sr, pitch)); S.st_v1 = load8(ROWP(Vp, k0, 32 + sr, pitch));              \
                         S.st_k0 = load8(ROWP(Kp, k0, sr, pitch)); S.st_k1 = load8(ROWP(Kp, k0, 32 + sr, pitch));                                    \
                         S.cb0 = (Cp) ? (Cp)[(k0) + r32] : 0.f; S.cb1 = (Cp) ? (Cp)[(k0) + 32 + r32] : 0.f; } while (0)
#define SWRITE_HK(bf) do { *(bf16x8*)(K_lds + (bf) * SHM_K + kws) = S.st_k0; *(bf16x8*)(K_lds + (bf) * SHM_K + kws + 32 * 256) = S.st_k1; } while (0)
#define SWRITE_HV(bf) do { *(bf16x8*)(V_lds + (bf) * SHM_V + vst0) = S.st_v0; *(bf16x8*)(V_lds + (bf) * SHM_V + vst1) = S.st_v1; } while (0)
#define SWRITE_H(bf) do { SWRITE_HV(bf); SWRITE_HK(bf); } while (0)
__device__ __forceinline__ void attn_prime(const BlockRef& cur, char* lds, Seam& S, const int wave_in) {
    const int tid = wave_in * 64 + lane_id_v(), wid = wave_in, lane = tid & 63, r32 = lane & 31, hi = lane >> 5;
    const int sr = tid >> 4, sc = (tid & 15) * 8, kws = KSWZ(sr, sc * 2); char* K_lds = lds + 2 * SHM_V;
#pragma unroll
    for (int d0 = 0; d0 < 8; ++d0) S.qr[d0] = load8(cur.Q + (size_t)(wid * QBLK + r32) * cur.qp + d0 * 16 + hi * 8);
    SLOAD_H(cur.K, cur.V, cur.CB, 0, cur.kp); VMW(); SWRITE_HK(0);
    __syncthreads();
}
__device__ __forceinline__ void attn_block(const BlockRef& cur, const BlockRef& nxt, char* lds, Seam& S, const int wave_in) {
    const int tid = wave_in * 64 + lane_id_v(), wid = wave_in, lane = tid & 63, r32 = lane & 31, hi = lane >> 5;
    constexpr int W = 1 << 30;
    int j_hi = (cur.P0 + QB - 1) / KVBLK + 1; if (j_hi > cur.skv / KVBLK) j_hi = cur.skv / KVBLK;
    const int NT = j_hi;
    const int qlo = cur.P0 + wid * QBLK, qm = qlo + r32 - 4 * hi;
    char* V_lds = lds; char* K_lds = lds + 2 * SHM_V;
    float* ws = (float*)(lds + 2 * SHM_V + 2 * SHM_K) + wid * 64; float* li_l = ws, * al_l = ws + 32;
    float m_reg = -1e30f, l_reg = 0; f32x16 o[4] = {};
    const int sr = tid >> 4, sc = (tid & 15) * 8, vst0 = v_st(sr, sc), vst1 = v_st(32 + sr, sc), kws = KSWZ(sr, sc * 2);
    const int vb0 = (int)(uintptr_t)V_lds + v_rd_base(lane);
    const bf16* Kh = cur.K; const bf16* Vh = cur.V; const float* Ch = cur.CB; const int KP = cur.kp;
#define QX() ones_frag(hi_opaque())
#define RESC(a) do { if (__any((a) < 1.f)) { if (hi == 0) al_l[r32] = (a); asm volatile("s_waitcnt lgkmcnt(0)" ::: "memory");              \
                     for (int d_ = 0; d_ < 4; ++d_) for (int r = 0; r < 16; ++r) o[d_][r] *= al_l[crow(r, hi)]; } } while (0)
#define KBASE(t) ((t) * KVBLK)
#define MASKT(P0_, P1_, t) do { const int kb_ = KBASE(t); if (kb_ + KVBLK - 1 > qlo) mask_tile(P0_, P1_, qm - kb_, (unsigned)W); } while (0)
#define SEAM_K0() do { VMWN(8); SWRITE_HK(0); SBAR(); } while (0)
    f32x16 pA0, pA1, pB0, pB1; float mnA, mnB, alA, alB; bf16x8 pa0, pa1, pa2, pa3; bf16x8 kx0, kx1;
    SWRITE_HV(0); SBAR();
    kx0 = cb_frag(S.cb0, hi); kx1 = cb_frag(S.cb1, hi);
    if (NT > 1) SLOAD_H(Kh, Vh, Ch, KBASE(1), KP);
    SBAR(); qkt<0>(pA0, pA1, K_lds, r32, hi, S.qr, kx0, kx1, QX());
    MASKT(pA0, pA1, 0); partialSM(pA0, pA1, m_reg, mnA, alA);
    if (NT > 1) { VMW(); SWRITE_H(1); }
    __syncthreads();
#define HALF_STEP(PX0, PX1, mnX, alX, PY0, PY1, alY, t, KB, VB, SB) do {                                                      \
        SBAR(); kx0 = cb_frag(S.cb0, hi); kx1 = cb_frag(S.cb1, hi);                                                           \
        qkt<KB>(PX0, PX1, K_lds, r32, hi, S.qr, kx0, kx1, QX());                                                                \
        finishSM(PY0, PY1, alY, l_reg, pa0, pa1, pa2, pa3); SBAR();                                                           \
        if ((t) + 1 < NT) { SLOAD_H(Kh, Vh, Ch, KBASE((t) + 1), KP); SBAR(); }                                                \
        pv_tile<VB>(o, vb0, pa0, pa1, pa2, pa3); MASKT(PX0, PX1, (t)); partialSM(PX0, PX1, m_reg, mnX, alX);                  \
        __syncthreads();                                                                                                      \
        if ((t) + 1 < NT) { VMW(); SWRITE_H(SB); }                                                                            \
        RESC(alX); __syncthreads(); } while (0)
    for (int t = 1; t + 1 < NT; t += 2) {
        HALF_STEP(pB0, pB1, mnB, alB, pA0, pA1, alA, t, 1, 0, 0);
        HALF_STEP(pA0, pA1, mnA, alA, pB0, pB1, alB, t + 1, 0, 1, 1);
    }
    const bool even = (NT & 1) == 0;
    if (even) { SBAR(); kx0 = cb_frag(S.cb0, hi); kx1 = cb_frag(S.cb1, hi); qkt<1>(pB0, pB1, K_lds, r32, hi, S.qr, kx0, kx1, QX()); SBAR(); }
    SLOAD_H(nxt.K, nxt.V, nxt.CB, 0, nxt.kp); SBAR();
#pragma unroll
    for (int d0 = 0; d0 < 8; ++d0) S.qr[d0] = load8(nxt.Q + (size_t)(wid * QBLK + r32) * nxt.qp + d0 * 16 + hi * 8);
    SBAR();
    finishSM(pA0, pA1, alA, l_reg, pa0, pa1, pa2, pa3); SBAR();
    pv_tile<0>(o, vb0, pa0, pa1, pa2, pa3);
    if (even) { MASKT(pB0, pB1, NT - 1); partialSM(pB0, pB1, m_reg, mnB, alB); __syncthreads(); RESC(alB);
        finishSM(pB0, pB1, alB, l_reg, pa0, pa1, pa2, pa3); SBAR(); pv_tile<1>(o, vb0, pa0, pa1, pa2, pa3); }
    SBAR(); SEAM_K0();
    if (hi == 0) li_l[r32] = l_reg; asm volatile("s_waitcnt lgkmcnt(0)" ::: "memory");
    float rli[16];
#pragma unroll
    for (int r = 0; r < 16; ++r) rli[r] = __builtin_amdgcn_rcpf(li_l[crow(r, hi)]);
    bf16* Ow = cur.O + (size_t)(wid * QBLK) * OP;
    const bf16* Gw = cur.G ? cur.G + (size_t)(wid * QBLK) * cur.qp : nullptr; const int GP = cur.qp;
#pragma unroll
    for (int r = 0; r < 16; ++r) { const int orow = crow(r, hi);
#pragma unroll
        for (int d0 = 0; d0 < 4; ++d0) { float v = o[d0][r] * rli[r];
            if (Gw) { const float g = __uint_as_float(((unsigned)Gw[(size_t)orow * GP + d0 * 32 + r32]) << 16);
                      v *= __builtin_amdgcn_rcpf(1.0f + __builtin_amdgcn_exp2f(-1.4426950408889634f * g)); }
            const float vn = __uint_as_float((unsigned)__builtin_amdgcn_update_dpp(0, (int)__float_as_uint(v), 0xB1, 0xF, 0xF, true));
            if ((r32 & 1) == 0) *(unsigned*)(Ow + (size_t)orow * OP + d0 * 32 + r32) = cvtpk(v, vn); } }
    __syncthreads();
#undef QX
#undef RESC
#undef KBASE
#undef MASKT
#undef SEAM_K0
#undef HALF_STEP
}
#undef ROWP
#undef VMW
#undef VMWN
#undef SLOAD_H
#undef SWRITE_HK
#undef SWRITE_HV
#undef SWRITE_H
#undef KSWZ
#undef SBAR
}

constexpr int NWAVES = 8;
#ifndef MK_PER_PHASE
#define MK_PER_PHASE 0
#endif
#ifndef MK_STOP_PC
#define MK_STOP_PC 1000
#endif
#ifndef REP_CVT
#define REP_CVT 1
#endif
#ifndef REP_MEMG
#define REP_MEMG 1
#endif
#ifndef REP_NORM
#define REP_NORM 1
#endif
#ifndef REP_KVG
#define REP_KVG 1
#endif
#ifndef REP_UP
#define REP_UP 1
#endif
#ifndef REP_DN
#define REP_DN 1
#endif
#ifndef REP_IN
#define REP_IN 1
#endif
#ifndef REP_PREP
#define REP_PREP 1
#endif
#ifndef REP_SCAN
#define REP_SCAN 1
#endif
#ifndef REP_ATT
#define REP_ATT 1
#endif
#ifndef REP_OUT
#define REP_OUT 1
#endif
constexpr int NPH = 40;

constexpr int BATCH = 8, SEQ = 4096, DM = 2048, M = BATCH * SEQ, FF = 5632, NUP = 2 * FF, DEPTH = 4;
constexpr int NA = 5888, NB = 3584, NKV = 3328, NMEMW = 4096;
constexpr int A_Q = 0, A_K = 768, A_V = 1536, A_G = 3072, A_QM = 4608, A_GATE = 5120;
constexpr int B_Q = 0, B_G = 1536, B_QM = 3072;
constexpr int MEMT = 256, MROWS = BATCH * MEMT;
constexpr float EPS = 1e-6f;

constexpr size_t MiB = 1u << 20;
constexpr size_t WS_CTL = 0, CTL_ZERO_BYTES = 1 * MiB;
constexpr size_t WS_CB = 1 * MiB, WS_F = 3 * MiB, WS_ACH = 5 * MiB, WS_DSEG = 7 * MiB, WS_MEMB = 8 * MiB, WS_MKVF = 16 * MiB, WS_MK = 48 * MiB, WS_MV = 56 * MiB;
constexpr size_t WS_WUP = 64 * MiB, WS_WDN = 416 * MiB, WS_WAIN = 592 * MiB, WS_WBIN = 638 * MiB, WS_WOUT = 666 * MiB, WS_WKV = 698 * MiB, WS_WMEM = 711 * MiB;
constexpr size_t WS_HMIX = 728 * MiB, WS_ACT = 856 * MiB, WS_KDT = 1224 * MiB, WS_VT = 1272 * MiB, WS_OG = 1368 * MiB, WS_KSVS = 1224 * MiB, WS_FST = 1464 * MiB, WS_QF = 1528 * MiB, WS_XB2 = 1416 * MiB, WS_SS = 1576 * MiB, WS_END = 1580 * MiB;
constexpr size_t SS_BYTES = (size_t)13 * M * 8;
static_assert(WS_WUP + 8 * (size_t)NUP * DM * 2 <= WS_WDN && WS_WDN + 8 * (size_t)DM * FF * 2 <= WS_WAIN && WS_WAIN + 2 * (size_t)NA * DM * 2 <= WS_WBIN && WS_WBIN + 2 * (size_t)NB * DM * 2 <= WS_WOUT &&
              WS_WOUT + 4 * (size_t)DM * DM * 2 <= WS_WKV && WS_WKV + (size_t)NKV * DM * 2 <= WS_WMEM && WS_WMEM + (size_t)NMEMW * DM * 2 <= WS_HMIX && WS_HMIX + (size_t)M * DM * 2 <= WS_ACT &&
              WS_ACT + (size_t)M * NA * 2 <= WS_KDT && WS_KDT + (size_t)2048 * 192 * 64 * 2 <= WS_VT && WS_VT + (size_t)2048 * 384 * 64 * 2 <= WS_OG && WS_OG + (size_t)M * 1536 * 2 <= WS_FST && WS_FST + (size_t)384 * 7 * 24 * 64 * 16 <= WS_QF && WS_QF + (size_t)2048 * 192 * 64 * 2 <= WS_SS && WS_SS + SS_BYTES <= WS_END && WS_XB2 >= WS_KSVS + (size_t)M * 3072 * 2 && WS_XB2 + (size_t)M * DM * 2 <= WS_SS &&
              WS_KSVS + (size_t)M * 3072 * 2 <= WS_END && WS_MKVF + (size_t)MROWS * NMEMW * 4 <= WS_MK && WS_MEMB + (size_t)MROWS * DM * 2 <= WS_MKVF, "d_ws map");
constexpr int CW_TMO = 0, CW_BAR = 4096;
constexpr int RING_BYTES = 131072, LDSCTL_OFF = RING_BYTES, MISC_OFF = LDSCTL_OFF + 320, RTAB_OFF = LDSCTL_OFF + 1024  , LDS_BYTES = 147456;

#define GAS __attribute__((address_space(1)))
#define LAS __attribute__((address_space(3)))
typedef unsigned short bf16;
typedef unsigned v4u __attribute__((ext_vector_type(4)));
typedef float f32x4 __attribute__((ext_vector_type(4)));
typedef float f32x16 __attribute__((ext_vector_type(16)));
typedef short bf16x8 __attribute__((ext_vector_type(8)));
typedef GAS unsigned gu32;
#define RLX_AGENT __ATOMIC_RELAXED, __HIP_MEMORY_SCOPE_AGENT
#define LDS_WAIT() asm volatile("s_waitcnt lgkmcnt(0)" ::: "memory")
using pg8::pkbf;
__device__ __forceinline__ float bf_lo(unsigned w) { return __uint_as_float(w << 16); }
__device__ __forceinline__ float bf_hi(unsigned w) { return __uint_as_float(w & 0xffff0000u); }
__device__ __forceinline__ float bf2f(bf16 b) { return __uint_as_float(((unsigned)b) << 16); }
__device__ __forceinline__ float logsig(float x) { return fminf(x, 0.f) - __logf(1.0f + __expf(-fabsf(x))); }
#define XCH1(v)  __uint_as_float((unsigned)__builtin_amdgcn_update_dpp(0, (int)__float_as_uint(v), 0xB1, 0xF, 0xF, true))
#define XCH2(v)  __uint_as_float((unsigned)__builtin_amdgcn_update_dpp(0, (int)__float_as_uint(v), 0x4E, 0xF, 0xF, true))
#define XCH4(v)  __uint_as_float((unsigned)__builtin_amdgcn_ds_swizzle((int)__float_as_uint(v), (4 << 10) | 0x1f))
#define XCH8(v)  __uint_as_float((unsigned)__builtin_amdgcn_ds_swizzle((int)__float_as_uint(v), (8 << 10) | 0x1f))
#define XCH16(v) __uint_as_float((unsigned)__builtin_amdgcn_ds_swizzle((int)__float_as_uint(v), (16 << 10) | 0x1f))
__device__ __forceinline__ float wave_sum(float v) {
    v += XCH1(v); v += XCH2(v); v += XCH4(v); v += XCH8(v); v += XCH16(v);
    const auto rr = __builtin_amdgcn_permlane32_swap(__float_as_uint(v), __float_as_uint(v), false, false);
    return __uint_as_float(rr[0]) + __uint_as_float(rr[1]);
}
__device__ __forceinline__ int launder_s(int v) { asm volatile("" : "+s"(v)); return v; }

#define XB_TMO      128
#define XB_XCNT(j)  (256  + 64 * (j))
#define XB_XSUB(j)  (1280 + 64 * (j))
#define XB_XGEN(j)  (2304 + 64 * (j))
#define XB_TOP      3328
#define XB_TOPGEN   3392
#define XCD_BAR_WORDS 3456
#define XB_SPIN_CAP (1u << 18)
__device__ __forceinline__ unsigned xb_ld(unsigned* p)              { return __hip_atomic_load(p, __ATOMIC_RELAXED, __HIP_MEMORY_SCOPE_AGENT); }
__device__ __forceinline__ unsigned xb_add(unsigned* p, unsigned v) { return __hip_atomic_fetch_add(p, v, __ATOMIC_RELAXED, __HIP_MEMORY_SCOPE_AGENT); }
__device__ __forceinline__ unsigned xb_xcc_id() { return (unsigned)__builtin_amdgcn_s_getreg((3 << 11) | 20) & 0xFu; }
#define XB_SPIN(cond, bar) do { unsigned _sp = 0; while (cond) { __builtin_amdgcn_s_sleep(1); \
    if ((++_sp & 255u) == 0u) { if (xb_ld(&(bar)[XB_TMO])) break; if (_sp > XB_SPIN_CAP) { atomicAdd(&(bar)[XB_TMO], 1u); break; } } } } while (0)
struct XcdBarrier { unsigned* bar; unsigned x; volatile LAS unsigned* st; int wave; };
__device__ __forceinline__ XcdBarrier xcd_barrier_post(unsigned* bar, volatile LAS unsigned* st, int wave) {
    XcdBarrier b; b.bar = bar; b.x = xb_xcc_id(); b.st = st; b.wave = wave;
    if (threadIdx.x == 0) (void)xb_add(&bar[XB_XCNT(b.x)], 1u);
    return b;
}
__device__ __forceinline__ void xcd_barrier_complete(unsigned* bar, unsigned x, unsigned& nloc, unsigned& nx) {
    const unsigned G = gridDim.x * gridDim.y * gridDim.z;
    unsigned sum, cnt, mine, sp = 0u;
    for (;;) {
        sum = 0u; cnt = 0u; mine = 0u;
#pragma unroll
        for (unsigned j = 0; j < 16; ++j) { const unsigned c = xb_ld(&bar[XB_XCNT(j)]); sum += c; cnt += (c > 0u) ? 1u : 0u; mine = (j == x) ? c : mine; }
        if (sum == G) break;
        __builtin_amdgcn_s_sleep(1);
        if ((++sp & 255u) == 0u) { if (xb_ld(&bar[XB_TMO])) break; if (sp > XB_SPIN_CAP) { atomicAdd(&bar[XB_TMO], 1u); break; } }
    }
    nloc = mine > 0u ? mine : 1u; nx = cnt > 0u ? cnt : 1u;
}
__device__ __forceinline__ void xcd_barrier(const XcdBarrier& b) {
    asm volatile("s_waitcnt vmcnt(0)" ::: "memory");
    __syncthreads();
    if (b.wave == 0 && lane_id_v() == 0) {
        unsigned* bar = b.bar;
        __builtin_amdgcn_s_waitcnt(0);
        unsigned nloc = b.st[0], nx = b.st[1];
        if (nloc == 0u) { xcd_barrier_complete(bar, b.x, nloc, nx); b.st[0] = nloc; b.st[1] = nx; }
        const unsigned old = xb_add(&bar[XB_XSUB(b.x)], 1u);
        const unsigned gen = old / nloc;
        if (old + 1u == (gen + 1u) * nloc) {
            __builtin_amdgcn_fence(__ATOMIC_RELEASE, "agent");
            asm volatile("s_waitcnt vmcnt(0)" ::: "memory");
            const unsigned og = xb_add(&bar[XB_TOP], 1u);
            const unsigned tg = og / nx;
            if (og + 1u == (tg + 1u) * nx) xb_add(&bar[XB_TOPGEN], 1u);
            else XB_SPIN(xb_ld(&bar[XB_TOPGEN]) == tg, bar);
            __builtin_amdgcn_fence(__ATOMIC_ACQUIRE, "agent");
            xb_add(&bar[XB_XGEN(b.x)], 1u);
            asm volatile("s_waitcnt vmcnt(0)" ::: "memory");
        } else {
            XB_SPIN(xb_ld(&bar[XB_XGEN(b.x)]) == gen, bar);
            __builtin_amdgcn_fence(__ATOMIC_ACQUIRE, "agent");
            asm volatile("s_waitcnt vmcnt(0)" ::: "memory");
        }
    }
    __syncthreads();
}

__device__ __forceinline__ const float* ldp(volatile LAS unsigned* T, int k) { const unsigned lo = __builtin_amdgcn_readfirstlane(T[2 * k]), hi = __builtin_amdgcn_readfirstlane(T[2 * k + 1]); return (const float*)(const GAS float*)(((unsigned long long)hi << 32) | lo); }
__device__ __forceinline__ int launder(int v) { asm volatile("" : "+v"(v)); return v; }
__device__ __forceinline__ int lane_id() { return lane_id_v(); }
__device__ __forceinline__ void cvt_item(const float* W, int ldw, int srccol, const float* gain, float scale, bf16* Bt, int K, int dstrow, int k0, LAS float* scr, int lane) {
    float v[32], g[32];
    const float* src = W + (size_t)(k0 + (lane >> 5)) * ldw + srccol + (lane & 31);
#pragma unroll
    for (int i = 0; i < 32; ++i) v[i] = src[(size_t)(2 * i) * ldw];
#pragma unroll
    for (int i = 0; i < 32; ++i) g[i] = gain ? gain[k0 + 2 * i + (lane >> 5)] * scale : scale;
#pragma unroll
    for (int i = 0; i < 32; ++i) scr[(2 * i + (lane >> 5)) * 33 + (lane & 31)] = v[i] * g[i];
    LDS_WAIT();
    const int c = lane & 7;
#pragma unroll
    for (int j = 0; j < 4; ++j) { const int n = (lane >> 3) + 8 * j; const LAS float* s = scr + (8 * c) * 33 + n;
        v4u o; o.x = pkbf(s[0 * 33], s[1 * 33]); o.y = pkbf(s[2 * 33], s[3 * 33]); o.z = pkbf(s[4 * 33], s[5 * 33]); o.w = pkbf(s[6 * 33], s[7 * 33]);
        *(v4u*)(Bt + (size_t)(dstrow + n) * K + k0 + 8 * c) = o; }
    LDS_WAIT();
}
__device__ __forceinline__ void rms_row_to_bf16(const float* xrow, bf16* orow, int lane) {
    const f32x4* xr = (const f32x4*)xrow + lane;
    f32x4 v[8]; float s = 0.f;
#pragma unroll
    for (int j = 0; j < 8; ++j) { v[j] = xr[64 * j]; s += (v[j].x * v[j].x + v[j].y * v[j].y) + (v[j].z * v[j].z + v[j].w * v[j].w); }
    const float rinv = 1.0f / sqrtf(wave_sum(s) * (1.0f / DM) + EPS);
    unsigned long long* o8 = (unsigned long long*)orow + lane;
#pragma unroll
    for (int j = 0; j < 8; ++j) o8[64 * j] = (unsigned long long)pkbf(v[j].x * rinv, v[j].y * rinv) | ((unsigned long long)pkbf(v[j].z * rinv, v[j].w * rinv) << 32);
}
__device__ __forceinline__ void xb_row(const float* xrow, float* xcopy, bf16* orow, float* ssrow, int lane) {
    const f32x4* xr = (const f32x4*)xrow + lane;
    f32x4 v[8]; float s = 0.f;
#pragma unroll
    for (int j = 0; j < 8; ++j) { v[j] = xr[64 * j]; s += (v[j].x * v[j].x + v[j].y * v[j].y) + (v[j].z * v[j].z + v[j].w * v[j].w); }
    s = wave_sum(s);
    if (lane == 0) *(unsigned long long*)ssrow = (unsigned long long)(s * 16777216.0f);
    f32x4* xc = (f32x4*)xcopy + lane;
#pragma unroll
    for (int j = 0; j < 8; ++j) xc[64 * j] = v[j];
    unsigned long long* o8 = (unsigned long long*)orow + lane;
#pragma unroll
    for (int j = 0; j < 8; ++j) o8[64 * j] = (unsigned long long)pkbf(v[j].x, v[j].y) | ((unsigned long long)pkbf(v[j].z, v[j].w) << 32);
}
struct InPtrs { const float *x, *mem, *ffn_norm, *w1, *w3, *w2, *mix_norm, *mem_norm, *w_mem_kv, *mem_q_norm, *mem_k_norm, *w_out, *a_w_in, *a_w_gate_up, *a_b_gate, *a_out_norm, *b_w_in, *b_q_norm, *kv_norm, *w_kv, *b_f, *k_norm; };

__device__ __forceinline__ void convert_phase(volatile LAS unsigned* PT, unsigned char* ws, float* xout, LAS unsigned char* lds, int gw, int NGW, int lane, int wave) {
    InPtrs I;
    I.x = ldp(PT, 0); I.mem = ldp(PT, 1); I.ffn_norm = ldp(PT, 2); I.w1 = ldp(PT, 3); I.w3 = ldp(PT, 4); I.w2 = ldp(PT, 5); I.mix_norm = ldp(PT, 6); I.mem_norm = ldp(PT, 7);
    I.w_mem_kv = ldp(PT, 8); I.mem_q_norm = ldp(PT, 9); I.mem_k_norm = ldp(PT, 10); I.w_out = ldp(PT, 11); I.a_w_in = ldp(PT, 12); I.a_w_gate_up = ldp(PT, 13); I.a_b_gate = ldp(PT, 14);
    I.a_out_norm = ldp(PT, 15); I.b_w_in = ldp(PT, 16); I.b_q_norm = ldp(PT, 17); I.kv_norm = ldp(PT, 18); I.w_kv = ldp(PT, 19); I.b_f = ldp(PT, 20); I.k_norm = ldp(PT, 21);
    LAS float* scr = (LAS float*)(lds + wave * 16384);
    bf16* WUP = (bf16*)(ws + WS_WUP); bf16* WDN = (bf16*)(ws + WS_WDN); bf16* WAIN = (bf16*)(ws + WS_WAIN); bf16* WBIN = (bf16*)(ws + WS_WBIN);
    bf16* WOUT = (bf16*)(ws + WS_WOUT); bf16* WKV = (bf16*)(ws + WS_WKV); bf16* WMEM = (bf16*)(ws + WS_WMEM);
    constexpr int IT_W1 = 8 * 32 * 176, IT_W2 = 8 * 88 * 64, IT_A = 2 * 32 * 160, IT_B = 2 * 32 * 112, IT_O = 4 * 32 * 64, IT_KV = 32 * 96, IT_MEM = 4 * 32 * 32;
    constexpr int IT_TOTAL = 2 * IT_W1 + IT_W2 + IT_A + IT_B + IT_O + IT_KV + IT_MEM;
    for (int it = gw; it < IT_TOTAL; it += NGW) {
        int r = it;
        if (r < 2 * IT_W1) { const int which = r / IT_W1; r -= which * IT_W1; const int mat = r / (32 * 176); r -= mat * (32 * 176); const int kb = r / 176, nb = r % 176; const int j0 = 32 * nb;
            cvt_item((which ? I.w3 : I.w1) + (size_t)mat * DM * FF, FF, j0, I.ffn_norm + mat * DM, 1.f, WUP + (size_t)mat * NUP * DM, DM, 256 * (j0 / 128) + which * 128 + (j0 % 128), 64 * kb, scr, lane); continue; }
        r -= 2 * IT_W1;
        if (r < IT_W2) { const int mat = r / (88 * 64); r -= mat * (88 * 64); const int kb = r / 64, nb = r % 64;
            cvt_item(I.w2 + (size_t)mat * FF * DM, DM, 32 * nb, nullptr, 1.f, WDN + (size_t)mat * DM * FF, FF, 32 * nb, 64 * kb, scr, lane); continue; }
        r -= IT_W2;
        if (r < IT_A) { const int l = r / (32 * 160); r -= l * (32 * 160); const int kb = r / 160, nb = r % 160; const int n0 = 32 * nb;
            cvt_item(I.a_w_in + (size_t)l * DM * 5136, 5136, n0 < 3072 ? n0 : n0 + 16, I.mix_norm + l * DM, n0 < 768 ? 0.07216878364870322f : 1.f, WAIN + (size_t)l * NA * DM, DM, n0, 64 * kb, scr, lane); continue; }
        r -= IT_A;
        if (r < IT_B) { const int j = r / (32 * 112); r -= j * (32 * 112); const int kb = r / 112, nb = r % 112;
            cvt_item(I.b_w_in + (size_t)j * DM * NB, NB, 32 * nb, I.mix_norm + (2 + j) * DM, 1.f, WBIN + (size_t)j * NB * DM, DM, 32 * nb, 64 * kb, scr, lane); continue; }
        r -= IT_B;
        if (r < IT_O) { const int l = r / (32 * 64); r -= l * (32 * 64); const int kb = r / 64, nb = r % 64;
            cvt_item(I.w_out + (size_t)l * DM * DM, DM, 32 * nb, nullptr, 1.f, WOUT + (size_t)l * DM * DM, DM, 32 * nb, 64 * kb, scr, lane); continue; }
        r -= IT_O;
        if (r < IT_KV) { const int kb = r / 96, nb = r % 96;
            cvt_item(I.w_kv, 3084, 32 * nb, I.kv_norm, 1.f, WKV, DM, 32 * nb, 64 * kb, scr, lane); continue; }
        r -= IT_KV;
        { const int l = r / (32 * 32); r -= l * (32 * 32); const int kb = r / 32, nb = r % 32;
            cvt_item(I.w_mem_kv + (size_t)l * DM * 1024, 1024, 32 * nb, I.mem_norm + l * DM, 1.f, WMEM, DM, l * 1024 + 32 * nb, 64 * kb, scr, lane); }
    }
    const int gtid = gw * 64 + lane, NT = NGW * 64;
    for (int idx = gtid; idx < 2 * 768 * 256; idx += NT) { const int l = idx / (768 * 256); const int rem = idx - l * (768 * 256); const int n = rem >> 8, k0 = (rem & 255) * 8;
        float a[8];
#pragma unroll
        for (int j = 0; j < 8; ++j) a[j] = 0.f;
        const float* win = I.a_w_in + (size_t)l * DM * 5136 + (size_t)k0 * 5136 + 3072; const float* wg = I.a_w_gate_up + (size_t)l * 16 * 768 + n;
#pragma unroll
        for (int rr = 0; rr < 16; ++rr) { const float g = wg[rr * 768];
#pragma unroll
            for (int j = 0; j < 8; ++j) a[j] += win[(size_t)j * 5136 + rr] * g; }
        const float* gn = I.mix_norm + l * DM + k0;
        v4u o; o.x = pkbf(a[0] * gn[0], a[1] * gn[1]); o.y = pkbf(a[2] * gn[2], a[3] * gn[3]); o.z = pkbf(a[4] * gn[4], a[5] * gn[5]); o.w = pkbf(a[6] * gn[6], a[7] * gn[7]);
        *(v4u*)(WAIN + (size_t)l * NA * DM + (size_t)(A_GATE + n) * DM + k0) = o; }
    for (int idx = gtid; idx < 256 * 256; idx += NT) { const int n = idx >> 8, k0 = (idx & 255) * 8;
        float a[8];
#pragma unroll
        for (int j = 0; j < 8; ++j) a[j] = (n < 12) ? I.w_kv[(size_t)(k0 + j) * 3084 + 3072 + n] * I.kv_norm[k0 + j] : 0.f;
        v4u o; o.x = pkbf(a[0], a[1]); o.y = pkbf(a[2], a[3]); o.z = pkbf(a[4], a[5]); o.w = pkbf(a[6], a[7]);
        *(v4u*)(WKV + (size_t)(3072 + n) * DM + k0) = o; }
    for (int m = gw; m < MROWS; m += NGW) rms_row_to_bf16(I.mem + (size_t)m * DM, (bf16*)(ws + WS_MEMB) + (size_t)m * DM, lane);
    for (int m = gw; m < M; m += NGW) xb_row(I.x + (size_t)m * DM, xout + (size_t)m * DM, (bf16*)(ws + WS_HMIX) + (size_t)m * DM, (float*)(ws + WS_SS) + 2 * (size_t)m, lane);
}
__device__ __forceinline__ void hn_pass(bf16* buf, int pitch, int col0, int nheads, const float* gain, int gw, int NGW, int lane) {
    const int l16 = lane & 15; const int ntask4 = M * nheads / 4;
    f32x4 g0 = *(const f32x4*)(gain + 8 * l16), g1 = *(const f32x4*)(gain + 8 * l16 + 4);
    for (int t4 = gw; t4 < ntask4; t4 += NGW) { const int t = t4 * 4 + (lane >> 4); const int row = t / nheads, hh = t - row * nheads;
        bf16* p = buf + (size_t)row * pitch + col0 + hh * 128 + 8 * l16;
        const v4u w = *(const v4u*)p;
        float x[8] = {bf_lo(w.x), bf_hi(w.x), bf_lo(w.y), bf_hi(w.y), bf_lo(w.z), bf_hi(w.z), bf_lo(w.w), bf_hi(w.w)};
        float ss = 0.f;
#pragma unroll
        for (int e = 0; e < 8; ++e) ss += x[e] * x[e];
        ss += XCH1(ss); ss += XCH2(ss); ss += XCH4(ss); ss += XCH8(ss);
        const float rinv = 1.0f / sqrtf(ss * (1.0f / 128.f) + EPS);
        v4u o; o.x = pkbf(x[0] * rinv * g0[0], x[1] * rinv * g0[1]); o.y = pkbf(x[2] * rinv * g0[2], x[3] * rinv * g0[3]);
        o.z = pkbf(x[4] * rinv * g1[0], x[5] * rinv * g1[1]); o.w = pkbf(x[6] * rinv * g1[2], x[7] * rinv * g1[3]);
        *(v4u*)p = o; }
}
__device__ __forceinline__ void mkmv_pass(const float* MKVF, bf16* MK, bf16* MV, const float* mem_k_norm, int gw, int NGW, int lane) {
    const int l16 = lane & 15;
    for (int t4 = gw; t4 < MROWS * 32 / 4; t4 += NGW) { const int t = t4 * 4 + (lane >> 4); const int row = t >> 5, rem = t & 31; const int l = rem >> 3, kv = (rem >> 2) & 1, hh = rem & 3;
        const float* src = MKVF + (size_t)row * NMEMW + l * 1024 + kv * 512 + hh * 128 + 8 * l16;
        const f32x4 a = *(const f32x4*)src, b = *(const f32x4*)(src + 4);
        float ss = (a.x * a.x + a.y * a.y) + (a.z * a.z + a.w * a.w) + (b.x * b.x + b.y * b.y) + (b.z * b.z + b.w * b.w);
        ss += XCH1(ss); ss += XCH2(ss); ss += XCH4(ss); ss += XCH8(ss);
        const float rinv = kv ? 1.0f : 1.0f / sqrtf(ss * (1.0f / 128.f) + EPS);
        f32x4 g0 = {1.f, 1.f, 1.f, 1.f}, g1 = {1.f, 1.f, 1.f, 1.f};
        if (!kv) { g0 = *(const f32x4*)(mem_k_norm + l * 128 + 8 * l16); g1 = *(const f32x4*)(mem_k_norm + l * 128 + 8 * l16 + 4); }
        v4u o; o.x = pkbf(a.x * rinv * g0[0], a.y * rinv * g0[1]); o.y = pkbf(a.z * rinv * g0[2], a.w * rinv * g0[3]);
        o.z = pkbf(b.x * rinv * g1[0], b.y * rinv * g1[1]); o.w = pkbf(b.z * rinv * g1[2], b.w * rinv * g1[3]);
        *(v4u*)((kv ? MV : MK) + ((size_t)l * MROWS + row) * 512 + hh * 128 + 8 * l16) = o; }
}
__device__ __forceinline__ void gla_prep(const bf16* PROJ, const float* b_gate  , bf16* KDT, bf16* VT, bf16* QF, float* ACH, int gw, int NGW, int lane) {
    const int r = lane & 31, hi = lane >> 5;
    for (int t = gw; t < 2048; t += NGW) {
        const int b = t >> 8, c = (t >> 2) & 63, h = t & 3; const int ci = (b * 4 + h) * 64 + c;
        const bf16* P = PROJ + ((size_t)b * SEQ + c * 64) * NA;
        for (int cg = 0; cg < 3; ++cg) { const int d = cg * 64 + lane;
            const float bias = b_gate[h * 192 + d];
            const bf16* pg = P + A_GATE + h * 192 + d; const bf16* pk = P + A_K + h * 192 + d;
            float cum[64]; float run = 0.f;
#pragma unroll
            for (int j = 0; j < 64; ++j) { const float gp = bf2f(pg[(size_t)j * NA]) + bias; run += logsig(gp) * (1.0f / 16.0f); cum[j] = run; }
            ACH[ci * 192 + d] = __expf(run);
            bf16* dst = KDT + ((size_t)(ci * 6 + cg * 2 + hi) * 4 * 64 + r) * 8;
#pragma unroll
            for (int j8 = 0; j8 < 8; ++j8) { float kd[8];
#pragma unroll
                for (int e = 0; e < 8; ++e) { const int j = 8 * j8 + e; kd[e] = bf2f(pk[(size_t)j * NA]) * __expf(run - cum[j]); }
                v4u o; o.x = pkbf(kd[0], kd[1]); o.y = pkbf(kd[2], kd[3]); o.z = pkbf(kd[4], kd[5]); o.w = pkbf(kd[6], kd[7]);
                *(v4u*)(dst + ((j8 >> 1) * 64 + (j8 & 1) * 32) * 8) = o; } }
        for (int cg = 0; cg < 6; ++cg) { const int dv = cg * 64 + lane; const bf16* pv = P + A_V + h * 384 + dv;
            bf16* dst = VT + ((size_t)(ci * 12 + cg * 2 + hi) * 4 * 64 + r) * 8;
#pragma unroll
            for (int j8 = 0; j8 < 8; ++j8) { unsigned rr[8];
#pragma unroll
                for (int e = 0; e < 8; ++e) rr[e] = pv[(size_t)(8 * j8 + e) * NA];
                v4u o; o.x = rr[0] | (rr[1] << 16); o.y = rr[2] | (rr[3] << 16); o.z = rr[4] | (rr[5] << 16); o.w = rr[6] | (rr[7] << 16);
                *(v4u*)(dst + ((j8 >> 1) * 64 + (j8 & 1) * 32) * 8) = o; } }
        { const bf16* pq = P + (size_t)r * NA + A_Q + h * 192 + 4 * hi; bf16* dst = QF + ((size_t)ci * 24 * 64 + lane) * 8;
#pragma unroll
            for (int tt = 0; tt < 2; ++tt)
#pragma unroll
                for (int mt = 0; mt < 6; ++mt)
#pragma unroll
                    for (int s2 = 0; s2 < 2; ++s2) { const bf16* p = pq + (size_t)tt * 32 * NA + 32 * mt + 16 * s2;
                        const uint2 a = *(const uint2*)p, c2 = *(const uint2*)(p + 8);
                        v4u o = {a.x, a.y, c2.x, c2.y};
                        *(v4u*)(dst + (size_t)((tt * 6 + mt) * 2 + s2) * 64 * 8) = o; } }
    }
}
__device__ __forceinline__ void gla_update(f32x16 (&S)[6], const bf16* kd, const bf16* vt, const float* ac, int lane, int hi) {
    const unsigned lo16 = (unsigned)lane * 16u;
    bf16x8 vb[4];
#pragma unroll
    for (int s = 0; s < 4; ++s) vb[s] = *(const bf16x8*)((const char*)(vt + s * 512) + lo16);
#pragma unroll
    for (int half = 0; half < 2; ++half) {
        bf16x8 ka[3][4]; f32x4 a4[3][4];
#pragma unroll
        for (int m3 = 0; m3 < 3; ++m3)
#pragma unroll
            for (int s = 0; s < 4; ++s) ka[m3][s] = *(const bf16x8*)((const char*)(kd + ((3 * half + m3) * 4 + s) * 512) + lo16);
#pragma unroll
        for (int m3 = 0; m3 < 3; ++m3)
#pragma unroll
            for (int i4 = 0; i4 < 4; ++i4) a4[m3][i4] = *(const f32x4*)((const char*)(ac + 32 * (3 * half + m3) + 8 * i4) + (unsigned)hi * 16u);
        __builtin_amdgcn_sched_barrier(0);
#pragma unroll
        for (int m3 = 0; m3 < 3; ++m3) { const int mt = 3 * half + m3;
#pragma unroll
            for (int i4 = 0; i4 < 4; ++i4)
#pragma unroll
                for (int e = 0; e < 4; ++e) S[mt][4 * i4 + e] *= a4[m3][i4][e];
#pragma unroll
            for (int s = 0; s < 4; ++s) S[mt] = __builtin_amdgcn_mfma_f32_32x32x16_bf16(ka[m3][s], vb[s], S[mt], 0, 0, 0); }
        __builtin_amdgcn_sched_barrier(0);
    }
}
__device__ __forceinline__ void gla_output(const f32x16 (&S)[6], const bf16* qf, bf16* og, int lane, int r, int hi) {
    const unsigned lo16 = (unsigned)lane * 16u;
    f32x16 o0, o1;
#pragma unroll
    for (int i = 0; i < 16; ++i) { o0[i] = 0.f; o1[i] = 0.f; }
#pragma unroll
    for (int half = 0; half < 2; ++half) {
        bf16x8 qa[3][2][2];
#pragma unroll
        for (int m3 = 0; m3 < 3; ++m3)
#pragma unroll
            for (int s = 0; s < 2; ++s) { qa[m3][s][0] = *(const bf16x8*)((const char*)(qf + ((0 * 6 + 3 * half + m3) * 2 + s) * 512) + lo16); qa[m3][s][1] = *(const bf16x8*)((const char*)(qf + ((1 * 6 + 3 * half + m3) * 2 + s) * 512) + lo16); }
        __builtin_amdgcn_sched_barrier(0);
#pragma unroll
        for (int m3 = 0; m3 < 3; ++m3) { const int mt = 3 * half + m3;
#pragma unroll
            for (int s = 0; s < 2; ++s) {
                v4u xw; xw.x = pkbf(S[mt][8 * s + 0], S[mt][8 * s + 1]); xw.y = pkbf(S[mt][8 * s + 2], S[mt][8 * s + 3]); xw.z = pkbf(S[mt][8 * s + 4], S[mt][8 * s + 5]); xw.w = pkbf(S[mt][8 * s + 6], S[mt][8 * s + 7]);
                const bf16x8 xs = __builtin_bit_cast(bf16x8, xw);
                o0 = __builtin_amdgcn_mfma_f32_32x32x16_bf16(qa[m3][s][0], xs, o0, 0, 0, 0);
                o1 = __builtin_amdgcn_mfma_f32_32x32x16_bf16(qa[m3][s][1], xs, o1, 0, 0, 0); } }
        __builtin_amdgcn_sched_barrier(0);
    }
#pragma unroll
    for (int i = 0; i < 16; ++i) { const int row = (i & 3) + 8 * (i >> 2) + 4 * hi;
        const float v0 = o0[i], v1 = o1[i]; const float n0 = XCH1(v0), n1 = XCH1(v1);
        if ((r & 1) == 0) { *(unsigned*)(og + (size_t)row * 1536) = pkbf(v0, n0); *(unsigned*)(og + (size_t)(32 + row) * 1536) = pkbf(v1, n1); } }
}
__device__ __forceinline__ void gla_seg_states(const bf16* KDT, const bf16* VT, const float* ACH, float* FST, float* DSEG, int gw, int NGW, int lane) {
    const int r = lane & 31, hi = lane >> 5;
    for (int idx = gw * 64 + lane; idx < 32 * 8 * 192; idx += NGW * 64) { const int bh = idx / (8 * 192), rem = idx - bh * (8 * 192), g = rem / 192, k = rem - g * 192;
        float d = 1.f;
#pragma unroll
        for (int c = 0; c < 8; ++c) d *= ACH[(size_t)(bh * 64 + 8 * g + c) * 192 + k];
        DSEG[idx] = d; }
    for (int t = gw; t < 384 * 7; t += NGW) { const int g = t / 384, u = t - g * 384; const int bh = u / 12, n32 = u - bh * 12;
        f32x16 S[6];
#pragma unroll
        for (int mt = 0; mt < 6; ++mt)
#pragma unroll
            for (int i = 0; i < 16; ++i) S[mt][i] = 0.f;
        for (int c = 8 * g; c < 8 * g + 8; ++c) { const int ci = bh * 64 + c;
            gla_update(S, KDT + (size_t)ci * 192 * 64, VT + ((size_t)ci * 12 + n32) * 4 * 64 * 8, ACH + (size_t)ci * 192, lane, hi); }
        f32x4* dst = (f32x4*)FST + (size_t)(u * 7 + g) * 24 * 64 + lane;
#pragma unroll
        for (int mt = 0; mt < 6; ++mt)
#pragma unroll
            for (int i4 = 0; i4 < 4; ++i4) dst[(mt * 4 + i4) * 64] = (f32x4){S[mt][4 * i4], S[mt][4 * i4 + 1], S[mt][4 * i4 + 2], S[mt][4 * i4 + 3]}; }
}
__device__ __forceinline__ void gla_seg_outputs(const bf16* QF, const bf16* KDT, const bf16* VT, const float* ACH, const float* FST, const float* DSEG, bf16* OG, int gw, int NGW, int lane) {
    const int r = lane & 31, hi = lane >> 5;
    for (int t = gw; t < 384 * 8; t += NGW) { const int g = t / 384, u = t - g * 384; const int bh = u / 12, n32 = u - bh * 12, b = bh >> 2, h = bh & 3;
        f32x16 S[6];
#pragma unroll
        for (int mt = 0; mt < 6; ++mt)
#pragma unroll
            for (int i = 0; i < 16; ++i) S[mt][i] = 0.f;
        for (int gp = 0; gp < g; ++gp) {
            const float* fs = FST + (size_t)(u * 7 + gp) * 24 * 64 * 4; const float* ds = DSEG + (size_t)(bh * 8 + gp) * 192; const unsigned lo16 = (unsigned)lane * 16u, hi16 = (unsigned)hi * 16u;
#pragma unroll
            for (int half = 0; half < 2; ++half) { f32x4 f4[3][4], d4[3][4];
#pragma unroll
                for (int m3 = 0; m3 < 3; ++m3)
#pragma unroll
                    for (int i4 = 0; i4 < 4; ++i4) { f4[m3][i4] = *(const f32x4*)((const char*)(fs + ((3 * half + m3) * 4 + i4) * 256) + lo16); d4[m3][i4] = *(const f32x4*)((const char*)(ds + 32 * (3 * half + m3) + 8 * i4) + hi16); }
                __builtin_amdgcn_sched_barrier(0);
#pragma unroll
                for (int m3 = 0; m3 < 3; ++m3)
#pragma unroll
                    for (int i4 = 0; i4 < 4; ++i4)
#pragma unroll
                        for (int e = 0; e < 4; ++e) S[3 * half + m3][4 * i4 + e] = S[3 * half + m3][4 * i4 + e] * d4[m3][i4][e] + f4[m3][i4][e];
                __builtin_amdgcn_sched_barrier(0); } }
        for (int c = 8 * g; c < 8 * g + 8; ++c) { const int ci = bh * 64 + c; const size_t t0 = (size_t)b * SEQ + c * 64;
            gla_update(S, KDT + (size_t)ci * 192 * 64, VT + ((size_t)ci * 12 + n32) * 4 * 64 * 8, ACH + (size_t)ci * 192, lane, hi);
            gla_output(S, QF + (size_t)ci * 192 * 64, OG + t0 * 1536 + h * 384 + n32 * 32 + r, lane, r, hi); }
    }
}
__device__ __forceinline__ void gla_post(const bf16* OG, const bf16* PROJ, const float* onorm  , bf16* MIX, int gw, int NGW, int lane) {
    const int la = lane < 48 ? lane : 0;
    const f32x4 g0 = *(const f32x4*)(onorm + 8 * la), g1 = *(const f32x4*)(onorm + 8 * la + 4);
    for (int t = gw; t < M * 4; t += NGW) { const int row = t >> 2, h = t & 3;
        v4u w = {0u, 0u, 0u, 0u}, gw4 = {0u, 0u, 0u, 0u};
        if (lane < 48) { w = *(const v4u*)(OG + (size_t)row * 1536 + h * 384 + 8 * lane); gw4 = *(const v4u*)(PROJ + (size_t)row * NA + A_G + h * 384 + 8 * lane); }
        float x[8] = {bf_lo(w.x), bf_hi(w.x), bf_lo(w.y), bf_hi(w.y), bf_lo(w.z), bf_hi(w.z), bf_lo(w.w), bf_hi(w.w)};
        float g[8] = {bf_lo(gw4.x), bf_hi(gw4.x), bf_lo(gw4.y), bf_hi(gw4.y), bf_lo(gw4.z), bf_hi(gw4.z), bf_lo(gw4.w), bf_hi(gw4.w)};
        float ss = 0.f;
#pragma unroll
        for (int e = 0; e < 8; ++e) ss += x[e] * x[e];
        const float rinv = 1.0f / sqrtf(wave_sum(ss) * (1.0f / 384.f) + EPS);
        float y[8];
#pragma unroll
        for (int e = 0; e < 8; ++e) y[e] = x[e] * rinv * (e < 4 ? g0[e] : g1[e - 4]) * pg8::silu_f(g[e]);
        if (lane < 48) { v4u o; o.x = pkbf(y[0], y[1]); o.y = pkbf(y[2], y[3]); o.z = pkbf(y[4], y[5]); o.w = pkbf(y[6], y[7]);
            *(v4u*)(MIX + (size_t)row * DM + h * 384 + 8 * lane) = o; } }
}
__device__ __forceinline__ void fox_cumsum(const float* F, const float* b_f, float* CB, int gw, int NGW, int lane) {
    for (int t = gw; t < BATCH * 12; t += NGW) { const int b = t / 12, h = t - b * 12; const float bf = b_f[h];
        const float* src = F + ((size_t)b * SEQ + lane * 64) * 16 + h;
        float v[64]; float run = 0.f;
#pragma unroll
        for (int j = 0; j < 64; ++j) { run += logsig(src[(size_t)j * 16] + bf); v[j] = run; }
        float incl = run;
#pragma unroll
        for (int o = 1; o < 64; o <<= 1) { const float y = __uint_as_float((unsigned)__builtin_amdgcn_ds_bpermute((lane - o) << 2, (int)__float_as_uint(incl))); if (lane >= o) incl += y; }
        const float excl = incl - run;
        float* dst = CB + (size_t)t * SEQ + lane * 64;
#pragma unroll
        for (int j = 0; j < 64; ++j) dst[j] = -(excl + v[j]) * 11.313708498984761f; }
}
struct AttCfg { const bf16* PROJ; const bf16* KSVS; const float* CB; const bf16* MK; const bf16* MV; bf16* MIX; int np, qmcol, fox, vcu, G; };
__device__ __forceinline__ fa::BlockRef att_ref(const AttCfg& c, int idx, int nf) {
    fa::BlockRef r;
    if (idx < nf) { const int L = c.vcu + c.G * (idx >> 1); const int bh = L >> 3, x = L & 7; const int qb = (idx & 1) ? 15 - x : x; const int b = bh / 12, h = bh - b * 12;
        const size_t row0 = (size_t)b * SEQ + qb * 256;
        r.Q = c.PROJ + row0 * c.np + B_Q + h * 128; r.G = c.PROJ + row0 * c.np + B_G + h * 128; r.K = c.KSVS + (size_t)b * SEQ * 3072 + h * 128; r.V = r.K + 1536; r.O = c.MIX + row0 * DM + h * 128;
        r.CB = c.CB + (size_t)bh * SEQ; r.P0 = qb * 256; r.skv = SEQ; r.qp = c.np; r.kp = 3072; }
    else { const int mb = c.vcu + c.G * (idx - nf); const int rb = mb >> 2, mh = mb & 3; const int b = rb >> 4; const size_t row0 = (size_t)rb * 256;
        r.Q = c.PROJ + row0 * c.np + c.qmcol + mh * 128; r.G = nullptr; r.K = c.MK + (size_t)b * MEMT * 512 + mh * 128; r.V = c.MV + (size_t)b * MEMT * 512 + mh * 128; r.O = c.MIX + row0 * DM + 1536 + mh * 128;
        r.CB = nullptr; r.P0 = 256; r.skv = MEMT; r.qp = c.np; r.kp = 512; }
    return r;
}
__device__ __forceinline__ void att_phase(const AttCfg& c, char* lds, int wave) {
    const int nfi = (c.fox && c.vcu < 768) ? (768 - c.vcu + c.G - 1) / c.G : 0, nf = 2 * nfi;
    const int nm = c.vcu < 512 ? (512 - c.vcu + c.G - 1) / c.G : 0;
    const int nblk = nf + nm;
    if (nblk == 0) return;
    fa::BlockRef cur = att_ref(c, 0, nf); fa::Seam S;
    fa::attn_prime(cur, lds, S, wave);
    for (int i = 0; i < nblk; ++i) {
        const fa::BlockRef nxt = (i + 1 < nblk) ? att_ref(c, i + 1, nf) : cur;
        fa::attn_block(cur, nxt, lds, S, wave);
        cur = nxt;
    }
}

struct Args { const float* in[22]; float* out; unsigned char* ws; int lo, hi; };
constexpr int PT_OUT = 22, PT_WS = 23;
#define PTR(k) ldp(PT, (k))
__global__ void __launch_bounds__(NWAVES * 64, 2) mega_fwd(Args args) {
    extern __shared__ __attribute__((aligned(16))) unsigned char lds_raw[];
    LAS unsigned char* lds = (LAS unsigned char*)lds_raw;
    volatile LAS unsigned* MISC = (volatile LAS unsigned*)(lds + MISC_OFF);
    volatile LAS unsigned* PT = (volatile LAS unsigned*)(lds + MISC_OFF + 128);
    const int wave = __builtin_amdgcn_readfirstlane((int)threadIdx.x >> 6);
    const int G = gridDim.x; const int bx = blockIdx.x; const int vcu = (G % 8 == 0) ? (bx % 8) * (G / 8) + bx / 8 : bx;
    const int gw = vcu * NWAVES + wave, NGW = G * NWAVES;
    for (int u = threadIdx.x; u < (LDS_BYTES - LDSCTL_OFF) / 4; u += NWAVES * 64) ((LAS unsigned*)(lds + LDSCTL_OFF))[u] = 0u;
    __syncthreads();
    if (threadIdx.x == 0) {
#pragma unroll
        for (int k = 0; k < 22; ++k) { const unsigned long long p = (unsigned long long)args.in[k]; PT[2 * k] = (unsigned)p; PT[2 * k + 1] = (unsigned)(p >> 32); }
        { const unsigned long long p = (unsigned long long)args.out; PT[2 * PT_OUT] = (unsigned)p; PT[2 * PT_OUT + 1] = (unsigned)(p >> 32); }
        { const unsigned long long p = (unsigned long long)args.ws; PT[2 * PT_WS] = (unsigned)p; PT[2 * PT_WS + 1] = (unsigned)(p >> 32); }
    }
    __syncthreads();
    const int lo = args.lo, hi = args.hi < MK_STOP_PC ? args.hi : MK_STOP_PC;
    const bool use_bar = (args.hi - args.lo) > 1;
    XcdBarrier bar; bar.bar = (unsigned*)((unsigned char*)PTR(PT_WS) + WS_CTL) + CW_BAR; bar.x = 0; bar.st = MISC + 8; bar.wave = wave;
    if (use_bar) bar = xcd_barrier_post(bar.bar, MISC + 8, wave);

    int pc = 0;
#define PH_ON (pc >= lo && pc < hi)
#define PH_END do { if (use_bar && pc >= lo && pc + 1 < hi) { XcdBarrier bb; bb.bar = (unsigned*)((unsigned char*)PTR(PT_WS) + WS_CTL) + CW_BAR; bb.x = bar.x; bb.st = MISC + 8; bb.wave = wave; xcd_barrier(bb); } ++pc; } while (0)
#define WSP ((unsigned char*)PTR(PT_WS))
#define PH_BEGIN if (PH_ON) { const int lane = lane_id(); const int gwp = launder_s(gw), vcup = launder_s(vcu), bxp = launder_s(bx), wavep = launder_s(wave); unsigned char* ws = WSP; (void)lane; (void)gwp; (void)vcup; (void)bxp; (void)wavep;
#define XOUT ((float*)PTR(PT_OUT))

    PH_BEGIN
#ifndef DBG_NO_CVT
        for (int rep = 0; rep < REP_CVT; ++rep) convert_phase(PT, ws, XOUT, lds, gwp, NGW, lane, wavep);
#endif
    }
    PH_END;
    PH_BEGIN pg8::Gemm g{(const bf16*)(ws + WS_MEMB), (const bf16*)(ws + WS_WMEM), MROWS, NMEMW, DM}; pg8::StaticOrder S; S.init(MROWS, NMEMW, G, bxp);
        pg8::EpiF32 E{(float*)(ws + WS_MKVF), NMEMW};
        for (int rep = 0; rep < REP_MEMG; ++rep) pg8::gemm_phase<pg8::EpiF32, pg8::StaticOrder, true, true>(lds, g, S, E, wavep); }
    PH_END;

    for (int l = 0; l < DEPTH; ++l) {
        for (int sub = 0; sub < 2; ++sub) {
            const int mat = l * 2 + sub;
            if (l == 2 && sub == 0) {
                PH_BEGIN pg8::Gemm g{(const bf16*)(ws + WS_HMIX), (const bf16*)(ws + WS_WKV), M, NKV, DM}; pg8::StaticOrder S; S.init(M, NKV, G, bxp);
                    pg8::EpiKV E{(bf16*)(ws + WS_KSVS), 3072, (float*)(ws + WS_F), pg8::RinvCache{(const float*)(ws + WS_SS) + (size_t)6 * M * 2, (LAS float*)(lds + RTAB_OFF), -1}};
                    for (int rep = 0; rep < REP_KVG; ++rep) pg8::gemm_phase<pg8::EpiKV, pg8::StaticOrder, true, true>(lds, g, S, E, wavep); }
                PH_END;
                PH_BEGIN hn_pass((bf16*)(ws + WS_KSVS), 3072, 0, 12, PTR(21), gwp, NGW, lane);
#ifndef DBG_NO_CUM
                    fox_cumsum((const float*)(ws + WS_F), PTR(20), (float*)(ws + WS_CB), gwp, NGW, lane);
#endif
                    }
                PH_END;
            }
            PH_BEGIN if (l == 0 && sub == 0) mkmv_pass((const float*)(ws + WS_MKVF), (bf16*)(ws + WS_MK), (bf16*)(ws + WS_MV), PTR(10), gwp, NGW, lane);
                pg8::Gemm g{(const bf16*)(ws + (sub ? WS_XB2 : WS_HMIX)), (const bf16*)(ws + WS_WUP) + (size_t)mat * NUP * DM, M, NUP, DM}; pg8::StaticOrder S; S.init(M, NUP, G, bxp);
                pg8::EpiSwiGLU E{(bf16*)(ws + WS_ACT), FF, pg8::RinvCache{(const float*)(ws + WS_SS) + (size_t)(3 * l + 2 * sub) * M * 2, (LAS float*)(lds + RTAB_OFF), -1}};
                for (int rep = 0; rep < REP_UP; ++rep) pg8::gemm_phase<pg8::EpiSwiGLU, pg8::StaticOrder, true, true>(lds, g, S, E, wavep); }
            PH_END;
            PH_BEGIN pg8::Gemm g{(const bf16*)(ws + WS_ACT), (const bf16*)(ws + WS_WDN) + (size_t)mat * DM * FF, M, DM, FF}; pg8::StaticOrder S; S.init(M, DM, G, bxp);
                float* X = XOUT;
                const int ssid = (l == DEPTH - 1 && sub == 1) ? 12 : (sub ? 3 * (l + 1) : 3 * l + 1);
                { pg8::EpiResAdd E{PT, PT_OUT, PT_WS, WS_HMIX, WS_SS + (size_t)ssid * M * 8, DM, 0.5f};
                  pg8::gemm_phase<pg8::EpiResAdd, pg8::StaticOrder, true, true>(lds, g, S, E, wavep); }
#if REP_DN > 1
                for (int rep = 1; rep < REP_DN; ++rep) { pg8::EpiResAdd E{PT, PT_OUT, PT_WS, WS_XB2, WS_SS + (size_t)12 * M * 8, DM, 0.f}; pg8::gemm_phase<pg8::EpiResAdd, pg8::StaticOrder, true, true>(lds, g, S, E, wavep); }
#endif
                }
            PH_END;
            if (sub == 0) {
                const int np = l < 2 ? NA : NB;
                PH_BEGIN const bf16* wt = l < 2 ? (const bf16*)(ws + WS_WAIN) + (size_t)l * NA * DM : (const bf16*)(ws + WS_WBIN) + (size_t)(l - 2) * NB * DM;
                    pg8::Gemm g{(const bf16*)(ws + WS_HMIX), wt, M, np, DM}; pg8::StaticOrder S; S.init(M, np, G, bxp);
                    pg8::EpiB16 E{(bf16*)(ws + WS_ACT), np, pg8::RinvCache{(const float*)(ws + WS_SS) + (size_t)(3 * l + 1) * M * 2, (LAS float*)(lds + RTAB_OFF), -1}};
                    for (int rep = 0; rep < REP_IN; ++rep) pg8::gemm_phase<pg8::EpiB16, pg8::StaticOrder, true, true>(lds, g, S, E, wavep); }
                PH_END;
                if (l < 2) {
                    PH_BEGIN
#ifndef DBG_NO_PREP
                        for (int rep = 0; rep < REP_PREP; ++rep) gla_prep((const bf16*)(ws + WS_ACT), PTR(14) + l * 768, (bf16*)(ws + WS_KDT), (bf16*)(ws + WS_VT), (bf16*)(ws + WS_QF), (float*)(ws + WS_ACH), gwp, NGW, lane);
#endif
                        hn_pass((bf16*)(ws + WS_ACT), NA, A_QM, 4, PTR(9) + l * 128, gwp, NGW, lane); }
                    PH_END;
                    PH_BEGIN
                        for (int rep = 0; rep < REP_SCAN; ++rep) gla_seg_states((const bf16*)(ws + WS_KDT), (const bf16*)(ws + WS_VT), (const float*)(ws + WS_ACH), (float*)(ws + WS_FST), (float*)(ws + WS_DSEG), gwp, NGW, lane);
                    }
                    PH_END;
                    PH_BEGIN
                        for (int rep = 0; rep < REP_SCAN; ++rep) gla_seg_outputs((const bf16*)(ws + WS_QF), (const bf16*)(ws + WS_KDT), (const bf16*)(ws + WS_VT), (const float*)(ws + WS_ACH), (const float*)(ws + WS_FST), (const float*)(ws + WS_DSEG), (bf16*)(ws + WS_OG), gwp, NGW, lane);
                    }
                    PH_END;
                } else {
                    PH_BEGIN
                        hn_pass((bf16*)(ws + WS_ACT), NB, B_Q, 12, PTR(17) + (l - 2) * 128, gwp, NGW, lane); hn_pass((bf16*)(ws + WS_ACT), NB, B_QM, 4, PTR(9) + l * 128, gwp, NGW, lane); }
                    PH_END;
                }
                PH_BEGIN
                    if (l < 2) gla_post((const bf16*)(ws + WS_OG), (const bf16*)(ws + WS_ACT), PTR(15) + l * 384, (bf16*)(ws + WS_HMIX), gwp, NGW, lane);
                    AttCfg c; c.PROJ = (const bf16*)(ws + WS_ACT); c.KSVS = (const bf16*)(ws + WS_KSVS); c.CB = (const float*)(ws + WS_CB); c.MK = (const bf16*)(ws + WS_MK) + (size_t)l * MROWS * 512; c.MV = (const bf16*)(ws + WS_MV) + (size_t)l * MROWS * 512;
                    c.MIX = (bf16*)(ws + WS_HMIX); c.np = np; c.qmcol = l < 2 ? A_QM : B_QM; c.fox = l >= 2; c.vcu = vcup; c.G = G;
                    __syncthreads();
#ifndef DBG_NO_ATT
                    for (int rep = 0; rep < REP_ATT; ++rep) att_phase(c, (char*)lds_raw, wavep);
#endif
                    }
                PH_END;
                PH_BEGIN pg8::Gemm g{(const bf16*)(ws + WS_HMIX), (const bf16*)(ws + WS_WOUT) + (size_t)l * DM * DM, M, DM, DM}; pg8::StaticOrder S; S.init(M, DM, G, bxp);
                    float* X = XOUT;
                    { pg8::EpiResAdd E{PT, PT_OUT, PT_WS, WS_XB2, WS_SS + (size_t)(3 * l + 2) * M * 8, DM, 1.0f};
                      pg8::gemm_phase<pg8::EpiResAdd, pg8::StaticOrder, true, true>(lds, g, S, E, wavep); }
#if REP_OUT > 1
                    for (int rep = 1; rep < REP_OUT; ++rep) { pg8::EpiResAdd E{PT, PT_OUT, PT_WS, WS_XB2, WS_SS + (size_t)12 * M * 8, DM, 0.f}; pg8::gemm_phase<pg8::EpiResAdd, pg8::StaticOrder, true, true>(lds, g, S, E, wavep); }
#endif
                    }
                PH_END;
            }
        }
    }
#undef PH_ON
#undef PH_END
#undef WSP
#undef PH_BEGIN
#undef XOUT
}

extern "C" void kernel_launch(void* const* d_in, const int* in_sizes, int n_in, void* d_out, int out_size, void* d_ws, size_t ws_size, hipStream_t stream) {
    static int grid = 0;
    if (grid == 0) {
        if (n_in != 22 || in_sizes[0] != M * DM || out_size != M * DM || ws_size < WS_END) { fprintf(stderr, "kernel_launch: unexpected shapes (n_in %d, in0 %d, out %d, ws %zu < %zu); nothing launched\n", n_in, n_in > 0 ? in_sizes[0] : -1, out_size, ws_size, (size_t)WS_END); grid = -1; return; }
        int dev = 0, cus = 0, per_cu = 0;
        if (hipGetDevice(&dev) != hipSuccess || hipDeviceGetAttribute(&cus, hipDeviceAttributeMultiprocessorCount, dev) != hipSuccess) { fprintf(stderr, "kernel_launch: device query failed\n"); grid = -1; return; }
        if (hipFuncSetAttribute((const void*)mega_fwd, hipFuncAttributeMaxDynamicSharedMemorySize, LDS_BYTES) != hipSuccess) { fprintf(stderr, "kernel_launch: hipFuncSetAttribute failed\n"); grid = -1; return; }
        if (hipOccupancyMaxActiveBlocksPerMultiprocessor(&per_cu, (const void*)mega_fwd, NWAVES * 64, LDS_BYTES) != hipSuccess || per_cu < 1)
            fprintf(stderr, "kernel_launch: note: occupancy query reports %d workgroups per CU\n", per_cu);
        (void)hipGetLastError();
        grid = cus;
    }
    if (grid < 0) return;
    (void)hipMemsetAsync((char*)d_ws + WS_CTL, 0, CTL_ZERO_BYTES, stream);
    (void)hipMemsetAsync((char*)d_ws + WS_SS, 0, SS_BYTES, stream);
    Args a{};
    for (int i = 0; i < 22; ++i) a.in[i] = (const float*)d_in[i];
    a.out = (float*)d_out; a.ws = (unsigned char*)d_ws;
#if MK_PER_PHASE
    for (int p = 0; p < NPH && p < MK_STOP_PC; ++p) { a.lo = p; a.hi = p + 1; hipLaunchKernelGGL(mega_fwd, dim3(grid), dim3(NWAVES * 64), LDS_BYTES, stream, a); }
#else
    a.lo = 0; a.hi = NPH; hipLaunchKernelGGL(mega_fwd, dim3(grid), dim3(NWAVES * 64), LDS_BYTES, stream, a);
#endif
}
```

```cpp
#include <hip/hip_runtime.h>
#include <cstdio>
#include <cstdint>
__device__ __forceinline__ int lane_id_v() { int l; asm volatile("v_mbcnt_lo_u32_b32 %0, -1, 0\n\tv_mbcnt_hi_u32_b32 %0, -1, %0" : "=v"(l)); return l; }
namespace pg8 {
#define PG8_LAS __attribute__((address_space(3)))
typedef unsigned short bf16_t;
typedef short bf16x8 __attribute__((ext_vector_type(8)));
typedef float f32x4 __attribute__((ext_vector_type(4)));
typedef unsigned u32x4 __attribute__((ext_vector_type(4)));
constexpr int BM = 256, BK = 64, HALF = 128, HTB = HALF * BK * 2  , STAGE_BYTES = 8 * HTB, NXCD = 8, WGM = 8;

__host__ __device__ __forceinline__ int lds_byte(int r, int c) { const int st = (r >> 4) * 2 + (c >> 5), rr = r & 15, cc = c & 31, ob = rr * 64 + cc * 2; return st * 1024 + (ob ^ (((ob >> 9) & 1) << 5)); }
__host__ __device__ __forceinline__ void stage_rc(int b, int& R, int& C) { const int st = b / 1024, sb = b % 1024, swz = sb ^ (((sb >> 9) & 1) << 5); R = (st >> 1) * 16 + swz / 64; C = (st & 1) * 32 + (swz % 64) / 2; }
__host__ __device__ __forceinline__ int perm32(int rho) { const int n = rho >> 4, i = rho & 15; return 8 * (i >> 2) + 4 * n + (i & 3); }

struct Unit { int pm, pn; };
struct Gemm { const bf16_t* A; const bf16_t* Bt; int M, N, K; };

struct StaticOrder {
    int nM, nN, nwg, G, c;
    __host__ __device__ void init(int M, int N, int G_, int c_) { nM = M / BM; nN = N / BM; nwg = nM * nN; G = G_; c = c_; }
    __host__ __device__ bool next(int i, Unit& u) const {
        const long L = (long)i * G + c; if (L >= nwg) return false;
        int wgid = (int)L; { const int q = nwg / NXCD, r = nwg % NXCD, xcd = wgid % NXCD, off = wgid / NXCD; wgid = (xcd < r ? xcd * (q + 1) : r * (q + 1) + (xcd - r) * q) + off; }
        const int nig = WGM * nN, gid = wgid / nig, fm = gid * WGM, gsz = (nM - fm) < WGM ? (nM - fm) : WGM;
        u.pm = fm + ((wgid % nig) % gsz); u.pn = (wgid % nig) / gsz; return true;
    }
    __device__ __forceinline__ void a_ready(const Unit&) const {}
    __device__ __forceinline__ void done(const Unit&) const {}
};

__device__ __forceinline__ unsigned cvt_pk_bf16(float lo, float hi) { unsigned r; asm volatile("v_cvt_pk_bf16_f32 %0, %1, %2" : "=v"(r) : "v"(lo), "v"(hi)); return r; }
typedef float f32x2 __attribute__((ext_vector_type(2)));
__device__ __forceinline__ f32x2 gelu_pk(f32x2 v) {
    const f32x2 av = __builtin_elementwise_abs(v), d = av * 0.2316418882f + 1.0f;
    f32x2 t; t.x = __builtin_amdgcn_rcpf(d.x); t.y = __builtin_amdgcn_rcpf(d.y);
    f32x2 q = t * 0.5307027145f + (-0.7265760135f); q = q * t + 0.7107068705f; q = q * t + (-0.142248368f); q = q * t + 0.127414796f; q = q * t;
    const f32x2 s = (v * v) * (-0.72134752044f);
    f32x2 e; e.x = __builtin_amdgcn_exp2f(s.x); e.y = __builtin_amdgcn_exp2f(s.y);
    const f32x2 m = v * (q * e), r = v - m;
    f32x2 o; o.x = v.x < 0.f ? m.x : r.x; o.y = v.y < 0.f ? m.y : r.y; return o;
}

template <int ACT  > struct EpiBf16 {
    static constexpr bool PERM = true, AFTER_DRAIN = false; static_assert(ACT == 0 || ACT == 1, "EpiBf16: ACT is 0 (none) or 1 (gelu_pk)");
    bf16_t* O; int ldc; const float* bias; int split_cols; size_t split_stride; float scale0;
    __device__ __forceinline__ void operator()(const f32x4 (&acc)[2][2][4][2], const Unit& u, int wr, int wc, int fr, int fq) const {
        const int row0 = u.pm * BM + wr * 64 + fr; int colt = u.pn * BM; bf16_t* base = O;
        float sc = 1.f; if (split_cols) { const int t = colt / split_cols; base += (size_t)t * split_stride; colt -= t * split_cols; if (t == 0) sc = scale0; }
        const int col0 = colt + wc * 32 + 8 * fq, bcol0 = u.pn * BM + wc * 32 + 8 * fq;
        f32x4 bv[2][2];
#pragma unroll
        for (int bj = 0; bj < 2; ++bj)
#pragma unroll
            for (int n = 0; n < 2; ++n) bv[bj][n] = bias ? *(const f32x4*)(bias + bcol0 + bj * HALF + 4 * n) : (f32x4){0.f, 0.f, 0.f, 0.f};
#pragma unroll
        for (int ai = 0; ai < 2; ++ai)
#pragma unroll
            for (int m = 0; m < 4; ++m) { bf16_t* rowp = base + (size_t)(row0 + ai * HALF + m * 16) * ldc + col0;
#pragma unroll
                for (int bj = 0; bj < 2; ++bj) { f32x4 v0 = acc[ai][bj][m][0] + bv[bj][0], v1 = acc[ai][bj][m][1] + bv[bj][1];
                    if (ACT == 1) { f32x2 a = gelu_pk((f32x2){v0[0], v0[1]}), b = gelu_pk((f32x2){v0[2], v0[3]}), c = gelu_pk((f32x2){v1[0], v1[1]}), d = gelu_pk((f32x2){v1[2], v1[3]});
                        v0 = (f32x4){a.x, a.y, b.x, b.y}; v1 = (f32x4){c.x, c.y, d.x, d.y}; }
                    v0 = v0 * sc; v1 = v1 * sc; u32x4 w; w.x = cvt_pk_bf16(v0[0], v0[1]); w.y = cvt_pk_bf16(v0[2], v0[3]); w.z = cvt_pk_bf16(v1[0], v1[1]); w.w = cvt_pk_bf16(v1[2], v1[3]);
                    *(u32x4*)(rowp + bj * HALF) = w; } }
    }
};

__device__ __forceinline__ unsigned pkbf(float lo, float hi) {
    typedef __bf16 bf2_t __attribute__((ext_vector_type(2))); typedef float fl2_t __attribute__((ext_vector_type(2)));
    fl2_t v = {lo, hi}; bf2_t r = __builtin_convertvector(v, bf2_t); return __builtin_bit_cast(unsigned, r);
}
__device__ __forceinline__ float silu_f(float x) { return x * __builtin_amdgcn_rcpf(1.0f + __builtin_amdgcn_exp2f(-1.4426950408889634f * x)); }

__device__ __forceinline__ float rinv_of(const float* ss, int row) { const float s = (float)((const unsigned long long*)ss)[row] * (1.0f / 16777216.0f); return 1.0f / sqrtf(s * (1.0f / 2048.f) + 1e-6f); }
struct RinvCache {
    const float* ss; PG8_LAS float* tab; mutable int pm_cached;
    __device__ __forceinline__ void get(float (&ri)[2][4], const Unit& u, int wr, int wc, int fr) const {
        PG8_LAS float* t = tab + (wr * 4 + wc) * 128;
        if (u.pm != pm_cached) { pm_cached = u.pm; const int l = lane_id_v();
            t[l] = rinv_of(ss, u.pm * BM + wr * 64 + l); t[64 + l] = rinv_of(ss, u.pm * BM + HALF + wr * 64 + l);
            asm volatile("s_waitcnt lgkmcnt(0)" ::: "memory"); }
#pragma unroll
        for (int ai = 0; ai < 2; ++ai)
#pragma unroll
            for (int m = 0; m < 4; ++m) ri[ai][m] = t[ai * 64 + m * 16 + fr];
    }
};
struct EpiSwiGLU {
    static constexpr bool PERM = true, AFTER_DRAIN = false;
    bf16_t* O; int ldc; RinvCache rc;
    __device__ __forceinline__ void operator()(const f32x4 (&acc)[2][2][4][2], const Unit& u, int wr, int wc, int fr, int fq) const {
        const int row0 = u.pm * BM + wr * 64 + fr, col0 = u.pn * HALF + wc * 32 + 8 * fq;
        float rit[2][4]; rc.get(rit, u, wr, wc, fr);
#pragma unroll
        for (int ai = 0; ai < 2; ++ai)
#pragma unroll
            for (int m = 0; m < 4; ++m) { bf16_t* rowp = O + (size_t)(row0 + ai * HALF + m * 16) * ldc + col0;
                const float ri = rit[ai][m];
                const f32x4 g0 = acc[ai][0][m][0] * ri, g1 = acc[ai][0][m][1] * ri, u0 = acc[ai][1][m][0] * ri, u1 = acc[ai][1][m][1] * ri;
                u32x4 w;
                w.x = pkbf(silu_f(g0[0]) * u0[0], silu_f(g0[1]) * u0[1]); w.y = pkbf(silu_f(g0[2]) * u0[2], silu_f(g0[3]) * u0[3]);
                w.z = pkbf(silu_f(g1[0]) * u1[0], silu_f(g1[1]) * u1[1]); w.w = pkbf(silu_f(g1[2]) * u1[2], silu_f(g1[3]) * u1[3]);
                *(u32x4*)rowp = w; }
    }
};
typedef unsigned u32x2 __attribute__((ext_vector_type(2)));
template <bool FINAL> struct EpiRes {
    static constexpr bool PERM = true, AFTER_DRAIN = false;
    volatile PG8_LAS unsigned* PT; int slot_out, slot_ws; size_t base_off, out_off, ss_off; int base_in_ws, out_in_ws; float scale; int row_base;
    __device__ __forceinline__ void operator()(const f32x4 (&acc)[2][2][4][2], const Unit& u, int wr, int wc, int fr, int fq) const {
        typedef __attribute__((address_space(1))) unsigned char gchar;
        unsigned char* dout = (unsigned char*)(gchar*)(((unsigned long long)__builtin_amdgcn_readfirstlane(PT[2 * slot_out + 1]) << 32) | (unsigned)__builtin_amdgcn_readfirstlane(PT[2 * slot_out]));
        unsigned char* ws = (unsigned char*)(gchar*)(((unsigned long long)__builtin_amdgcn_readfirstlane(PT[2 * slot_ws + 1]) << 32) | (unsigned)__builtin_amdgcn_readfirstlane(PT[2 * slot_ws]));
        const bf16_t* base = (const bf16_t*)(base_in_ws ? ws + base_off : dout); bf16_t* outb = (bf16_t*)(out_in_ws ? ws + out_off : dout); float* outf = (float*)dout; float* ss = (float*)(ws + ss_off);
        constexpr int ldc = 2048;
        const int row0 = row_base + u.pm * BM + wr * 64 + fr, col0 = u.pn * BM + wc * 32 + 8 * fq;
#pragma unroll
        for (int ai = 0; ai < 2; ++ai) {
            u32x4 b[4][2];
#pragma unroll
            for (int m = 0; m < 4; ++m) { const size_t off = (size_t)(row0 + ai * HALF + m * 16) * ldc + col0;
#pragma unroll
                for (int bj = 0; bj < 2; ++bj) b[m][bj] = *(const u32x4*)(base + off + bj * HALF); }
#pragma unroll
            for (int m = 0; m < 4; ++m) { const size_t off = (size_t)(row0 + ai * HALF + m * 16) * ldc + col0; float q = 0.f;
#pragma unroll
                for (int bj = 0; bj < 2; ++bj) { const u32x4 r = b[m][bj];
                    f32x4 x0 = {__uint_as_float(r.x << 16), __uint_as_float(r.x & 0xffff0000u), __uint_as_float(r.y << 16), __uint_as_float(r.y & 0xffff0000u)};
                    f32x4 x1 = {__uint_as_float(r.z << 16), __uint_as_float(r.z & 0xffff0000u), __uint_as_float(r.w << 16), __uint_as_float(r.w & 0xffff0000u)};
                    x0 = x0 + acc[ai][bj][m][0] * scale; x1 = x1 + acc[ai][bj][m][1] * scale;
                    if (FINAL) { *(f32x4*)(outf + off + bj * HALF) = x0; *(f32x4*)(outf + off + bj * HALF + 4) = x1; }
                    else { q += ((x0[0] * x0[0] + x0[1] * x0[1]) + (x0[2] * x0[2] + x0[3] * x0[3])) + ((x1[0] * x1[0] + x1[1] * x1[1]) + (x1[2] * x1[2] + x1[3] * x1[3]));
                        u32x4 w; w.x = pkbf(x0[0], x0[1]); w.y = pkbf(x0[2], x0[3]); w.z = pkbf(x1[0], x1[1]); w.w = pkbf(x1[2], x1[3]); *(u32x4*)(outb + off + bj * HALF) = w; } }
                if (!FINAL) {
                    q += __uint_as_float((unsigned)__builtin_amdgcn_ds_swizzle((int)__float_as_uint(q), (16 << 10) | 0x1f));
                    const auto rr = __builtin_amdgcn_permlane32_swap(__float_as_uint(q), __float_as_uint(q), false, false);
                    q = __uint_as_float(rr[0]) + __uint_as_float(rr[1]);
                    if (fq == 0) atomicAdd((unsigned long long*)ss + row0 + ai * HALF + m * 16, (unsigned long long)(q * 16777216.0f)); } }
            asm volatile("" ::: "memory"); }
    }
};
struct EpiF32 {
    static constexpr bool PERM = false, AFTER_DRAIN = false;
    float* C; int ldc;
    __device__ __forceinline__ void operator()(const f32x4 (&acc)[2][2][4][2], const Unit& u, int wr, int wc, int fr, int fq) const {
        const int row0 = u.pm * BM + wr * 64 + fr, col0 = u.pn * BM + wc * 32 + 4 * fq;
#pragma unroll
        for (int ai = 0; ai < 2; ++ai)
#pragma unroll
            for (int m = 0; m < 4; ++m) { float* rowp = C + (size_t)(row0 + ai * HALF + m * 16) * ldc + col0;
#pragma unroll
                for (int bj = 0; bj < 2; ++bj)
#pragma unroll
                    for (int n = 0; n < 2; ++n) *(f32x4*)(rowp + bj * HALF + n * 16) = acc[ai][bj][m][n]; }
    }
};
struct EpiB16 {
    static constexpr bool PERM = true, AFTER_DRAIN = false;
    bf16_t* O; int ldc; RinvCache rc;
    __device__ __forceinline__ void operator()(const f32x4 (&acc)[2][2][4][2], const Unit& u, int wr, int wc, int fr, int fq) const {
        const int row0 = u.pm * BM + wr * 64 + fr, col0 = u.pn * BM + wc * 32 + 8 * fq;
        float rit[2][4]; rc.get(rit, u, wr, wc, fr);
#pragma unroll
        for (int ai = 0; ai < 2; ++ai)
#pragma unroll
            for (int m = 0; m < 4; ++m) { bf16_t* rowp = O + (size_t)(row0 + ai * HALF + m * 16) * ldc + col0; const float ri = rit[ai][m];
#pragma unroll
                for (int bj = 0; bj < 2; ++bj) { const f32x4 v0 = acc[ai][bj][m][0] * ri, v1 = acc[ai][bj][m][1] * ri;
                    u32x4 w; w.x = pkbf(v0[0], v0[1]); w.y = pkbf(v0[2], v0[3]); w.z = pkbf(v1[0], v1[1]); w.w = pkbf(v1[2], v1[3]);
                    *(u32x4*)(rowp + bj * HALF) = w; } }
    }
};
struct EpiKV {
    static constexpr bool PERM = true, AFTER_DRAIN = false;
    bf16_t* O; int ldc; float* F; RinvCache rc;
    __device__ __forceinline__ void operator()(const f32x4 (&acc)[2][2][4][2], const Unit& u, int wr, int wc, int fr, int fq) const {
        const int row0 = u.pm * BM + wr * 64 + fr;
        float rit[2][4]; rc.get(rit, u, wr, wc, fr);
        if (u.pn < 12) {
            const int col0 = u.pn * BM + wc * 32 + 8 * fq;
#pragma unroll
            for (int ai = 0; ai < 2; ++ai)
#pragma unroll
                for (int m = 0; m < 4; ++m) { bf16_t* rowp = O + (size_t)(row0 + ai * HALF + m * 16) * ldc + col0; const float ri = rit[ai][m];
#pragma unroll
                    for (int bj = 0; bj < 2; ++bj) { const f32x4 v0 = acc[ai][bj][m][0] * ri, v1 = acc[ai][bj][m][1] * ri;
                        u32x4 w; w.x = pkbf(v0[0], v0[1]); w.y = pkbf(v0[2], v0[3]); w.z = pkbf(v1[0], v1[1]); w.w = pkbf(v1[2], v1[3]);
                        *(u32x4*)(rowp + bj * HALF) = w; } }
        } else if (wc == 0 && fq < 2) {
#pragma unroll
            for (int ai = 0; ai < 2; ++ai)
#pragma unroll
                for (int m = 0; m < 4; ++m) { float* rowp = F + (size_t)(row0 + ai * HALF + m * 16) * 16 + 8 * fq; const float ri = rit[ai][m];
                    *(f32x4*)(rowp) = acc[ai][0][m][0] * ri; *(f32x4*)(rowp + 4) = acc[ai][0][m][1] * ri; }
        }
    }
};

struct EpiDummy {
    static constexpr bool PERM = true, AFTER_DRAIN = false;
    bf16_t* O; int ldc;
    __device__ __forceinline__ void operator()(const f32x4 (&acc)[2][2][4][2], const Unit& u, int wr, int wc, int fr, int fq) const {
        const int row0 = u.pm * BM + wr * 64 + fr, col0 = u.pn * BM + wc * 32 + 8 * fq;
#pragma unroll
        for (int ai = 0; ai < 2; ++ai)
#pragma unroll
            for (int m = 0; m < 4; ++m) { bf16_t* rowp = O + (size_t)(row0 + ai * HALF + m * 16) * ldc + col0;
#pragma unroll
                for (int bj = 0; bj < 2; ++bj) { const f32x4 v0 = acc[ai][bj][m][0], v1 = acc[ai][bj][m][1];
                    u32x4 w; w.x = pkbf(v0[0], v0[1]); w.y = pkbf(v0[2], v0[3]); w.z = pkbf(v1[0], v1[1]); w.w = pkbf(v1[2], v1[3]);
                    *(u32x4*)(rowp + bj * HALF) = w; } }
    }
};
template <class Epi, class Sched, bool ALIGN_EPI = false, bool SP2 = false>
__device__ __forceinline__ void gemm_phase(PG8_LAS unsigned char* lds, const Gemm g, const Sched& S, const Epi E, const int wave_in) {
    const int tid_l = wave_in * 64 + lane_id_v();
    const int tid = tid_l, wid = wave_in, lane = tid & 63, wr = wid >> 2, wc = wid & 3, fr = lane & 15, fq = lane >> 4;
    const int K = g.K, nt = K / BK;
    unsigned voffA[2], voffB[2];
#pragma unroll
    for (int i = 0; i < 2; ++i) { int R, C; stage_rc(tid * 16 + i * 8192, R, C); const int Rb = Epi::PERM ? ((R & ~31) + perm32(R & 31)) : R;
        voffA[i] = (unsigned)(R * K + C) * 2u; voffB[i] = (unsigned)(Rb * K + C) * 2u; }
    const size_t kstep = (size_t)(BK * 2);
    const size_t hstep = (size_t)HALF * K * 2;
    const size_t tstep = 2 * hstep;
    const unsigned ldsw = (unsigned)wid * 1024u;
    const int aoff = lds_byte(wr * 64 + fr, fq * 8), boff = lds_byte(wc * 32 + fr, fq * 8);
#define PG8_SA(b, h) (((b) * 2 + (h)) * HTB)
#define PG8_SB(b, h) ((4 + (b) * 2 + (h)) * HTB)
#define PG8_STAGE(bufoff, gbase, voff) do { _Pragma("unroll") for (int _i = 0; _i < 2; ++_i) \
        __builtin_amdgcn_global_load_lds((const unsigned*)((const char*)(gbase) + (voff)[_i]), (PG8_LAS unsigned*)(lds + (bufoff) + ldsw + _i * 8192), 16, 0, 0); } while (0)
#define PG8_LDA(dst, b, h) do { _Pragma("unroll") for (int m = 0; m < 4; ++m) _Pragma("unroll") for (int k = 0; k < 2; ++k) dst[m][k] = *(const PG8_LAS bf16x8*)(lds + PG8_SA(b, h) + aoff + m * 2048 + k * 1024); } while (0)
#define PG8_LDB(dst, b, h) do { _Pragma("unroll") for (int n = 0; n < 2; ++n) _Pragma("unroll") for (int k = 0; k < 2; ++k) dst[n][k] = *(const PG8_LAS bf16x8*)(lds + PG8_SB(b, h) + boff + n * 2048 + k * 1024); } while (0)
#define PG8_MMA(ai, bj, At, Bt) do { __builtin_amdgcn_s_setprio(1); _Pragma("unroll") for (int m = 0; m < 4; ++m) _Pragma("unroll") for (int n = 0; n < 2; ++n) _Pragma("unroll") for (int k = 0; k < 2; ++k) \
        acc[ai][bj][m][n] = __builtin_amdgcn_mfma_f32_16x16x32_bf16(Bt[n][k], At[m][k], acc[ai][bj][m][n], 0, 0, 0); __builtin_amdgcn_s_setprio(0); } while (0)
#define PG8_WAIT_V(n) asm volatile("s_waitcnt vmcnt(" #n ")" ::: "memory")
#define PG8_WAIT_L(n) asm volatile("s_waitcnt lgkmcnt(" #n ")" ::: "memory")
#define PG8_BAR __builtin_amdgcn_s_barrier()
#define PG8_SCHED __builtin_amdgcn_sched_barrier(0)
    Unit cur, nxt; int ui = 0;
    if (!S.next(0, cur)) return;
    f32x4 acc[2][2][4][2];
#pragma unroll
    for (int a = 0; a < 2; ++a)
#pragma unroll
        for (int b = 0; b < 2; ++b)
#pragma unroll
            for (int m = 0; m < 4; ++m)
#pragma unroll
                for (int n = 0; n < 2; ++n) acc[a][b][m][n] = (f32x4){0.f, 0.f, 0.f, 0.f};
    bf16x8 At[4][2], B0[2][2], B1[2][2];
    const char* cA = (const char*)g.A + (size_t)cur.pm * tstep; const char* cB = (const char*)g.Bt + (size_t)cur.pn * tstep;
    S.a_ready(cur);
    if constexpr (SP2) {
        PG8_STAGE(PG8_SB(0, 0), cB, voffB); PG8_STAGE(PG8_SB(0, 1), cB + hstep, voffB); PG8_STAGE(PG8_SA(0, 0), cA, voffA); PG8_STAGE(PG8_SA(0, 1), cA + hstep, voffA);
        if (wr == 1) PG8_BAR;
        PG8_WAIT_V(2); PG8_BAR;
        PG8_STAGE(PG8_SB(1, 0), cB + kstep, voffB); PG8_STAGE(PG8_SA(1, 0), cA + kstep, voffA); PG8_STAGE(PG8_SB(1, 1), cB + hstep + kstep, voffB);
        PG8_WAIT_V(6); PG8_BAR;
    } else {
        PG8_STAGE(PG8_SB(0, 0), cB, voffB); PG8_STAGE(PG8_SA(0, 0), cA, voffA); PG8_STAGE(PG8_SB(0, 1), cB + hstep, voffB); PG8_STAGE(PG8_SA(0, 1), cA + hstep, voffA);
        if (wr == 1) PG8_BAR;
        PG8_WAIT_V(4); PG8_BAR;
        PG8_STAGE(PG8_SB(1, 0), cB + kstep, voffB); PG8_STAGE(PG8_SA(1, 0), cA + kstep, voffA); PG8_STAGE(PG8_SB(1, 1), cB + hstep + kstep, voffB);
        PG8_WAIT_V(6); PG8_BAR;
    }
    for (;;) {
        const bool has_next = S.next(ui + 1, nxt);
        const char* nA = has_next ? (const char*)g.A + (size_t)nxt.pm * tstep : cA; const char* nB = has_next ? (const char*)g.Bt + (size_t)nxt.pn * tstep : cB;
        for (int t = 0; t < nt; t += 2) {
            const bool last = (t == nt - 2);
            const char* a1 = cA + (size_t)(t + 1) * kstep;
            const char* a2 = last ? nA : cA + (size_t)(t + 2) * kstep; const char* b2 = last ? nB : cB + (size_t)(t + 2) * kstep;
            const char* a3 = a2 + kstep; const char* b3 = b2 + kstep;
            if (last && has_next) S.a_ready(nxt);
            if constexpr (SP2) {
            PG8_LDB(B0, 0, 0); PG8_LDB(B1, 0, 1); PG8_SCHED; PG8_LDA(At, 0, 0); PG8_STAGE(PG8_SA(1, 1), a1 + hstep, voffA);
            PG8_WAIT_V(8); PG8_WAIT_L(0); PG8_BAR; PG8_MMA(0, 0, At, B0); PG8_MMA(0, 1, At, B1); PG8_BAR; PG8_SCHED;
            PG8_LDA(At, 0, 1); PG8_STAGE(PG8_SB(0, 0), b2, voffB); PG8_STAGE(PG8_SB(0, 1), b2 + hstep, voffB); PG8_STAGE(PG8_SA(0, 0), a2, voffA);
            PG8_WAIT_V(8); PG8_WAIT_L(0); PG8_BAR; PG8_MMA(1, 0, At, B0); PG8_MMA(1, 1, At, B1); PG8_BAR; PG8_SCHED;
            PG8_LDB(B0, 1, 0); PG8_LDB(B1, 1, 1); PG8_SCHED; PG8_LDA(At, 1, 0); PG8_STAGE(PG8_SA(0, 1), a2 + hstep, voffA);
            PG8_WAIT_V(8); PG8_WAIT_L(0); PG8_BAR; PG8_MMA(0, 0, At, B0); PG8_MMA(0, 1, At, B1); PG8_BAR; PG8_SCHED;
            PG8_LDA(At, 1, 1); PG8_STAGE(PG8_SB(1, 0), b3, voffB); PG8_STAGE(PG8_SB(1, 1), b3 + hstep, voffB); PG8_STAGE(PG8_SA(1, 0), a3, voffA);
            PG8_WAIT_V(8); PG8_WAIT_L(0); PG8_BAR; PG8_MMA(1, 0, At, B0); PG8_MMA(1, 1, At, B1); PG8_BAR; PG8_SCHED;
            } else {
            PG8_LDB(B0, 0, 0); PG8_SCHED; PG8_LDA(At, 0, 0); PG8_STAGE(PG8_SA(1, 1), a1 + hstep, voffA);
            PG8_WAIT_L(8); PG8_BAR; PG8_WAIT_L(0); PG8_MMA(0, 0, At, B0); PG8_BAR; PG8_SCHED;
            PG8_LDB(B1, 0, 1); PG8_STAGE(PG8_SB(0, 0), b2, voffB);
            PG8_BAR; PG8_WAIT_L(0); PG8_MMA(0, 1, At, B1); PG8_BAR;
            PG8_LDA(At, 0, 1); PG8_STAGE(PG8_SA(0, 0), a2, voffA);
            PG8_BAR; PG8_WAIT_L(0); PG8_MMA(1, 0, At, B0); PG8_BAR; PG8_SCHED;
            PG8_STAGE(PG8_SB(0, 1), b2 + hstep, voffB);
            PG8_WAIT_V(6); PG8_BAR; PG8_MMA(1, 1, At, B1); PG8_BAR;
            PG8_LDB(B0, 1, 0); PG8_SCHED; PG8_LDA(At, 1, 0); PG8_STAGE(PG8_SA(0, 1), a2 + hstep, voffA);
            PG8_WAIT_L(8); PG8_BAR; PG8_WAIT_L(0); PG8_MMA(0, 0, At, B0); PG8_BAR; PG8_SCHED;
            PG8_LDB(B1, 1, 1); PG8_STAGE(PG8_SB(1, 0), b3, voffB);
            PG8_BAR; PG8_WAIT_L(0); PG8_MMA(0, 1, At, B1); PG8_BAR;
            PG8_LDA(At, 1, 1); PG8_STAGE(PG8_SA(1, 0), a3, voffA);
            PG8_BAR; PG8_WAIT_L(0); PG8_MMA(1, 0, At, B0); PG8_BAR; PG8_SCHED;
            PG8_STAGE(PG8_SB(1, 1), b3 + hstep, voffB);
            PG8_WAIT_V(6); PG8_BAR; PG8_MMA(1, 1, At, B1); PG8_BAR;
            }
        }
        if constexpr (ALIGN_EPI) { if (wr == 0) PG8_BAR; }
        if constexpr (!Epi::AFTER_DRAIN) { E(acc, cur, wr, wc, fr, fq); S.done(cur); }
        if (!has_next) break;
#pragma unroll
        for (int a = 0; a < 2; ++a)
#pragma unroll
            for (int b = 0; b < 2; ++b)
#pragma unroll
                for (int m = 0; m < 4; ++m)
#pragma unroll
                    for (int n = 0; n < 2; ++n) acc[a][b][m][n] = (f32x4){0.f, 0.f, 0.f, 0.f};
        cur = nxt; cA = nA; cB = nB; ++ui;
        if constexpr (ALIGN_EPI) { if (wr == 1) PG8_BAR; }
    }
    PG8_WAIT_V(0);
    if constexpr (!ALIGN_EPI) { if (wr == 0) PG8_BAR; }
    PG8_BAR;
    if constexpr (Epi::AFTER_DRAIN) { E.fused(acc, cur, wr, wc, fr, fq, lds, wid, lane); S.done(cur); }
#undef PG8_SA
#undef PG8_SB
#undef PG8_STAGE
#undef PG8_LDA
#undef PG8_LDB
#undef PG8_MMA
#undef PG8_WAIT_V
#undef PG8_WAIT_L
#undef PG8_BAR
#undef PG8_SCHED
}
}

namespace fa {
constexpr float SCALE = 0.08838834764831845f;
constexpr int D = 128, NW = 8, QBLK = 32, KVBLK = 64, QB = NW * QBLK;
constexpr int SHM_V = KVBLK * D * 2, SHM_K = KVBLK * D * 2;
constexpr int LDS_BYTES = 2 * SHM_V + 2 * SHM_K + NW * 64 * 4;
constexpr float THR = 8.f;
constexpr int OP = 2048;
typedef unsigned short bf16;
typedef short bf16x8 __attribute__((ext_vector_type(8)));
typedef short s16x4 __attribute__((ext_vector_type(4)));
typedef float f32x16 __attribute__((ext_vector_type(16)));
typedef float f32x4 __attribute__((ext_vector_type(4)));
typedef unsigned u32x4 __attribute__((ext_vector_type(4)));

#define KSWZ(row, colB) ((row) * 256 + ((colB) ^ (((row) & 7) << 4)))
#define SBAR() __builtin_amdgcn_sched_barrier(0)
__device__ __forceinline__ int v_st(int k, int c) { const int kk = (k & ~0xC) | ((k & 4) << 1) | ((k & 8) >> 1); return ((kk >> 3) * 4 + (c >> 5)) * 512 + ((kk & 7) * 32 + (c & 31)) * 2; }
__device__ __forceinline__ int v_rd_base(int lane) { return ((lane & 3) << 3) | (((lane >> 2) & 3) << 6) | (((lane >> 4) & 1) << 5) | (((lane >> 5) & 1) << 8); }
constexpr int v_rd_off(int d0, int ks, int half) { return d0 * 512 + ks * 4096 + half * 2048; }
__device__ __forceinline__ int crow(int r, int hi) { return (r & 3) + 8 * (r >> 2) + 4 * hi; }
__device__ __forceinline__ unsigned cvtpk(float lo, float hi) {
    unsigned r; asm volatile("v_cvt_pk_bf16_f32 %0, %1, %2" : "=v"(r) : "v"(lo), "v"(hi)); return r;
}
__device__ __forceinline__ bf16x8 load8(const bf16* p) { return *reinterpret_cast<const bf16x8*>(p); }
__device__ __forceinline__ bf16x8 cb_frag(float c, int hi) {
    const unsigned u1 = __float_as_uint(c) & 0xffff0000u; const float r1 = c - __uint_as_float(u1);
    const unsigned v1 = __float_as_uint(r1) & 0xffff0000u; const float r2 = r1 - __uint_as_float(v1);
    const unsigned w1 = __float_as_uint(r2) & 0xffff0000u;
    u32x4 w = {hi ? 0u : ((u1 >> 16) | v1), hi ? 0u : (w1 >> 16), 0u, 0u};
    return *reinterpret_cast<bf16x8*>(&w);
}
__device__ __forceinline__ int hi_opaque() { return lane_id_v() >> 5; }
__device__ __forceinline__ bf16x8 ones_frag(int hi) { u32x4 w = {hi ? 0u : 0x3F803F80u, hi ? 0u : 0x00003F80u, 0u, 0u}; return *reinterpret_cast<bf16x8*>(&w); }
__device__ __forceinline__ void mask_tile(f32x16& p0, f32x16& p1, int dq, unsigned W) {
    const float NEG = -__builtin_inff();
#pragma unroll
    for (int r = 0; r < 16; ++r) {
        const int c = (r & 3) + 8 * (r >> 2);
        if ((unsigned)(dq - c) >= W) p0[r] = NEG;
        if ((unsigned)(dq - c - 32) >= W) p1[r] = NEG;
    }
}
__device__ __forceinline__ void partialSM(f32x16& p0, f32x16& p1, float& m_reg, float& mn, float& alpha) {
    float pmax = p0[0]; for (int r = 1; r < 16; ++r) pmax = fmaxf(pmax, p0[r]); for (int r = 0; r < 16; ++r) pmax = fmaxf(pmax, p1[r]);
    { auto rr = __builtin_amdgcn_permlane32_swap(__float_as_uint(pmax), __float_as_uint(pmax), false, false);
      pmax = fmaxf(__uint_as_float(rr[0]), __uint_as_float(rr[1])); }
    constexpr float C2 = 1.4426950408889634f * SCALE;
    if (__builtin_expect(__all((pmax - m_reg) * SCALE <= THR), 1)) { mn = m_reg; alpha = 1.f; }
    else { mn = fmaxf(m_reg, pmax); alpha = __builtin_amdgcn_exp2f((m_reg - mn) * C2); m_reg = mn; }
    const float mnL = -mn * C2;
    for (int r = 0; r < 16; ++r) p0[r] = fmaf(p0[r], C2, mnL); for (int r = 0; r < 16; ++r) p1[r] = fmaf(p1[r], C2, mnL);
    for (int r = 0; r < 16; ++r) p0[r] = __builtin_amdgcn_exp2f(p0[r]);
}
__device__ __forceinline__ void finishSM(f32x16& p0, f32x16& p1, float alpha, float& l_reg, bf16x8& pa0, bf16x8& pa1, bf16x8& pa2, bf16x8& pa3) {
    for (int r = 0; r < 16; ++r) p1[r] = __builtin_amdgcn_exp2f(p1[r]);
    float ps = 0; for (int r = 0; r < 16; ++r) ps += p0[r]; for (int r = 0; r < 16; ++r) ps += p1[r];
    { auto rr = __builtin_amdgcn_permlane32_swap(__float_as_uint(ps), __float_as_uint(ps), false, false);
      ps = __uint_as_float(rr[0]) + __uint_as_float(rr[1]); }
    l_reg = l_reg * alpha + ps;
#define PK4(P, B_, OUT) do { unsigned a0 = cvtpk(P[B_+0], P[B_+1]), a1 = cvtpk(P[B_+2], P[B_+3]);                          \
        unsigned b0 = cvtpk(P[B_+4], P[B_+5]), b1 = cvtpk(P[B_+6], P[B_+7]);                                             \
        auto r0 = __builtin_amdgcn_permlane32_swap(a0, b0, false, false); auto r1 = __builtin_amdgcn_permlane32_swap(a1, b1, false, false); \
        u32x4 w = {r0[0], r1[0], r0[1], r1[1]}; OUT = *reinterpret_cast<bf16x8*>(&w); } while (0)
    PK4(p0, 0, pa0); PK4(p0, 8, pa1); PK4(p1, 0, pa2); PK4(p1, 8, pa3);
#undef PK4
}
template <int KB>
__device__ __forceinline__ void qkt(f32x16& p0, f32x16& p1, const char* K_lds, int r32, int hi, const bf16x8* qr, bf16x8 kx0, bf16x8 kx1, bf16x8 qx) {
    p0 = __builtin_amdgcn_mfma_f32_32x32x16_bf16(kx0, qx, f32x16{}, 0, 0, 0);
    p1 = __builtin_amdgcn_mfma_f32_32x32x16_bf16(kx1, qx, f32x16{}, 0, 0, 0);
    const char* kb[4];
#pragma unroll
    for (int dd = 0; dd < 4; ++dd) kb[dd] = K_lds + KB * SHM_K + KSWZ(r32, (dd * 16 + hi * 8) * 2);
#pragma unroll
    for (int d0 = 0; d0 < 8; ++d0) { const char* a = kb[d0 & 3] + (d0 >> 2) * 128;
        bf16x8 b0 = *reinterpret_cast<const bf16x8*>(a);
        bf16x8 b1 = *reinterpret_cast<const bf16x8*>(a + 32 * 256);
        p0 = __builtin_amdgcn_mfma_f32_32x32x16_bf16(b0, qr[d0], p0, 0, 0, 0);
        p1 = __builtin_amdgcn_mfma_f32_32x32x16_bf16(b1, qr[d0], p1, 0, 0, 0); }
}
template <int VB>
__device__ __forceinline__ void pv_tile(f32x16* o, int vb0, bf16x8 pa0, bf16x8 pa1, bf16x8 pa2, bf16x8 pa3) {
#define TRRD(dst, off) asm volatile("ds_read_b64_tr_b16 %0, %1 offset:%2" : "=&v"(dst) : "v"(vb0), "i"(off) : "memory")
#define PV_D0(d0) do { s16x4 l0, l1, l2, l3, h0, h1, h2, h3; constexpr int b_ = VB * SHM_V + v_rd_off(d0, 0, 0);     \
        TRRD(l0, b_); TRRD(h0, b_ + 2048); TRRD(l1, b_ + 4096); TRRD(h1, b_ + 6144); TRRD(l2, b_ + 8192); TRRD(h2, b_ + 10240); TRRD(l3, b_ + 12288); TRRD(h3, b_ + 14336); \
        asm volatile("s_waitcnt lgkmcnt(0)" ::: "memory"); SBAR();                 \
        o[d0] = __builtin_amdgcn_mfma_f32_32x32x16_bf16(pa0, (bf16x8){l0[0], l0[1], l0[2], l0[3], h0[0], h0[1], h0[2], h0[3]}, o[d0], 0, 0, 0);   \
        o[d0] = __builtin_amdgcn_mfma_f32_32x32x16_bf16(pa1, (bf16x8){l1[0], l1[1], l1[2], l1[3], h1[0], h1[1], h1[2], h1[3]}, o[d0], 0, 0, 0);   \
        o[d0] = __builtin_amdgcn_mfma_f32_32x32x16_bf16(pa2, (bf16x8){l2[0], l2[1], l2[2], l2[3], h2[0], h2[1], h2[2], h2[3]}, o[d0], 0, 0, 0);   \
        o[d0] = __builtin_amdgcn_mfma_f32_32x32x16_bf16(pa3, (bf16x8){l3[0], l3[1], l3[2], l3[3], h3[0], h3[1], h3[2], h3[3]}, o[d0], 0, 0, 0); } while (0)
    PV_D0(0); PV_D0(1); PV_D0(2); PV_D0(3);
#undef PV_D0
#undef TRRD
}

struct BlockRef { const bf16* Q; const bf16* K; const bf16* V; bf16* O; const bf16* G; const float* CB; int P0, skv, qp, kp; };
struct Seam { bf16x8 qr[8]; bf16x8 st_v0, st_v1, st_k0, st_k1; float cb0, cb1; };
#define ROWP(p, k0, rr, pitch) ((p) + (size_t)(k0) * (pitch) + (unsigned)((rr) * (pitch) + sc))
#define VMW() asm volatile("s_waitcnt vmcnt(0)" ::: "memory")
#define VMWN(n) asm volatile("s_waitcnt vmcnt(%0)" :: "i"(n) : "memory")
#define SLOAD_H(Kp, Vp, Cp, k0, pitch) do { S.st_v0 = load8(ROWP(Vp, k0, sr, pitch)); S.st_v1 = load8(ROWP(Vp, k0, 32 + sr, pitch));              \
                         S.st_k0 = load8(ROWP(Kp, k0, sr, pitch)); S.st_k1 = load8(ROWP(Kp, k0, 32 + sr, pitch));                                    \
                         S.cb0 = (Cp) ? (Cp)[(k0) + r32] : 0.f; S.cb1 = (Cp) ? (Cp)[(k0) + 32 + r32] : 0.f; } while (0)
#define SWRITE_HK(bf) do { *(bf16x8*)(K_lds + (bf) * SHM_K + kws) = S.st_k0; *(bf16x8*)(K_lds + (bf) * SHM_K + kws + 32 * 256) = S.st_k1; } while (0)
#define SWRITE_HV(bf) do { *(bf16x8*)(V_lds + (bf) * SHM_V + vst0) = S.st_v0; *(bf16x8*)(V_lds + (bf) * SHM_V + vst1) = S.st_v1; } while (0)
#define SWRITE_H(bf) do { SWRITE_HV(bf); SWRITE_HK(bf); } while (0)
__device__ __forceinline__ void attn_prime(const BlockRef& cur, char* lds, Seam& S, const int wave_in) {
    const int tid = wave_in * 64 + lane_id_v(), wid = wave_in, lane = tid & 63, r32 = lane & 31, hi = lane >> 5;
    const int sr = tid >> 4, sc = (tid & 15) * 8, kws = KSWZ(sr, sc * 2); char* K_lds = lds + 2 * SHM_V;
#pragma unroll
    for (int d0 = 0; d0 < 8; ++d0) S.qr[d0] = load8(cur.Q + (size_t)(wid * QBLK + r32) * cur.qp + d0 * 16 + hi * 8);
    SLOAD_H(cur.K, cur.V, cur.CB, 0, cur.kp); VMW(); SWRITE_HK(0);
    __syncthreads();
}
__device__ __forceinline__ void attn_block(const BlockRef& cur, const BlockRef& nxt, char* lds, Seam& S, const int wave_in) {
    const int tid = wave_in * 64 + lane_id_v(), wid = wave_in, lane = tid & 63, r32 = lane & 31, hi = lane >> 5;
    constexpr int W = 1 << 30;
    int j_hi = (cur.P0 + QB - 1) / KVBLK + 1; if (j_hi > cur.skv / KVBLK) j_hi = cur.skv / KVBLK;
    const int NT = j_hi;
    const int qlo = cur.P0 + wid * QBLK, qm = qlo + r32 - 4 * hi;
    char* V_lds = lds; char* K_lds = lds + 2 * SHM_V;
    float* ws = (float*)(lds + 2 * SHM_V + 2 * SHM_K) + wid * 64; float* li_l = ws, * al_l = ws + 32;
    float m_reg = -1e30f, l_reg = 0; f32x16 o[4] = {};
    const int sr = tid >> 4, sc = (tid & 15) * 8, vst0 = v_st(sr, sc), vst1 = v_st(32 + sr, sc), kws = KSWZ(sr, sc * 2);
    const int vb0 = (int)(uintptr_t)V_lds + v_rd_base(lane);
    const bf16* Kh = cur.K; const bf16* Vh = cur.V; const float* Ch = cur.CB; const int KP = cur.kp;
#define QX() ones_frag(hi_opaque())
#define RESC(a) do { if (__any((a) < 1.f)) { if (hi == 0) al_l[r32] = (a); asm volatile("s_waitcnt lgkmcnt(0)" ::: "memory");              \
                     for (int d_ = 0; d_ < 4; ++d_) for (int r = 0; r < 16; ++r) o[d_][r] *= al_l[crow(r, hi)]; } } while (0)
#define KBASE(t) ((t) * KVBLK)
#define MASKT(P0_, P1_, t) do { const int kb_ = KBASE(t); if (kb_ + KVBLK - 1 > qlo) mask_tile(P0_, P1_, qm - kb_, (unsigned)W); } while (0)
#define SEAM_K0() do { VMWN(8); SWRITE_HK(0); SBAR(); } while (0)
    f32x16 pA0, pA1, pB0, pB1; float mnA, mnB, alA, alB; bf16x8 pa0, pa1, pa2, pa3; bf16x8 kx0, kx1;
    SWRITE_HV(0); SBAR();
    kx0 = cb_frag(S.cb0, hi); kx1 = cb_frag(S.cb1, hi);
    if (NT > 1) SLOAD_H(Kh, Vh, Ch, KBASE(1), KP);
    SBAR(); qkt<0>(pA0, pA1, K_lds, r32, hi, S.qr, kx0, kx1, QX());
    MASKT(pA0, pA1, 0); partialSM(pA0, pA1, m_reg, mnA, alA);
    if (NT > 1) { VMW(); SWRITE_H(1); }
    __syncthreads();
#define HALF_STEP(PX0, PX1, mnX, alX, PY0, PY1, alY, t, KB, VB, SB) do {                                                      \
        SBAR(); kx0 = cb_frag(S.cb0, hi); kx1 = cb_frag(S.cb1, hi);                                                           \
        qkt<KB>(PX0, PX1, K_lds, r32, hi, S.qr, kx0, kx1, QX());                                                                \
        finishSM(PY0, PY1, alY, l_reg, pa0, pa1, pa2, pa3); SBAR();                                                           \
        if ((t) + 1 < NT) { SLOAD_H(Kh, Vh, Ch, KBASE((t) + 1), KP); SBAR(); }                                                \
        pv_tile<VB>(o, vb0, pa0, pa1, pa2, pa3); MASKT(PX0, PX1, (t)); partialSM(PX0, PX1, m_reg, mnX, alX);                  \
        __syncthreads();                                                                                                      \
        if ((t) + 1 < NT) { VMW(); SWRITE_H(SB); }                                                                            \
        RESC(alX); __syncthreads(); } while (0)
    for (int t = 1; t + 1 < NT; t += 2) {
        HALF_STEP(pB0, pB1, mnB, alB, pA0, pA1, alA, t, 1, 0, 0);
        HALF_STEP(pA0, pA1, mnA, alA, pB0, pB1, alB, t + 1, 0, 1, 1);
    }
    const bool even = (NT & 1) == 0;
    if (even) { SBAR(); kx0 = cb_frag(S.cb0, hi); kx1 = cb_frag(S.cb1, hi); qkt<1>(pB0, pB1, K_lds, r32, hi, S.qr, kx0, kx1, QX()); SBAR(); }
    SLOAD_H(nxt.K, nxt.V, nxt.CB, 0, nxt.kp); SBAR();
#pragma unroll
    for (int d0 = 0; d0 < 8; ++d0) S.qr[d0] = load8(nxt.Q + (size_t)(wid * QBLK + r32) * nxt.qp + d0 * 16 + hi * 8);
    SBAR();
    finishSM(pA0, pA1, alA, l_reg, pa0, pa1, pa2, pa3); SBAR();
    pv_tile<0>(o, vb0, pa0, pa1, pa2, pa3);
    if (even) { MASKT(pB0, pB1, NT - 1); partialSM(pB0, pB1, m_reg, mnB, alB); __syncthreads(); RESC(alB);
        finishSM(pB0, pB1, alB, l_reg, pa0, pa1, pa2, pa3); SBAR(); pv_tile<1>(o, vb0, pa0, pa1, pa2, pa3); }
    SBAR(); SEAM_K0();
    if (hi == 0) li_l[r32] = l_reg; asm volatile("s_waitcnt lgkmcnt(0)" ::: "memory");
    float rli[16];
#pragma unroll
    for (int r = 0; r < 16; ++r) rli[r] = __builtin_amdgcn_rcpf(li_l[crow(r, hi)]);
    bf16* Ow = cur.O + (size_t)(wid * QBLK) * OP;
    const bf16* Gw = cur.G ? cur.G + (size_t)(wid * QBLK) * cur.qp : nullptr; const int GP = cur.qp;
#pragma unroll
    for (int r = 0; r < 16; ++r) { const int orow = crow(r, hi);
#pragma unroll
        for (int d0 = 0; d0 < 4; ++d0) { float v = o[d0][r] * rli[r];
            if (Gw) { const float g = __uint_as_float(((unsigned)Gw[(size_t)orow * GP + d0 * 32 + r32]) << 16);
                      v *= __builtin_amdgcn_rcpf(1.0f + __builtin_amdgcn_exp2f(-1.4426950408889634f * g)); }
            const float vn = __uint_as_float((unsigned)__builtin_amdgcn_update_dpp(0, (int)__float_as_uint(v), 0xB1, 0xF, 0xF, true));
            if ((r32 & 1) == 0) *(unsigned*)(Ow + (size_t)orow * OP + d0 * 32 + r32) = cvtpk(v, vn); } }
    __syncthreads();
#undef QX
#undef RESC
#undef KBASE
#undef MASKT
#undef SEAM_K0
#undef HALF_STEP
}
#undef ROWP
#undef VMW
#undef VMWN
#undef SLOAD_H
#undef SWRITE_HK
#undef SWRITE_HV
#undef SWRITE_H
#undef KSWZ
#undef SBAR
}

constexpr int NWAVES = 8;
#ifndef MK_PER_PHASE
#define MK_PER_PHASE 0
#endif
#ifndef MK_STOP_PC
#define MK_STOP_PC 1000
#endif
#ifndef REP_CVT
#define REP_CVT 1
#endif
#ifndef REP_MEMG
#define REP_MEMG 1
#endif
#ifndef REP_NORM
#define REP_NORM 1
#endif
#ifndef REP_KVG
#define REP_KVG 1
#endif
#ifndef REP_UP
#define REP_UP 1
#endif
#ifndef REP_DN
#define REP_DN 1
#endif
#ifndef REP_IN
#define REP_IN 1
#endif
#ifndef REP_PREP
#define REP_PREP 1
#endif
#ifndef REP_SCAN
#define REP_SCAN 1
#endif
#ifndef REP_ATT
#define REP_ATT 1
#endif
#ifndef REP_OUT
#define REP_OUT 1
#endif
#ifndef FFN_SPLIT
#define FFN_SPLIT 1
#endif
constexpr int NPH = 24 + 16 * FFN_SPLIT;

constexpr int BATCH = 8, SEQ = 4096, DM = 2048, M = BATCH * SEQ, FF = 5632, NUP = 2 * FF, DEPTH = 4;
constexpr int NA = 5888, NB = 3584, NKV = 3328, NMEMW = 4096;
constexpr int A_Q = 0, A_K = 768, A_V = 1536, A_G = 3072, A_QM = 4608, A_GATE = 5120;
constexpr int B_Q = 0, B_G = 1536, B_QM = 3072;
constexpr int MEMT = 256, MROWS = BATCH * MEMT;
constexpr float EPS = 1e-6f;

constexpr size_t MiB = 1u << 20;
constexpr size_t WS_CTL = 0, CTL_ZERO_BYTES = 1 * MiB;
constexpr size_t WS_CB = 1 * MiB, WS_F = 3 * MiB, WS_ACH = 5 * MiB, WS_DSEG = 7 * MiB, WS_MEMB = 8 * MiB, WS_MKVF = 16 * MiB, WS_MK = 48 * MiB, WS_MV = 56 * MiB;
constexpr size_t WS_WUP = 64 * MiB, WS_WDN = 416 * MiB, WS_WAIN = 592 * MiB, WS_WBIN = 638 * MiB, WS_WOUT = 666 * MiB, WS_WKV = 698 * MiB, WS_WMEM = 711 * MiB;
constexpr size_t WS_HMIX = 728 * MiB, WS_ACT = 856 * MiB, WS_KDT = 1224 * MiB, WS_VT = 1272 * MiB, WS_OG = 1368 * MiB, WS_KSVS = 1224 * MiB, WS_FST = 1464 * MiB, WS_QF = 1528 * MiB, WS_XB2 = 1416 * MiB, WS_SS = 1576 * MiB, WS_END = 1580 * MiB;
constexpr size_t SS_BYTES = (size_t)13 * M * 8;
static_assert(WS_WUP + 8 * (size_t)NUP * DM * 2 <= WS_WDN && WS_WDN + 8 * (size_t)DM * FF * 2 <= WS_WAIN && WS_WAIN + 2 * (size_t)NA * DM * 2 <= WS_WBIN && WS_WBIN + 2 * (size_t)NB * DM * 2 <= WS_WOUT &&
              WS_WOUT + 4 * (size_t)DM * DM * 2 <= WS_WKV && WS_WKV + (size_t)NKV * DM * 2 <= WS_WMEM && WS_WMEM + (size_t)NMEMW * DM * 2 <= WS_HMIX && WS_HMIX + (size_t)M * DM * 2 <= WS_ACT &&
              WS_ACT + (size_t)M * NA * 2 <= WS_KDT && WS_KDT + (size_t)2048 * 192 * 64 * 2 <= WS_VT && WS_VT + (size_t)2048 * 384 * 64 * 2 <= WS_OG && WS_OG + (size_t)M * 1536 * 2 <= WS_FST && WS_FST + (size_t)384 * 7 * 24 * 64 * 16 <= WS_QF && WS_QF + (size_t)2048 * 192 * 64 * 2 <= WS_SS && WS_SS + SS_BYTES <= WS_END && WS_XB2 >= WS_KSVS + (size_t)M * 3072 * 2 && WS_XB2 + (size_t)M * DM * 2 <= WS_SS &&
              WS_KSVS + (size_t)M * 3072 * 2 <= WS_END && WS_MKVF + (size_t)MROWS * NMEMW * 4 <= WS_MK && WS_MEMB + (size_t)MROWS * DM * 2 <= WS_MKVF, "d_ws map");
constexpr int CW_TMO = 0, CW_BAR = 4096;
constexpr int RING_BYTES = 131072, LDSCTL_OFF = RING_BYTES, MISC_OFF = LDSCTL_OFF + 320, RTAB_OFF = LDSCTL_OFF + 1024  , LDS_BYTES = 147456;

#define GAS __attribute__((address_space(1)))
#define LAS __attribute__((address_space(3)))
typedef unsigned short bf16;
typedef unsigned v4u __attribute__((ext_vector_type(4)));
typedef float f32x4 __attribute__((ext_vector_type(4)));
typedef float f32x16 __attribute__((ext_vector_type(16)));
typedef short bf16x8 __attribute__((ext_vector_type(8)));
typedef GAS unsigned gu32;
#define RLX_AGENT __ATOMIC_RELAXED, __HIP_MEMORY_SCOPE_AGENT
#define LDS_WAIT() asm volatile("s_waitcnt lgkmcnt(0)" ::: "memory")
using pg8::pkbf;
__device__ __forceinline__ float bf_lo(unsigned w) { return __uint_as_float(w << 16); }
__device__ __forceinline__ float bf_hi(unsigned w) { return __uint_as_float(w & 0xffff0000u); }
__device__ __forceinline__ float bf2f(bf16 b) { return __uint_as_float(((unsigned)b) << 16); }
__device__ __forceinline__ float logsig(float x) { return fminf(x, 0.f) - __logf(1.0f + __expf(-fabsf(x))); }
#define XCH1(v)  __uint_as_float((unsigned)__builtin_amdgcn_update_dpp(0, (int)__float_as_uint(v), 0xB1, 0xF, 0xF, true))
#define XCH2(v)  __uint_as_float((unsigned)__builtin_amdgcn_update_dpp(0, (int)__float_as_uint(v), 0x4E, 0xF, 0xF, true))
#define XCH4(v)  __uint_as_float((unsigned)__builtin_amdgcn_ds_swizzle((int)__float_as_uint(v), (4 << 10) | 0x1f))
#define XCH8(v)  __uint_as_float((unsigned)__builtin_amdgcn_ds_swizzle((int)__float_as_uint(v), (8 << 10) | 0x1f))
#define XCH16(v) __uint_as_float((unsigned)__builtin_amdgcn_ds_swizzle((int)__float_as_uint(v), (16 << 10) | 0x1f))
__device__ __forceinline__ float wave_sum(float v) {
    v += XCH1(v); v += XCH2(v); v += XCH4(v); v += XCH8(v); v += XCH16(v);
    const auto rr = __builtin_amdgcn_permlane32_swap(__float_as_uint(v), __float_as_uint(v), false, false);
    return __uint_as_float(rr[0]) + __uint_as_float(rr[1]);
}
__device__ __forceinline__ int launder_s(int v) { asm volatile("" : "+s"(v)); return v; }

#define XB_TMO      128
#define XB_XCNT(j)  (256  + 64 * (j))
#define XB_XSUB(j)  (1280 + 64 * (j))
#define XB_XGEN(j)  (2304 + 64 * (j))
#define XB_TOP      3328
#define XB_TOPGEN   3392
#define XCD_BAR_WORDS 3456
#define XB_SPIN_CAP (1u << 18)
__device__ __forceinline__ unsigned xb_ld(unsigned* p)              { return __hip_atomic_load(p, __ATOMIC_RELAXED, __HIP_MEMORY_SCOPE_AGENT); }
__device__ __forceinline__ unsigned xb_add(unsigned* p, unsigned v) { return __hip_atomic_fetch_add(p, v, __ATOMIC_RELAXED, __HIP_MEMORY_SCOPE_AGENT); }
__device__ __forceinline__ unsigned xb_xcc_id() { return (unsigned)__builtin_amdgcn_s_getreg((3 << 11) | 20) & 0xFu; }
#define XB_SPIN(cond, bar) do { unsigned _sp = 0; while (cond) { __builtin_amdgcn_s_sleep(1); \
    if ((++_sp & 255u) == 0u) { if (xb_ld(&(bar)[XB_TMO])) break; if (_sp > XB_SPIN_CAP) { atomicAdd(&(bar)[XB_TMO], 1u); break; } } } } while (0)
struct XcdBarrier { unsigned* bar; unsigned x; volatile LAS unsigned* st; int wave; };
__device__ __forceinline__ XcdBarrier xcd_barrier_post(unsigned* bar, volatile LAS unsigned* st, int wave) {
    XcdBarrier b; b.bar = bar; b.x = xb_xcc_id(); b.st = st; b.wave = wave;
    if (threadIdx.x == 0) (void)xb_add(&bar[XB_XCNT(b.x)], 1u);
    return b;
}
__device__ __forceinline__ void xcd_barrier_complete(unsigned* bar, unsigned x, unsigned& nloc, unsigned& nx) {
    const unsigned G = gridDim.x * gridDim.y * gridDim.z;
    unsigned sum, cnt, mine, sp = 0u;
    for (;;) {
        sum = 0u; cnt = 0u; mine = 0u;
#pragma unroll
        for (unsigned j = 0; j < 16; ++j) { const unsigned c = xb_ld(&bar[XB_XCNT(j)]); sum += c; cnt += (c > 0u) ? 1u : 0u; mine = (j == x) ? c : mine; }
        if (sum == G) break;
        __builtin_amdgcn_s_sleep(1);
        if ((++sp & 255u) == 0u) { if (xb_ld(&bar[XB_TMO])) break; if (sp > XB_SPIN_CAP) { atomicAdd(&bar[XB_TMO], 1u); break; } }
    }
    nloc = mine > 0u ? mine : 1u; nx = cnt > 0u ? cnt : 1u;
}
__device__ __forceinline__ void xcd_barrier(const XcdBarrier& b) {
    asm volatile("s_waitcnt vmcnt(0)" ::: "memory");
    __syncthreads();
    if (b.wave == 0 && lane_id_v() == 0) {
        unsigned* bar = b.bar;
        __builtin_amdgcn_s_waitcnt(0);
        unsigned nloc = b.st[0], nx = b.st[1];
        if (nloc == 0u) { xcd_barrier_complete(bar, b.x, nloc, nx); b.st[0] = nloc; b.st[1] = nx; }
        const unsigned old = xb_add(&bar[XB_XSUB(b.x)], 1u);
        const unsigned gen = old / nloc;
        if (old + 1u == (gen + 1u) * nloc) {
            __builtin_amdgcn_fence(__ATOMIC_RELEASE, "agent");
            asm volatile("s_waitcnt vmcnt(0)" ::: "memory");
            const unsigned og = xb_add(&bar[XB_TOP], 1u);
            const unsigned tg = og / nx;
            if (og + 1u == (tg + 1u) * nx) xb_add(&bar[XB_TOPGEN], 1u);
            else XB_SPIN(xb_ld(&bar[XB_TOPGEN]) == tg, bar);
            __builtin_amdgcn_fence(__ATOMIC_ACQUIRE, "agent");
            xb_add(&bar[XB_XGEN(b.x)], 1u);
            asm volatile("s_waitcnt vmcnt(0)" ::: "memory");
        } else {
            XB_SPIN(xb_ld(&bar[XB_XGEN(b.x)]) == gen, bar);
            __builtin_amdgcn_fence(__ATOMIC_ACQUIRE, "agent");
            asm volatile("s_waitcnt vmcnt(0)" ::: "memory");
        }
    }
    __syncthreads();
}

__device__ __forceinline__ const float* ldp(volatile LAS unsigned* T, int k) { const unsigned lo = __builtin_amdgcn_readfirstlane(T[2 * k]), hi = __builtin_amdgcn_readfirstlane(T[2 * k + 1]); return (const float*)(const GAS float*)(((unsigned long long)hi << 32) | lo); }
__device__ __forceinline__ int launder(int v) { asm volatile("" : "+v"(v)); return v; }
__device__ __forceinline__ int lane_id() { return lane_id_v(); }
__device__ __forceinline__ void cvt_item(const float* W, int ldw, int srccol, const float* gain, float scale, bf16* Bt, int K, int dstrow, int k0, LAS float* scr, int lane) {
    float v[32], g[32];
    const float* src = W + (size_t)(k0 + (lane >> 5)) * ldw + srccol + (lane & 31);
#pragma unroll
    for (int i = 0; i < 32; ++i) v[i] = src[(size_t)(2 * i) * ldw];
#pragma unroll
    for (int i = 0; i < 32; ++i) g[i] = gain ? gain[k0 + 2 * i + (lane >> 5)] * scale : scale;
#pragma unroll
    for (int i = 0; i < 32; ++i) scr[(2 * i + (lane >> 5)) * 33 + (lane & 31)] = v[i] * g[i];
    LDS_WAIT();
    const int c = lane & 7;
#pragma unroll
    for (int j = 0; j < 4; ++j) { const int n = (lane >> 3) + 8 * j; const LAS float* s = scr + (8 * c) * 33 + n;
        v4u o; o.x = pkbf(s[0 * 33], s[1 * 33]); o.y = pkbf(s[2 * 33], s[3 * 33]); o.z = pkbf(s[4 * 33], s[5 * 33]); o.w = pkbf(s[6 * 33], s[7 * 33]);
        *(v4u*)(Bt + (size_t)(dstrow + n) * K + k0 + 8 * c) = o; }
    LDS_WAIT();
}
__device__ __forceinline__ void rms_row_to_bf16(const float* xrow, bf16* orow, int lane) {
    const f32x4* xr = (const f32x4*)xrow + lane;
    f32x4 v[8]; float s = 0.f;
#pragma unroll
    for (int j = 0; j < 8; ++j) { v[j] = xr[64 * j]; s += (v[j].x * v[j].x + v[j].y * v[j].y) + (v[j].z * v[j].z + v[j].w * v[j].w); }
    const float rinv = 1.0f / sqrtf(wave_sum(s) * (1.0f / DM) + EPS);
    unsigned long long* o8 = (unsigned long long*)orow + lane;
#pragma unroll
    for (int j = 0; j < 8; ++j) o8[64 * j] = (unsigned long long)pkbf(v[j].x * rinv, v[j].y * rinv) | ((unsigned long long)pkbf(v[j].z * rinv, v[j].w * rinv) << 32);
}
__device__ __forceinline__ void xb_row(const float* xrow, bf16* orow, float* ssrow, int lane) {
    const f32x4* xr = (const f32x4*)xrow + lane;
    f32x4 v[8]; float s = 0.f;
#pragma unroll
    for (int j = 0; j < 8; ++j) { v[j] = xr[64 * j]; s += (v[j].x * v[j].x + v[j].y * v[j].y) + (v[j].z * v[j].z + v[j].w * v[j].w); }
    s = wave_sum(s);
    if (lane == 0) *(unsigned long long*)ssrow = (unsigned long long)(s * 16777216.0f);
    unsigned long long* o8 = (unsigned long long*)orow + lane;
#pragma unroll
    for (int j = 0; j < 8; ++j) o8[64 * j] = (unsigned long long)pkbf(v[j].x, v[j].y) | ((unsigned long long)pkbf(v[j].z, v[j].w) << 32);
}
struct InPtrs { const float *x, *mem, *ffn_norm, *w1, *w3, *w2, *mix_norm, *mem_norm, *w_mem_kv, *mem_q_norm, *mem_k_norm, *w_out, *a_w_in, *a_w_gate_up, *a_b_gate, *a_out_norm, *b_w_in, *b_q_norm, *kv_norm, *w_kv, *b_f, *k_norm; };

__device__ __forceinline__ void convert_phase(volatile LAS unsigned* PT, unsigned char* ws, float* xout, LAS unsigned char* lds, int gw, int NGW, int lane, int wave) {
    InPtrs I;
    I.x = ldp(PT, 0); I.mem = ldp(PT, 1); I.ffn_norm = ldp(PT, 2); I.w1 = ldp(PT, 3); I.w3 = ldp(PT, 4); I.w2 = ldp(PT, 5); I.mix_norm = ldp(PT, 6); I.mem_norm = ldp(PT, 7);
    I.w_mem_kv = ldp(PT, 8); I.mem_q_norm = ldp(PT, 9); I.mem_k_norm = ldp(PT, 10); I.w_out = ldp(PT, 11); I.a_w_in = ldp(PT, 12); I.a_w_gate_up = ldp(PT, 13); I.a_b_gate = ldp(PT, 14);
    I.a_out_norm = ldp(PT, 15); I.b_w_in = ldp(PT, 16); I.b_q_norm = ldp(PT, 17); I.kv_norm = ldp(PT, 18); I.w_kv = ldp(PT, 19); I.b_f = ldp(PT, 20); I.k_norm = ldp(PT, 21);
    LAS float* scr = (LAS float*)(lds + wave * 16384);
    bf16* WUP = (bf16*)(ws + WS_WUP); bf16* WDN = (bf16*)(ws + WS_WDN); bf16* WAIN = (bf16*)(ws + WS_WAIN); bf16* WBIN = (bf16*)(ws + WS_WBIN);
    bf16* WOUT = (bf16*)(ws + WS_WOUT); bf16* WKV = (bf16*)(ws + WS_WKV); bf16* WMEM = (bf16*)(ws + WS_WMEM);
    constexpr int IT_W1 = 8 * 32 * 176, IT_W2 = 8 * 88 * 64, IT_A = 2 * 32 * 160, IT_B = 2 * 32 * 112, IT_O = 4 * 32 * 64, IT_KV = 32 * 96, IT_MEM = 4 * 32 * 32;
    constexpr int IT_TOTAL = 2 * IT_W1 + IT_W2 + IT_A + IT_B + IT_O + IT_KV + IT_MEM;
    for (int it = gw; it < IT_TOTAL; it += NGW) {
        int r = it;
        if (r < 2 * IT_W1) { const int which = r / IT_W1; r -= which * IT_W1; const int mat = r / (32 * 176); r -= mat * (32 * 176); const int kb = r / 176, nb = r % 176; const int j0 = 32 * nb;
            cvt_item((which ? I.w3 : I.w1) + (size_t)mat * DM * FF, FF, j0, I.ffn_norm + mat * DM, 1.f, WUP + (size_t)mat * NUP * DM, DM, 256 * (j0 / 128) + which * 128 + (j0 % 128), 64 * kb, scr, lane); continue; }
        r -= 2 * IT_W1;
        if (r < IT_W2) { const int mat = r / (88 * 64); r -= mat * (88 * 64); const int kb = r / 64, nb = r % 64;
            cvt_item(I.w2 + (size_t)mat * FF * DM, DM, 32 * nb, nullptr, 1.f, WDN + (size_t)mat * DM * FF, FF, 32 * nb, 64 * kb, scr, lane); continue; }
        r -= IT_W2;
        if (r < IT_A) { const int l = r / (32 * 160); r -= l * (32 * 160); const int kb = r / 160, nb = r % 160; const int n0 = 32 * nb;
            cvt_item(I.a_w_in + (size_t)l * DM * 5136, 5136, n0 < 3072 ? n0 : n0 + 16, I.mix_norm + l * DM, n0 < 768 ? 0.07216878364870322f : 1.f, WAIN + (size_t)l * NA * DM, DM, n0, 64 * kb, scr, lane); continue; }
        r -= IT_A;
        if (r < IT_B) { const int j = r / (32 * 112); r -= j * (32 * 112); const int kb = r / 112, nb = r % 112;
            cvt_item(I.b_w_in + (size_t)j * DM * NB, NB, 32 * nb, I.mix_norm + (2 + j) * DM, 1.f, WBIN + (size_t)j * NB * DM, DM, 32 * nb, 64 * kb, scr, lane); continue; }
        r -= IT_B;
        if (r < IT_O) { const int l = r / (32 * 64); r -= l * (32 * 64); const int kb = r / 64, nb = r % 64;
            cvt_item(I.w_out + (size_t)l * DM * DM, DM, 32 * nb, nullptr, 1.f, WOUT + (size_t)l * DM * DM, DM, 32 * nb, 64 * kb, scr, lane); continue; }
        r -= IT_O;
        if (r < IT_KV) { const int kb = r / 96, nb = r % 96;
            cvt_item(I.w_kv, 3084, 32 * nb, I.kv_norm, 1.f, WKV, DM, 32 * nb, 64 * kb, scr, lane); continue; }
        r -= IT_KV;
        { const int l = r / (32 * 32); r -= l * (32 * 32); const int kb = r / 32, nb = r % 32;
            cvt_item(I.w_mem_kv + (size_t)l * DM * 1024, 1024, 32 * nb, I.mem_norm + l * DM, 1.f, WMEM, DM, l * 1024 + 32 * nb, 64 * kb, scr, lane); }
    }
    const int gtid = gw * 64 + lane, NT = NGW * 64;
    for (int idx = gtid; idx < 2 * 768 * 256; idx += NT) { const int l = idx / (768 * 256); const int rem = idx - l * (768 * 256); const int n = rem >> 8, k0 = (rem & 255) * 8;
        float a[8];
#pragma unroll
        for (int j = 0; j < 8; ++j) a[j] = 0.f;
        const float* win = I.a_w_in + (size_t)l * DM * 5136 + (size_t)k0 * 5136 + 3072; const float* wg = I.a_w_gate_up + (size_t)l * 16 * 768 + n;
#pragma unroll
        for (int rr = 0; rr < 16; ++rr) { const float g = wg[rr * 768];
#pragma unroll
            for (int j = 0; j < 8; ++j) a[j] += win[(size_t)j * 5136 + rr] * g; }
        const float* gn = I.mix_norm + l * DM + k0;
        v4u o; o.x = pkbf(a[0] * gn[0], a[1] * gn[1]); o.y = pkbf(a[2] * gn[2], a[3] * gn[3]); o.z = pkbf(a[4] * gn[4], a[5] * gn[5]); o.w = pkbf(a[6] * gn[6], a[7] * gn[7]);
        *(v4u*)(WAIN + (size_t)l * NA * DM + (size_t)(A_GATE + n) * DM + k0) = o; }
    for (int idx = gtid; idx < 256 * 256; idx += NT) { const int n = idx >> 8, k0 = (idx & 255) * 8;
        float a[8];
#pragma unroll
        for (int j = 0; j < 8; ++j) a[j] = (n < 12) ? I.w_kv[(size_t)(k0 + j) * 3084 + 3072 + n] * I.kv_norm[k0 + j] : 0.f;
        v4u o; o.x = pkbf(a[0], a[1]); o.y = pkbf(a[2], a[3]); o.z = pkbf(a[4], a[5]); o.w = pkbf(a[6], a[7]);
        *(v4u*)(WKV + (size_t)(3072 + n) * DM + k0) = o; }
    for (int m = gw; m < MROWS; m += NGW) rms_row_to_bf16(I.mem + (size_t)m * DM, (bf16*)(ws + WS_MEMB) + (size_t)m * DM, lane);
    for (int m = gw; m < M; m += NGW) xb_row(I.x + (size_t)m * DM, (bf16*)xout + (size_t)m * DM, (float*)(ws + WS_SS) + 2 * (size_t)m, lane);
}
__device__ __forceinline__ void hn_pass(bf16* buf, int pitch, int col0, int nheads, const float* gain, int gw, int NGW, int lane) {
    const int l16 = lane & 15; const int ntask4 = M * nheads / 4;
    f32x4 g0 = *(const f32x4*)(gain + 8 * l16), g1 = *(const f32x4*)(gain + 8 * l16 + 4);
    for (int t4 = gw; t4 < ntask4; t4 += NGW) { const int t = t4 * 4 + (lane >> 4); const int row = t / nheads, hh = t - row * nheads;
        bf16* p = buf + (size_t)row * pitch + col0 + hh * 128 + 8 * l16;
        const v4u w = *(const v4u*)p;
        float x[8] = {bf_lo(w.x), bf_hi(w.x), bf_lo(w.y), bf_hi(w.y), bf_lo(w.z), bf_hi(w.z), bf_lo(w.w), bf_hi(w.w)};
        float ss = 0.f;
#pragma unroll
        for (int e = 0; e < 8; ++e) ss += x[e] * x[e];
        ss += XCH1(ss); ss += XCH2(ss); ss += XCH4(ss); ss += XCH8(ss);
        const float rinv = 1.0f / sqrtf(ss * (1.0f / 128.f) + EPS);
        v4u o; o.x = pkbf(x[0] * rinv * g0[0], x[1] * rinv * g0[1]); o.y = pkbf(x[2] * rinv * g0[2], x[3] * rinv * g0[3]);
        o.z = pkbf(x[4] * rinv * g1[0], x[5] * rinv * g1[1]); o.w = pkbf(x[6] * rinv * g1[2], x[7] * rinv * g1[3]);
        *(v4u*)p = o; }
}
__device__ __forceinline__ void mkmv_pass(const float* MKVF, bf16* MK, bf16* MV, const float* mem_k_norm, int gw, int NGW, int lane) {
    const int l16 = lane & 15;
    for (int t4 = gw; t4 < MROWS * 32 / 4; t4 += NGW) { const int t = t4 * 4 + (lane >> 4); const int row = t >> 5, rem = t & 31; const int l = rem >> 3, kv = (rem >> 2) & 1, hh = rem & 3;
        const float* src = MKVF + (size_t)row * NMEMW + l * 1024 + kv * 512 + hh * 128 + 8 * l16;
        const f32x4 a = *(const f32x4*)src, b = *(const f32x4*)(src + 4);
        float ss = (a.x * a.x + a.y * a.y) + (a.z * a.z + a.w * a.w) + (b.x * b.x + b.y * b.y) + (b.z * b.z + b.w * b.w);
        ss += XCH1(ss); ss += XCH2(ss); ss += XCH4(ss); ss += XCH8(ss);
        const float rinv = kv ? 1.0f : 1.0f / sqrtf(ss * (1.0f / 128.f) + EPS);
        f32x4 g0 = {1.f, 1.f, 1.f, 1.f}, g1 = {1.f, 1.f, 1.f, 1.f};
        if (!kv) { g0 = *(const f32x4*)(mem_k_norm + l * 128 + 8 * l16); g1 = *(const f32x4*)(mem_k_norm + l * 128 + 8 * l16 + 4); }
        v4u o; o.x = pkbf(a.x * rinv * g0[0], a.y * rinv * g0[1]); o.y = pkbf(a.z * rinv * g0[2], a.w * rinv * g0[3]);
        o.z = pkbf(b.x * rinv * g1[0], b.y * rinv * g1[1]); o.w = pkbf(b.z * rinv * g1[2], b.w * rinv * g1[3]);
        *(v4u*)((kv ? MV : MK) + ((size_t)l * MROWS + row) * 512 + hh * 128 + 8 * l16) = o; }
}
__device__ __forceinline__ void gla_prep(const bf16* PROJ, const float* b_gate  , bf16* KDT, bf16* VT, bf16* QF, float* ACH, int gw, int NGW, int lane) {
    const int r = lane & 31, hi = lane >> 5;
    for (int t = gw; t < 2048; t += NGW) {
        const int b = t >> 8, c = (t >> 2) & 63, h = t & 3; const int ci = (b * 4 + h) * 64 + c;
        const bf16* P = PROJ + ((size_t)b * SEQ + c * 64) * NA;
        for (int cg = 0; cg < 3; ++cg) { const int d = cg * 64 + lane;
            const float bias = b_gate[h * 192 + d];
            const bf16* pg = P + A_GATE + h * 192 + d; const bf16* pk = P + A_K + h * 192 + d;
            float cum[64]; float run = 0.f;
#pragma unroll
            for (int j = 0; j < 64; ++j) { const float gp = bf2f(pg[(size_t)j * NA]) + bias; run += logsig(gp) * (1.0f / 16.0f); cum[j] = run; }
            ACH[ci * 192 + d] = __expf(run);
            bf16* dst = KDT + ((size_t)(ci * 6 + cg * 2 + hi) * 4 * 64 + r) * 8;
#pragma unroll
            for (int j8 = 0; j8 < 8; ++j8) { float kd[8];
#pragma unroll
                for (int e = 0; e < 8; ++e) { const int j = 8 * j8 + e; kd[e] = bf2f(pk[(size_t)j * NA]) * __expf(run - cum[j]); }
                v4u o; o.x = pkbf(kd[0], kd[1]); o.y = pkbf(kd[2], kd[3]); o.z = pkbf(kd[4], kd[5]); o.w = pkbf(kd[6], kd[7]);
                *(v4u*)(dst + ((j8 >> 1) * 64 + (j8 & 1) * 32) * 8) = o; } }
        for (int cg = 0; cg < 6; ++cg) { const int dv = cg * 64 + lane; const bf16* pv = P + A_V + h * 384 + dv;
            bf16* dst = VT + ((size_t)(ci * 12 + cg * 2 + hi) * 4 * 64 + r) * 8;
#pragma unroll
            for (int j8 = 0; j8 < 8; ++j8) { unsigned rr[8];
#pragma unroll
                for (int e = 0; e < 8; ++e) rr[e] = pv[(size_t)(8 * j8 + e) * NA];
                v4u o; o.x = rr[0] | (rr[1] << 16); o.y = rr[2] | (rr[3] << 16); o.z = rr[4] | (rr[5] << 16); o.w = rr[6] | (rr[7] << 16);
                *(v4u*)(dst + ((j8 >> 1) * 64 + (j8 & 1) * 32) * 8) = o; } }
        { const bf16* pq = P + (size_t)r * NA + A_Q + h * 192 + 4 * hi; bf16* dst = QF + ((size_t)ci * 24 * 64 + lane) * 8;
#pragma unroll
            for (int tt = 0; tt < 2; ++tt)
#pragma unroll
                for (int mt = 0; mt < 6; ++mt)
#pragma unroll
                    for (int s2 = 0; s2 < 2; ++s2) { const bf16* p = pq + (size_t)tt * 32 * NA + 32 * mt + 16 * s2;
                        const uint2 a = *(const uint2*)p, c2 = *(const uint2*)(p + 8);
                        v4u o = {a.x, a.y, c2.x, c2.y};
                        *(v4u*)(dst + (size_t)((tt * 6 + mt) * 2 + s2) * 64 * 8) = o; } }
    }
}
__device__ __forceinline__ void gla_update(f32x16 (&S)[6], const bf16* kd, const bf16* vt, const float* ac, int lane, int hi) {
    const unsigned lo16 = (unsigned)lane * 16u;
    bf16x8 vb[4];
#pragma unroll
    for (int s = 0; s < 4; ++s) vb[s] = *(const bf16x8*)((const char*)(vt + s * 512) + lo16);
#pragma unroll
    for (int half = 0; half < 2; ++half) {
        bf16x8 ka[3][4]; f32x4 a4[3][4];
#pragma unroll
        for (int m3 = 0; m3 < 3; ++m3)
#pragma unroll
            for (int s = 0; s < 4; ++s) ka[m3][s] = *(const bf16x8*)((const char*)(kd + ((3 * half + m3) * 4 + s) * 512) + lo16);
#pragma unroll
        for (int m3 = 0; m3 < 3; ++m3)
#pragma unroll
            for (int i4 = 0; i4 < 4; ++i4) a4[m3][i4] = *(const f32x4*)((const char*)(ac + 32 * (3 * half + m3) + 8 * i4) + (unsigned)hi * 16u);
        __builtin_amdgcn_sched_barrier(0);
#pragma unroll
        for (int m3 = 0; m3 < 3; ++m3) { const int mt = 3 * half + m3;
#pragma unroll
            for (int i4 = 0; i4 < 4; ++i4)
#pragma unroll
                for (int e = 0; e < 4; ++e) S[mt][4 * i4 + e] *= a4[m3][i4][e];
#pragma unroll
            for (int s = 0; s < 4; ++s) S[mt] = __builtin_amdgcn_mfma_f32_32x32x16_bf16(ka[m3][s], vb[s], S[mt], 0, 0, 0); }
        __builtin_amdgcn_sched_barrier(0);
    }
}
__device__ __forceinline__ void gla_output(const f32x16 (&S)[6], const bf16* qf, bf16* og, int lane, int r, int hi) {
    const unsigned lo16 = (unsigned)lane * 16u;
    f32x16 o0, o1;
#pragma unroll
    for (int i = 0; i < 16; ++i) { o0[i] = 0.f; o1[i] = 0.f; }
#pragma unroll
    for (int half = 0; half < 2; ++half) {
        bf16x8 qa[3][2][2];
#pragma unroll
        for (int m3 = 0; m3 < 3; ++m3)
#pragma unroll
            for (int s = 0; s < 2; ++s) { qa[m3][s][0] = *(const bf16x8*)((const char*)(qf + ((0 * 6 + 3 * half + m3) * 2 + s) * 512) + lo16); qa[m3][s][1] = *(const bf16x8*)((const char*)(qf + ((1 * 6 + 3 * half + m3) * 2 + s) * 512) + lo16); }
        __builtin_amdgcn_sched_barrier(0);
#pragma unroll
        for (int m3 = 0; m3 < 3; ++m3) { const int mt = 3 * half + m3;
#pragma unroll
            for (int s = 0; s < 2; ++s) {
                v4u xw; xw.x = pkbf(S[mt][8 * s + 0], S[mt][8 * s + 1]); xw.y = pkbf(S[mt][8 * s + 2], S[mt][8 * s + 3]); xw.z = pkbf(S[mt][8 * s + 4], S[mt][8 * s + 5]); xw.w = pkbf(S[mt][8 * s + 6], S[mt][8 * s + 7]);
                const bf16x8 xs = __builtin_bit_cast(bf16x8, xw);
                o0 = __builtin_amdgcn_mfma_f32_32x32x16_bf16(qa[m3][s][0], xs, o0, 0, 0, 0);
                o1 = __builtin_amdgcn_mfma_f32_32x32x16_bf16(qa[m3][s][1], xs, o1, 0, 0, 0); } }
        __builtin_amdgcn_sched_barrier(0);
    }
#pragma unroll
    for (int i = 0; i < 16; ++i) { const int row = (i & 3) + 8 * (i >> 2) + 4 * hi;
        const float v0 = o0[i], v1 = o1[i]; const float n0 = XCH1(v0), n1 = XCH1(v1);
        if ((r & 1) == 0) { *(unsigned*)(og + (size_t)row * 1536) = pkbf(v0, n0); *(unsigned*)(og + (size_t)(32 + row) * 1536) = pkbf(v1, n1); } }
}
__device__ __forceinline__ void gla_seg_states(const bf16* KDT, const bf16* VT, const float* ACH, float* FST, float* DSEG, int gw, int NGW, int lane) {
    const int r = lane & 31, hi = lane >> 5;
    for (int idx = gw * 64 + lane; idx < 32 * 8 * 192; idx += NGW * 64) { const int bh = idx / (8 * 192), rem = idx - bh * (8 * 192), g = rem / 192, k = rem - g * 192;
        float d = 1.f;
#pragma unroll
        for (int c = 0; c < 8; ++c) d *= ACH[(size_t)(bh * 64 + 8 * g + c) * 192 + k];
        DSEG[idx] = d; }
    for (int t = gw; t < 384 * 7; t += NGW) { const int g = t / 384, u = t - g * 384; const int bh = u / 12, n32 = u - bh * 12;
        f32x16 S[6];
#pragma unroll
        for (int mt = 0; mt < 6; ++mt)
#pragma unroll
            for (int i = 0; i < 16; ++i) S[mt][i] = 0.f;
        for (int c = 8 * g; c < 8 * g + 8; ++c) { const int ci = bh * 64 + c;
            gla_update(S, KDT + (size_t)ci * 192 * 64, VT + ((size_t)ci * 12 + n32) * 4 * 64 * 8, ACH + (size_t)ci * 192, lane, hi); }
        f32x4* dst = (f32x4*)FST + (size_t)(u * 7 + g) * 24 * 64 + lane;
#pragma unroll
        for (int mt = 0; mt < 6; ++mt)
#pragma unroll
            for (int i4 = 0; i4 < 4; ++i4) dst[(mt * 4 + i4) * 64] = (f32x4){S[mt][4 * i4], S[mt][4 * i4 + 1], S[mt][4 * i4 + 2], S[mt][4 * i4 + 3]}; }
}
__device__ __forceinline__ void gla_seg_outputs(const bf16* QF, const bf16* KDT, const bf16* VT, const float* ACH, const float* FST, const float* DSEG, bf16* OG, int gw, int NGW, int lane) {
    const int r = lane & 31, hi = lane >> 5;
    for (int t = gw; t < 384 * 8; t += NGW) { const int g = t / 384, u = t - g * 384; const int bh = u / 12, n32 = u - bh * 12, b = bh >> 2, h = bh & 3;
        f32x16 S[6];
#pragma unroll
        for (int mt = 0; mt < 6; ++mt)
#pragma unroll
            for (int i = 0; i < 16; ++i) S[mt][i] = 0.f;
        for (int gp = 0; gp < g; ++gp) {
            const float* fs = FST + (size_t)(u * 7 + gp) * 24 * 64 * 4; const float* ds = DSEG + (size_t)(bh * 8 + gp) * 192; const unsigned lo16 = (unsigned)lane * 16u, hi16 = (unsigned)hi * 16u;
#pragma unroll
            for (int half = 0; half < 2; ++half) { f32x4 f4[3][4], d4[3][4];
#pragma unroll
                for (int m3 = 0; m3 < 3; ++m3)
#pragma unroll
                    for (int i4 = 0; i4 < 4; ++i4) { f4[m3][i4] = *(const f32x4*)((const char*)(fs + ((3 * half + m3) * 4 + i4) * 256) + lo16); d4[m3][i4] = *(const f32x4*)((const char*)(ds + 32 * (3 * half + m3) + 8 * i4) + hi16); }
                __builtin_amdgcn_sched_barrier(0);
#pragma unroll
                for (int m3 = 0; m3 < 3; ++m3)
#pragma unroll
                    for (int i4 = 0; i4 < 4; ++i4)
#pragma unroll
                        for (int e = 0; e < 4; ++e) S[3 * half + m3][4 * i4 + e] = S[3 * half + m3][4 * i4 + e] * d4[m3][i4][e] + f4[m3][i4][e];
                __builtin_amdgcn_sched_barrier(0); } }
        for (int c = 8 * g; c < 8 * g + 8; ++c) { const int ci = bh * 64 + c; const size_t t0 = (size_t)b * SEQ + c * 64;
            gla_update(S, KDT + (size_t)ci * 192 * 64, VT + ((size_t)ci * 12 + n32) * 4 * 64 * 8, ACH + (size_t)ci * 192, lane, hi);
            gla_output(S, QF + (size_t)ci * 192 * 64, OG + t0 * 1536 + h * 384 + n32 * 32 + r, lane, r, hi); }
    }
}
__device__ __forceinline__ void gla_post(const bf16* OG, const bf16* PROJ, const float* onorm  , bf16* MIX, int gw, int NGW, int lane) {
    const int la = lane < 48 ? lane : 0;
    const f32x4 g0 = *(const f32x4*)(onorm + 8 * la), g1 = *(const f32x4*)(onorm + 8 * la + 4);
    for (int t = gw; t < M * 4; t += NGW) { const int row = t >> 2, h = t & 3;
        v4u w = {0u, 0u, 0u, 0u}, gw4 = {0u, 0u, 0u, 0u};
        if (lane < 48) { w = *(const v4u*)(OG + (size_t)row * 1536 + h * 384 + 8 * lane); gw4 = *(const v4u*)(PROJ + (size_t)row * NA + A_G + h * 384 + 8 * lane); }
        float x[8] = {bf_lo(w.x), bf_hi(w.x), bf_lo(w.y), bf_hi(w.y), bf_lo(w.z), bf_hi(w.z), bf_lo(w.w), bf_hi(w.w)};
        float g[8] = {bf_lo(gw4.x), bf_hi(gw4.x), bf_lo(gw4.y), bf_hi(gw4.y), bf_lo(gw4.z), bf_hi(gw4.z), bf_lo(gw4.w), bf_hi(gw4.w)};
        float ss = 0.f;
#pragma unroll
        for (int e = 0; e < 8; ++e) ss += x[e] * x[e];
        const float rinv = 1.0f / sqrtf(wave_sum(ss) * (1.0f / 384.f) + EPS);
        float y[8];
#pragma unroll
        for (int e = 0; e < 8; ++e) y[e] = x[e] * rinv * (e < 4 ? g0[e] : g1[e - 4]) * pg8::silu_f(g[e]);
        if (lane < 48) { v4u o; o.x = pkbf(y[0], y[1]); o.y = pkbf(y[2], y[3]); o.z = pkbf(y[4], y[5]); o.w = pkbf(y[6], y[7]);
            *(v4u*)(MIX + (size_t)row * DM + h * 384 + 8 * lane) = o; } }
}
__device__ __forceinline__ void fox_cumsum(const float* F, const float* b_f, float* CB, int gw, int NGW, int lane) {
    for (int t = gw; t < BATCH * 12; t += NGW) { const int b = t / 12, h = t - b * 12; const float bf = b_f[h];
        const float* src = F + ((size_t)b * SEQ + lane * 64) * 16 + h;
        float v[64]; float run = 0.f;
#pragma unroll
        for (int j = 0; j < 64; ++j) { run += logsig(src[(size_t)j * 16] + bf); v[j] = run; }
        float incl = run;
#pragma unroll
        for (int o = 1; o < 64; o <<= 1) { const float y = __uint_as_float((unsigned)__builtin_amdgcn_ds_bpermute((lane - o) << 2, (int)__float_as_uint(incl))); if (lane >= o) incl += y; }
        const float excl = incl - run;
        float* dst = CB + (size_t)t * SEQ + lane * 64;
#pragma unroll
        for (int j = 0; j < 64; ++j) dst[j] = -(excl + v[j]) * 11.313708498984761f; }
}
struct AttCfg { const bf16* PROJ; const bf16* KSVS; const float* CB; const bf16* MK; const bf16* MV; bf16* MIX; int np, qmcol, fox, vcu, G; };
__device__ __forceinline__ fa::BlockRef att_ref(const AttCfg& c, int idx, int nf) {
    fa::BlockRef r;
    if (idx < nf) { const int L = c.vcu + c.G * (idx >> 1); const int bh = L >> 3, x = L & 7; const int qb = (idx & 1) ? 15 - x : x; const int b = bh / 12, h = bh - b * 12;
        const size_t row0 = (size_t)b * SEQ + qb * 256;
        r.Q = c.PROJ + row0 * c.np + B_Q + h * 128; r.G = c.PROJ + row0 * c.np + B_G + h * 128; r.K = c.KSVS + (size_t)b * SEQ * 3072 + h * 128; r.V = r.K + 1536; r.O = c.MIX + row0 * DM + h * 128;
        r.CB = c.CB + (size_t)bh * SEQ; r.P0 = qb * 256; r.skv = SEQ; r.qp = c.np; r.kp = 3072; }
    else { const int mb = c.vcu + c.G * (idx - nf); const int rb = mb >> 2, mh = mb & 3; const int b = rb >> 4; const size_t row0 = (size_t)rb * 256;
        r.Q = c.PROJ + row0 * c.np + c.qmcol + mh * 128; r.G = nullptr; r.K = c.MK + (size_t)b * MEMT * 512 + mh * 128; r.V = c.MV + (size_t)b * MEMT * 512 + mh * 128; r.O = c.MIX + row0 * DM + 1536 + mh * 128;
        r.CB = nullptr; r.P0 = 256; r.skv = MEMT; r.qp = c.np; r.kp = 512; }
    return r;
}
__device__ __forceinline__ void att_phase(const AttCfg& c, char* lds, int wave) {
    const int nfi = (c.fox && c.vcu < 768) ? (768 - c.vcu + c.G - 1) / c.G : 0, nf = 2 * nfi;
    const int nm = c.vcu < 512 ? (512 - c.vcu + c.G - 1) / c.G : 0;
    const int nblk = nf + nm;
    if (nblk == 0) return;
    fa::BlockRef cur = att_ref(c, 0, nf); fa::Seam S;
    fa::attn_prime(cur, lds, S, wave);
    for (int i = 0; i < nblk; ++i) {
        const fa::BlockRef nxt = (i + 1 < nblk) ? att_ref(c, i + 1, nf) : cur;
        fa::attn_block(cur, nxt, lds, S, wave);
        cur = nxt;
    }
}

struct Args { const float* in[22]; float* out; unsigned char* ws; int lo, hi; };
constexpr int PT_OUT = 22, PT_WS = 23;
#define PTR(k) ldp(PT, (k))
__global__ void __launch_bounds__(NWAVES * 64, 2) mega_fwd(Args args) {
    extern __shared__ __attribute__((aligned(16))) unsigned char lds_raw[];
    LAS unsigned char* lds = (LAS unsigned char*)lds_raw;
    volatile LAS unsigned* MISC = (volatile LAS unsigned*)(lds + MISC_OFF);
    volatile LAS unsigned* PT = (volatile LAS unsigned*)(lds + MISC_OFF + 128);
    const int wave = __builtin_amdgcn_readfirstlane((int)threadIdx.x >> 6);
    const int G = gridDim.x; const int bx = blockIdx.x; const int vcu = (G % 8 == 0) ? (bx % 8) * (G / 8) + bx / 8 : bx;
    const int gw = vcu * NWAVES + wave, NGW = G * NWAVES;
    for (int u = threadIdx.x; u < (LDS_BYTES - LDSCTL_OFF) / 4; u += NWAVES * 64) ((LAS unsigned*)(lds + LDSCTL_OFF))[u] = 0u;
    __syncthreads();
    if (threadIdx.x == 0) {
#pragma unroll
        for (int k = 0; k < 22; ++k) { const unsigned long long p = (unsigned long long)args.in[k]; PT[2 * k] = (unsigned)p; PT[2 * k + 1] = (unsigned)(p >> 32); }
        { const unsigned long long p = (unsigned long long)args.out; PT[2 * PT_OUT] = (unsigned)p; PT[2 * PT_OUT + 1] = (unsigned)(p >> 32); }
        { const unsigned long long p = (unsigned long long)args.ws; PT[2 * PT_WS] = (unsigned)p; PT[2 * PT_WS + 1] = (unsigned)(p >> 32); }
    }
    __syncthreads();
    const int lo = args.lo, hi = args.hi < MK_STOP_PC ? args.hi : MK_STOP_PC;
    const bool use_bar = (args.hi - args.lo) > 1;
    XcdBarrier bar; bar.bar = (unsigned*)((unsigned char*)PTR(PT_WS) + WS_CTL) + CW_BAR; bar.x = 0; bar.st = MISC + 8; bar.wave = wave;
    if (use_bar) bar = xcd_barrier_post(bar.bar, MISC + 8, wave);

    int pc = 0;
#define PH_ON (pc >= lo && pc < hi)
#define PH_END do { if (use_bar && pc >= lo && pc + 1 < hi) { XcdBarrier bb; bb.bar = (unsigned*)((unsigned char*)PTR(PT_WS) + WS_CTL) + CW_BAR; bb.x = bar.x; bb.st = MISC + 8; bb.wave = wave; xcd_barrier(bb); } ++pc; } while (0)
#define WSP ((unsigned char*)PTR(PT_WS))
#define PH_BEGIN if (PH_ON) { const int lane = lane_id(); const int gwp = launder_s(gw), vcup = launder_s(vcu), bxp = launder_s(bx), wavep = launder_s(wave); unsigned char* ws = WSP; (void)lane; (void)gwp; (void)vcup; (void)bxp; (void)wavep;
#define XOUT ((float*)PTR(PT_OUT))

    PH_BEGIN
#ifndef DBG_NO_CVT
        for (int rep = 0; rep < REP_CVT; ++rep) convert_phase(PT, ws, XOUT, lds, gwp, NGW, lane, wavep);
#endif
    }
    PH_END;
    PH_BEGIN pg8::Gemm g{(const bf16*)(ws + WS_MEMB), (const bf16*)(ws + WS_WMEM), MROWS, NMEMW, DM}; pg8::StaticOrder S; S.init(MROWS, NMEMW, G, bxp);
        pg8::EpiF32 E{(float*)(ws + WS_MKVF), NMEMW};
        for (int rep = 0; rep < REP_MEMG; ++rep) pg8::gemm_phase<pg8::EpiF32, pg8::StaticOrder, true, true>(lds, g, S, E, wavep); }
    PH_END;

    for (int l = 0; l < DEPTH; ++l) {
        for (int sub = 0; sub < 2; ++sub) {
            const int mat = l * 2 + sub;
            if (l == 2 && sub == 0) {
                PH_BEGIN pg8::Gemm g{(const bf16*)XOUT, (const bf16*)(ws + WS_WKV), M, NKV, DM}; pg8::StaticOrder S; S.init(M, NKV, G, bxp);
                    pg8::EpiKV E{(bf16*)(ws + WS_KSVS), 3072, (float*)(ws + WS_F), pg8::RinvCache{(const float*)(ws + WS_SS) + (size_t)6 * M * 2, (LAS float*)(lds + RTAB_OFF), -1}};
                    for (int rep = 0; rep < REP_KVG; ++rep) pg8::gemm_phase<pg8::EpiKV, pg8::StaticOrder, true, true>(lds, g, S, E, wavep); }
                PH_END;
                PH_BEGIN hn_pass((bf16*)(ws + WS_KSVS), 3072, 0, 12, PTR(21), gwp, NGW, lane);
#ifndef DBG_NO_CUM
                    fox_cumsum((const float*)(ws + WS_F), PTR(20), (float*)(ws + WS_CB), gwp, NGW, lane);
#endif
                    }
                PH_END;
            }
            for (int part = 0; part < FFN_SPLIT; ++part) {
            constexpr int MP = M / FFN_SPLIT; const size_t r0 = (size_t)part * MP;
            PH_BEGIN if (l == 0 && sub == 0 && part == 0) mkmv_pass((const float*)(ws + WS_MKVF), (bf16*)(ws + WS_MK), (bf16*)(ws + WS_MV), PTR(10), gwp, NGW, lane);
                const bf16* resA = (l == DEPTH - 1 && sub == 1) ? (const bf16*)(ws + WS_XB2) : (const bf16*)XOUT;
                pg8::Gemm g{resA + r0 * DM, (const bf16*)(ws + WS_WUP) + (size_t)mat * NUP * DM, MP, NUP, DM}; pg8::StaticOrder S; S.init(MP, NUP, G, bxp);
                pg8::EpiSwiGLU E{(bf16*)(ws + WS_ACT) + r0 * FF, FF, pg8::RinvCache{(const float*)(ws + WS_SS) + ((size_t)(3 * l + 2 * sub) * M + r0) * 2, (LAS float*)(lds + RTAB_OFF), -1}};
                for (int rep = 0; rep < REP_UP; ++rep) pg8::gemm_phase<pg8::EpiSwiGLU, pg8::StaticOrder, true, true>(lds, g, S, E, wavep); }
            PH_END;
            PH_BEGIN pg8::Gemm g{(const bf16*)(ws + WS_ACT) + r0 * FF, (const bf16*)(ws + WS_WDN) + (size_t)mat * DM * FF, MP, DM, FF}; pg8::StaticOrder S; S.init(MP, DM, G, bxp);
                const int ssid = sub ? 3 * (l + 1) : 3 * l + 1;
                if (l == DEPTH - 1 && sub == 1) {
                    pg8::EpiRes<true> E{PT, PT_OUT, PT_WS, WS_XB2, 0, WS_SS + (size_t)12 * M * 8, 1, 0, 0.5f, (int)r0};
                    pg8::gemm_phase<pg8::EpiRes<true>, pg8::StaticOrder, true, true>(lds, g, S, E, wavep);
                } else {
                    pg8::EpiRes<false> E{PT, PT_OUT, PT_WS, 0, 0, WS_SS + (size_t)ssid * M * 8, 0, 0, 0.5f, (int)r0};
                    pg8::gemm_phase<pg8::EpiRes<false>, pg8::StaticOrder, true, true>(lds, g, S, E, wavep); }
#if REP_DN > 1
                for (int rep = 1; rep < REP_DN; ++rep) { pg8::EpiDummy E{(bf16*)(ws + WS_HMIX) + r0 * DM, DM}; pg8::gemm_phase<pg8::EpiDummy, pg8::StaticOrder, true, true>(lds, g, S, E, wavep); }
#endif
                }
            PH_END;
            }
            if (sub == 0) {
                const int np = l < 2 ? NA : NB;
                PH_BEGIN const bf16* wt = l < 2 ? (const bf16*)(ws + WS_WAIN) + (size_t)l * NA * DM : (const bf16*)(ws + WS_WBIN) + (size_t)(l - 2) * NB * DM;
                    pg8::Gemm g{(const bf16*)XOUT, wt, M, np, DM}; pg8::StaticOrder S; S.init(M, np, G, bxp);
                    pg8::EpiB16 E{(bf16*)(ws + WS_ACT), np, pg8::RinvCache{(const float*)(ws + WS_SS) + (size_t)(3 * l + 1) * M * 2, (LAS float*)(lds + RTAB_OFF), -1}};
                    for (int rep = 0; rep < REP_IN; ++rep) pg8::gemm_phase<pg8::EpiB16, pg8::StaticOrder, true, true>(lds, g, S, E, wavep); }
                PH_END;
                if (l < 2) {
                    PH_BEGIN
#ifndef DBG_NO_PREP
                        for (int rep = 0; rep < REP_PREP; ++rep) gla_prep((const bf16*)(ws + WS_ACT), PTR(14) + l * 768, (bf16*)(ws + WS_KDT), (bf16*)(ws + WS_VT), (bf16*)(ws + WS_QF), (float*)(ws + WS_ACH), gwp, NGW, lane);
#endif
                        hn_pass((bf16*)(ws + WS_ACT), NA, A_QM, 4, PTR(9) + l * 128, gwp, NGW, lane); }
                    PH_END;
                    PH_BEGIN
                        for (int rep = 0; rep < REP_SCAN; ++rep) gla_seg_states((const bf16*)(ws + WS_KDT), (const bf16*)(ws + WS_VT), (const float*)(ws + WS_ACH), (float*)(ws + WS_FST), (float*)(ws + WS_DSEG), gwp, NGW, lane);
                    }
                    PH_END;
                    PH_BEGIN
                        for (int rep = 0; rep < REP_SCAN; ++rep) gla_seg_outputs((const bf16*)(ws + WS_QF), (const bf16*)(ws + WS_KDT), (const bf16*)(ws + WS_VT), (const float*)(ws + WS_ACH), (const float*)(ws + WS_FST), (const float*)(ws + WS_DSEG), (bf16*)(ws + WS_OG), gwp, NGW, lane);
                    }
                    PH_END;
                } else {
                    PH_BEGIN
                        hn_pass((bf16*)(ws + WS_ACT), NB, B_Q, 12, PTR(17) + (l - 2) * 128, gwp, NGW, lane); hn_pass((bf16*)(ws + WS_ACT), NB, B_QM, 4, PTR(9) + l * 128, gwp, NGW, lane); }
                    PH_END;
                }
                PH_BEGIN
                    if (l < 2) gla_post((const bf16*)(ws + WS_OG), (const bf16*)(ws + WS_ACT), PTR(15) + l * 384, (bf16*)(ws + WS_HMIX), gwp, NGW, lane);
                    AttCfg c; c.PROJ = (const bf16*)(ws + WS_ACT); c.KSVS = (const bf16*)(ws + WS_KSVS); c.CB = (const float*)(ws + WS_CB); c.MK = (const bf16*)(ws + WS_MK) + (size_t)l * MROWS * 512; c.MV = (const bf16*)(ws + WS_MV) + (size_t)l * MROWS * 512;
                    c.MIX = (bf16*)(ws + WS_HMIX); c.np = np; c.qmcol = l < 2 ? A_QM : B_QM; c.fox = l >= 2; c.vcu = vcup; c.G = G;
                    __syncthreads();
#ifndef DBG_NO_ATT
                    for (int rep = 0; rep < REP_ATT; ++rep) att_phase(c, (char*)lds_raw, wavep);
#endif
                    }
                PH_END;
                PH_BEGIN pg8::Gemm g{(const bf16*)(ws + WS_HMIX), (const bf16*)(ws + WS_WOUT) + (size_t)l * DM * DM, M, DM, DM}; pg8::StaticOrder S; S.init(M, DM, G, bxp);
                    { pg8::EpiRes<false> E{PT, PT_OUT, PT_WS, 0, WS_XB2, WS_SS + (size_t)(3 * l + 2) * M * 8, 0, l == DEPTH - 1 ? 1 : 0, 1.0f, 0};
                      pg8::gemm_phase<pg8::EpiRes<false>, pg8::StaticOrder, true, true>(lds, g, S, E, wavep); }
#if REP_OUT > 1
                    for (int rep = 1; rep < REP_OUT; ++rep) { pg8::EpiDummy E{(bf16*)(ws + WS_ACT), DM}; pg8::gemm_phase<pg8::EpiDummy, pg8::StaticOrder, true, true>(lds, g, S, E, wavep); }
#endif
                    }
                PH_END;
            }
        }
    }
#undef PH_ON
#undef PH_END
#undef WSP
#undef PH_BEGIN
#undef XOUT
}

extern "C" void kernel_launch(void* const* d_in, const int* in_sizes, int n_in, void* d_out, int out_size, void* d_ws, size_t ws_size, hipStream_t stream) {
    static int grid = 0;
    if (grid == 0) {
        if (n_in != 22 || in_sizes[0] != M * DM || out_size != M * DM || ws_size < WS_END) { fprintf(stderr, "kernel_launch: unexpected shapes (n_in %d, in0 %d, out %d, ws %zu < %zu); nothing launched\n", n_in, n_in > 0 ? in_sizes[0] : -1, out_size, ws_size, (size_t)WS_END); grid = -1; return; }
        int dev = 0, cus = 0, per_cu = 0;
        if (hipGetDevice(&dev) != hipSuccess || hipDeviceGetAttribute(&cus, hipDeviceAttributeMultiprocessorCount, dev) != hipSuccess) { fprintf(stderr, "kernel_launch: device query failed\n"); grid = -1; return; }
        if (hipFuncSetAttribute((const void*)mega_fwd, hipFuncAttributeMaxDynamicSharedMemorySize, LDS_BYTES) != hipSuccess) { fprintf(stderr, "kernel_launch: hipFuncSetAttribute failed\n"); grid = -1; return; }
        if (hipOccupancyMaxActiveBlocksPerMultiprocessor(&per_cu, (const void*)mega_fwd, NWAVES * 64, LDS_BYTES) != hipSuccess || per_cu < 1)
            fprintf(stderr, "kernel_launch: note: occupancy query reports %d workgroups per CU\n", per_cu);
        (void)hipGetLastError();
        grid = cus;
    }
    if (grid < 0) return;
    (void)hipMemsetAsync((char*)d_ws + WS_CTL, 0, CTL_ZERO_BYTES, stream);
    (void)hipMemsetAsync((char*)d_ws + WS_SS, 0, SS_BYTES, stream);
    Args a{};
    for (int i = 0; i < 22; ++i) a.in[i] = (const float*)d_in[i];
    a.out = (float*)d_out; a.ws = (unsigned char*)d_ws;
#if MK_PER_PHASE
    for (int p = 0; p < NPH && p < MK_STOP_PC; ++p) { a.lo = p; a.hi = p + 1; hipLaunchKernelGGL(mega_fwd, dim3(grid), dim3(NWAVES * 64), LDS_BYTES, stream, a); }
#else
    a.lo = 0; a.hi = NPH; hipLaunchKernelGGL(mega_fwd, dim3(grid), dim3(NWAVES * 64), LDS_BYTES, stream, a);
#endif
}
```

```cpp
#ifndef PG8_WGM
#define PG8_WGM 8
#endif
#include <hip/hip_runtime.h>
#include <cstdio>
#include <cstdint>
__device__ __forceinline__ int lane_id_v() { int l; asm volatile("v_mbcnt_lo_u32_b32 %0, -1, 0\n\tv_mbcnt_hi_u32_b32 %0, -1, %0" : "=v"(l)); return l; }
namespace pg8 {
#define PG8_LAS __attribute__((address_space(3)))
typedef unsigned short bf16_t;
typedef short bf16x8 __attribute__((ext_vector_type(8)));
typedef float f32x4 __attribute__((ext_vector_type(4)));
typedef unsigned u32x4 __attribute__((ext_vector_type(4)));
constexpr int BM = 256, BK = 64, HALF = 128, HTB = HALF * BK * 2  , STAGE_BYTES = 8 * HTB, NXCD = 8, WGM = PG8_WGM;

__host__ __device__ __forceinline__ int lds_byte(int r, int c) { const int st = (r >> 4) * 2 + (c >> 5), rr = r & 15, cc = c & 31, ob = rr * 64 + cc * 2; return st * 1024 + (ob ^ (((ob >> 9) & 1) << 5)); }
__host__ __device__ __forceinline__ void stage_rc(int b, int& R, int& C) { const int st = b / 1024, sb = b % 1024, swz = sb ^ (((sb >> 9) & 1) << 5); R = (st >> 1) * 16 + swz / 64; C = (st & 1) * 32 + (swz % 64) / 2; }
__host__ __device__ __forceinline__ int perm32(int rho) { const int n = rho >> 4, i = rho & 15; return 8 * (i >> 2) + 4 * n + (i & 3); }

struct Unit { int pm, pn; };
struct Gemm { const bf16_t* A; const bf16_t* Bt; int M, N, K; };

struct StaticOrder {
    int nM, nN, nwg, G, c;
    __host__ __device__ void init(int M, int N, int G_, int c_) { nM = M / BM; nN = N / BM; nwg = nM * nN; G = G_; c = c_; }
    __host__ __device__ bool next(int i, Unit& u) const {
        const long L = (long)i * G + c; if (L >= nwg) return false;
        int wgid = (int)L; { const int q = nwg / NXCD, r = nwg % NXCD, xcd = wgid % NXCD, off = wgid / NXCD; wgid = (xcd < r ? xcd * (q + 1) : r * (q + 1) + (xcd - r) * q) + off; }
        const int nig = WGM * nN, gid = wgid / nig, fm = gid * WGM, gsz = (nM - fm) < WGM ? (nM - fm) : WGM;
        u.pm = fm + ((wgid % nig) % gsz); u.pn = (wgid % nig) / gsz; return true;
    }
    __device__ __forceinline__ void a_ready(const Unit&) const {}
    __device__ __forceinline__ void done(const Unit&) const {}
};

__device__ __forceinline__ unsigned cvt_pk_bf16(float lo, float hi) { unsigned r; asm volatile("v_cvt_pk_bf16_f32 %0, %1, %2" : "=v"(r) : "v"(lo), "v"(hi)); return r; }
typedef float f32x2 __attribute__((ext_vector_type(2)));
__device__ __forceinline__ f32x2 gelu_pk(f32x2 v) {
    const f32x2 av = __builtin_elementwise_abs(v), d = av * 0.2316418882f + 1.0f;
    f32x2 t; t.x = __builtin_amdgcn_rcpf(d.x); t.y = __builtin_amdgcn_rcpf(d.y);
    f32x2 q = t * 0.5307027145f + (-0.7265760135f); q = q * t + 0.7107068705f; q = q * t + (-0.142248368f); q = q * t + 0.127414796f; q = q * t;
    const f32x2 s = (v * v) * (-0.72134752044f);
    f32x2 e; e.x = __builtin_amdgcn_exp2f(s.x); e.y = __builtin_amdgcn_exp2f(s.y);
    const f32x2 m = v * (q * e), r = v - m;
    f32x2 o; o.x = v.x < 0.f ? m.x : r.x; o.y = v.y < 0.f ? m.y : r.y; return o;
}

template <int ACT  > struct EpiBf16 {
    static constexpr bool PERM = true, AFTER_DRAIN = false; static_assert(ACT == 0 || ACT == 1, "EpiBf16: ACT is 0 (none) or 1 (gelu_pk)");
    bf16_t* O; int ldc; const float* bias; int split_cols; size_t split_stride; float scale0;
    __device__ __forceinline__ void operator()(const f32x4 (&acc)[2][2][4][2], const Unit& u, int wr, int wc, int fr, int fq) const {
        const int row0 = u.pm * BM + wr * 64 + fr; int colt = u.pn * BM; bf16_t* base = O;
        float sc = 1.f; if (split_cols) { const int t = colt / split_cols; base += (size_t)t * split_stride; colt -= t * split_cols; if (t == 0) sc = scale0; }
        const int col0 = colt + wc * 32 + 8 * fq, bcol0 = u.pn * BM + wc * 32 + 8 * fq;
        f32x4 bv[2][2];
#pragma unroll
        for (int bj = 0; bj < 2; ++bj)
#pragma unroll
            for (int n = 0; n < 2; ++n) bv[bj][n] = bias ? *(const f32x4*)(bias + bcol0 + bj * HALF + 4 * n) : (f32x4){0.f, 0.f, 0.f, 0.f};
#pragma unroll
        for (int ai = 0; ai < 2; ++ai)
#pragma unroll
            for (int m = 0; m < 4; ++m) { bf16_t* rowp = base + (size_t)(row0 + ai * HALF + m * 16) * ldc + col0;
#pragma unroll
                for (int bj = 0; bj < 2; ++bj) { f32x4 v0 = acc[ai][bj][m][0] + bv[bj][0], v1 = acc[ai][bj][m][1] + bv[bj][1];
                    if (ACT == 1) { f32x2 a = gelu_pk((f32x2){v0[0], v0[1]}), b = gelu_pk((f32x2){v0[2], v0[3]}), c = gelu_pk((f32x2){v1[0], v1[1]}), d = gelu_pk((f32x2){v1[2], v1[3]});
                        v0 = (f32x4){a.x, a.y, b.x, b.y}; v1 = (f32x4){c.x, c.y, d.x, d.y}; }
                    v0 = v0 * sc; v1 = v1 * sc; u32x4 w; w.x = cvt_pk_bf16(v0[0], v0[1]); w.y = cvt_pk_bf16(v0[2], v0[3]); w.z = cvt_pk_bf16(v1[0], v1[1]); w.w = cvt_pk_bf16(v1[2], v1[3]);
                    *(u32x4*)(rowp + bj * HALF) = w; } }
    }
};

__device__ __forceinline__ unsigned pkbf(float lo, float hi) {
    typedef __bf16 bf2_t __attribute__((ext_vector_type(2))); typedef float fl2_t __attribute__((ext_vector_type(2)));
    fl2_t v = {lo, hi}; bf2_t r = __builtin_convertvector(v, bf2_t); return __builtin_bit_cast(unsigned, r);
}
__device__ __forceinline__ float silu_f(float x) { return x * __builtin_amdgcn_rcpf(1.0f + __builtin_amdgcn_exp2f(-1.4426950408889634f * x)); }

__device__ __forceinline__ float rinv_of(const float* ss, int row) { const float s = (float)((const unsigned long long*)ss)[row] * (1.0f / 16777216.0f); return 1.0f / sqrtf(s * (1.0f / 2048.f) + 1e-6f); }
struct RinvCache {
    const float* ss; PG8_LAS float* tab; mutable int pm_cached;
    __device__ __forceinline__ void get(float (&ri)[2][4], const Unit& u, int wr, int wc, int fr) const {
        PG8_LAS float* t = tab + (wr * 4 + wc) * 128;
        if (u.pm != pm_cached) { pm_cached = u.pm; const int l = lane_id_v();
            t[l] = rinv_of(ss, u.pm * BM + wr * 64 + l); t[64 + l] = rinv_of(ss, u.pm * BM + HALF + wr * 64 + l);
            asm volatile("s_waitcnt lgkmcnt(0)" ::: "memory"); }
#pragma unroll
        for (int ai = 0; ai < 2; ++ai)
#pragma unroll
            for (int m = 0; m < 4; ++m) ri[ai][m] = t[ai * 64 + m * 16 + fr];
    }
};
struct EpiSwiGLU {
    static constexpr bool PERM = true, AFTER_DRAIN = false;
    bf16_t* O; int ldc; RinvCache rc;
    __device__ __forceinline__ void operator()(const f32x4 (&acc)[2][2][4][2], const Unit& u, int wr, int wc, int fr, int fq) const {
        const int row0 = u.pm * BM + wr * 64 + fr, col0 = u.pn * HALF + wc * 32 + 8 * fq;
        float rit[2][4]; rc.get(rit, u, wr, wc, fr);
#pragma unroll
        for (int ai = 0; ai < 2; ++ai)
#pragma unroll
            for (int m = 0; m < 4; ++m) { bf16_t* rowp = O + (size_t)(row0 + ai * HALF + m * 16) * ldc + col0;
                const float ri = rit[ai][m]; const float ce = -1.4426950408889634f * ri, kk = __builtin_amdgcn_rcpf(ri * ri);
                const f32x4 ag0 = acc[ai][0][m][0], ag1 = acc[ai][0][m][1], au0 = acc[ai][1][m][0], au1 = acc[ai][1][m][1];
                const f32x4 t0 = ag0 * ce, t1 = ag1 * ce; f32x4 e0, e1;
#pragma unroll
                for (int j = 0; j < 4; ++j) { e0[j] = __builtin_amdgcn_exp2f(t0[j]); e1[j] = __builtin_amdgcn_exp2f(t1[j]); }
                const f32x4 d0 = e0 * kk + kk, d1 = e1 * kk + kk; f32x4 r0, r1;
#pragma unroll
                for (int j = 0; j < 4; ++j) { r0[j] = __builtin_amdgcn_rcpf(d0[j]); r1[j] = __builtin_amdgcn_rcpf(d1[j]); }
                const f32x4 o0 = (ag0 * au0) * r0, o1 = (ag1 * au1) * r1;
                u32x4 w;
                w.x = pkbf(o0[0], o0[1]); w.y = pkbf(o0[2], o0[3]); w.z = pkbf(o1[0], o1[1]); w.w = pkbf(o1[2], o1[3]);
                __builtin_nontemporal_store(w, (u32x4*)rowp); }
    }
};
typedef unsigned u32x2 __attribute__((ext_vector_type(2)));
template <bool FINAL> struct EpiRes {
    static constexpr bool PERM = true, AFTER_DRAIN = false;
    volatile PG8_LAS unsigned* PT; int slot_out, slot_ws; size_t base_off, out_off, ss_off; int base_in_ws, out_in_ws; float scale; int row_base;
    __device__ __forceinline__ void operator()(const f32x4 (&acc)[2][2][4][2], const Unit& u, int wr, int wc, int fr, int fq) const {
        typedef __attribute__((address_space(1))) unsigned char gchar;
        unsigned char* dout = (unsigned char*)(gchar*)(((unsigned long long)__builtin_amdgcn_readfirstlane(PT[2 * slot_out + 1]) << 32) | (unsigned)__builtin_amdgcn_readfirstlane(PT[2 * slot_out]));
        unsigned char* ws = (unsigned char*)(gchar*)(((unsigned long long)__builtin_amdgcn_readfirstlane(PT[2 * slot_ws + 1]) << 32) | (unsigned)__builtin_amdgcn_readfirstlane(PT[2 * slot_ws]));
        const bf16_t* base = (const bf16_t*)(base_in_ws ? ws + base_off : dout); bf16_t* outb = (bf16_t*)(out_in_ws ? ws + out_off : dout); float* outf = (float*)dout; float* ss = (float*)(ws + ss_off);
        constexpr int ldc = 2048;
        const int row0 = row_base + u.pm * BM + wr * 64 + fr, col0 = u.pn * BM + wc * 32 + 8 * fq;
        u32x4 b[2][4][2];
#pragma unroll
        for (int ai = 0; ai < 2; ++ai)
#pragma unroll
            for (int m = 0; m < 4; ++m) { const size_t off = (size_t)(row0 + ai * HALF + m * 16) * ldc + col0;
#pragma unroll
                for (int bj = 0; bj < 2; ++bj) b[ai][m][bj] = *(const u32x4*)(base + off + bj * HALF); }
#pragma unroll
        for (int ai = 0; ai < 2; ++ai) {
#pragma unroll
            for (int m = 0; m < 4; ++m) { const size_t off = (size_t)(row0 + ai * HALF + m * 16) * ldc + col0; float q = 0.f;
#pragma unroll
                for (int bj = 0; bj < 2; ++bj) { const u32x4 r = b[ai][m][bj];
                    f32x4 x0 = {__uint_as_float(r.x << 16), __uint_as_float(r.x & 0xffff0000u), __uint_as_float(r.y << 16), __uint_as_float(r.y & 0xffff0000u)};
                    f32x4 x1 = {__uint_as_float(r.z << 16), __uint_as_float(r.z & 0xffff0000u), __uint_as_float(r.w << 16), __uint_as_float(r.w & 0xffff0000u)};
                    x0 = x0 + acc[ai][bj][m][0] * scale; x1 = x1 + acc[ai][bj][m][1] * scale;
                    if (FINAL) { *(f32x4*)(outf + off + bj * HALF) = x0; *(f32x4*)(outf + off + bj * HALF + 4) = x1; }
                    else { q += ((x0[0] * x0[0] + x0[1] * x0[1]) + (x0[2] * x0[2] + x0[3] * x0[3])) + ((x1[0] * x1[0] + x1[1] * x1[1]) + (x1[2] * x1[2] + x1[3] * x1[3]));
                        u32x4 w; w.x = pkbf(x0[0], x0[1]); w.y = pkbf(x0[2], x0[3]); w.z = pkbf(x1[0], x1[1]); w.w = pkbf(x1[2], x1[3]); *(u32x4*)(outb + off + bj * HALF) = w; } }
                if (!FINAL) {
                    q += __uint_as_float((unsigned)__builtin_amdgcn_ds_swizzle((int)__float_as_uint(q), (16 << 10) | 0x1f));
                    const auto rr = __builtin_amdgcn_permlane32_swap(__float_as_uint(q), __float_as_uint(q), false, false);
                    q = __uint_as_float(rr[0]) + __uint_as_float(rr[1]);
                    if (fq == 0) atomicAdd((unsigned long long*)ss + row0 + ai * HALF + m * 16, (unsigned long long)(q * 16777216.0f)); } }
            asm volatile("" ::: "memory"); }
    }
};
struct EpiF32 {
    static constexpr bool PERM = false, AFTER_DRAIN = false;
    float* C; int ldc;
    __device__ __forceinline__ void operator()(const f32x4 (&acc)[2][2][4][2], const Unit& u, int wr, int wc, int fr, int fq) const {
        const int row0 = u.pm * BM + wr * 64 + fr, col0 = u.pn * BM + wc * 32 + 4 * fq;
#pragma unroll
        for (int ai = 0; ai < 2; ++ai)
#pragma unroll
            for (int m = 0; m < 4; ++m) { float* rowp = C + (size_t)(row0 + ai * HALF + m * 16) * ldc + col0;
#pragma unroll
                for (int bj = 0; bj < 2; ++bj)
#pragma unroll
                    for (int n = 0; n < 2; ++n) *(f32x4*)(rowp + bj * HALF + n * 16) = acc[ai][bj][m][n]; }
    }
};
struct HeadNorm { PG8_LAS float* hnt; PG8_LAS const float* gain; };
__device__ __forceinline__ void store_b16_tile(const f32x4 (&acc)[2][2][4][2], bf16_t* O, int ldc, int row0, int col0, const float (&rit)[2][4], const HeadNorm hn, int wr, int wc, int fr, int fq) {
    if (hn.gain) {
#pragma unroll
        for (int ai = 0; ai < 2; ++ai)
#pragma unroll
            for (int m = 0; m < 4; ++m) { const float ri = rit[ai][m];
#pragma unroll
                for (int bj = 0; bj < 2; ++bj) { const f32x4 v0 = acc[ai][bj][m][0] * ri, v1 = acc[ai][bj][m][1] * ri;
                    float q = ((v0[0] * v0[0] + v0[1] * v0[1]) + (v0[2] * v0[2] + v0[3] * v0[3])) + ((v1[0] * v1[0] + v1[1] * v1[1]) + (v1[2] * v1[2] + v1[3] * v1[3]));
                    q += __uint_as_float((unsigned)__builtin_amdgcn_ds_swizzle((int)__float_as_uint(q), (16 << 10) | 0x1f));
                    const auto rr = __builtin_amdgcn_permlane32_swap(__float_as_uint(q), __float_as_uint(q), false, false);
                    q = __uint_as_float(rr[0]) + __uint_as_float(rr[1]);
                    if (fq == 0) hn.hnt[((ai * HALF + wr * 64 + m * 16 + fr) * 2 + bj) * 4 + wc] = q; } }
        asm volatile("s_waitcnt lgkmcnt(0)" ::: "memory"); __builtin_amdgcn_s_barrier(); asm volatile("" ::: "memory");
        const f32x4 g0 = *(PG8_LAS const f32x4*)(hn.gain + wc * 32 + 8 * fq), g1 = *(PG8_LAS const f32x4*)(hn.gain + wc * 32 + 8 * fq + 4);
#pragma unroll
        for (int ai = 0; ai < 2; ++ai)
#pragma unroll
            for (int m = 0; m < 4; ++m) { bf16_t* rowp = O + (size_t)(row0 + ai * HALF + m * 16) * ldc + col0; const float ri = rit[ai][m];
#pragma unroll
                for (int bj = 0; bj < 2; ++bj) { const f32x4 p4 = *(PG8_LAS const f32x4*)(hn.hnt + ((ai * HALF + wr * 64 + m * 16 + fr) * 2 + bj) * 4);
                    const float rh = ri / sqrtf(((p4[0] + p4[1]) + (p4[2] + p4[3])) * (1.0f / 128.f) + 1e-6f);
                    const f32x4 v0 = acc[ai][bj][m][0] * rh * g0, v1 = acc[ai][bj][m][1] * rh * g1;
                    u32x4 w; w.x = pkbf(v0[0], v0[1]); w.y = pkbf(v0[2], v0[3]); w.z = pkbf(v1[0], v1[1]); w.w = pkbf(v1[2], v1[3]);
                    *(u32x4*)(rowp + bj * HALF) = w; } }
    } else {
#pragma unroll
        for (int ai = 0; ai < 2; ++ai)
#pragma unroll
            for (int m = 0; m < 4; ++m) { bf16_t* rowp = O + (size_t)(row0 + ai * HALF + m * 16) * ldc + col0; const float ri = rit[ai][m];
#pragma unroll
                for (int bj = 0; bj < 2; ++bj) { const f32x4 v0 = acc[ai][bj][m][0] * ri, v1 = acc[ai][bj][m][1] * ri;
                    u32x4 w; w.x = pkbf(v0[0], v0[1]); w.y = pkbf(v0[2], v0[3]); w.z = pkbf(v1[0], v1[1]); w.w = pkbf(v1[2], v1[3]);
                    *(u32x4*)(rowp + bj * HALF) = w; } }
    }
}
struct EpiB16 {
    static constexpr bool PERM = true, AFTER_DRAIN = false;
    bf16_t* O; int ldc; RinvCache rc; PG8_LAS float* hnt; PG8_LAS const float* gains; int t0lo, t0hi, t1lo, t1hi;
    __device__ __forceinline__ void operator()(const f32x4 (&acc)[2][2][4][2], const Unit& u, int wr, int wc, int fr, int fq) const {
        const int row0 = u.pm * BM + wr * 64 + fr, col0 = u.pn * BM + wc * 32 + 8 * fq;
        float rit[2][4]; rc.get(rit, u, wr, wc, fr);
        HeadNorm hn{hnt, nullptr};
        if (u.pn >= t0lo && u.pn < t0hi) hn.gain = gains; else if (u.pn >= t1lo && u.pn < t1hi) hn.gain = gains + 128;
        store_b16_tile(acc, O, ldc, row0, col0, rit, hn, wr, wc, fr, fq);
    }
};
struct EpiKV {
    static constexpr bool PERM = true, AFTER_DRAIN = false;
    bf16_t* O; int ldc; float* F; RinvCache rc; PG8_LAS float* hnt; PG8_LAS const float* gains;
    __device__ __forceinline__ void operator()(const f32x4 (&acc)[2][2][4][2], const Unit& u, int wr, int wc, int fr, int fq) const {
        const int row0 = u.pm * BM + wr * 64 + fr;
        float rit[2][4]; rc.get(rit, u, wr, wc, fr);
        if (u.pn < 12) {
            HeadNorm hn{hnt, u.pn < 6 ? gains : nullptr};
            store_b16_tile(acc, O, ldc, row0, u.pn * BM + wc * 32 + 8 * fq, rit, hn, wr, wc, fr, fq);
        } else if (wc == 0 && fq < 2) {
#pragma unroll
            for (int ai = 0; ai < 2; ++ai)
#pragma unroll
                for (int m = 0; m < 4; ++m) { float* rowp = F + (size_t)(row0 + ai * HALF + m * 16) * 16 + 8 * fq; const float ri = rit[ai][m];
                    *(f32x4*)(rowp) = acc[ai][0][m][0] * ri; *(f32x4*)(rowp + 4) = acc[ai][0][m][1] * ri; }
        }
    }
};
struct EpiDummy {
    static constexpr bool PERM = true, AFTER_DRAIN = false;
    bf16_t* O; int ldc;
    __device__ __forceinline__ void operator()(const f32x4 (&acc)[2][2][4][2], const Unit& u, int wr, int wc, int fr, int fq) const {
        const int row0 = u.pm * BM + wr * 64 + fr, col0 = u.pn * BM + wc * 32 + 8 * fq;
#pragma unroll
        for (int ai = 0; ai < 2; ++ai)
#pragma unroll
            for (int m = 0; m < 4; ++m) { bf16_t* rowp = O + (size_t)(row0 + ai * HALF + m * 16) * ldc + col0;
#pragma unroll
                for (int bj = 0; bj < 2; ++bj) { const f32x4 v0 = acc[ai][bj][m][0], v1 = acc[ai][bj][m][1];
                    u32x4 w; w.x = pkbf(v0[0], v0[1]); w.y = pkbf(v0[2], v0[3]); w.z = pkbf(v1[0], v1[1]); w.w = pkbf(v1[2], v1[3]);
                    *(u32x4*)(rowp + bj * HALF) = w; } }
    }
};

struct EpiNull {
    static constexpr bool PERM = true, AFTER_DRAIN = false;
    float* sink;
    __device__ __forceinline__ void operator()(const f32x4 (&acc)[2][2][4][2], const Unit& u, int wr, int wc, int fr, int fq) const {
        f32x4 t = {0.f, 0.f, 0.f, 0.f};
#pragma unroll
        for (int ai = 0; ai < 2; ++ai)
#pragma unroll
            for (int bj = 0; bj < 2; ++bj)
#pragma unroll
                for (int m = 0; m < 4; ++m) { t = t + acc[ai][bj][m][0]; t = t + acc[ai][bj][m][1]; }
        if ((t[0] + t[1]) + (t[2] + t[3]) == 1.2345678e33f) sink[0] = t[0];
    }
};
template <class Epi, class Sched, bool ALIGN_EPI = false, bool SP2 = false>
__device__ __forceinline__ void gemm_phase(PG8_LAS unsigned char* lds, const Gemm g, const Sched& S, const Epi E, const int wave_in) {
    const int tid_l = wave_in * 64 + lane_id_v();
    const int tid = tid_l, wid = wave_in, lane = tid & 63, wr = wid >> 2, wc = wid & 3, fr = lane & 15, fq = lane >> 4;
    const int K = g.K, nt = K / BK;
    unsigned voffA[2], voffB[2];
#pragma unroll
    for (int i = 0; i < 2; ++i) { int R, C; stage_rc(tid * 16 + i * 8192, R, C); const int Rb = Epi::PERM ? ((R & ~31) + perm32(R & 31)) : R;
        voffA[i] = (unsigned)(R * K + C) * 2u; voffB[i] = (unsigned)(Rb * K + C) * 2u; }
    const size_t kstep = (size_t)(BK * 2);
    const size_t hstep = (size_t)HALF * K * 2;
    const size_t tstep = 2 * hstep;
    const unsigned ldsw = (unsigned)wid * 1024u;
    const int aoff = lds_byte(wr * 64 + fr, fq * 8), boff = lds_byte(wc * 32 + fr, fq * 8);
#define PG8_SA(b, h) (((b) * 2 + (h)) * HTB)
#define PG8_SB(b, h) ((4 + (b) * 2 + (h)) * HTB)
#define PG8_STAGE(bufoff, gbase, voff) do { _Pragma("unroll") for (int _i = 0; _i < 2; ++_i) \
        __builtin_amdgcn_global_load_lds((const unsigned*)((const char*)(gbase) + (voff)[_i]), (PG8_LAS unsigned*)(lds + (bufoff) + ldsw + _i * 8192), 16, 0, 0); } while (0)
#define PG8_LDA(dst, b, h) do { _Pragma("unroll") for (int m = 0; m < 4; ++m) _Pragma("unroll") for (int k = 0; k < 2; ++k) dst[m][k] = *(const PG8_LAS bf16x8*)(lds + PG8_SA(b, h) + aoff + m * 2048 + k * 1024); } while (0)
#define PG8_LDB(dst, b, h) do { _Pragma("unroll") for (int n = 0; n < 2; ++n) _Pragma("unroll") for (int k = 0; k < 2; ++k) dst[n][k] = *(const PG8_LAS bf16x8*)(lds + PG8_SB(b, h) + boff + n * 2048 + k * 1024); } while (0)
#define PG8_MMA(ai, bj, At, Bt) do { __builtin_amdgcn_s_setprio(1); _Pragma("unroll") for (int m = 0; m < 4; ++m) _Pragma("unroll") for (int n = 0; n < 2; ++n) _Pragma("unroll") for (int k = 0; k < 2; ++k) \
        acc[ai][bj][m][n] = __builtin_amdgcn_mfma_f32_16x16x32_bf16(Bt[n][k], At[m][k], acc[ai][bj][m][n], 0, 0, 0); __builtin_amdgcn_s_setprio(0); } while (0)
#define PG8_WAIT_V(n) asm volatile("s_waitcnt vmcnt(" #n ")" ::: "memory")
#define PG8_WAIT_L(n) asm volatile("s_waitcnt lgkmcnt(" #n ")" ::: "memory")
#define PG8_BAR __builtin_amdgcn_s_barrier()
#define PG8_SCHED __builtin_amdgcn_sched_barrier(0)
    Unit cur, nxt; int ui = 0;
    if (!S.next(0, cur)) return;
    f32x4 acc[2][2][4][2];
#pragma unroll
    for (int a = 0; a < 2; ++a)
#pragma unroll
        for (int b = 0; b < 2; ++b)
#pragma unroll
            for (int m = 0; m < 4; ++m)
#pragma unroll
                for (int n = 0; n < 2; ++n) acc[a][b][m][n] = (f32x4){0.f, 0.f, 0.f, 0.f};
    bf16x8 At[4][2], B0[2][2], B1[2][2];
    const char* cA = (const char*)g.A + (size_t)cur.pm * tstep; const char* cB = (const char*)g.Bt + (size_t)cur.pn * tstep;
    S.a_ready(cur);
    if constexpr (SP2) {
        PG8_STAGE(PG8_SB(0, 0), cB, voffB); PG8_STAGE(PG8_SB(0, 1), cB + hstep, voffB); PG8_STAGE(PG8_SA(0, 0), cA, voffA); PG8_STAGE(PG8_SA(0, 1), cA + hstep, voffA);
        if (wr == 1) PG8_BAR;
        PG8_WAIT_V(2); PG8_BAR;
        PG8_STAGE(PG8_SB(1, 0), cB + kstep, voffB); PG8_STAGE(PG8_SA(1, 0), cA + kstep, voffA); PG8_STAGE(PG8_SB(1, 1), cB + hstep + kstep, voffB);
        PG8_WAIT_V(6); PG8_BAR;
    } else {
        PG8_STAGE(PG8_SB(0, 0), cB, voffB); PG8_STAGE(PG8_SA(0, 0), cA, voffA); PG8_STAGE(PG8_SB(0, 1), cB + hstep, voffB); PG8_STAGE(PG8_SA(0, 1), cA + hstep, voffA);
        if (wr == 1) PG8_BAR;
        PG8_WAIT_V(4); PG8_BAR;
        PG8_STAGE(PG8_SB(1, 0), cB + kstep, voffB); PG8_STAGE(PG8_SA(1, 0), cA + kstep, voffA); PG8_STAGE(PG8_SB(1, 1), cB + hstep + kstep, voffB);
        PG8_WAIT_V(6); PG8_BAR;
    }
    for (;;) {
        const bool has_next = S.next(ui + 1, nxt);
        const char* nA = has_next ? (const char*)g.A + (size_t)nxt.pm * tstep : cA; const char* nB = has_next ? (const char*)g.Bt + (size_t)nxt.pn * tstep : cB;
        for (int t = 0; t < nt; t += 2) {
            const bool last = (t == nt - 2);
            const char* a1 = cA + (size_t)(t + 1) * kstep;
            const char* a2 = last ? nA : cA + (size_t)(t + 2) * kstep; const char* b2 = last ? nB : cB + (size_t)(t + 2) * kstep;
            const char* a3 = a2 + kstep; const char* b3 = b2 + kstep;
            if (last && has_next) S.a_ready(nxt);
            if constexpr (SP2) {
            PG8_LDB(B0, 0, 0); PG8_LDB(B1, 0, 1); PG8_SCHED; PG8_LDA(At, 0, 0); PG8_STAGE(PG8_SA(1, 1), a1 + hstep, voffA);
            PG8_WAIT_V(8); PG8_WAIT_L(0); PG8_BAR; PG8_MMA(0, 0, At, B0); PG8_MMA(0, 1, At, B1); PG8_BAR; PG8_SCHED;
            PG8_LDA(At, 0, 1); PG8_STAGE(PG8_SB(0, 0), b2, voffB); PG8_STAGE(PG8_SB(0, 1), b2 + hstep, voffB); PG8_STAGE(PG8_SA(0, 0), a2, voffA);
            PG8_WAIT_V(8); PG8_WAIT_L(0); PG8_BAR; PG8_MMA(1, 0, At, B0); PG8_MMA(1, 1, At, B1); PG8_BAR; PG8_SCHED;
            PG8_LDB(B0, 1, 0); PG8_LDB(B1, 1, 1); PG8_SCHED; PG8_LDA(At, 1, 0); PG8_STAGE(PG8_SA(0, 1), a2 + hstep, voffA);
            PG8_WAIT_V(8); PG8_WAIT_L(0); PG8_BAR; PG8_MMA(0, 0, At, B0); PG8_MMA(0, 1, At, B1); PG8_BAR; PG8_SCHED;
            PG8_LDA(At, 1, 1); PG8_STAGE(PG8_SB(1, 0), b3, voffB); PG8_STAGE(PG8_SB(1, 1), b3 + hstep, voffB); PG8_STAGE(PG8_SA(1, 0), a3, voffA);
            PG8_WAIT_V(8); PG8_WAIT_L(0); PG8_BAR; PG8_MMA(1, 0, At, B0); PG8_MMA(1, 1, At, B1); PG8_BAR; PG8_SCHED;
            } else {
            PG8_LDB(B0, 0, 0); PG8_SCHED; PG8_LDA(At, 0, 0); PG8_STAGE(PG8_SA(1, 1), a1 + hstep, voffA);
            PG8_WAIT_L(8); PG8_BAR; PG8_WAIT_L(0); PG8_MMA(0, 0, At, B0); PG8_BAR; PG8_SCHED;
            PG8_LDB(B1, 0, 1); PG8_STAGE(PG8_SB(0, 0), b2, voffB);
            PG8_BAR; PG8_WAIT_L(0); PG8_MMA(0, 1, At, B1); PG8_BAR;
            PG8_LDA(At, 0, 1); PG8_STAGE(PG8_SA(0, 0), a2, voffA);
            PG8_BAR; PG8_WAIT_L(0); PG8_MMA(1, 0, At, B0); PG8_BAR; PG8_SCHED;
            PG8_STAGE(PG8_SB(0, 1), b2 + hstep, voffB);
            PG8_WAIT_V(6); PG8_BAR; PG8_MMA(1, 1, At, B1); PG8_BAR;
            PG8_LDB(B0, 1, 0); PG8_SCHED; PG8_LDA(At, 1, 0); PG8_STAGE(PG8_SA(0, 1), a2 + hstep, voffA);
            PG8_WAIT_L(8); PG8_BAR; PG8_WAIT_L(0); PG8_MMA(0, 0, At, B0); PG8_BAR; PG8_SCHED;
            PG8_LDB(B1, 1, 1); PG8_STAGE(PG8_SB(1, 0), b3, voffB);
            PG8_BAR; PG8_WAIT_L(0); PG8_MMA(0, 1, At, B1); PG8_BAR;
            PG8_LDA(At, 1, 1); PG8_STAGE(PG8_SA(1, 0), a3, voffA);
            PG8_BAR; PG8_WAIT_L(0); PG8_MMA(1, 0, At, B0); PG8_BAR; PG8_SCHED;
            PG8_STAGE(PG8_SB(1, 1), b3 + hstep, voffB);
            PG8_WAIT_V(6); PG8_BAR; PG8_MMA(1, 1, At, B1); PG8_BAR;
            }
        }
        if constexpr (ALIGN_EPI) { if (wr == 0) PG8_BAR; }
        if constexpr (!Epi::AFTER_DRAIN) { E(acc, cur, wr, wc, fr, fq); S.done(cur); }
        if (!has_next) break;
#pragma unroll
        for (int a = 0; a < 2; ++a)
#pragma unroll
            for (int b = 0; b < 2; ++b)
#pragma unroll
                for (int m = 0; m < 4; ++m)
#pragma unroll
                    for (int n = 0; n < 2; ++n) acc[a][b][m][n] = (f32x4){0.f, 0.f, 0.f, 0.f};
        cur = nxt; cA = nA; cB = nB; ++ui;
        if constexpr (ALIGN_EPI) { if (wr == 1) PG8_BAR; }
    }
    PG8_WAIT_V(0);
    if constexpr (!ALIGN_EPI) { if (wr == 0) PG8_BAR; }
    PG8_BAR;
    if constexpr (Epi::AFTER_DRAIN) { E.fused(acc, cur, wr, wc, fr, fq, lds, wid, lane); S.done(cur); }
#undef PG8_SA
#undef PG8_SB
#undef PG8_STAGE
#undef PG8_LDA
#undef PG8_LDB
#undef PG8_MMA
#undef PG8_WAIT_V
#undef PG8_WAIT_L
#undef PG8_BAR
#undef PG8_SCHED
}
}

namespace fa {
constexpr float SCALE = 0.08838834764831845f;
constexpr int D = 128, NW = 8, QBLK = 32, KVBLK = 64, QB = NW * QBLK;
constexpr int SHM_V = KVBLK * D * 2, SHM_K = KVBLK * D * 2;
constexpr int LDS_BYTES = 2 * SHM_V + 2 * SHM_K + NW * 64 * 4;
constexpr float THR = 8.f;
constexpr int EPI_PITCH = 528;
constexpr int OP = 2048;
typedef unsigned short bf16;
typedef short bf16x8 __attribute__((ext_vector_type(8)));
typedef short s16x4 __attribute__((ext_vector_type(4)));
typedef float f32x16 __attribute__((ext_vector_type(16)));
typedef float f32x4 __attribute__((ext_vector_type(4)));
typedef unsigned u32x4 __attribute__((ext_vector_type(4)));

#define KSWZ(row, colB) ((row) * 256 + ((colB) ^ (((row) & 7) << 4)))
#define SBAR() __builtin_amdgcn_sched_barrier(0)
__device__ __forceinline__ int v_st(int k, int c) { const int kk = (k & ~0xC) | ((k & 4) << 1) | ((k & 8) >> 1); return ((kk >> 3) * 4 + (c >> 5)) * 512 + ((kk & 7) * 32 + (c & 31)) * 2; }
__device__ __forceinline__ int v_rd_base(int lane) { return ((lane & 3) << 3) | (((lane >> 2) & 3) << 6) | (((lane >> 4) & 1) << 5) | (((lane >> 5) & 1) << 8); }
constexpr int v_rd_off(int d0, int ks, int half) { return d0 * 512 + ks * 4096 + half * 2048; }
__device__ __forceinline__ int crow(int r, int hi) { return (r & 3) + 8 * (r >> 2) + 4 * hi; }
__device__ __forceinline__ unsigned cvtpk(float lo, float hi) {
    unsigned r; asm volatile("v_cvt_pk_bf16_f32 %0, %1, %2" : "=v"(r) : "v"(lo), "v"(hi)); return r;
}
__device__ __forceinline__ bf16x8 load8(const bf16* p) { return *reinterpret_cast<const bf16x8*>(p); }
__device__ __forceinline__ bf16x8 cb_frag(float c, int hi) {
    const unsigned u1 = __float_as_uint(c) & 0xffff0000u; const float r1 = c - __uint_as_float(u1);
    const unsigned v1 = __float_as_uint(r1) & 0xffff0000u; const float r2 = r1 - __uint_as_float(v1);
    const unsigned w1 = __float_as_uint(r2) & 0xffff0000u;
    u32x4 w = {hi ? 0u : ((u1 >> 16) | v1), hi ? 0u : (w1 >> 16), 0u, 0u};
    return *reinterpret_cast<bf16x8*>(&w);
}
__device__ __forceinline__ int hi_opaque() { return lane_id_v() >> 5; }
__device__ __forceinline__ bf16x8 ones_frag(int hi) { u32x4 w = {hi ? 0u : 0x3F803F80u, hi ? 0u : 0x00003F80u, 0u, 0u}; return *reinterpret_cast<bf16x8*>(&w); }
__device__ __forceinline__ void mask_tile(f32x16& p0, f32x16& p1, int dq, unsigned W) {
    const float NEG = -__builtin_inff();
#pragma unroll
    for (int r = 0; r < 16; ++r) {
        const int c = (r & 3) + 8 * (r >> 2);
        if ((unsigned)(dq - c) >= W) p0[r] = NEG;
        if ((unsigned)(dq - c - 32) >= W) p1[r] = NEG;
    }
}
__device__ __forceinline__ void partialSM(f32x16& p0, f32x16& p1, float& m_reg, float& mn, float& alpha) {
    float pmax = p0[0]; for (int r = 1; r < 16; ++r) pmax = fmaxf(pmax, p0[r]); for (int r = 0; r < 16; ++r) pmax = fmaxf(pmax, p1[r]);
    { auto rr = __builtin_amdgcn_permlane32_swap(__float_as_uint(pmax), __float_as_uint(pmax), false, false);
      pmax = fmaxf(__uint_as_float(rr[0]), __uint_as_float(rr[1])); }
    constexpr float C2 = 1.4426950408889634f * SCALE;
    if (__builtin_expect(__all((pmax - m_reg) * SCALE <= THR), 1)) { mn = m_reg; alpha = 1.f; }
    else { mn = fmaxf(m_reg, pmax); alpha = __builtin_amdgcn_exp2f((m_reg - mn) * C2); m_reg = mn; }
    const float mnL = -mn * C2;
    for (int r = 0; r < 16; ++r) p0[r] = fmaf(p0[r], C2, mnL); for (int r = 0; r < 16; ++r) p1[r] = fmaf(p1[r], C2, mnL);
    for (int r = 0; r < 16; ++r) p0[r] = __builtin_amdgcn_exp2f(p0[r]);
}
__device__ __forceinline__ void finishSM(f32x16& p0, f32x16& p1, float alpha, float& l_reg, bf16x8& pa0, bf16x8& pa1, bf16x8& pa2, bf16x8& pa3) {
    for (int r = 0; r < 16; ++r) p1[r] = __builtin_amdgcn_exp2f(p1[r]);
    float ps = 0; for (int r = 0; r < 16; ++r) ps += p0[r]; for (int r = 0; r < 16; ++r) ps += p1[r];
    { auto rr = __builtin_amdgcn_permlane32_swap(__float_as_uint(ps), __float_as_uint(ps), false, false);
      ps = __uint_as_float(rr[0]) + __uint_as_float(rr[1]); }
    l_reg = l_reg * alpha + ps;
#define PK4(P, B_, OUT) do { unsigned a0 = cvtpk(P[B_+0], P[B_+1]), a1 = cvtpk(P[B_+2], P[B_+3]);                          \
        unsigned b0 = cvtpk(P[B_+4], P[B_+5]), b1 = cvtpk(P[B_+6], P[B_+7]);                                             \
        auto r0 = __builtin_amdgcn_permlane32_swap(a0, b0, false, false); auto r1 = __builtin_amdgcn_permlane32_swap(a1, b1, false, false); \
        u32x4 w = {r0[0], r1[0], r0[1], r1[1]}; OUT = *reinterpret_cast<bf16x8*>(&w); } while (0)
    PK4(p0, 0, pa0); PK4(p0, 8, pa1); PK4(p1, 0, pa2); PK4(p1, 8, pa3);
#undef PK4
}
template <int KB>
__device__ __forceinline__ void qkt(f32x16& p0, f32x16& p1, const char* K_lds, int r32, int hi, const bf16x8* qr, bf16x8 kx0, bf16x8 kx1, bf16x8 qx) {
    p0 = __builtin_amdgcn_mfma_f32_32x32x16_bf16(kx0, qx, f32x16{}, 0, 0, 0);
    p1 = __builtin_amdgcn_mfma_f32_32x32x16_bf16(kx1, qx, f32x16{}, 0, 0, 0);
    const char* kb[4];
#pragma unroll
    for (int dd = 0; dd < 4; ++dd) kb[dd] = K_lds + KB * SHM_K + KSWZ(r32, (dd * 16 + hi * 8) * 2);
#pragma unroll
    for (int d0 = 0; d0 < 8; ++d0) { const char* a = kb[d0 & 3] + (d0 >> 2) * 128;
        bf16x8 b0 = *reinterpret_cast<const bf16x8*>(a);
        bf16x8 b1 = *reinterpret_cast<const bf16x8*>(a + 32 * 256);
        p0 = __builtin_amdgcn_mfma_f32_32x32x16_bf16(b0, qr[d0], p0, 0, 0, 0);
        p1 = __builtin_amdgcn_mfma_f32_32x32x16_bf16(b1, qr[d0], p1, 0, 0, 0); }
}
template <int VB>
__device__ __forceinline__ void pv_tile(f32x16* o, int vb0, bf16x8 pa0, bf16x8 pa1, bf16x8 pa2, bf16x8 pa3) {
#define TRRD(dst, off) asm volatile("ds_read_b64_tr_b16 %0, %1 offset:%2" : "=&v"(dst) : "v"(vb0), "i"(off) : "memory")
#define PV_D0(d0) do { s16x4 l0, l1, l2, l3, h0, h1, h2, h3; constexpr int b_ = VB * SHM_V + v_rd_off(d0, 0, 0);     \
        TRRD(l0, b_); TRRD(h0, b_ + 2048); TRRD(l1, b_ + 4096); TRRD(h1, b_ + 6144); TRRD(l2, b_ + 8192); TRRD(h2, b_ + 10240); TRRD(l3, b_ + 12288); TRRD(h3, b_ + 14336); \
        asm volatile("s_waitcnt lgkmcnt(0)" ::: "memory"); SBAR();                 \
        o[d0] = __builtin_amdgcn_mfma_f32_32x32x16_bf16(pa0, (bf16x8){l0[0], l0[1], l0[2], l0[3], h0[0], h0[1], h0[2], h0[3]}, o[d0], 0, 0, 0);   \
        o[d0] = __builtin_amdgcn_mfma_f32_32x32x16_bf16(pa1, (bf16x8){l1[0], l1[1], l1[2], l1[3], h1[0], h1[1], h1[2], h1[3]}, o[d0], 0, 0, 0);   \
        o[d0] = __builtin_amdgcn_mfma_f32_32x32x16_bf16(pa2, (bf16x8){l2[0], l2[1], l2[2], l2[3], h2[0], h2[1], h2[2], h2[3]}, o[d0], 0, 0, 0);   \
        o[d0] = __builtin_amdgcn_mfma_f32_32x32x16_bf16(pa3, (bf16x8){l3[0], l3[1], l3[2], l3[3], h3[0], h3[1], h3[2], h3[3]}, o[d0], 0, 0, 0); } while (0)
    PV_D0(0); PV_D0(1); PV_D0(2); PV_D0(3);
#undef PV_D0
#undef TRRD
}

struct BlockRef { const bf16* Q; const bf16* K; const bf16* V; bf16* O; const bf16* G; const float* CB; int P0, skv, qp, kp, jlo; };
struct Seam { bf16x8 qr[8]; bf16x8 st_v0, st_v1, st_k0, st_k1; float cb0, cb1; };
#define ROWP(p, k0, rr, pitch) ((p) + (size_t)(k0) * (pitch) + (unsigned)((rr) * (pitch) + sc))
#define VMW() asm volatile("s_waitcnt vmcnt(0)" ::: "memory")
#define VMWN(n) asm volatile("s_waitcnt vmcnt(%0)" :: "i"(n) : "memory")
#define SLOAD_H(Kp, Vp, Cp, k0, pitch) do { S.st_v0 = load8(ROWP(Vp, k0, sr, pitch)); S.st_v1 = load8(ROWP(Vp, k0, 32 + sr, pitch));              \
                         S.st_k0 = load8(ROWP(Kp, k0, sr, pitch)); S.st_k1 = load8(ROWP(Kp, k0, 32 + sr, pitch));                                    \
                         S.cb0 = (Cp) ? (Cp)[(k0) + r32] : 0.f; S.cb1 = (Cp) ? (Cp)[(k0) + 32 + r32] : 0.f; } while (0)
#define SWRITE_HK(bf) do { *(bf16x8*)(K_lds + (bf) * SHM_K + kws) = S.st_k0; *(bf16x8*)(K_lds + (bf) * SHM_K + kws + 32 * 256) = S.st_k1; } while (0)
#define SWRITE_HV(bf) do { *(bf16x8*)(V_lds + (bf) * SHM_V + vst0) = S.st_v0; *(bf16x8*)(V_lds + (bf) * SHM_V + vst1) = S.st_v1; } while (0)
#define SWRITE_H(bf) do { SWRITE_HV(bf); SWRITE_HK(bf); } while (0)
__device__ __forceinline__ void attn_prime(const BlockRef& cur, char* lds, Seam& S, const int wave_in) {
    const int tid = wave_in * 64 + lane_id_v(), wid = wave_in, lane = tid & 63, r32 = lane & 31, hi = lane >> 5;
    const int sr = tid >> 4, sc = (tid & 15) * 8, kws = KSWZ(sr, sc * 2); char* K_lds = lds + 2 * SHM_V;
#pragma unroll
    for (int d0 = 0; d0 < 8; ++d0) S.qr[d0] = load8(cur.Q + (size_t)(wid * QBLK + r32) * cur.qp + d0 * 16 + hi * 8);
    SLOAD_H(cur.K, cur.V, cur.CB, cur.jlo * KVBLK, cur.kp); VMW(); SWRITE_HK(0);
    __syncthreads();
}
__device__ __forceinline__ void attn_block(const BlockRef& cur, const BlockRef& nxt, char* lds, Seam& S, const int wave_in) {
    const int tid = wave_in * 64 + lane_id_v(), wid = wave_in, lane = tid & 63, r32 = lane & 31, hi = lane >> 5;
    constexpr int W = 1 << 30;
    int j_hi = (cur.P0 + QB - 1) / KVBLK + 1; if (j_hi > cur.skv / KVBLK) j_hi = cur.skv / KVBLK;
    const int j_lo = cur.jlo; const int NT = j_hi - j_lo;
    const int qlo = cur.P0 + wid * QBLK, qm = qlo + r32 - 4 * hi;
    char* V_lds = lds; char* K_lds = lds + 2 * SHM_V;
    float* ws = (float*)(lds + 2 * SHM_V + 2 * SHM_K) + wid * 64; float* li_l = ws, * al_l = ws + 32;
    float m_reg = -1e30f, l_reg = 0; f32x16 o[4] = {};
    const int sr = tid >> 4, sc = (tid & 15) * 8, vst0 = v_st(sr, sc), vst1 = v_st(32 + sr, sc), kws = KSWZ(sr, sc * 2);
    const int vb0 = (int)(uintptr_t)V_lds + v_rd_base(lane);
    const bf16* Kh = cur.K; const bf16* Vh = cur.V; const float* Ch = cur.CB; const int KP = cur.kp;
#define QX() ones_frag(hi_opaque())
#define RESC(a) do { if (__any((a) < 1.f)) { if (hi == 0) al_l[r32] = (a); asm volatile("s_waitcnt lgkmcnt(0)" ::: "memory");              \
                     for (int d_ = 0; d_ < 4; ++d_) for (int r = 0; r < 16; ++r) o[d_][r] *= al_l[crow(r, hi)]; } } while (0)
#define KBASE(t) ((j_lo + (t)) * KVBLK)
#define MASKT(P0_, P1_, t) do { const int kb_ = KBASE(t); if (kb_ + KVBLK - 1 > qlo) mask_tile(P0_, P1_, qm - kb_, (unsigned)W); } while (0)
#define SEAM_K0() do { VMWN(8); SWRITE_HK(0); SBAR(); } while (0)
    f32x16 pA0, pA1, pB0, pB1; float mnA, mnB, alA, alB; bf16x8 pa0, pa1, pa2, pa3; bf16x8 kx0, kx1;
    SWRITE_HV(0); SBAR();
    kx0 = cb_frag(S.cb0, hi); kx1 = cb_frag(S.cb1, hi);
    if (NT > 1) SLOAD_H(Kh, Vh, Ch, KBASE(1), KP);
    SBAR(); qkt<0>(pA0, pA1, K_lds, r32, hi, S.qr, kx0, kx1, QX());
    MASKT(pA0, pA1, 0); partialSM(pA0, pA1, m_reg, mnA, alA);
    if (NT > 1) { VMW(); SWRITE_H(1); }
    __syncthreads();
#define HALF_STEP(PX0, PX1, mnX, alX, PY0, PY1, alY, t, KB, VB, SB) do {                                                      \
        SBAR(); kx0 = cb_frag(S.cb0, hi); kx1 = cb_frag(S.cb1, hi);                                                           \
        qkt<KB>(PX0, PX1, K_lds, r32, hi, S.qr, kx0, kx1, QX());                                                                \
        finishSM(PY0, PY1, alY, l_reg, pa0, pa1, pa2, pa3); SBAR();                                                           \
        if ((t) + 1 < NT) { SLOAD_H(Kh, Vh, Ch, KBASE((t) + 1), KP); SBAR(); }                                                \
        pv_tile<VB>(o, vb0, pa0, pa1, pa2, pa3); MASKT(PX0, PX1, (t)); partialSM(PX0, PX1, m_reg, mnX, alX);                  \
        __syncthreads();                                                                                                      \
        if ((t) + 1 < NT) { VMW(); SWRITE_H(SB); }                                                                            \
        RESC(alX); __syncthreads(); } while (0)
    for (int t = 1; t + 1 < NT; t += 2) {
        HALF_STEP(pB0, pB1, mnB, alB, pA0, pA1, alA, t, 1, 0, 0);
        HALF_STEP(pA0, pA1, mnA, alA, pB0, pB1, alB, t + 1, 0, 1, 1);
    }
    const bool even = (NT & 1) == 0;
    if (even) { SBAR(); kx0 = cb_frag(S.cb0, hi); kx1 = cb_frag(S.cb1, hi); qkt<1>(pB0, pB1, K_lds, r32, hi, S.qr, kx0, kx1, QX()); SBAR(); }
    SLOAD_H(nxt.K, nxt.V, nxt.CB, nxt.jlo * KVBLK, nxt.kp); SBAR();
#pragma unroll
    for (int d0 = 0; d0 < 8; ++d0) S.qr[d0] = load8(nxt.Q + (size_t)(wid * QBLK + r32) * nxt.qp + d0 * 16 + hi * 8);
    SBAR();
    finishSM(pA0, pA1, alA, l_reg, pa0, pa1, pa2, pa3); SBAR();
    pv_tile<0>(o, vb0, pa0, pa1, pa2, pa3);
    if (even) { MASKT(pB0, pB1, NT - 1); partialSM(pB0, pB1, m_reg, mnB, alB); __syncthreads(); RESC(alB);
        finishSM(pB0, pB1, alB, l_reg, pa0, pa1, pa2, pa3); SBAR(); pv_tile<1>(o, vb0, pa0, pa1, pa2, pa3); }
    SBAR(); SEAM_K0();
    if (hi == 0) li_l[r32] = l_reg; asm volatile("s_waitcnt lgkmcnt(0)" ::: "memory");
    float rli[16];
#pragma unroll
    for (int r = 0; r < 16; ++r) rli[r] = __builtin_amdgcn_rcpf(li_l[crow(r, hi)]);
    bf16* Ow = cur.O + (size_t)(wid * QBLK) * OP;
    const bf16* Gw = cur.G ? cur.G + (size_t)(wid * QBLK) * cur.qp : nullptr; const int GP = cur.qp;
    char* stg = lds + LDS_BYTES + wid * (8 * EPI_PITCH);
    const int erow = lane >> 4, egrp = lane & 15;
    u32x4 gq[8];
    if (Gw) {
#pragma unroll
        for (int i = 0; i < 8; ++i) gq[i] = *(const u32x4*)(Gw + (size_t)(8 * (i >> 1) + 4 * (i & 1) + erow) * GP + egrp * 8); }
#pragma unroll
    for (int p = 0; p < 4; ++p) {
#pragma unroll
        for (int rr = 0; rr < 4; ++rr)
#pragma unroll
            for (int d0 = 0; d0 < 4; ++d0) *(float*)(stg + (rr + 4 * hi) * EPI_PITCH + (d0 * 32 + r32) * 4) = o[d0][4 * p + rr] * rli[4 * p + rr];
        asm volatile("s_waitcnt lgkmcnt(0)" ::: "memory");
#pragma unroll
        for (int i = 0; i < 2; ++i) { const int row = erow + 4 * i;
            f32x4 va = *(const f32x4*)(stg + row * EPI_PITCH + egrp * 32), vb = *(const f32x4*)(stg + row * EPI_PITCH + egrp * 32 + 16);
            if (Gw) { const u32x4 g = gq[2 * p + i];
#pragma unroll
                for (int j = 0; j < 4; ++j) { const unsigned gw_ = j == 0 ? g.x : j == 1 ? g.y : j == 2 ? g.z : g.w;
                    const float g0 = __uint_as_float(gw_ << 16), g1 = __uint_as_float(gw_ & 0xffff0000u);
                    const float s0 = __builtin_amdgcn_rcpf(1.0f + __builtin_amdgcn_exp2f(-1.4426950408889634f * g0)), s1 = __builtin_amdgcn_rcpf(1.0f + __builtin_amdgcn_exp2f(-1.4426950408889634f * g1));
                    if (j < 2) { va[2 * j] *= s0; va[2 * j + 1] *= s1; } else { vb[2 * j - 4] *= s0; vb[2 * j - 3] *= s1; } } }
            u32x4 w; w.x = cvtpk(va[0], va[1]); w.y = cvtpk(va[2], va[3]); w.z = cvtpk(vb[0], vb[1]); w.w = cvtpk(vb[2], vb[3]);
            *(u32x4*)(Ow + (size_t)(8 * p + row) * OP + egrp * 8) = w; }
    }
    __syncthreads();
#undef QX
#undef RESC
#undef KBASE
#undef MASKT
#undef SEAM_K0
#undef HALF_STEP
}
#undef ROWP
#undef VMW
#undef VMWN
#undef SLOAD_H
#undef SWRITE_HK
#undef SWRITE_HV
#undef SWRITE_H
#undef KSWZ
#undef SBAR
}

constexpr int NWAVES = 8;
#ifndef MK_PER_PHASE
#define MK_PER_PHASE 0
#endif
#ifndef MK_STOP_PC
#define MK_STOP_PC 1000
#endif
#ifndef REP_CVT
#define REP_CVT 1
#endif
#ifndef REP_MEMG
#define REP_MEMG 1
#endif
#ifndef REP_NORM
#define REP_NORM 1
#endif
#ifndef REP_KVG
#define REP_KVG 1
#endif
#ifndef REP_UP
#define REP_UP 1
#endif
#ifndef REP_DN
#define REP_DN 1
#endif
#ifndef REP_IN
#define REP_IN 1
#endif
#ifndef REP_PREP
#define REP_PREP 1
#endif
#ifndef REP_SCAN
#define REP_SCAN 1
#endif
#ifndef REP_ATT
#define REP_ATT 1
#endif
#ifndef REP_OUT
#define REP_OUT 1
#endif
#ifndef REP_POST
#define REP_POST 1
#endif
#ifndef REP_CUM
#define REP_CUM 1
#endif
#ifndef REP_HNFAKE
#define REP_HNFAKE 0
#endif
#ifndef UP_STAGGER_US
#define UP_STAGGER_US 0
#endif
#ifndef UP_ALIGN
#define UP_ALIGN true
#endif
#ifndef DN_STAGGER_US
#define DN_STAGGER_US 0
#endif
#ifndef GEMM_SP2
#define GEMM_SP2 true
#endif
#ifndef SEG_N
#define SEG_N 5
#endif
#ifndef SEG_LEN
#define SEG_LEN 13
#endif
#ifndef SCAN_WG
#define SCAN_WG 1
#endif
#ifndef FOX_SKIP
#define FOX_SKIP 1
#endif
#ifndef FFN_SPLIT
#define FFN_SPLIT 1
#endif
constexpr int NPH = 21 + 16 * FFN_SPLIT;

constexpr int BATCH = 8, SEQ = 4096, DM = 2048, M = BATCH * SEQ, FF = 5632, NUP = 2 * FF, DEPTH = 4;
constexpr int NA = 5376, NB = 3584, NKV = 3328, NMEMW = 4096;
constexpr int A_Q = 0, A_K = 768, A_V = 1536, A_G = 3072, A_QM = 4608, A_LR = 5120;
constexpr int B_Q = 0, B_G = 1536, B_QM = 3072;
constexpr int MEMT = 256, MROWS = BATCH * MEMT;
constexpr float EPS = 1e-6f;

constexpr size_t MiB = 1u << 20;
constexpr size_t WS_CTL = 0, CTL_ZERO_BYTES = 1 * MiB;
constexpr size_t WS_CB = 1 * MiB, WS_F = 3 * MiB, WS_ACH = 5 * MiB, WS_DSEG = 7 * MiB, WS_MEMB = 8 * MiB, WS_MKVF = 16 * MiB, WS_MK = 48 * MiB, WS_MV = 56 * MiB;
constexpr size_t WS_WUP = 64 * MiB, WS_WDN = 416 * MiB, WS_WAIN = 592 * MiB, WS_WBIN = 638 * MiB, WS_WOUT = 666 * MiB, WS_WKV = 698 * MiB, WS_WMEM = 711 * MiB;
constexpr size_t WS_HMIX = 728 * MiB, WS_ACT = 856 * MiB, WS_KDT = 1224 * MiB, WS_VT = 1272 * MiB, WS_OG = 1368 * MiB, WS_KSVS = 1224 * MiB, WS_FST = 1464 * MiB, WS_QF = 1528 * MiB, WS_XB2 = 1416 * MiB, WS_SS = 1576 * MiB, WS_END = 1580 * MiB;
constexpr size_t SS_BYTES = (size_t)13 * M * 8;
static_assert(WS_WUP + 8 * (size_t)NUP * DM * 2 <= WS_WDN && WS_WDN + 8 * (size_t)DM * FF * 2 <= WS_WAIN && WS_WAIN + 2 * (size_t)NA * DM * 2 <= WS_WBIN && WS_WBIN + 2 * (size_t)NB * DM * 2 <= WS_WOUT &&
              WS_WOUT + 4 * (size_t)DM * DM * 2 <= WS_WKV && WS_WKV + (size_t)NKV * DM * 2 <= WS_WMEM && WS_WMEM + (size_t)NMEMW * DM * 2 <= WS_HMIX && WS_HMIX + (size_t)M * DM * 2 <= WS_ACT &&
              WS_ACT + (size_t)M * NA * 2 <= WS_KDT && WS_KDT + (size_t)2048 * 192 * 64 * 2 <= WS_VT && WS_VT + (size_t)2048 * 384 * 64 * 2 <= WS_OG && WS_OG + (size_t)M * 1536 * 2 <= WS_FST && WS_FST + (size_t)384 * 7 * 24 * 64 * 16 <= WS_QF && WS_QF + (size_t)2048 * 192 * 64 * 2 <= WS_SS && WS_SS + SS_BYTES <= WS_END && WS_XB2 >= WS_KSVS + (size_t)M * 3072 * 2 && WS_XB2 + (size_t)M * DM * 2 <= WS_SS &&
              WS_KSVS + (size_t)M * 3072 * 2 <= WS_END && WS_MKVF + (size_t)MROWS * NMEMW * 4 <= WS_MK && WS_MEMB + (size_t)MROWS * DM * 2 <= WS_MKVF, "d_ws map");
constexpr int CW_TMO = 0, CW_BAR = 4096, CW_QUE = 16384  ;
constexpr int RING_BYTES = 131072, LDSCTL_OFF = RING_BYTES, MISC_OFF = LDSCTL_OFF + 320, RTAB_OFF = LDSCTL_OFF + 1024  , HNT_OFF = LDSCTL_OFF + 5120  , GAIN_OFF = LDSCTL_OFF + 13312  , LDS_BYTES = 147456;

#define GAS __attribute__((address_space(1)))
#define LAS __attribute__((address_space(3)))
typedef unsigned short bf16;
typedef unsigned v4u __attribute__((ext_vector_type(4)));
typedef float f32x4 __attribute__((ext_vector_type(4)));
typedef float f32x16 __attribute__((ext_vector_type(16)));
typedef short bf16x8 __attribute__((ext_vector_type(8)));
typedef GAS unsigned gu32;
#define RLX_AGENT __ATOMIC_RELAXED, __HIP_MEMORY_SCOPE_AGENT
#define LDS_WAIT() asm volatile("s_waitcnt lgkmcnt(0)" ::: "memory")
using pg8::pkbf;
__device__ __forceinline__ float bf_lo(unsigned w) { return __uint_as_float(w << 16); }
__device__ __forceinline__ float bf_hi(unsigned w) { return __uint_as_float(w & 0xffff0000u); }
__device__ __forceinline__ float bf2f(bf16 b) { return __uint_as_float(((unsigned)b) << 16); }
__device__ __forceinline__ float logsig(float x) { return fminf(x, 0.f) - __logf(1.0f + __expf(-fabsf(x))); }
#define XCH1(v)  __uint_as_float((unsigned)__builtin_amdgcn_update_dpp(0, (int)__float_as_uint(v), 0xB1, 0xF, 0xF, true))
#define XCH2(v)  __uint_as_float((unsigned)__builtin_amdgcn_update_dpp(0, (int)__float_as_uint(v), 0x4E, 0xF, 0xF, true))
#define XCH4(v)  __uint_as_float((unsigned)__builtin_amdgcn_ds_swizzle((int)__float_as_uint(v), (4 << 10) | 0x1f))
#define XCH8(v)  __uint_as_float((unsigned)__builtin_amdgcn_ds_swizzle((int)__float_as_uint(v), (8 << 10) | 0x1f))
#define XCH16(v) __uint_as_float((unsigned)__builtin_amdgcn_ds_swizzle((int)__float_as_uint(v), (16 << 10) | 0x1f))
__device__ __forceinline__ float wave_sum(float v) {
    v += XCH1(v); v += XCH2(v); v += XCH4(v); v += XCH8(v); v += XCH16(v);
    const auto rr = __builtin_amdgcn_permlane32_swap(__float_as_uint(v), __float_as_uint(v), false, false);
    return __uint_as_float(rr[0]) + __uint_as_float(rr[1]);
}
__device__ __forceinline__ float wave_max(float v) {
    v = fmaxf(v, XCH1(v)); v = fmaxf(v, XCH2(v)); v = fmaxf(v, XCH4(v)); v = fmaxf(v, XCH8(v)); v = fmaxf(v, XCH16(v));
    const auto rr = __builtin_amdgcn_permlane32_swap(__float_as_uint(v), __float_as_uint(v), false, false);
    return fmaxf(__uint_as_float(rr[0]), __uint_as_float(rr[1]));
}
__device__ __forceinline__ int launder_s(int v) { asm volatile("" : "+s"(v)); return v; }

#define XB_TMO      128
#define XB_XCNT(j)  (256  + 64 * (j))
#define XB_XSUB(j)  (1280 + 64 * (j))
#define XB_XGEN(j)  (2304 + 64 * (j))
#define XB_TOP      3328
#define XB_TOPGEN   3392
#define XCD_BAR_WORDS 3456
#define XB_SPIN_CAP (1u << 18)
__device__ __forceinline__ unsigned xb_ld(unsigned* p)              { return __hip_atomic_load(p, __ATOMIC_RELAXED, __HIP_MEMORY_SCOPE_AGENT); }
__device__ __forceinline__ unsigned xb_add(unsigned* p, unsigned v) { return __hip_atomic_fetch_add(p, v, __ATOMIC_RELAXED, __HIP_MEMORY_SCOPE_AGENT); }
__device__ __forceinline__ unsigned xb_xcc_id() { return (unsigned)__builtin_amdgcn_s_getreg((3 << 11) | 20) & 0xFu; }
#define XB_SPIN(cond, bar) do { unsigned _sp = 0; while (cond) { __builtin_amdgcn_s_sleep(1); \
    if ((++_sp & 255u) == 0u) { if (xb_ld(&(bar)[XB_TMO])) break; if (_sp > XB_SPIN_CAP) { atomicAdd(&(bar)[XB_TMO], 1u); break; } } } } while (0)
struct XcdBarrier { unsigned* bar; unsigned x; volatile LAS unsigned* st; int wave; };
__device__ __forceinline__ XcdBarrier xcd_barrier_post(unsigned* bar, volatile LAS unsigned* st, int wave) {
    XcdBarrier b; b.bar = bar; b.x = xb_xcc_id(); b.st = st; b.wave = wave;
    if (threadIdx.x == 0) (void)xb_add(&bar[XB_XCNT(b.x)], 1u);
    return b;
}
__device__ __forceinline__ void xcd_barrier_complete(unsigned* bar, unsigned x, unsigned& nloc, unsigned& nx) {
    const unsigned G = gridDim.x * gridDim.y * gridDim.z;
    unsigned sum, cnt, mine, sp = 0u;
    for (;;) {
        sum = 0u; cnt = 0u; mine = 0u;
#pragma unroll
        for (unsigned j = 0; j < 16; ++j) { const unsigned c = xb_ld(&bar[XB_XCNT(j)]); sum += c; cnt += (c > 0u) ? 1u : 0u; mine = (j == x) ? c : mine; }
        if (sum == G) break;
        __builtin_amdgcn_s_sleep(1);
        if ((++sp & 255u) == 0u) { if (xb_ld(&bar[XB_TMO])) break; if (sp > XB_SPIN_CAP) { atomicAdd(&bar[XB_TMO], 1u); break; } }
    }
    nloc = mine > 0u ? mine : 1u; nx = cnt > 0u ? cnt : 1u;
}
__device__ __forceinline__ void xcd_barrier(const XcdBarrier& b) {
    asm volatile("s_waitcnt vmcnt(0)" ::: "memory");
    __syncthreads();
    if (b.wave == 0 && lane_id_v() == 0) {
        unsigned* bar = b.bar;
        __builtin_amdgcn_s_waitcnt(0);
        unsigned nloc = b.st[0], nx = b.st[1];
        if (nloc == 0u) { xcd_barrier_complete(bar, b.x, nloc, nx); b.st[0] = nloc; b.st[1] = nx; }
        const unsigned old = xb_add(&bar[XB_XSUB(b.x)], 1u);
        const unsigned gen = old / nloc;
        if (old + 1u == (gen + 1u) * nloc) {
            __builtin_amdgcn_fence(__ATOMIC_RELEASE, "agent");
            asm volatile("s_waitcnt vmcnt(0)" ::: "memory");
            const unsigned og = xb_add(&bar[XB_TOP], 1u);
            const unsigned tg = og / nx;
            if (og + 1u == (tg + 1u) * nx) xb_add(&bar[XB_TOPGEN], 1u);
            else XB_SPIN(xb_ld(&bar[XB_TOPGEN]) == tg, bar);
            __builtin_amdgcn_fence(__ATOMIC_ACQUIRE, "agent");
            xb_add(&bar[XB_XGEN(b.x)], 1u);
            asm volatile("s_waitcnt vmcnt(0)" ::: "memory");
        } else {
            XB_SPIN(xb_ld(&bar[XB_XGEN(b.x)]) == gen, bar);
            __builtin_amdgcn_fence(__ATOMIC_ACQUIRE, "agent");
            asm volatile("s_waitcnt vmcnt(0)" ::: "memory");
        }
    }
    __syncthreads();
}

__device__ __forceinline__ const float* ldp(volatile LAS unsigned* T, int k) { const unsigned lo = __builtin_amdgcn_readfirstlane(T[2 * k]), hi = __builtin_amdgcn_readfirstlane(T[2 * k + 1]); return (const float*)(const GAS float*)(((unsigned long long)hi << 32) | lo); }
__device__ __forceinline__ int launder(int v) { asm volatile("" : "+v"(v)); return v; }
__device__ __forceinline__ int lane_id() { return lane_id_v(); }
__device__ __forceinline__ void cvt_item(const float* W, int ldw, int srccol, const float* gain, float scale, bf16* Bt, int K, int dstrow, int k0, LAS float* scr, int lane) {
    float v[32], g[32];
    const float* src = W + (size_t)(k0 + (lane >> 5)) * ldw + srccol + (lane & 31);
#pragma unroll
    for (int i = 0; i < 32; ++i) v[i] = src[(size_t)(2 * i) * ldw];
#pragma unroll
    for (int i = 0; i < 32; ++i) g[i] = gain ? gain[k0 + 2 * i + (lane >> 5)] * scale : scale;
#pragma unroll
    for (int i = 0; i < 32; ++i) scr[(2 * i + (lane >> 5)) * 33 + (lane & 31)] = v[i] * g[i];
    LDS_WAIT();
    const int c = lane & 7;
#pragma unroll
    for (int j = 0; j < 4; ++j) { const int n = (lane >> 3) + 8 * j; const LAS float* s = scr + (8 * c) * 33 + n;
        v4u o; o.x = pkbf(s[0 * 33], s[1 * 33]); o.y = pkbf(s[2 * 33], s[3 * 33]); o.z = pkbf(s[4 * 33], s[5 * 33]); o.w = pkbf(s[6 * 33], s[7 * 33]);
        *(v4u*)(Bt + (size_t)(dstrow + n) * K + k0 + 8 * c) = o; }
    LDS_WAIT();
}
__device__ __forceinline__ void rms_row_to_bf16(const float* xrow, bf16* orow, int lane) {
    const f32x4* xr = (const f32x4*)xrow + lane;
    f32x4 v[8]; float s = 0.f;
#pragma unroll
    for (int j = 0; j < 8; ++j) { v[j] = xr[64 * j]; s += (v[j].x * v[j].x + v[j].y * v[j].y) + (v[j].z * v[j].z + v[j].w * v[j].w); }
    const float rinv = 1.0f / sqrtf(wave_sum(s) * (1.0f / DM) + EPS);
    unsigned long long* o8 = (unsigned long long*)orow + lane;
#pragma unroll
    for (int j = 0; j < 8; ++j) o8[64 * j] = (unsigned long long)pkbf(v[j].x * rinv, v[j].y * rinv) | ((unsigned long long)pkbf(v[j].z * rinv, v[j].w * rinv) << 32);
}
__device__ __forceinline__ void xb_row(const float* xrow, bf16* orow, float* ssrow, int lane) {
    const f32x4* xr = (const f32x4*)xrow + lane;
    f32x4 v[8]; float s = 0.f;
#pragma unroll
    for (int j = 0; j < 8; ++j) { v[j] = xr[64 * j]; s += (v[j].x * v[j].x + v[j].y * v[j].y) + (v[j].z * v[j].z + v[j].w * v[j].w); }
    s = wave_sum(s);
    if (lane == 0) *(unsigned long long*)ssrow = (unsigned long long)(s * 16777216.0f);
    unsigned long long* o8 = (unsigned long long*)orow + lane;
#pragma unroll
    for (int j = 0; j < 8; ++j) o8[64 * j] = (unsigned long long)pkbf(v[j].x, v[j].y) | ((unsigned long long)pkbf(v[j].z, v[j].w) << 32);
}
__device__ __forceinline__ void load_gains(LAS unsigned char* lds, const float* g0, const float* g1, int wave, int lane) {
    LAS float* G = (LAS float*)(lds + GAIN_OFF);
    if (wave < 2) { G[wave * 64 + lane] = g0[wave * 64 + lane]; G[128 + wave * 64 + lane] = g1[wave * 64 + lane]; }
    __syncthreads();
}
struct InPtrs { const float *x, *mem, *ffn_norm, *w1, *w3, *w2, *mix_norm, *mem_norm, *w_mem_kv, *mem_q_norm, *mem_k_norm, *w_out, *a_w_in, *a_w_gate_up, *a_b_gate, *a_out_norm, *b_w_in, *b_q_norm, *kv_norm, *w_kv, *b_f, *k_norm; };

__device__ __forceinline__ void convert_phase(volatile LAS unsigned* PT, unsigned char* ws, float* xout, LAS unsigned char* lds, int gw, int NGW, int lane, int wave) {
    InPtrs I;
    I.x = ldp(PT, 0); I.mem = ldp(PT, 1); I.ffn_norm = ldp(PT, 2); I.w1 = ldp(PT, 3); I.w3 = ldp(PT, 4); I.w2 = ldp(PT, 5); I.mix_norm = ldp(PT, 6); I.mem_norm = ldp(PT, 7);
    I.w_mem_kv = ldp(PT, 8); I.mem_q_norm = ldp(PT, 9); I.mem_k_norm = ldp(PT, 10); I.w_out = ldp(PT, 11); I.a_w_in = ldp(PT, 12); I.a_w_gate_up = ldp(PT, 13); I.a_b_gate = ldp(PT, 14);
    I.a_out_norm = ldp(PT, 15); I.b_w_in = ldp(PT, 16); I.b_q_norm = ldp(PT, 17); I.kv_norm = ldp(PT, 18); I.w_kv = ldp(PT, 19); I.b_f = ldp(PT, 20); I.k_norm = ldp(PT, 21);
    LAS float* scr = (LAS float*)(lds + wave * 16384);
    bf16* WUP = (bf16*)(ws + WS_WUP); bf16* WDN = (bf16*)(ws + WS_WDN); bf16* WAIN = (bf16*)(ws + WS_WAIN); bf16* WBIN = (bf16*)(ws + WS_WBIN);
    bf16* WOUT = (bf16*)(ws + WS_WOUT); bf16* WKV = (bf16*)(ws + WS_WKV); bf16* WMEM = (bf16*)(ws + WS_WMEM);
    constexpr int IT_W1 = 8 * 32 * 176, IT_W2 = 8 * 88 * 64, IT_A = 2 * 32 * 160, IT_B = 2 * 32 * 112, IT_O = 4 * 32 * 64, IT_KV = 32 * 96, IT_MEM = 4 * 32 * 32;
    constexpr int IT_TOTAL = 2 * IT_W1 + IT_W2 + IT_A + IT_B + IT_O + IT_KV + IT_MEM;
    for (int it = gw; it < IT_TOTAL; it += NGW) {
        int r = it;
        if (r < 2 * IT_W1) { const int which = r / IT_W1; r -= which * IT_W1; const int mat = r / (32 * 176); r -= mat * (32 * 176); const int kb = r / 176, nb = r % 176; const int j0 = 32 * nb;
            cvt_item((which ? I.w3 : I.w1) + (size_t)mat * DM * FF, FF, j0, I.ffn_norm + mat * DM, 1.f, WUP + (size_t)mat * NUP * DM, DM, 256 * (j0 / 128) + which * 128 + (j0 % 128), 64 * kb, scr, lane); continue; }
        r -= 2 * IT_W1;
        if (r < IT_W2) { const int mat = r / (88 * 64); r -= mat * (88 * 64); const int kb = r / 64, nb = r % 64;
            cvt_item(I.w2 + (size_t)mat * FF * DM, DM, 32 * nb, nullptr, 1.f, WDN + (size_t)mat * DM * FF, FF, 32 * nb, 64 * kb, scr, lane); continue; }
        r -= IT_W2;
        if (r < IT_A) { const int l = r / (32 * 160); r -= l * (32 * 160); const int kb = r / 160, nb = r % 160; const int n0 = 32 * nb;
            cvt_item(I.a_w_in + (size_t)l * DM * 5136, 5136, n0 < 3072 ? n0 : n0 + 16, I.mix_norm + l * DM, n0 < 768 ? 0.07216878364870322f : 1.f, WAIN + (size_t)l * NA * DM, DM, n0, 64 * kb, scr, lane); continue; }
        r -= IT_A;
        if (r < IT_B) { const int j = r / (32 * 112); r -= j * (32 * 112); const int kb = r / 112, nb = r % 112;
            cvt_item(I.b_w_in + (size_t)j * DM * NB, NB, 32 * nb, I.mix_norm + (2 + j) * DM, 1.f, WBIN + (size_t)j * NB * DM, DM, 32 * nb, 64 * kb, scr, lane); continue; }
        r -= IT_B;
        if (r < IT_O) { const int l = r / (32 * 64); r -= l * (32 * 64); const int kb = r / 64, nb = r % 64;
            cvt_item(I.w_out + (size_t)l * DM * DM, DM, 32 * nb, nullptr, 1.f, WOUT + (size_t)l * DM * DM, DM, 32 * nb, 64 * kb, scr, lane); continue; }
        r -= IT_O;
        if (r < IT_KV) { const int kb = r / 96, nb = r % 96;
            cvt_item(I.w_kv, 3084, 32 * nb, I.kv_norm, 1.f, WKV, DM, 32 * nb, 64 * kb, scr, lane); continue; }
        r -= IT_KV;
        { const int l = r / (32 * 32); r -= l * (32 * 32); const int kb = r / 32, nb = r % 32;
            cvt_item(I.w_mem_kv + (size_t)l * DM * 1024, 1024, 32 * nb, I.mem_norm + l * DM, 1.f, WMEM, DM, l * 1024 + 32 * nb, 64 * kb, scr, lane); }
    }
    const int gtid = gw * 64 + lane, NT = NGW * 64;
    for (int idx = gtid; idx < 2 * 256 * 256; idx += NT) { const int l = idx >> 16, n = (idx >> 8) & 255, k0 = (idx & 255) * 8;
        float a[8];
#pragma unroll
        for (int j = 0; j < 8; ++j) a[j] = (n < 16) ? I.a_w_in[(size_t)l * DM * 5136 + (size_t)(k0 + j) * 5136 + 3072 + n] * I.mix_norm[l * DM + k0 + j] : 0.f;
        v4u o; o.x = pkbf(a[0], a[1]); o.y = pkbf(a[2], a[3]); o.z = pkbf(a[4], a[5]); o.w = pkbf(a[6], a[7]);
        *(v4u*)(WAIN + (size_t)l * NA * DM + (size_t)(A_LR + n) * DM + k0) = o; }
    for (int idx = gtid; idx < 256 * 256; idx += NT) { const int n = idx >> 8, k0 = (idx & 255) * 8;
        float a[8];
#pragma unroll
        for (int j = 0; j < 8; ++j) a[j] = (n < 12) ? I.w_kv[(size_t)(k0 + j) * 3084 + 3072 + n] * I.kv_norm[k0 + j] : 0.f;
        v4u o; o.x = pkbf(a[0], a[1]); o.y = pkbf(a[2], a[3]); o.z = pkbf(a[4], a[5]); o.w = pkbf(a[6], a[7]);
        *(v4u*)(WKV + (size_t)(3072 + n) * DM + k0) = o; }
    for (int m = gw; m < MROWS; m += NGW) rms_row_to_bf16(I.mem + (size_t)m * DM, (bf16*)(ws + WS_MEMB) + (size_t)m * DM, lane);
    for (int m = gw; m < M; m += NGW) xb_row(I.x + (size_t)m * DM, (bf16*)xout + (size_t)m * DM, (float*)(ws + WS_SS) + 2 * (size_t)m, lane);
}
__device__ __forceinline__ void hn_pass(bf16* buf, int pitch, int col0, int nheads, const float* gain, int gw, int NGW, int lane) {
    const int l16 = lane & 15; const int ntask4 = M * nheads / 4;
    f32x4 g0 = *(const f32x4*)(gain + 8 * l16), g1 = *(const f32x4*)(gain + 8 * l16 + 4);
    for (int t4 = gw; t4 < ntask4; t4 += NGW) { const int t = t4 * 4 + (lane >> 4); const int row = t / nheads, hh = t - row * nheads;
        bf16* p = buf + (size_t)row * pitch + col0 + hh * 128 + 8 * l16;
        const v4u w = *(const v4u*)p;
        float x[8] = {bf_lo(w.x), bf_hi(w.x), bf_lo(w.y), bf_hi(w.y), bf_lo(w.z), bf_hi(w.z), bf_lo(w.w), bf_hi(w.w)};
        float ss = 0.f;
#pragma unroll
        for (int e = 0; e < 8; ++e) ss += x[e] * x[e];
        ss += XCH1(ss); ss += XCH2(ss); ss += XCH4(ss); ss += XCH8(ss);
        const float rinv = 1.0f / sqrtf(ss * (1.0f / 128.f) + EPS);
        v4u o; o.x = pkbf(x[0] * rinv * g0[0], x[1] * rinv * g0[1]); o.y = pkbf(x[2] * rinv * g0[2], x[3] * rinv * g0[3]);
        o.z = pkbf(x[4] * rinv * g1[0], x[5] * rinv * g1[1]); o.w = pkbf(x[6] * rinv * g1[2], x[7] * rinv * g1[3]);
        *(v4u*)p = o; }
}
__device__ __forceinline__ void mkmv_pass(const float* MKVF, bf16* MK, bf16* MV, const float* mem_k_norm, int gw, int NGW, int lane) {
    const int l16 = lane & 15;
    for (int t4 = gw; t4 < MROWS * 32 / 4; t4 += NGW) { const int t = t4 * 4 + (lane >> 4); const int row = t >> 5, rem = t & 31; const int l = rem >> 3, kv = (rem >> 2) & 1, hh = rem & 3;
        const float* src = MKVF + (size_t)row * NMEMW + l * 1024 + kv * 512 + hh * 128 + 8 * l16;
        const f32x4 a = *(const f32x4*)src, b = *(const f32x4*)(src + 4);
        float ss = (a.x * a.x + a.y * a.y) + (a.z * a.z + a.w * a.w) + (b.x * b.x + b.y * b.y) + (b.z * b.z + b.w * b.w);
        ss += XCH1(ss); ss += XCH2(ss); ss += XCH4(ss); ss += XCH8(ss);
        const float rinv = kv ? 1.0f : 1.0f / sqrtf(ss * (1.0f / 128.f) + EPS);
        f32x4 g0 = {1.f, 1.f, 1.f, 1.f}, g1 = {1.f, 1.f, 1.f, 1.f};
        if (!kv) { g0 = *(const f32x4*)(mem_k_norm + l * 128 + 8 * l16); g1 = *(const f32x4*)(mem_k_norm + l * 128 + 8 * l16 + 4); }
        v4u o; o.x = pkbf(a.x * rinv * g0[0], a.y * rinv * g0[1]); o.y = pkbf(a.z * rinv * g0[2], a.w * rinv * g0[3]);
        o.z = pkbf(b.x * rinv * g1[0], b.y * rinv * g1[1]); o.w = pkbf(b.z * rinv * g1[2], b.w * rinv * g1[3]);
        *(v4u*)((kv ? MV : MK) + ((size_t)l * MROWS + row) * 512 + hh * 128 + 8 * l16) = o; }
}
__device__ __forceinline__ void gla_prep(const bf16* PROJ, const float* b_gate  , const float* w_up  , bf16* KDT, bf16* VT, bf16* QF, float* ACH, int gw, int NGW, int lane) {
    const int r = lane & 31, hi = lane >> 5;
    for (int t = gw; t < 2048; t += NGW) {
        const int b = t >> 8, c = (t >> 2) & 63, h = t & 3; const int ci = (b * 4 + h) * 64 + c;
        const bf16* P = PROJ + ((size_t)b * SEQ + c * 64) * NA;
        if (lane < 48) { const int d0 = 4 * lane;
            const f32x4 bias = *(const f32x4*)(b_gate + h * 192 + d0);
            const bf16* plr = P + A_LR; const bf16* pk = P + A_K + h * 192 + d0;
            f32x4 wg[16];
#pragma unroll
            for (int rr = 0; rr < 16; ++rr) wg[rr] = *(const f32x4*)(w_up + rr * 768 + h * 192 + d0);
#define GATE4(gp, j) do { const v4u L0 = *(const v4u*)(plr + (size_t)(j) * NA), L1 = *(const v4u*)(plr + (size_t)(j) * NA + 8); gp = bias;  \
                gp = gp + wg[0] * bf_lo(L0.x) + wg[1] * bf_hi(L0.x) + wg[2] * bf_lo(L0.y) + wg[3] * bf_hi(L0.y) + wg[4] * bf_lo(L0.z) + wg[5] * bf_hi(L0.z) + wg[6] * bf_lo(L0.w) + wg[7] * bf_hi(L0.w);  \
                gp = gp + wg[8] * bf_lo(L1.x) + wg[9] * bf_hi(L1.x) + wg[10] * bf_lo(L1.y) + wg[11] * bf_hi(L1.y) + wg[12] * bf_lo(L1.z) + wg[13] * bf_hi(L1.z) + wg[14] * bf_lo(L1.w) + wg[15] * bf_hi(L1.w); } while (0)
            bf16* dst = KDT + ((size_t)(ci * 6 + (d0 >> 5)) * 4 * 64 + (d0 & 31)) * 8;
            f32x4 suf = {0.f, 0.f, 0.f, 0.f};
#pragma unroll
            for (int jj = 0; jj < 8; ++jj) { const int j8 = 7 - jj; float kd[4][8];
#pragma unroll
                for (int ee = 0; ee < 8; ++ee) { const int e8 = 7 - ee; const int j = 8 * j8 + e8; const uint2 kw = *(const uint2*)(pk + (size_t)j * NA); f32x4 gp; GATE4(gp, j);
                    kd[0][e8] = bf_lo(kw.x) * __expf(suf[0]); kd[1][e8] = bf_hi(kw.x) * __expf(suf[1]); kd[2][e8] = bf_lo(kw.y) * __expf(suf[2]); kd[3][e8] = bf_hi(kw.y) * __expf(suf[3]);
                    suf[0] += logsig(gp[0]) * (1.0f / 16.0f); suf[1] += logsig(gp[1]) * (1.0f / 16.0f); suf[2] += logsig(gp[2]) * (1.0f / 16.0f); suf[3] += logsig(gp[3]) * (1.0f / 16.0f); }
#pragma unroll
                for (int e = 0; e < 4; ++e) { v4u o; o.x = pkbf(kd[e][0], kd[e][1]); o.y = pkbf(kd[e][2], kd[e][3]); o.z = pkbf(kd[e][4], kd[e][5]); o.w = pkbf(kd[e][6], kd[e][7]);
                    *(v4u*)(dst + ((size_t)((j8 >> 1) * 64 + (j8 & 1) * 32 + e)) * 8) = o; } }
            *(f32x4*)(ACH + ci * 192 + d0) = (f32x4){__expf(suf[0]), __expf(suf[1]), __expf(suf[2]), __expf(suf[3])};
#undef GATE4
            }
        if (lane < 48) { const int dv0 = 8 * lane; const bf16* pv = P + A_V + h * 384 + dv0;
            bf16* dst = VT + ((size_t)(ci * 12 + (dv0 >> 5)) * 4 * 64 + (dv0 & 31)) * 8;
#pragma unroll
            for (int j8 = 0; j8 < 8; ++j8) { v4u w[8];
#pragma unroll
                for (int e8 = 0; e8 < 8; ++e8) w[e8] = *(const v4u*)(pv + (size_t)(8 * j8 + e8) * NA);
#pragma unroll
                for (int e = 0; e < 8; ++e) { v4u o;
#define VSEL(k) ((e & 1) ? (((e >> 1) == 0 ? w[k].x : (e >> 1) == 1 ? w[k].y : (e >> 1) == 2 ? w[k].z : w[k].w) >> 16) : (((e >> 1) == 0 ? w[k].x : (e >> 1) == 1 ? w[k].y : (e >> 1) == 2 ? w[k].z : w[k].w) & 0xffffu))
                    o.x = VSEL(0) | (VSEL(1) << 16); o.y = VSEL(2) | (VSEL(3) << 16); o.z = VSEL(4) | (VSEL(5) << 16); o.w = VSEL(6) | (VSEL(7) << 16);
#undef VSEL
                    *(v4u*)(dst + ((size_t)((j8 >> 1) * 64 + (j8 & 1) * 32 + e)) * 8) = o; } } }
        { const bf16* pq = P + (size_t)r * NA + A_Q + h * 192 + 4 * hi; bf16* dst = QF + ((size_t)ci * 24 * 64 + lane) * 8;
#pragma unroll
            for (int tt = 0; tt < 2; ++tt)
#pragma unroll
                for (int mt = 0; mt < 6; ++mt)
#pragma unroll
                    for (int s2 = 0; s2 < 2; ++s2) { const bf16* p = pq + (size_t)tt * 32 * NA + 32 * mt + 16 * s2;
                        const uint2 a = *(const uint2*)p, c2 = *(const uint2*)(p + 8);
                        v4u o = {a.x, a.y, c2.x, c2.y};
                        *(v4u*)(dst + (size_t)((tt * 6 + mt) * 2 + s2) * 64 * 8) = o; } }
    }
}
__device__ __forceinline__ void gla_update(f32x16 (&S)[6], const bf16* kd, const bf16* vt, const float* ac, int lane, int hi) {
    const unsigned lo16 = (unsigned)lane * 16u;
    bf16x8 vb[4];
#pragma unroll
    for (int s = 0; s < 4; ++s) vb[s] = *(const bf16x8*)((const char*)(vt + s * 512) + lo16);
#pragma unroll
    for (int half = 0; half < 2; ++half) {
        bf16x8 ka[3][4]; f32x4 a4[3][4];
#pragma unroll
        for (int m3 = 0; m3 < 3; ++m3)
#pragma unroll
            for (int s = 0; s < 4; ++s) ka[m3][s] = *(const bf16x8*)((const char*)(kd + ((3 * half + m3) * 4 + s) * 512) + lo16);
#pragma unroll
        for (int m3 = 0; m3 < 3; ++m3)
#pragma unroll
            for (int i4 = 0; i4 < 4; ++i4) a4[m3][i4] = *(const f32x4*)((const char*)(ac + 32 * (3 * half + m3) + 8 * i4) + (unsigned)hi * 16u);
        __builtin_amdgcn_sched_barrier(0);
#pragma unroll
        for (int m3 = 0; m3 < 3; ++m3) { const int mt = 3 * half + m3;
#pragma unroll
            for (int i4 = 0; i4 < 4; ++i4)
#pragma unroll
                for (int e = 0; e < 4; ++e) S[mt][4 * i4 + e] *= a4[m3][i4][e];
#pragma unroll
            for (int s = 0; s < 4; ++s) S[mt] = __builtin_amdgcn_mfma_f32_32x32x16_bf16(ka[m3][s], vb[s], S[mt], 0, 0, 0); }
        __builtin_amdgcn_sched_barrier(0);
    }
}
__device__ __forceinline__ void gla_output(const f32x16 (&S)[6], const bf16* qf, bf16* og_u  , int lane, int r, int hi) {
    const unsigned lo16 = (unsigned)lane * 16u;
    f32x16 o0, o1;
#pragma unroll
    for (int i = 0; i < 16; ++i) { o0[i] = 0.f; o1[i] = 0.f; }
#pragma unroll
    for (int half = 0; half < 2; ++half) {
        bf16x8 qa[3][2][2];
#pragma unroll
        for (int m3 = 0; m3 < 3; ++m3)
#pragma unroll
            for (int s = 0; s < 2; ++s) { qa[m3][s][0] = *(const bf16x8*)((const char*)(qf + ((0 * 6 + 3 * half + m3) * 2 + s) * 512) + lo16); qa[m3][s][1] = *(const bf16x8*)((const char*)(qf + ((1 * 6 + 3 * half + m3) * 2 + s) * 512) + lo16); }
        __builtin_amdgcn_sched_barrier(0);
#pragma unroll
        for (int m3 = 0; m3 < 3; ++m3) { const int mt = 3 * half + m3;
#pragma unroll
            for (int s = 0; s < 2; ++s) {
                v4u xw; xw.x = pkbf(S[mt][8 * s + 0], S[mt][8 * s + 1]); xw.y = pkbf(S[mt][8 * s + 2], S[mt][8 * s + 3]); xw.z = pkbf(S[mt][8 * s + 4], S[mt][8 * s + 5]); xw.w = pkbf(S[mt][8 * s + 6], S[mt][8 * s + 7]);
                const bf16x8 xs = __builtin_bit_cast(bf16x8, xw);
                o0 = __builtin_amdgcn_mfma_f32_32x32x16_bf16(qa[m3][s][0], xs, o0, 0, 0, 0);
                o1 = __builtin_amdgcn_mfma_f32_32x32x16_bf16(qa[m3][s][1], xs, o1, 0, 0, 0); } }
        __builtin_amdgcn_sched_barrier(0);
    }
    const unsigned so = (unsigned)(4 * hi * 1536 + r) * 2u;
#pragma unroll
    for (int i = 0; i < 16; ++i) { const int rowc = (i & 3) + 8 * (i >> 2);
        const float v0 = o0[i], v1 = o1[i]; const float n0 = XCH1(v0), n1 = XCH1(v1);
        if ((r & 1) == 0) { *(unsigned*)((char*)(og_u + (size_t)rowc * 1536) + so) = pkbf(v0, n0); *(unsigned*)((char*)(og_u + (size_t)(32 + rowc) * 1536) + so) = pkbf(v1, n1); } }
}
__device__ __forceinline__ void gla_seg_states(const bf16* KDT, const bf16* VT, const float* ACH, float* FST, float* DSEG, int gw, int NGW, int lane) {
    const int r = lane & 31, hi = lane >> 5;
    static_assert(SEG_N * SEG_LEN >= 64 && (SEG_N - 1) * SEG_LEN < 64 && SEG_N <= 8, "segments must cover the 64 chunks (FST holds up to 7 segment states per unit)");
    for (int idx = gw * 64 + lane; idx < 32 * SEG_N * 192; idx += NGW * 64) { const int bh = idx / (SEG_N * 192), rem = idx - bh * (SEG_N * 192), g = rem / 192, k = rem - g * 192;
        float d = 1.f;
#pragma unroll
        for (int c = g * SEG_LEN; c < g * SEG_LEN + SEG_LEN && c < 64; ++c) d *= ACH[(size_t)(bh * 64 + c) * 192 + k];
        DSEG[idx] = d; }
    for (int t = gw; t < 384 * (SEG_N - 1); t += NGW) { const int g = t / 384, u = t - g * 384; const int bh = u / 12, n32 = u - bh * 12;
        f32x16 S[6];
#pragma unroll
        for (int mt = 0; mt < 6; ++mt)
#pragma unroll
            for (int i = 0; i < 16; ++i) S[mt][i] = 0.f;
        for (int c = g * SEG_LEN; c < g * SEG_LEN + SEG_LEN; ++c) { const int ci = bh * 64 + c;
            gla_update(S, KDT + (size_t)ci * 192 * 64, VT + ((size_t)ci * 12 + n32) * 4 * 64 * 8, ACH + (size_t)ci * 192, lane, hi); }
        f32x4* dst = (f32x4*)FST + (size_t)(u * 7 + g) * 24 * 64 + lane;
#pragma unroll
        for (int mt = 0; mt < 6; ++mt)
#pragma unroll
            for (int i4 = 0; i4 < 4; ++i4) dst[(mt * 4 + i4) * 64] = (f32x4){S[mt][4 * i4], S[mt][4 * i4 + 1], S[mt][4 * i4 + 2], S[mt][4 * i4 + 3]}; }
}
__device__ __forceinline__ void gla_seg_outputs(const bf16* QF, const bf16* KDT, const bf16* VT, const float* ACH, const float* FST, const float* DSEG, bf16* OG, int gw, int NGW, int lane) {
    const int r = lane & 31, hi = lane >> 5;
    for (int t = gw; t < 384 * SEG_N; t += NGW) { const int g = t / 384, u = t - g * 384; const int bh = u / 12, n32 = u - bh * 12, b = bh >> 2, h = bh & 3;
        f32x16 S[6];
#pragma unroll
        for (int mt = 0; mt < 6; ++mt)
#pragma unroll
            for (int i = 0; i < 16; ++i) S[mt][i] = 0.f;
        for (int gp = 0; gp < g; ++gp) {
            const float* fs = FST + (size_t)(u * 7 + gp) * 24 * 64 * 4; const float* ds = DSEG + (size_t)(bh * SEG_N + gp) * 192; const unsigned lo16 = (unsigned)lane * 16u, hi16 = (unsigned)hi * 16u;
#pragma unroll
            for (int half = 0; half < 2; ++half) { f32x4 f4[3][4], d4[3][4];
#pragma unroll
                for (int m3 = 0; m3 < 3; ++m3)
#pragma unroll
                    for (int i4 = 0; i4 < 4; ++i4) { f4[m3][i4] = *(const f32x4*)((const char*)(fs + ((3 * half + m3) * 4 + i4) * 256) + lo16); d4[m3][i4] = *(const f32x4*)((const char*)(ds + 32 * (3 * half + m3) + 8 * i4) + hi16); }
                __builtin_amdgcn_sched_barrier(0);
#pragma unroll
                for (int m3 = 0; m3 < 3; ++m3)
#pragma unroll
                    for (int i4 = 0; i4 < 4; ++i4)
#pragma unroll
                        for (int e = 0; e < 4; ++e) S[3 * half + m3][4 * i4 + e] = S[3 * half + m3][4 * i4 + e] * d4[m3][i4][e] + f4[m3][i4][e];
                __builtin_amdgcn_sched_barrier(0); } }
        for (int c = g * SEG_LEN; c < g * SEG_LEN + SEG_LEN && c < 64; ++c) { const int ci = bh * 64 + c; const size_t t0 = (size_t)b * SEQ + c * 64;
            gla_update(S, KDT + (size_t)ci * 192 * 64, VT + ((size_t)ci * 12 + n32) * 4 * 64 * 8, ACH + (size_t)ci * 192, lane, hi);
            gla_output(S, QF + (size_t)ci * 192 * 64, OG + t0 * 1536 + h * 384 + n32 * 32, lane, r, hi); }
    }
}
constexpr int SC_BUF = 50176, SC_K = 0, SC_Q = 24576, SC_A = 49152;
struct ScanStage { v4u k[3], q[3], a; };
template <bool WITHQ> __device__ __forceinline__ void scan_stage_issue(ScanStage& st, const bf16* KDT, const bf16* QF, const float* ACH, int ci, int tid) {
    const unsigned to = (unsigned)tid * 16u;
    const char* kb = (const char*)(KDT + (size_t)ci * 192 * 64);
#pragma unroll
    for (int i = 0; i < 3; ++i) st.k[i] = *(const v4u*)(kb + i * 8192 + to);
    if (WITHQ) { const char* qb = (const char*)(QF + (size_t)ci * 192 * 64);
#pragma unroll
        for (int i = 0; i < 3; ++i) st.q[i] = *(const v4u*)(qb + i * 8192 + to); }
    if (tid < 48) st.a = *(const v4u*)((const char*)(ACH + (size_t)ci * 192) + to);
}
template <bool WITHQ> __device__ __forceinline__ void scan_stage_commit(const ScanStage& st, LAS unsigned char* buf, int tid) {
    const unsigned to = (unsigned)tid * 16u;
#pragma unroll
    for (int i = 0; i < 3; ++i) *(LAS v4u*)(buf + SC_K + i * 8192 + to) = st.k[i];
    if (WITHQ) {
#pragma unroll
        for (int i = 0; i < 3; ++i) *(LAS v4u*)(buf + SC_Q + i * 8192 + to) = st.q[i]; }
    if (tid < 48) *(LAS v4u*)(buf + SC_A + to) = st.a;
}
__device__ __forceinline__ void scan_load_vb(bf16x8 (&vb)[4], const bf16* VT, int ci, int n32, int lane) {
    const bf16* vt = VT + ((size_t)ci * 12 + n32) * 4 * 64 * 8;
#pragma unroll
    for (int s = 0; s < 4; ++s) vb[s] = *(const bf16x8*)((const char*)(vt + s * 512) + (unsigned)lane * 16u);
}
__device__ __forceinline__ void gla_update_lds(f32x16 (&S)[6], LAS const unsigned char* buf, const bf16x8 (&vb)[4], int lane, int hi) {
    const unsigned lo16 = (unsigned)lane * 16u;
#pragma unroll
    for (int mt = 0; mt < 6; ++mt) {
        bf16x8 ka[4]; f32x4 a4[4];
#pragma unroll
        for (int s = 0; s < 4; ++s) ka[s] = *(LAS const bf16x8*)(buf + SC_K + (mt * 4 + s) * 1024 + lo16);
#pragma unroll
        for (int i4 = 0; i4 < 4; ++i4) a4[i4] = *(LAS const f32x4*)(buf + SC_A + (32 * mt + 8 * i4) * 4 + (unsigned)hi * 16u);
#pragma unroll
        for (int i4 = 0; i4 < 4; ++i4)
#pragma unroll
            for (int e = 0; e < 4; ++e) S[mt][4 * i4 + e] *= a4[i4][e];
#pragma unroll
        for (int s = 0; s < 4; ++s) S[mt] = __builtin_amdgcn_mfma_f32_32x32x16_bf16(ka[s], vb[s], S[mt], 0, 0, 0); }
}
__device__ __forceinline__ void gla_output_lds(const f32x16 (&S)[6], LAS const unsigned char* buf, bf16* og_u, int lane, int r, int hi) {
    const unsigned lo16 = (unsigned)lane * 16u;
    f32x16 o0, o1;
#pragma unroll
    for (int i = 0; i < 16; ++i) { o0[i] = 0.f; o1[i] = 0.f; }
#pragma unroll
    for (int mt = 0; mt < 6; ++mt) {
        bf16x8 qa[2][2];
#pragma unroll
        for (int s = 0; s < 2; ++s) { qa[s][0] = *(LAS const bf16x8*)(buf + SC_Q + ((0 * 6 + mt) * 2 + s) * 1024 + lo16); qa[s][1] = *(LAS const bf16x8*)(buf + SC_Q + ((1 * 6 + mt) * 2 + s) * 1024 + lo16); }
#pragma unroll
        for (int s = 0; s < 2; ++s) {
            v4u xw; xw.x = pkbf(S[mt][8 * s + 0], S[mt][8 * s + 1]); xw.y = pkbf(S[mt][8 * s + 2], S[mt][8 * s + 3]); xw.z = pkbf(S[mt][8 * s + 4], S[mt][8 * s + 5]); xw.w = pkbf(S[mt][8 * s + 6], S[mt][8 * s + 7]);
            const bf16x8 xs = __builtin_bit_cast(bf16x8, xw);
            o0 = __builtin_amdgcn_mfma_f32_32x32x16_bf16(qa[s][0], xs, o0, 0, 0, 0);
            o1 = __builtin_amdgcn_mfma_f32_32x32x16_bf16(qa[s][1], xs, o1, 0, 0, 0); } }
    const unsigned so = (unsigned)(4 * hi * 1536 + r) * 2u;
#pragma unroll
    for (int i = 0; i < 16; ++i) { const int rowc = (i & 3) + 8 * (i >> 2);
        const float v0 = o0[i], v1 = o1[i]; const float n0 = XCH1(v0), n1 = XCH1(v1);
        if ((r & 1) == 0) { *(unsigned*)((char*)(og_u + (size_t)rowc * 1536) + so) = pkbf(v0, n0); *(unsigned*)((char*)(og_u + (size_t)(32 + rowc) * 1536) + so) = pkbf(v1, n1); } }
}
constexpr int WSEG_N = 4, WSEG_LEN = 16;
__device__ __forceinline__ void gla_seg_states_wg(const bf16* KDT, const bf16* VT, const float* ACH, float* FST, float* DSEG, LAS unsigned char* lds, int vcu, int G, int wave, int lane, int gw, int NGW) {
    const int hi = lane >> 5, tid = wave * 64 + lane;
    for (int idx = gw * 64 + lane; idx < 32 * WSEG_N * 192; idx += NGW * 64) { const int bh = idx / (WSEG_N * 192), rem = idx - bh * (WSEG_N * 192), g = rem / 192, k = rem - g * 192;
        float d = 1.f;
        for (int c = g * WSEG_LEN; c < g * WSEG_LEN + WSEG_LEN; ++c) d *= ACH[(size_t)(bh * 64 + c) * 192 + k];
        DSEG[idx] = d; }
    for (int wt = vcu; wt < 32 * WSEG_N * 2; wt += G) { const int bh = wt / (WSEG_N * 2), rem = wt - bh * (WSEG_N * 2), g = rem >> 1, half = rem & 1;
        if (g == WSEG_N - 1) continue;
        const bool act = wave < 6; const int n32 = half * 6 + (act ? wave : 0), u = bh * 12 + n32;
        f32x16 S[6];
#pragma unroll
        for (int mt = 0; mt < 6; ++mt)
#pragma unroll
            for (int i = 0; i < 16; ++i) S[mt][i] = 0.f;
        const int c0 = g * WSEG_LEN, c1 = c0 + WSEG_LEN;
        ScanStage st; bf16x8 vb[4], vbn[4];
        scan_stage_issue<false>(st, KDT, nullptr, ACH, bh * 64 + c0, tid); if (act) scan_load_vb(vb, VT, bh * 64 + c0, n32, lane);
        scan_stage_commit<false>(st, lds, tid);
        __syncthreads();
        for (int c = c0; c < c1; ++c) { LAS unsigned char* buf = lds + ((c - c0) & 1) * SC_BUF; LAS unsigned char* nbuf = lds + (((c - c0) & 1) ^ 1) * SC_BUF; const bool more = c + 1 < c1;
            if (more) { scan_stage_issue<false>(st, KDT, nullptr, ACH, bh * 64 + c + 1, tid); if (act) scan_load_vb(vbn, VT, bh * 64 + c + 1, n32, lane); }
            if (act) gla_update_lds(S, buf, vb, lane, hi);
            if (more) { scan_stage_commit<false>(st, nbuf, tid);
#pragma unroll
                for (int s = 0; s < 4; ++s) vb[s] = vbn[s]; }
            __syncthreads(); }
        if (act) { char* dst = (char*)(FST + (size_t)(u * 7 + g) * 24 * 64 * 4); const unsigned lo16 = (unsigned)lane * 16u;
#pragma unroll
            for (int mt = 0; mt < 6; ++mt)
#pragma unroll
                for (int i4 = 0; i4 < 4; ++i4) *(f32x4*)(dst + (mt * 4 + i4) * 1024 + lo16) = (f32x4){S[mt][4 * i4], S[mt][4 * i4 + 1], S[mt][4 * i4 + 2], S[mt][4 * i4 + 3]}; }
    }
}
__device__ __forceinline__ void gla_seg_outputs_wg(const bf16* QF, const bf16* KDT, const bf16* VT, const float* ACH, const float* FST, const float* DSEG, bf16* OG, LAS unsigned char* lds, int vcu, int G, int wave, int lane) {
    const int r = lane & 31, hi = lane >> 5, tid = wave * 64 + lane;
    for (int wt = vcu; wt < 32 * WSEG_N * 2; wt += G) { const int bh = wt / (WSEG_N * 2), rem = wt - bh * (WSEG_N * 2), g = rem >> 1, half = rem & 1, b = bh >> 2, h = bh & 3;
        const bool act = wave < 6; const int n32 = half * 6 + (act ? wave : 0), u = bh * 12 + n32;
        f32x16 S[6];
#pragma unroll
        for (int mt = 0; mt < 6; ++mt)
#pragma unroll
            for (int i = 0; i < 16; ++i) S[mt][i] = 0.f;
        const int c0 = g * WSEG_LEN, c1 = c0 + WSEG_LEN;
        ScanStage st; bf16x8 vb[4], vbn[4];
        scan_stage_issue<true>(st, KDT, QF, ACH, bh * 64 + c0, tid); if (act) scan_load_vb(vb, VT, bh * 64 + c0, n32, lane);
        if (act) for (int gp = 0; gp < g; ++gp) {
            const float* fs = FST + (size_t)(u * 7 + gp) * 24 * 64 * 4; const float* ds = DSEG + (size_t)(bh * WSEG_N + gp) * 192; const int lq = launder(lane); const unsigned lo16 = (unsigned)lq * 16u, hi16 = (unsigned)(lq >> 5) * 16u;
#pragma unroll
            for (int m2 = 0; m2 < 3; ++m2) { f32x4 f4[2][4], d4[2][4];
#pragma unroll
                for (int mm = 0; mm < 2; ++mm)
#pragma unroll
                    for (int i4 = 0; i4 < 4; ++i4) { f4[mm][i4] = *(const f32x4*)((const char*)(fs + ((2 * m2 + mm) * 4 + i4) * 256) + lo16); d4[mm][i4] = *(const f32x4*)((const char*)(ds + 32 * (2 * m2 + mm) + 8 * i4) + hi16); }
                __builtin_amdgcn_sched_barrier(0);
#pragma unroll
                for (int mm = 0; mm < 2; ++mm)
#pragma unroll
                    for (int i4 = 0; i4 < 4; ++i4)
#pragma unroll
                        for (int e = 0; e < 4; ++e) S[2 * m2 + mm][4 * i4 + e] = S[2 * m2 + mm][4 * i4 + e] * d4[mm][i4][e] + f4[mm][i4][e];
                __builtin_amdgcn_sched_barrier(0); } }
        scan_stage_commit<true>(st, lds, tid);
        __syncthreads();
        for (int c = c0; c < c1; ++c) { LAS unsigned char* buf = lds + ((c - c0) & 1) * SC_BUF; LAS unsigned char* nbuf = lds + (((c - c0) & 1) ^ 1) * SC_BUF; const bool more = c + 1 < c1;
            if (more) { scan_stage_issue<true>(st, KDT, QF, ACH, bh * 64 + c + 1, tid); if (act) scan_load_vb(vbn, VT, bh * 64 + c + 1, n32, lane); }
            if (act) { gla_update_lds(S, buf, vb, lane, hi);
                gla_output_lds(S, buf, OG + ((size_t)b * SEQ + c * 64) * 1536 + h * 384 + n32 * 32, lane, r, hi); }
            if (more) { scan_stage_commit<true>(st, nbuf, tid);
#pragma unroll
                for (int s = 0; s < 4; ++s) vb[s] = vbn[s]; }
            __syncthreads(); }
    }
}
__device__ __forceinline__ void gla_post(const bf16* OG, const bf16* PROJ, const float* onorm  , bf16* MIX, int gw, int NGW, int lane) {
    const int la = lane < 48 ? lane : 0;
    const f32x4 g0 = *(const f32x4*)(onorm + 8 * la), g1 = *(const f32x4*)(onorm + 8 * la + 4);
    for (int t = gw; t < M * 4; t += NGW) { const int row = t >> 2, h = t & 3;
        v4u w = {0u, 0u, 0u, 0u}, gw4 = {0u, 0u, 0u, 0u};
        if (lane < 48) { w = *(const v4u*)(OG + (size_t)row * 1536 + h * 384 + 8 * lane); gw4 = *(const v4u*)(PROJ + (size_t)row * NA + A_G + h * 384 + 8 * lane); }
        float x[8] = {bf_lo(w.x), bf_hi(w.x), bf_lo(w.y), bf_hi(w.y), bf_lo(w.z), bf_hi(w.z), bf_lo(w.w), bf_hi(w.w)};
        float g[8] = {bf_lo(gw4.x), bf_hi(gw4.x), bf_lo(gw4.y), bf_hi(gw4.y), bf_lo(gw4.z), bf_hi(gw4.z), bf_lo(gw4.w), bf_hi(gw4.w)};
        float ss = 0.f;
#pragma unroll
        for (int e = 0; e < 8; ++e) ss += x[e] * x[e];
        const float rinv = 1.0f / sqrtf(wave_sum(ss) * (1.0f / 384.f) + EPS);
        float y[8];
#pragma unroll
        for (int e = 0; e < 8; ++e) y[e] = x[e] * rinv * (e < 4 ? g0[e] : g1[e - 4]) * pg8::silu_f(g[e]);
        if (lane < 48) { v4u o; o.x = pkbf(y[0], y[1]); o.y = pkbf(y[2], y[3]); o.z = pkbf(y[4], y[5]); o.w = pkbf(y[6], y[7]);
            *(v4u*)(MIX + (size_t)row * DM + h * 384 + 8 * lane) = o; } }
}
__device__ __forceinline__ void fox_cumsum(const float* F, const float* b_f, float* CB, int gw, int NGW, int lane) {
    for (int t = gw; t < BATCH * 12; t += NGW) { const int b = t / 12, h = t - b * 12; const float bf = b_f[h];
        const float* src = F + ((size_t)b * SEQ + lane * 64) * 16 + h;
        float v[64]; float run = 0.f;
#pragma unroll
        for (int j = 0; j < 64; ++j) { run += logsig(src[(size_t)j * 16] + bf); v[j] = run; }
        float incl = run;
#pragma unroll
        for (int o = 1; o < 64; o <<= 1) { const float y = __uint_as_float((unsigned)__builtin_amdgcn_ds_bpermute((lane - o) << 2, (int)__float_as_uint(incl))); if (lane >= o) incl += y; }
        const float excl = incl - run;
        float* dst = CB + (size_t)t * SEQ + lane * 64;
#pragma unroll
        for (int j = 0; j < 64; ++j) dst[j] = -(excl + v[j]) * 11.313708498984761f; }
}
struct AttCfg { const bf16* PROJ; const bf16* KSVS; const float* CB; const bf16* MK; const bf16* MV; bf16* MIX; const float* BF; unsigned* que; volatile LAS unsigned* qs; int np, qmcol, fox, vcu, G, q, nq; float skip_th; };
__device__ __forceinline__ fa::BlockRef att_item(const AttCfg& c, int j, int half, int nF) {
    fa::BlockRef r; const int nb = 8 / c.nq;
    if (j < nF) { const int p = j / (8 * nb), rem = j - p * (8 * nb), bl = rem >> 3, x = rem & 7; const int b = c.q + c.nq * bl; const int qb = half ? 15 - x : x;
        const int ln = lane_id_v(); const float mine = c.BF[ln < 12 ? ln : 11]; int rank = 0;
#pragma unroll
        for (int k = 0; k < 12; ++k) { const float o = __uint_as_float((unsigned)__builtin_amdgcn_readlane((int)__float_as_uint(mine), k)); rank += (o > mine || (o == mine && k < ln)) ? 1 : 0; }
        const unsigned long long hm = __ballot(ln < 12 && rank == p); const int h = hm ? (int)__builtin_ctzll(hm) : 0; const int bh = b * 12 + h;
        const size_t row0 = (size_t)b * SEQ + qb * 256;
        r.Q = c.PROJ + row0 * c.np + B_Q + h * 128; r.G = c.PROJ + row0 * c.np + B_G + h * 128; r.K = c.KSVS + (size_t)b * SEQ * 3072 + h * 128; r.V = r.K + 1536; r.O = c.MIX + row0 * DM + h * 128;
        r.CB = c.CB + (size_t)bh * SEQ; r.P0 = qb * 256; r.skv = SEQ; r.qp = c.np; r.kp = 3072;
        { const float cb0 = r.CB[qb * 256], cbe = r.CB[64 * ln + 63];
          const unsigned long long mk = __ballot(cb0 - cbe <= c.skip_th); r.jlo = mk ? (int)__builtin_ctzll(mk) : 0; } }
    else { const int jm = j - nF; const int bl = jm >> 6, rbl = (jm & 63) >> 2, mh = jm & 3; const int b = c.q + c.nq * bl; const int rb = b * 16 + rbl; const size_t row0 = (size_t)rb * 256;
        r.Q = c.PROJ + row0 * c.np + c.qmcol + mh * 128; r.G = nullptr; r.K = c.MK + (size_t)b * MEMT * 512 + mh * 128; r.V = c.MV + (size_t)b * MEMT * 512 + mh * 128; r.O = c.MIX + row0 * DM + 1536 + mh * 128;
        r.CB = nullptr; r.P0 = 256; r.skv = MEMT; r.qp = c.np; r.kp = 512; r.jlo = 0; }
    return r;
}
__device__ __forceinline__ int att_fetch(const AttCfg& c, int wave, int GQ) {
    if (wave == 0 && lane_id_v() == 0) c.qs[0] = __hip_atomic_fetch_add(c.que, 1u, RLX_AGENT);
    __syncthreads();
    return __builtin_amdgcn_readfirstlane(GQ + (int)c.qs[0]);
}
__device__ __forceinline__ void att_phase(const AttCfg& c, char* lds, int wave) {
    const int nb = 8 / c.nq, nF = c.fox ? 96 * nb : 0, T = nF + 64 * nb, GQ = c.G / c.nq;
    int j = c.vcu - c.q * GQ, half = 0;
    if (j >= T) return;
    fa::BlockRef cur = att_item(c, j, 0, nF); fa::Seam S;
    fa::attn_prime(cur, lds, S, wave);
    for (;;) {
        int nj = j, nh = 1;
        if (!(j < nF && half == 0)) { nj = att_fetch(c, wave, GQ); nh = 0; }
        const bool has = nj < T;
        const fa::BlockRef nxt = has ? att_item(c, nj, nh, nF) : cur;
        fa::attn_block(cur, nxt, lds, S, wave);
        if (!has) break;
        cur = nxt; j = nj; half = nh;
    }
}

struct Args { const float* in[22]; float* out; unsigned char* ws; int lo, hi; };
constexpr int PT_OUT = 22, PT_WS = 23;
#define PTR(k) ldp(PT, (k))
__global__ void __launch_bounds__(NWAVES * 64, 2) mega_fwd(Args args) {
    extern __shared__ __attribute__((aligned(16))) unsigned char lds_raw[];
    LAS unsigned char* lds = (LAS unsigned char*)lds_raw;
    volatile LAS unsigned* MISC = (volatile LAS unsigned*)(lds + MISC_OFF);
    volatile LAS unsigned* PT = (volatile LAS unsigned*)(lds + MISC_OFF + 128);
    const int wave = __builtin_amdgcn_readfirstlane((int)threadIdx.x >> 6);
    const int G = gridDim.x; const int bx = blockIdx.x; const int vcu = (G % 8 == 0) ? (bx % 8) * (G / 8) + bx / 8 : bx;
    const int gw = vcu * NWAVES + wave, NGW = G * NWAVES;
    for (int u = threadIdx.x; u < (LDS_BYTES - LDSCTL_OFF) / 4; u += NWAVES * 64) ((LAS unsigned*)(lds + LDSCTL_OFF))[u] = 0u;
    __syncthreads();
    if (threadIdx.x == 0) {
#pragma unroll
        for (int k = 0; k < 22; ++k) { const unsigned long long p = (unsigned long long)args.in[k]; PT[2 * k] = (unsigned)p; PT[2 * k + 1] = (unsigned)(p >> 32); }
        { const unsigned long long p = (unsigned long long)args.out; PT[2 * PT_OUT] = (unsigned)p; PT[2 * PT_OUT + 1] = (unsigned)(p >> 32); }
        { const unsigned long long p = (unsigned long long)args.ws; PT[2 * PT_WS] = (unsigned)p; PT[2 * PT_WS + 1] = (unsigned)(p >> 32); }
    }
    __syncthreads();
    const int lo = args.lo, hi = args.hi < MK_STOP_PC ? args.hi : MK_STOP_PC;
    const bool use_bar = (args.hi - args.lo) > 1;
    XcdBarrier bar; bar.bar = (unsigned*)((unsigned char*)PTR(PT_WS) + WS_CTL) + CW_BAR; bar.x = 0; bar.st = MISC + 8; bar.wave = wave;
    if (use_bar) bar = xcd_barrier_post(bar.bar, MISC + 8, wave);

    int pc = 0;
#define PH_ON (pc >= lo && pc < hi)
#define PH_END do { if (use_bar && pc >= lo && pc + 1 < hi) { XcdBarrier bb; bb.bar = (unsigned*)((unsigned char*)PTR(PT_WS) + WS_CTL) + CW_BAR; bb.x = bar.x; bb.st = MISC + 8; bb.wave = wave; xcd_barrier(bb); } ++pc; } while (0)
#define WSP ((unsigned char*)PTR(PT_WS))
#define PH_BEGIN if (PH_ON) { const int lane = lane_id(); const int gwp = launder_s(gw), vcup = launder_s(vcu), bxp = launder_s(bx), wavep = launder_s(wave); unsigned char* ws = WSP; (void)lane; (void)gwp; (void)vcup; (void)bxp; (void)wavep;
#define XOUT ((float*)PTR(PT_OUT))

    PH_BEGIN
#ifndef DBG_NO_CVT
        for (int rep = 0; rep < REP_CVT; ++rep) convert_phase(PT, ws, XOUT, lds, gwp, NGW, lane, wavep);
#endif
    }
    PH_END;
#ifdef EXTRA_BARRIERS
    if (use_bar) for (int eb = 0; eb < EXTRA_BARRIERS; ++eb) { XcdBarrier bb; bb.bar = (unsigned*)((unsigned char*)PTR(PT_WS) + WS_CTL) + CW_BAR; bb.x = bar.x; bb.st = MISC + 8; bb.wave = wave; xcd_barrier(bb); }
#endif

#ifdef EXTRA_UP_PHASES
    for (int ex = 0; ex < EXTRA_UP_PHASES; ++ex) {
        if (pc >= lo && pc < hi) { unsigned char* ws = WSP; const int bxp = launder_s(bx), wavep = launder_s(wave);
            pg8::Gemm g{(const bf16*)XOUT, (const bf16*)(ws + WS_WUP) + (size_t)(7 - (ex & 3)) * NUP * DM, M, NUP, DM}; pg8::StaticOrder S; S.init(M, NUP, G, bxp);
            pg8::EpiNull E{(float*)(ws + WS_DSEG)};
            pg8::gemm_phase<pg8::EpiNull, pg8::StaticOrder, true, true>(lds, g, S, E, wavep); }
        if (use_bar && pc >= lo) { XcdBarrier bb; bb.bar = (unsigned*)((unsigned char*)PTR(PT_WS) + WS_CTL) + CW_BAR; bb.x = bar.x; bb.st = MISC + 8; bb.wave = wave; xcd_barrier(bb); }
    }
#endif
    for (int l = 0; l < DEPTH; ++l) {
        for (int sub = 0; sub < 2; ++sub) {
            const int mat = l * 2 + sub;
            if (l == 2 && sub == 0) {
                PH_BEGIN load_gains(lds, PTR(21), PTR(21), wavep, lane);
                    pg8::Gemm g{(const bf16*)XOUT, (const bf16*)(ws + WS_WKV), M, NKV, DM}; pg8::StaticOrder S; S.init(M, NKV, G, bxp);
                    pg8::EpiKV E{(bf16*)(ws + WS_KSVS), 3072, (float*)(ws + WS_F), pg8::RinvCache{(const float*)(ws + WS_SS) + (size_t)6 * M * 2, (LAS float*)(lds + RTAB_OFF), -1}, (LAS float*)(lds + HNT_OFF), (LAS const float*)(lds + GAIN_OFF)};
                    for (int rep = 0; rep < REP_KVG; ++rep) pg8::gemm_phase<pg8::EpiKV, pg8::StaticOrder, true, GEMM_SP2>(lds, g, S, E, wavep); }
                PH_END;
                PH_BEGIN
#ifndef DBG_NO_CUM
                    for (int rep = 0; rep < REP_CUM; ++rep) fox_cumsum((const float*)(ws + WS_F), PTR(20), (float*)(ws + WS_CB), gwp, NGW, lane);
#endif
                    }
                PH_END;
            }
            for (int part = 0; part < FFN_SPLIT; ++part) {
            constexpr int MP = M / FFN_SPLIT; const size_t r0 = (size_t)part * MP;
            PH_BEGIN
                if (UP_STAGGER_US > 0 && ((bxp >> 3) & 1)) { const unsigned long long t0 = __builtin_amdgcn_s_memrealtime(); while (__builtin_amdgcn_s_memrealtime() - t0 < (unsigned long long)UP_STAGGER_US * 100ull) __builtin_amdgcn_s_sleep(16); }
                const bf16* resA = (l == DEPTH - 1 && sub == 1) ? (const bf16*)(ws + WS_XB2) : (const bf16*)XOUT;
                pg8::Gemm g{resA + r0 * DM, (const bf16*)(ws + WS_WUP) + (size_t)mat * NUP * DM, MP, NUP, DM}; pg8::StaticOrder S; S.init(MP, NUP, G, bxp);
                pg8::EpiSwiGLU E{(bf16*)(ws + WS_ACT) + r0 * FF, FF, pg8::RinvCache{(const float*)(ws + WS_SS) + ((size_t)(3 * l + 2 * sub) * M + r0) * 2, (LAS float*)(lds + RTAB_OFF), -1}};
                pg8::gemm_phase<pg8::EpiSwiGLU, pg8::StaticOrder, UP_ALIGN, GEMM_SP2>(lds, g, S, E, wavep);
#if REP_UP > 1
#ifdef REP_UP_CHEAP
                for (int rep = 1; rep < REP_UP; ++rep) { pg8::EpiNull E2{(float*)(ws + WS_DSEG)}; pg8::gemm_phase<pg8::EpiNull, pg8::StaticOrder, true, GEMM_SP2>(lds, g, S, E2, wavep); }
#else
                for (int rep = 1; rep < REP_UP; ++rep) pg8::gemm_phase<pg8::EpiSwiGLU, pg8::StaticOrder, UP_ALIGN, GEMM_SP2>(lds, g, S, E, wavep);
#endif
#endif
                }
            PH_END;
            PH_BEGIN pg8::Gemm g{(const bf16*)(ws + WS_ACT) + r0 * FF, (const bf16*)(ws + WS_WDN) + (size_t)mat * DM * FF, MP, DM, FF}; pg8::StaticOrder S; S.init(MP, DM, G, bxp);
                const int ssid = sub ? 3 * (l + 1) : 3 * l + 1;
                if (DN_STAGGER_US > 0 && ((bxp >> 3) & 1)) { const unsigned long long t0 = __builtin_amdgcn_s_memrealtime(); while (__builtin_amdgcn_s_memrealtime() - t0 < (unsigned long long)DN_STAGGER_US * 100ull) __builtin_amdgcn_s_sleep(8); }
                if (l == DEPTH - 1 && sub == 1) {
                    pg8::EpiRes<true> E{PT, PT_OUT, PT_WS, WS_XB2, 0, WS_SS + (size_t)12 * M * 8, 1, 0, 0.5f, (int)r0};
                    pg8::gemm_phase<pg8::EpiRes<true>, pg8::StaticOrder, true, GEMM_SP2>(lds, g, S, E, wavep);
                } else {
                    pg8::EpiRes<false> E{PT, PT_OUT, PT_WS, 0, 0, WS_SS + (size_t)ssid * M * 8, 0, 0, 0.5f, (int)r0};
                    pg8::gemm_phase<pg8::EpiRes<false>, pg8::StaticOrder, true, GEMM_SP2>(lds, g, S, E, wavep); }
#if REP_DN > 1
                for (int rep = 1; rep < REP_DN; ++rep) { pg8::EpiDummy E{(bf16*)(ws + WS_HMIX) + r0 * DM, DM}; pg8::gemm_phase<pg8::EpiDummy, pg8::StaticOrder, true, GEMM_SP2>(lds, g, S, E, wavep); }
#endif
                }
            PH_END;
            }
            if (sub == 0) {
                const int np = l < 2 ? NA : NB;
                PH_BEGIN load_gains(lds, l < 2 ? PTR(9) + l * 128 : PTR(17) + (l - 2) * 128, PTR(9) + l * 128, wavep, lane);
                    const bf16* wt = l < 2 ? (const bf16*)(ws + WS_WAIN) + (size_t)l * NA * DM : (const bf16*)(ws + WS_WBIN) + (size_t)(l - 2) * NB * DM;
                    pg8::Gemm g{(const bf16*)XOUT, wt, M, np, DM}; pg8::StaticOrder S; S.init(M, np, G, bxp);
                    pg8::EpiB16 E{(bf16*)(ws + WS_ACT), np, pg8::RinvCache{(const float*)(ws + WS_SS) + (size_t)(3 * l + 1) * M * 2, (LAS float*)(lds + RTAB_OFF), -1}, (LAS float*)(lds + HNT_OFF), (LAS const float*)(lds + GAIN_OFF),
                        l < 2 ? A_QM / 256 : 0, l < 2 ? A_QM / 256 + 2 : 6, l < 2 ? 0 : B_QM / 256, l < 2 ? 0 : B_QM / 256 + 2};
                    for (int rep = 0; rep < REP_IN; ++rep) pg8::gemm_phase<pg8::EpiB16, pg8::StaticOrder, true, GEMM_SP2>(lds, g, S, E, wavep);
                    if (l == 0 && bxp >= G / 2) { pg8::Gemm g2{(const bf16*)(ws + WS_MEMB), (const bf16*)(ws + WS_WMEM), MROWS, NMEMW, DM}; pg8::StaticOrder S2; S2.init(MROWS, NMEMW, G - G / 2, bxp - G / 2);
                        pg8::EpiF32 E2{(float*)(ws + WS_MKVF), NMEMW};
                        pg8::gemm_phase<pg8::EpiF32, pg8::StaticOrder, true, GEMM_SP2>(lds, g2, S2, E2, wavep); } }
                PH_END;
                if (l < 2) {
                    PH_BEGIN if (l == 0) mkmv_pass((const float*)(ws + WS_MKVF), (bf16*)(ws + WS_MK), (bf16*)(ws + WS_MV), PTR(10), gwp, NGW, lane);
#ifndef DBG_NO_PREP
                        for (int rep = 0; rep < REP_PREP; ++rep) gla_prep((const bf16*)(ws + WS_ACT), PTR(14) + l * 768, PTR(13) + l * 16 * 768, (bf16*)(ws + WS_KDT), (bf16*)(ws + WS_VT), (bf16*)(ws + WS_QF), (float*)(ws + WS_ACH), gwp, NGW, lane);
#endif
                        }
                    PH_END;
                    PH_BEGIN
#if SCAN_WG
                        for (int rep = 0; rep < REP_SCAN; ++rep) gla_seg_states_wg((const bf16*)(ws + WS_KDT), (const bf16*)(ws + WS_VT), (const float*)(ws + WS_ACH), (float*)(ws + WS_FST), (float*)(ws + WS_DSEG), lds, vcup, G, wavep, lane, gwp, NGW);
#else
                        for (int rep = 0; rep < REP_SCAN; ++rep) gla_seg_states((const bf16*)(ws + WS_KDT), (const bf16*)(ws + WS_VT), (const float*)(ws + WS_ACH), (float*)(ws + WS_FST), (float*)(ws + WS_DSEG), gwp, NGW, lane);
#endif
                    }
                    PH_END;
                    PH_BEGIN
#if SCAN_WG
                        for (int rep = 0; rep < REP_SCAN; ++rep) gla_seg_outputs_wg((const bf16*)(ws + WS_QF), (const bf16*)(ws + WS_KDT), (const bf16*)(ws + WS_VT), (const float*)(ws + WS_ACH), (const float*)(ws + WS_FST), (const float*)(ws + WS_DSEG), (bf16*)(ws + WS_OG), lds, vcup, G, wavep, lane);
#else
                        for (int rep = 0; rep < REP_SCAN; ++rep) gla_seg_outputs((const bf16*)(ws + WS_QF), (const bf16*)(ws + WS_KDT), (const bf16*)(ws + WS_VT), (const float*)(ws + WS_ACH), (const float*)(ws + WS_FST), (const float*)(ws + WS_DSEG), (bf16*)(ws + WS_OG), gwp, NGW, lane);
#endif
                    }
                    PH_END;
                }
                PH_BEGIN
                    if (l < 2) for (int rep = 0; rep < REP_POST; ++rep) gla_post((const bf16*)(ws + WS_OG), (const bf16*)(ws + WS_ACT), PTR(15) + l * 384, (bf16*)(ws + WS_HMIX), gwp, NGW, lane);
                    AttCfg c; c.PROJ = (const bf16*)(ws + WS_ACT); c.KSVS = (const bf16*)(ws + WS_KSVS); c.CB = (const float*)(ws + WS_CB); c.MK = (const bf16*)(ws + WS_MK) + (size_t)l * MROWS * 512; c.MV = (const bf16*)(ws + WS_MV) + (size_t)l * MROWS * 512;
                    c.MIX = (bf16*)(ws + WS_HMIX); c.np = np; c.qmcol = l < 2 ? A_QM : B_QM; c.fox = l >= 2; c.vcu = vcup; c.G = G; c.skip_th = 0.f;
                    c.nq = (G % 8 == 0) ? 8 : 1; c.q = vcup / (G / c.nq); c.BF = PTR(20); c.qs = MISC + 16; c.que = (unsigned*)(ws + WS_CTL) + CW_QUE + (l * 8 + c.q) * 16;
                    if (l >= 2) {
                        const float* gq = PTR(17) + (l - 2) * 128; const float* gk = PTR(21);
                        float mq = fmaxf(fabsf(gq[lane]), fabsf(gq[64 + lane])), mkk = fmaxf(fabsf(gk[lane]), fabsf(gk[64 + lane]));
                        mq = wave_max(mq); mkk = wave_max(mkk);
                        c.skip_th = FOX_SKIP ? 1270.5f + 2.0f * 128.0f * 1.02f * mq * mkk : 3.0e38f; }
                    __syncthreads();
#ifndef DBG_NO_ATT
                    for (int rep = 0; rep < REP_ATT; ++rep) att_phase(c, (char*)lds_raw, wavep);
#endif
                    }
                PH_END;
                PH_BEGIN pg8::Gemm g{(const bf16*)(ws + WS_HMIX), (const bf16*)(ws + WS_WOUT) + (size_t)l * DM * DM, M, DM, DM}; pg8::StaticOrder S; S.init(M, DM, G, bxp);
                    { pg8::EpiRes<false> E{PT, PT_OUT, PT_WS, 0, WS_XB2, WS_SS + (size_t)(3 * l + 2) * M * 8, 0, l == DEPTH - 1 ? 1 : 0, 1.0f, 0};
                      pg8::gemm_phase<pg8::EpiRes<false>, pg8::StaticOrder, true, GEMM_SP2>(lds, g, S, E, wavep); }
#if REP_OUT > 1
                    for (int rep = 1; rep < REP_OUT; ++rep) { pg8::EpiDummy E{(bf16*)(ws + WS_ACT), DM}; pg8::gemm_phase<pg8::EpiDummy, pg8::StaticOrder, true, GEMM_SP2>(lds, g, S, E, wavep); }
#endif
                    }
                PH_END;
            }
        }
    }
#undef PH_ON
#undef PH_END
#undef WSP
#undef PH_BEGIN
#undef XOUT
}

extern "C" void kernel_launch(void* const* d_in, const int* in_sizes, int n_in, void* d_out, int out_size, void* d_ws, size_t ws_size, hipStream_t stream) {
    static int grid = 0;
    if (grid == 0) {
        if (n_in != 22 || in_sizes[0] != M * DM || out_size != M * DM || ws_size < WS_END) { fprintf(stderr, "kernel_launch: unexpected shapes (n_in %d, in0 %d, out %d, ws %zu < %zu); nothing launched\n", n_in, n_in > 0 ? in_sizes[0] : -1, out_size, ws_size, (size_t)WS_END); grid = -1; return; }
        int dev = 0, cus = 0, per_cu = 0;
        if (hipGetDevice(&dev) != hipSuccess || hipDeviceGetAttribute(&cus, hipDeviceAttributeMultiprocessorCount, dev) != hipSuccess) { fprintf(stderr, "kernel_launch: device query failed\n"); grid = -1; return; }
        if (hipFuncSetAttribute((const void*)mega_fwd, hipFuncAttributeMaxDynamicSharedMemorySize, LDS_BYTES) != hipSuccess) { fprintf(stderr, "kernel_launch: hipFuncSetAttribute failed\n"); grid = -1; return; }
        if (hipOccupancyMaxActiveBlocksPerMultiprocessor(&per_cu, (const void*)mega_fwd, NWAVES * 64, LDS_BYTES) != hipSuccess || per_cu < 1)
            fprintf(stderr, "kernel_launch: note: occupancy query reports %d workgroups per CU\n", per_cu);
        (void)hipGetLastError();
        grid = cus;
    }
    if (grid < 0) return;
    (void)hipMemsetAsync((char*)d_ws + WS_CTL, 0, CTL_ZERO_BYTES, stream);
    (void)hipMemsetAsync((char*)d_ws + WS_SS, 0, SS_BYTES, stream);
    Args a{};
    for (int i = 0; i < 22; ++i) a.in[i] = (const float*)d_in[i];
    a.out = (float*)d_out; a.ws = (unsigned char*)d_ws;
#if MK_PER_PHASE
    for (int p = 0; p < NPH && p < MK_STOP_PC; ++p) { a.lo = p; a.hi = p + 1; hipLaunchKernelGGL(mega_fwd, dim3(grid), dim3(NWAVES * 64), LDS_BYTES, stream, a); }
#else
    a.lo = 0; a.hi = NPH; hipLaunchKernelGGL(mega_fwd, dim3(grid), dim3(NWAVES * 64), LDS_BYTES, stream, a);
#endif
}
```

```cpp
#ifndef PG8_WGM
#define PG8_WGM 8
#endif
#include <hip/hip_runtime.h>
#include <cstdio>
#include <cstdint>
__device__ __forceinline__ int lane_id_v() { int l; asm volatile("v_mbcnt_lo_u32_b32 %0, -1, 0\n\tv_mbcnt_hi_u32_b32 %0, -1, %0" : "=v"(l)); return l; }
namespace pg8 {
#define PG8_LAS __attribute__((address_space(3)))
typedef unsigned short bf16_t;
typedef short bf16x8 __attribute__((ext_vector_type(8)));
typedef float f32x4 __attribute__((ext_vector_type(4)));
typedef unsigned u32x4 __attribute__((ext_vector_type(4)));
constexpr int BM = 256, BK = 64, HALF = 128, HTB = HALF * BK * 2  , STAGE_BYTES = 8 * HTB, NXCD = 8, WGM = PG8_WGM;

__host__ __device__ __forceinline__ int lds_byte(int r, int c) { const int st = (r >> 4) * 2 + (c >> 5), rr = r & 15, cc = c & 31, ob = rr * 64 + cc * 2; return st * 1024 + (ob ^ (((ob >> 9) & 1) << 5)); }
__host__ __device__ __forceinline__ void stage_rc(int b, int& R, int& C) { const int st = b / 1024, sb = b % 1024, swz = sb ^ (((sb >> 9) & 1) << 5); R = (st >> 1) * 16 + swz / 64; C = (st & 1) * 32 + (swz % 64) / 2; }
__host__ __device__ __forceinline__ int perm32(int rho) { const int n = rho >> 4, i = rho & 15; return 8 * (i >> 2) + 4 * n + (i & 3); }

struct Unit { int pm, pn; };
struct Gemm { const bf16_t* A; const bf16_t* Bt; int M, N, K; };

struct StaticOrder {
    int nM, nN, nwg, G, c;
    __host__ __device__ void init(int M, int N, int G_, int c_) { nM = M / BM; nN = N / BM; nwg = nM * nN; G = G_; c = c_; }
    __host__ __device__ bool next(int i, Unit& u) const {
        const long L = (long)i * G + c; if (L >= nwg) return false;
        int wgid = (int)L; { const int q = nwg / NXCD, r = nwg % NXCD, xcd = wgid % NXCD, off = wgid / NXCD; wgid = (xcd < r ? xcd * (q + 1) : r * (q + 1) + (xcd - r) * q) + off; }
        const int nig = WGM * nN, gid = wgid / nig, fm = gid * WGM, gsz = (nM - fm) < WGM ? (nM - fm) : WGM;
        u.pm = fm + ((wgid % nig) % gsz); u.pn = (wgid % nig) / gsz; return true;
    }
    __device__ __forceinline__ void a_ready(const Unit&) const {}
    __device__ __forceinline__ void done(const Unit&) const {}
};

__device__ __forceinline__ unsigned cvt_pk_bf16(float lo, float hi) { unsigned r; asm volatile("v_cvt_pk_bf16_f32 %0, %1, %2" : "=v"(r) : "v"(lo), "v"(hi)); return r; }
typedef float f32x2 __attribute__((ext_vector_type(2)));
__device__ __forceinline__ f32x2 gelu_pk(f32x2 v) {
    const f32x2 av = __builtin_elementwise_abs(v), d = av * 0.2316418882f + 1.0f;
    f32x2 t; t.x = __builtin_amdgcn_rcpf(d.x); t.y = __builtin_amdgcn_rcpf(d.y);
    f32x2 q = t * 0.5307027145f + (-0.7265760135f); q = q * t + 0.7107068705f; q = q * t + (-0.142248368f); q = q * t + 0.127414796f; q = q * t;
    const f32x2 s = (v * v) * (-0.72134752044f);
    f32x2 e; e.x = __builtin_amdgcn_exp2f(s.x); e.y = __builtin_amdgcn_exp2f(s.y);
    const f32x2 m = v * (q * e), r = v - m;
    f32x2 o; o.x = v.x < 0.f ? m.x : r.x; o.y = v.y < 0.f ? m.y : r.y; return o;
}

template <int ACT  > struct EpiBf16 {
    static constexpr bool PERM = true, AFTER_DRAIN = false; static_assert(ACT == 0 || ACT == 1, "EpiBf16: ACT is 0 (none) or 1 (gelu_pk)");
    bf16_t* O; int ldc; const float* bias; int split_cols; size_t split_stride; float scale0;
    __device__ __forceinline__ void operator()(const f32x4 (&acc)[2][2][4][2], const Unit& u, int wr, int wc, int fr, int fq) const {
        const int row0 = u.pm * BM + wr * 64 + fr; int colt = u.pn * BM; bf16_t* base = O;
        float sc = 1.f; if (split_cols) { const int t = colt / split_cols; base += (size_t)t * split_stride; colt -= t * split_cols; if (t == 0) sc = scale0; }
        const int col0 = colt + wc * 32 + 8 * fq, bcol0 = u.pn * BM + wc * 32 + 8 * fq;
        f32x4 bv[2][2];
#pragma unroll
        for (int bj = 0; bj < 2; ++bj)
#pragma unroll
            for (int n = 0; n < 2; ++n) bv[bj][n] = bias ? *(const f32x4*)(bias + bcol0 + bj * HALF + 4 * n) : (f32x4){0.f, 0.f, 0.f, 0.f};
#pragma unroll
        for (int ai = 0; ai < 2; ++ai)
#pragma unroll
            for (int m = 0; m < 4; ++m) { bf16_t* rowp = base + (size_t)(row0 + ai * HALF + m * 16) * ldc + col0;
#pragma unroll
                for (int bj = 0; bj < 2; ++bj) { f32x4 v0 = acc[ai][bj][m][0] + bv[bj][0], v1 = acc[ai][bj][m][1] + bv[bj][1];
                    if (ACT == 1) { f32x2 a = gelu_pk((f32x2){v0[0], v0[1]}), b = gelu_pk((f32x2){v0[2], v0[3]}), c = gelu_pk((f32x2){v1[0], v1[1]}), d = gelu_pk((f32x2){v1[2], v1[3]});
                        v0 = (f32x4){a.x, a.y, b.x, b.y}; v1 = (f32x4){c.x, c.y, d.x, d.y}; }
                    v0 = v0 * sc; v1 = v1 * sc; u32x4 w; w.x = cvt_pk_bf16(v0[0], v0[1]); w.y = cvt_pk_bf16(v0[2], v0[3]); w.z = cvt_pk_bf16(v1[0], v1[1]); w.w = cvt_pk_bf16(v1[2], v1[3]);
                    *(u32x4*)(rowp + bj * HALF) = w; } }
    }
};

__device__ __forceinline__ unsigned pkbf(float lo, float hi) {
    typedef __bf16 bf2_t __attribute__((ext_vector_type(2))); typedef float fl2_t __attribute__((ext_vector_type(2)));
    fl2_t v = {lo, hi}; bf2_t r = __builtin_convertvector(v, bf2_t); return __builtin_bit_cast(unsigned, r);
}
__device__ __forceinline__ float silu_f(float x) { return x * __builtin_amdgcn_rcpf(1.0f + __builtin_amdgcn_exp2f(-1.4426950408889634f * x)); }

__device__ __forceinline__ float rinv_of(const float* ss, int row) { const float s = (float)((const unsigned long long*)ss)[row] * (1.0f / 16777216.0f); return 1.0f / sqrtf(s * (1.0f / 2048.f) + 1e-6f); }
struct RinvCache {
    const float* ss; PG8_LAS float* tab; mutable int pm_cached;
    __device__ __forceinline__ void get(float (&ri)[2][4], const Unit& u, int wr, int wc, int fr) const {
        PG8_LAS float* t = tab + (wr * 4 + wc) * 128;
        if (u.pm != pm_cached) { pm_cached = u.pm; const int l = lane_id_v();
            t[l] = rinv_of(ss, u.pm * BM + wr * 64 + l); t[64 + l] = rinv_of(ss, u.pm * BM + HALF + wr * 64 + l);
            asm volatile("s_waitcnt lgkmcnt(0)" ::: "memory"); }
#pragma unroll
        for (int ai = 0; ai < 2; ++ai)
#pragma unroll
            for (int m = 0; m < 4; ++m) ri[ai][m] = t[ai * 64 + m * 16 + fr];
    }
};
struct EpiSwiGLU {
    static constexpr bool PERM = true, AFTER_DRAIN = false;
    bf16_t* O; int ldc; RinvCache rc;
    __device__ __forceinline__ void operator()(const f32x4 (&acc)[2][2][4][2], const Unit& u, int wr, int wc, int fr, int fq) const {
        const int row0 = u.pm * BM + wr * 64 + fr, col0 = u.pn * HALF + wc * 32 + 8 * fq;
        float rit[2][4]; rc.get(rit, u, wr, wc, fr);
#pragma unroll
        for (int ai = 0; ai < 2; ++ai)
#pragma unroll
            for (int m = 0; m < 4; ++m) { bf16_t* rowp = O + (size_t)(row0 + ai * HALF + m * 16) * ldc + col0;
                const float ri = rit[ai][m]; const float ce = -1.4426950408889634f * ri, kk = __builtin_amdgcn_rcpf(ri * ri);
                const f32x4 ag0 = acc[ai][0][m][0], ag1 = acc[ai][0][m][1], au0 = acc[ai][1][m][0], au1 = acc[ai][1][m][1];
                const f32x4 t0 = ag0 * ce, t1 = ag1 * ce; f32x4 e0, e1;
#pragma unroll
                for (int j = 0; j < 4; ++j) { e0[j] = __builtin_amdgcn_exp2f(t0[j]); e1[j] = __builtin_amdgcn_exp2f(t1[j]); }
                const f32x4 d0 = e0 * kk + kk, d1 = e1 * kk + kk; f32x4 r0, r1;
#pragma unroll
                for (int j = 0; j < 4; ++j) { r0[j] = __builtin_amdgcn_rcpf(d0[j]); r1[j] = __builtin_amdgcn_rcpf(d1[j]); }
                const f32x4 o0 = (ag0 * au0) * r0, o1 = (ag1 * au1) * r1;
                u32x4 w;
                w.x = pkbf(o0[0], o0[1]); w.y = pkbf(o0[2], o0[3]); w.z = pkbf(o1[0], o1[1]); w.w = pkbf(o1[2], o1[3]);
                __builtin_nontemporal_store(w, (u32x4*)rowp); }
    }
};
typedef unsigned u32x2 __attribute__((ext_vector_type(2)));
template <bool FINAL> struct EpiRes {
    static constexpr bool PERM = true, AFTER_DRAIN = false;
    volatile PG8_LAS unsigned* PT; int slot_out, slot_ws; size_t base_off, out_off, ss_off; int base_in_ws, out_in_ws; float scale; int row_base;
    __device__ __forceinline__ void operator()(const f32x4 (&acc)[2][2][4][2], const Unit& u, int wr, int wc, int fr, int fq) const {
        typedef __attribute__((address_space(1))) unsigned char gchar;
        unsigned char* dout = (unsigned char*)(gchar*)(((unsigned long long)__builtin_amdgcn_readfirstlane(PT[2 * slot_out + 1]) << 32) | (unsigned)__builtin_amdgcn_readfirstlane(PT[2 * slot_out]));
        unsigned char* ws = (unsigned char*)(gchar*)(((unsigned long long)__builtin_amdgcn_readfirstlane(PT[2 * slot_ws + 1]) << 32) | (unsigned)__builtin_amdgcn_readfirstlane(PT[2 * slot_ws]));
        const bf16_t* base = (const bf16_t*)(base_in_ws ? ws + base_off : dout); bf16_t* outb = (bf16_t*)(out_in_ws ? ws + out_off : dout); float* outf = (float*)dout; float* ss = (float*)(ws + ss_off);
        constexpr int ldc = 2048;
        const int row0 = row_base + u.pm * BM + wr * 64 + fr, col0 = u.pn * BM + wc * 32 + 8 * fq;
        u32x4 b[2][4][2];
#pragma unroll
        for (int ai = 0; ai < 2; ++ai)
#pragma unroll
            for (int m = 0; m < 4; ++m) { const size_t off = (size_t)(row0 + ai * HALF + m * 16) * ldc + col0;
#pragma unroll
                for (int bj = 0; bj < 2; ++bj) b[ai][m][bj] = *(const u32x4*)(base + off + bj * HALF); }
#pragma unroll
        for (int ai = 0; ai < 2; ++ai) {
#pragma unroll
            for (int m = 0; m < 4; ++m) { const size_t off = (size_t)(row0 + ai * HALF + m * 16) * ldc + col0; float q = 0.f;
#pragma unroll
                for (int bj = 0; bj < 2; ++bj) { const u32x4 r = b[ai][m][bj];
                    f32x4 x0 = {__uint_as_float(r.x << 16), __uint_as_float(r.x & 0xffff0000u), __uint_as_float(r.y << 16), __uint_as_float(r.y & 0xffff0000u)};
                    f32x4 x1 = {__uint_as_float(r.z << 16), __uint_as_float(r.z & 0xffff0000u), __uint_as_float(r.w << 16), __uint_as_float(r.w & 0xffff0000u)};
                    x0 = x0 + acc[ai][bj][m][0] * scale; x1 = x1 + acc[ai][bj][m][1] * scale;
                    if (FINAL) { *(f32x4*)(outf + off + bj * HALF) = x0; *(f32x4*)(outf + off + bj * HALF + 4) = x1; }
                    else { q += ((x0[0] * x0[0] + x0[1] * x0[1]) + (x0[2] * x0[2] + x0[3] * x0[3])) + ((x1[0] * x1[0] + x1[1] * x1[1]) + (x1[2] * x1[2] + x1[3] * x1[3]));
                        u32x4 w; w.x = pkbf(x0[0], x0[1]); w.y = pkbf(x0[2], x0[3]); w.z = pkbf(x1[0], x1[1]); w.w = pkbf(x1[2], x1[3]); *(u32x4*)(outb + off + bj * HALF) = w; } }
                if (!FINAL) {
                    q += __uint_as_float((unsigned)__builtin_amdgcn_ds_swizzle((int)__float_as_uint(q), (16 << 10) | 0x1f));
                    const auto rr = __builtin_amdgcn_permlane32_swap(__float_as_uint(q), __float_as_uint(q), false, false);
                    q = __uint_as_float(rr[0]) + __uint_as_float(rr[1]);
                    if (fq == 0) atomicAdd((unsigned long long*)ss + row0 + ai * HALF + m * 16, (unsigned long long)(q * 16777216.0f)); } }
            asm volatile("" ::: "memory"); }
    }
};
struct EpiF32 {
    static constexpr bool PERM = false, AFTER_DRAIN = false;
    float* C; int ldc;
    __device__ __forceinline__ void operator()(const f32x4 (&acc)[2][2][4][2], const Unit& u, int wr, int wc, int fr, int fq) const {
        const int row0 = u.pm * BM + wr * 64 + fr, col0 = u.pn * BM + wc * 32 + 4 * fq;
#pragma unroll
        for (int ai = 0; ai < 2; ++ai)
#pragma unroll
            for (int m = 0; m < 4; ++m) { float* rowp = C + (size_t)(row0 + ai * HALF + m * 16) * ldc + col0;
#pragma unroll
                for (int bj = 0; bj < 2; ++bj)
#pragma unroll
                    for (int n = 0; n < 2; ++n) *(f32x4*)(rowp + bj * HALF + n * 16) = acc[ai][bj][m][n]; }
    }
};
struct HeadNorm { PG8_LAS float* hnt; PG8_LAS const float* gain; };
__device__ __forceinline__ void store_b16_tile(const f32x4 (&acc)[2][2][4][2], bf16_t* O, int ldc, int row0, int col0, const float (&rit)[2][4], const HeadNorm hn, int wr, int wc, int fr, int fq) {
    if (hn.gain) {
#pragma unroll
        for (int ai = 0; ai < 2; ++ai)
#pragma unroll
            for (int m = 0; m < 4; ++m) { const float ri = rit[ai][m];
#pragma unroll
                for (int bj = 0; bj < 2; ++bj) { const f32x4 v0 = acc[ai][bj][m][0] * ri, v1 = acc[ai][bj][m][1] * ri;
                    float q = ((v0[0] * v0[0] + v0[1] * v0[1]) + (v0[2] * v0[2] + v0[3] * v0[3])) + ((v1[0] * v1[0] + v1[1] * v1[1]) + (v1[2] * v1[2] + v1[3] * v1[3]));
                    q += __uint_as_float((unsigned)__builtin_amdgcn_ds_swizzle((int)__float_as_uint(q), (16 << 10) | 0x1f));
                    const auto rr = __builtin_amdgcn_permlane32_swap(__float_as_uint(q), __float_as_uint(q), false, false);
                    q = __uint_as_float(rr[0]) + __uint_as_float(rr[1]);
                    if (fq == 0) hn.hnt[((ai * HALF + wr * 64 + m * 16 + fr) * 2 + bj) * 4 + wc] = q; } }
        asm volatile("s_waitcnt lgkmcnt(0)" ::: "memory"); __builtin_amdgcn_s_barrier(); asm volatile("" ::: "memory");
        const f32x4 g0 = *(PG8_LAS const f32x4*)(hn.gain + wc * 32 + 8 * fq), g1 = *(PG8_LAS const f32x4*)(hn.gain + wc * 32 + 8 * fq + 4);
#pragma unroll
        for (int ai = 0; ai < 2; ++ai)
#pragma unroll
            for (int m = 0; m < 4; ++m) { bf16_t* rowp = O + (size_t)(row0 + ai * HALF + m * 16) * ldc + col0; const float ri = rit[ai][m];
#pragma unroll
                for (int bj = 0; bj < 2; ++bj) { const f32x4 p4 = *(PG8_LAS const f32x4*)(hn.hnt + ((ai * HALF + wr * 64 + m * 16 + fr) * 2 + bj) * 4);
                    const float rh = ri / sqrtf(((p4[0] + p4[1]) + (p4[2] + p4[3])) * (1.0f / 128.f) + 1e-6f);
                    const f32x4 v0 = acc[ai][bj][m][0] * rh * g0, v1 = acc[ai][bj][m][1] * rh * g1;
                    u32x4 w; w.x = pkbf(v0[0], v0[1]); w.y = pkbf(v0[2], v0[3]); w.z = pkbf(v1[0], v1[1]); w.w = pkbf(v1[2], v1[3]);
                    *(u32x4*)(rowp + bj * HALF) = w; } }
    } else {
#pragma unroll
        for (int ai = 0; ai < 2; ++ai)
#pragma unroll
            for (int m = 0; m < 4; ++m) { bf16_t* rowp = O + (size_t)(row0 + ai * HALF + m * 16) * ldc + col0; const float ri = rit[ai][m];
#pragma unroll
                for (int bj = 0; bj < 2; ++bj) { const f32x4 v0 = acc[ai][bj][m][0] * ri, v1 = acc[ai][bj][m][1] * ri;
                    u32x4 w; w.x = pkbf(v0[0], v0[1]); w.y = pkbf(v0[2], v0[3]); w.z = pkbf(v1[0], v1[1]); w.w = pkbf(v1[2], v1[3]);
                    *(u32x4*)(rowp + bj * HALF) = w; } }
    }
}
struct EpiB16 {
    static constexpr bool PERM = true, AFTER_DRAIN = false;
    bf16_t* O; int ldc; RinvCache rc; PG8_LAS float* hnt; PG8_LAS const float* gains; int t0lo, t0hi, t1lo, t1hi;
    __device__ __forceinline__ void operator()(const f32x4 (&acc)[2][2][4][2], const Unit& u, int wr, int wc, int fr, int fq) const {
        const int row0 = u.pm * BM + wr * 64 + fr, col0 = u.pn * BM + wc * 32 + 8 * fq;
        float rit[2][4]; rc.get(rit, u, wr, wc, fr);
        HeadNorm hn{hnt, nullptr};
        if (u.pn >= t0lo && u.pn < t0hi) hn.gain = gains; else if (u.pn >= t1lo && u.pn < t1hi) hn.gain = gains + 128;
        store_b16_tile(acc, O, ldc, row0, col0, rit, hn, wr, wc, fr, fq);
    }
};
struct EpiKV {
    static constexpr bool PERM = true, AFTER_DRAIN = false;
    bf16_t* O; int ldc; float* F; RinvCache rc; PG8_LAS float* hnt; PG8_LAS const float* gains;
    __device__ __forceinline__ void operator()(const f32x4 (&acc)[2][2][4][2], const Unit& u, int wr, int wc, int fr, int fq) const {
        const int row0 = u.pm * BM + wr * 64 + fr;
        float rit[2][4]; rc.get(rit, u, wr, wc, fr);
        if (u.pn < 12) {
            HeadNorm hn{hnt, u.pn < 6 ? gains : nullptr};
            store_b16_tile(acc, O, ldc, row0, u.pn * BM + wc * 32 + 8 * fq, rit, hn, wr, wc, fr, fq);
        } else if (wc == 0 && fq < 2) {
#pragma unroll
            for (int ai = 0; ai < 2; ++ai)
#pragma unroll
                for (int m = 0; m < 4; ++m) { float* rowp = F + (size_t)(row0 + ai * HALF + m * 16) * 16 + 8 * fq; const float ri = rit[ai][m];
                    *(f32x4*)(rowp) = acc[ai][0][m][0] * ri; *(f32x4*)(rowp + 4) = acc[ai][0][m][1] * ri; }
        }
    }
};
struct EpiDummy {
    static constexpr bool PERM = true, AFTER_DRAIN = false;
    bf16_t* O; int ldc;
    __device__ __forceinline__ void operator()(const f32x4 (&acc)[2][2][4][2], const Unit& u, int wr, int wc, int fr, int fq) const {
        const int row0 = u.pm * BM + wr * 64 + fr, col0 = u.pn * BM + wc * 32 + 8 * fq;
#pragma unroll
        for (int ai = 0; ai < 2; ++ai)
#pragma unroll
            for (int m = 0; m < 4; ++m) { bf16_t* rowp = O + (size_t)(row0 + ai * HALF + m * 16) * ldc + col0;
#pragma unroll
                for (int bj = 0; bj < 2; ++bj) { const f32x4 v0 = acc[ai][bj][m][0], v1 = acc[ai][bj][m][1];
                    u32x4 w; w.x = pkbf(v0[0], v0[1]); w.y = pkbf(v0[2], v0[3]); w.z = pkbf(v1[0], v1[1]); w.w = pkbf(v1[2], v1[3]);
                    *(u32x4*)(rowp + bj * HALF) = w; } }
    }
};

struct EpiNull {
    static constexpr bool PERM = true, AFTER_DRAIN = false;
    float* sink;
    __device__ __forceinline__ void operator()(const f32x4 (&acc)[2][2][4][2], const Unit& u, int wr, int wc, int fr, int fq) const {
        f32x4 t = {0.f, 0.f, 0.f, 0.f};
#pragma unroll
        for (int ai = 0; ai < 2; ++ai)
#pragma unroll
            for (int bj = 0; bj < 2; ++bj)
#pragma unroll
                for (int m = 0; m < 4; ++m) { t = t + acc[ai][bj][m][0]; t = t + acc[ai][bj][m][1]; }
        if ((t[0] + t[1]) + (t[2] + t[3]) == 1.2345678e33f) sink[0] = t[0];
    }
};
template <class Epi, class Sched, bool ALIGN_EPI = false, bool SP2 = false>
__device__ __forceinline__ void gemm_phase(PG8_LAS unsigned char* lds, const Gemm g, const Sched& S, const Epi E, const int wave_in) {
    const int tid_l = wave_in * 64 + lane_id_v();
    const int tid = tid_l, wid = wave_in, lane = tid & 63, wr = wid >> 2, wc = wid & 3, fr = lane & 15, fq = lane >> 4;
    const int K = g.K, nt = K / BK;
    unsigned voffA[2], voffB[2];
#pragma unroll
    for (int i = 0; i < 2; ++i) { int R, C; stage_rc(tid * 16 + i * 8192, R, C); const int Rb = Epi::PERM ? ((R & ~31) + perm32(R & 31)) : R;
        voffA[i] = (unsigned)(R * K + C) * 2u; voffB[i] = (unsigned)(Rb * K + C) * 2u; }
    const size_t kstep = (size_t)(BK * 2);
    const size_t hstep = (size_t)HALF * K * 2;
    const size_t tstep = 2 * hstep;
    const unsigned ldsw = (unsigned)wid * 1024u;
    const int aoff = lds_byte(wr * 64 + fr, fq * 8), boff = lds_byte(wc * 32 + fr, fq * 8);
#define PG8_SA(b, h) (((b) * 2 + (h)) * HTB)
#define PG8_SB(b, h) ((4 + (b) * 2 + (h)) * HTB)
#define PG8_STAGE(bufoff, gbase, voff) do { _Pragma("unroll") for (int _i = 0; _i < 2; ++_i) \
        __builtin_amdgcn_global_load_lds((const unsigned*)((const char*)(gbase) + (voff)[_i]), (PG8_LAS unsigned*)(lds + (bufoff) + ldsw + _i * 8192), 16, 0, 0); } while (0)
#define PG8_LDA(dst, b, h) do { _Pragma("unroll") for (int m = 0; m < 4; ++m) _Pragma("unroll") for (int k = 0; k < 2; ++k) dst[m][k] = *(const PG8_LAS bf16x8*)(lds + PG8_SA(b, h) + aoff + m * 2048 + k * 1024); } while (0)
#define PG8_LDB(dst, b, h) do { _Pragma("unroll") for (int n = 0; n < 2; ++n) _Pragma("unroll") for (int k = 0; k < 2; ++k) dst[n][k] = *(const PG8_LAS bf16x8*)(lds + PG8_SB(b, h) + boff + n * 2048 + k * 1024); } while (0)
#define PG8_MMA(ai, bj, At, Bt) do { __builtin_amdgcn_s_setprio(1); _Pragma("unroll") for (int m = 0; m < 4; ++m) _Pragma("unroll") for (int n = 0; n < 2; ++n) _Pragma("unroll") for (int k = 0; k < 2; ++k) \
        acc[ai][bj][m][n] = __builtin_amdgcn_mfma_f32_16x16x32_bf16(Bt[n][k], At[m][k], acc[ai][bj][m][n], 0, 0, 0); __builtin_amdgcn_s_setprio(0); } while (0)
#define PG8_WAIT_V(n) asm volatile("s_waitcnt vmcnt(" #n ")" ::: "memory")
#define PG8_WAIT_L(n) asm volatile("s_waitcnt lgkmcnt(" #n ")" ::: "memory")
#define PG8_BAR __builtin_amdgcn_s_barrier()
#define PG8_SCHED __builtin_amdgcn_sched_barrier(0)
    Unit cur, nxt; int ui = 0;
    if (!S.next(0, cur)) return;
    f32x4 acc[2][2][4][2];
#pragma unroll
    for (int a = 0; a < 2; ++a)
#pragma unroll
        for (int b = 0; b < 2; ++b)
#pragma unroll
            for (int m = 0; m < 4; ++m)
#pragma unroll
                for (int n = 0; n < 2; ++n) acc[a][b][m][n] = (f32x4){0.f, 0.f, 0.f, 0.f};
    bf16x8 At[4][2], B0[2][2], B1[2][2];
    const char* cA = (const char*)g.A + (size_t)cur.pm * tstep; const char* cB = (const char*)g.Bt + (size_t)cur.pn * tstep;
    S.a_ready(cur);
    if constexpr (SP2) {
        PG8_STAGE(PG8_SB(0, 0), cB, voffB); PG8_STAGE(PG8_SB(0, 1), cB + hstep, voffB); PG8_STAGE(PG8_SA(0, 0), cA, voffA); PG8_STAGE(PG8_SA(0, 1), cA + hstep, voffA);
        if (wr == 1) PG8_BAR;
        PG8_WAIT_V(2); PG8_BAR;
        PG8_STAGE(PG8_SB(1, 0), cB + kstep, voffB); PG8_STAGE(PG8_SA(1, 0), cA + kstep, voffA); PG8_STAGE(PG8_SB(1, 1), cB + hstep + kstep, voffB);
        PG8_WAIT_V(6); PG8_BAR;
    } else {
        PG8_STAGE(PG8_SB(0, 0), cB, voffB); PG8_STAGE(PG8_SA(0, 0), cA, voffA); PG8_STAGE(PG8_SB(0, 1), cB + hstep, voffB); PG8_STAGE(PG8_SA(0, 1), cA + hstep, voffA);
        if (wr == 1) PG8_BAR;
        PG8_WAIT_V(4); PG8_BAR;
        PG8_STAGE(PG8_SB(1, 0), cB + kstep, voffB); PG8_STAGE(PG8_SA(1, 0), cA + kstep, voffA); PG8_STAGE(PG8_SB(1, 1), cB + hstep + kstep, voffB);
        PG8_WAIT_V(6); PG8_BAR;
    }
    for (;;) {
        const bool has_next = S.next(ui + 1, nxt);
        const char* nA = has_next ? (const char*)g.A + (size_t)nxt.pm * tstep : cA; const char* nB = has_next ? (const char*)g.Bt + (size_t)nxt.pn * tstep : cB;
        for (int t = 0; t < nt; t += 2) {
            const bool last = (t == nt - 2);
            const char* a1 = cA + (size_t)(t + 1) * kstep;
            const char* a2 = last ? nA : cA + (size_t)(t + 2) * kstep; const char* b2 = last ? nB : cB + (size_t)(t + 2) * kstep;
            const char* a3 = a2 + kstep; const char* b3 = b2 + kstep;
            if (last && has_next) S.a_ready(nxt);
            if constexpr (SP2) {
            PG8_LDB(B0, 0, 0); PG8_LDB(B1, 0, 1); PG8_SCHED; PG8_LDA(At, 0, 0); PG8_STAGE(PG8_SA(1, 1), a1 + hstep, voffA);
            PG8_WAIT_V(8); PG8_WAIT_L(0); PG8_BAR; PG8_MMA(0, 0, At, B0); PG8_MMA(0, 1, At, B1); PG8_BAR; PG8_SCHED;
            PG8_LDA(At, 0, 1); PG8_STAGE(PG8_SB(0, 0), b2, voffB); PG8_STAGE(PG8_SB(0, 1), b2 + hstep, voffB); PG8_STAGE(PG8_SA(0, 0), a2, voffA);
            PG8_WAIT_V(8); PG8_WAIT_L(0); PG8_BAR; PG8_MMA(1, 0, At, B0); PG8_MMA(1, 1, At, B1); PG8_BAR; PG8_SCHED;
            PG8_LDB(B0, 1, 0); PG8_LDB(B1, 1, 1); PG8_SCHED; PG8_LDA(At, 1, 0); PG8_STAGE(PG8_SA(0, 1), a2 + hstep, voffA);
            PG8_WAIT_V(8); PG8_WAIT_L(0); PG8_BAR; PG8_MMA(0, 0, At, B0); PG8_MMA(0, 1, At, B1); PG8_BAR; PG8_SCHED;
            PG8_LDA(At, 1, 1); PG8_STAGE(PG8_SB(1, 0), b3, voffB); PG8_STAGE(PG8_SB(1, 1), b3 + hstep, voffB); PG8_STAGE(PG8_SA(1, 0), a3, voffA);
            PG8_WAIT_V(8); PG8_WAIT_L(0); PG8_BAR; PG8_MMA(1, 0, At, B0); PG8_MMA(1, 1, At, B1); PG8_BAR; PG8_SCHED;
            } else {
            PG8_LDB(B0, 0, 0); PG8_SCHED; PG8_LDA(At, 0, 0); PG8_STAGE(PG8_SA(1, 1), a1 + hstep, voffA);
            PG8_WAIT_L(8); PG8_BAR; PG8_WAIT_L(0); PG8_MMA(0, 0, At, B0); PG8_BAR; PG8_SCHED;
            PG8_LDB(B1, 0, 1); PG8_STAGE(PG8_SB(0, 0), b2, voffB);
            PG8_BAR; PG8_WAIT_L(0); PG8_MMA(0, 1, At, B1); PG8_BAR;
            PG8_LDA(At, 0, 1); PG8_STAGE(PG8_SA(0, 0), a2, voffA);
            PG8_BAR; PG8_WAIT_L(0); PG8_MMA(1, 0, At, B0); PG8_BAR; PG8_SCHED;
            PG8_STAGE(PG8_SB(0, 1), b2 + hstep, voffB);
            PG8_WAIT_V(6); PG8_BAR; PG8_MMA(1, 1, At, B1); PG8_BAR;
            PG8_LDB(B0, 1, 0); PG8_SCHED; PG8_LDA(At, 1, 0); PG8_STAGE(PG8_SA(0, 1), a2 + hstep, voffA);
            PG8_WAIT_L(8); PG8_BAR; PG8_WAIT_L(0); PG8_MMA(0, 0, At, B0); PG8_BAR; PG8_SCHED;
            PG8_LDB(B1, 1, 1); PG8_STAGE(PG8_SB(1, 0), b3, voffB);
            PG8_BAR; PG8_WAIT_L(0); PG8_MMA(0, 1, At, B1); PG8_BAR;
            PG8_LDA(At, 1, 1); PG8_STAGE(PG8_SA(1, 0), a3, voffA);
            PG8_BAR; PG8_WAIT_L(0); PG8_MMA(1, 0, At, B0); PG8_BAR; PG8_SCHED;
            PG8_STAGE(PG8_SB(1, 1), b3 + hstep, voffB);
            PG8_WAIT_V(6); PG8_BAR; PG8_MMA(1, 1, At, B1); PG8_BAR;
            }
        }
        if constexpr (ALIGN_EPI) { if (wr == 0) PG8_BAR; }
        if constexpr (!Epi::AFTER_DRAIN) { E(acc, cur, wr, wc, fr, fq); S.done(cur); }
        if (!has_next) break;
#pragma unroll
        for (int a = 0; a < 2; ++a)
#pragma unroll
            for (int b = 0; b < 2; ++b)
#pragma unroll
                for (int m = 0; m < 4; ++m)
#pragma unroll
                    for (int n = 0; n < 2; ++n) acc[a][b][m][n] = (f32x4){0.f, 0.f, 0.f, 0.f};
        cur = nxt; cA = nA; cB = nB; ++ui;
        if constexpr (ALIGN_EPI) { if (wr == 1) PG8_BAR; }
    }
    PG8_WAIT_V(0);
    if constexpr (!ALIGN_EPI) { if (wr == 0) PG8_BAR; }
    PG8_BAR;
    if constexpr (Epi::AFTER_DRAIN) { E.fused(acc, cur, wr, wc, fr, fq, lds, wid, lane); S.done(cur); }
#undef PG8_SA
#undef PG8_SB
#undef PG8_STAGE
#undef PG8_LDA
#undef PG8_LDB
#undef PG8_MMA
#undef PG8_WAIT_V
#undef PG8_WAIT_L
#undef PG8_BAR
#undef PG8_SCHED
}
}

namespace fa {
constexpr float SCALE = 0.08838834764831845f;
constexpr int D = 128, NW = 8, QBLK = 32, KVBLK = 64, QB = NW * QBLK;
constexpr int SHM_V = KVBLK * D * 2, SHM_K = KVBLK * D * 2;
constexpr int LDS_BYTES = 2 * SHM_V + 2 * SHM_K + NW * 64 * 4;
constexpr float THR = 8.f;
constexpr int EPI_PITCH = 528;
constexpr int OP = 2048;
typedef unsigned short bf16;
typedef short bf16x8 __attribute__((ext_vector_type(8)));
typedef short s16x4 __attribute__((ext_vector_type(4)));
typedef float f32x16 __attribute__((ext_vector_type(16)));
typedef float f32x4 __attribute__((ext_vector_type(4)));
typedef unsigned u32x4 __attribute__((ext_vector_type(4)));

#define KSWZ(row, colB) ((row) * 256 + ((colB) ^ (((row) & 7) << 4)))
#define SBAR() __builtin_amdgcn_sched_barrier(0)
__device__ __forceinline__ int v_st(int k, int c) { const int kk = (k & ~0xC) | ((k & 4) << 1) | ((k & 8) >> 1); return ((kk >> 3) * 4 + (c >> 5)) * 512 + ((kk & 7) * 32 + (c & 31)) * 2; }
__device__ __forceinline__ int v_rd_base(int lane) { return ((lane & 3) << 3) | (((lane >> 2) & 3) << 6) | (((lane >> 4) & 1) << 5) | (((lane >> 5) & 1) << 8); }
constexpr int v_rd_off(int d0, int ks, int half) { return d0 * 512 + ks * 4096 + half * 2048; }
__device__ __forceinline__ int crow(int r, int hi) { return (r & 3) + 8 * (r >> 2) + 4 * hi; }
__device__ __forceinline__ unsigned cvtpk(float lo, float hi) {
    unsigned r; asm volatile("v_cvt_pk_bf16_f32 %0, %1, %2" : "=v"(r) : "v"(lo), "v"(hi)); return r;
}
__device__ __forceinline__ bf16x8 load8(const bf16* p) { return *reinterpret_cast<const bf16x8*>(p); }
__device__ __forceinline__ bf16x8 cb_frag(float c, int hi) {
    const unsigned u1 = __float_as_uint(c) & 0xffff0000u; const float r1 = c - __uint_as_float(u1);
    const unsigned v1 = __float_as_uint(r1) & 0xffff0000u; const float r2 = r1 - __uint_as_float(v1);
    const unsigned w1 = __float_as_uint(r2) & 0xffff0000u;
    u32x4 w = {hi ? 0u : ((u1 >> 16) | v1), hi ? 0u : (w1 >> 16), 0u, 0u};
    return *reinterpret_cast<bf16x8*>(&w);
}
__device__ __forceinline__ int hi_opaque() { return lane_id_v() >> 5; }
__device__ __forceinline__ bf16x8 ones_frag(int hi) { u32x4 w = {hi ? 0u : 0x3F803F80u, hi ? 0u : 0x00003F80u, 0u, 0u}; return *reinterpret_cast<bf16x8*>(&w); }
__device__ __forceinline__ void mask_tile(f32x16& p0, f32x16& p1, int dq, unsigned W) {
    const float NEG = -__builtin_inff();
#pragma unroll
    for (int r = 0; r < 16; ++r) {
        const int c = (r & 3) + 8 * (r >> 2);
        if ((unsigned)(dq - c) >= W) p0[r] = NEG;
        if ((unsigned)(dq - c - 32) >= W) p1[r] = NEG;
    }
}
__device__ __forceinline__ void partialSM(f32x16& p0, f32x16& p1, float& m_reg, float& mn, float& alpha) {
    float pmax = p0[0]; for (int r = 1; r < 16; ++r) pmax = fmaxf(pmax, p0[r]); for (int r = 0; r < 16; ++r) pmax = fmaxf(pmax, p1[r]);
    { auto rr = __builtin_amdgcn_permlane32_swap(__float_as_uint(pmax), __float_as_uint(pmax), false, false);
      pmax = fmaxf(__uint_as_float(rr[0]), __uint_as_float(rr[1])); }
    constexpr float C2 = 1.4426950408889634f * SCALE;
    if (__builtin_expect(__all((pmax - m_reg) * SCALE <= THR), 1)) { mn = m_reg; alpha = 1.f; }
    else { mn = fmaxf(m_reg, pmax); alpha = __builtin_amdgcn_exp2f((m_reg - mn) * C2); m_reg = mn; }
    const float mnL = -mn * C2;
    for (int r = 0; r < 16; ++r) p0[r] = fmaf(p0[r], C2, mnL); for (int r = 0; r < 16; ++r) p1[r] = fmaf(p1[r], C2, mnL);
    for (int r = 0; r < 16; ++r) p0[r] = __builtin_amdgcn_exp2f(p0[r]);
}
__device__ __forceinline__ void finishSM(f32x16& p0, f32x16& p1, float alpha, float& l_reg, bf16x8& pa0, bf16x8& pa1, bf16x8& pa2, bf16x8& pa3) {
    for (int r = 0; r < 16; ++r) p1[r] = __builtin_amdgcn_exp2f(p1[r]);
    float ps = 0; for (int r = 0; r < 16; ++r) ps += p0[r]; for (int r = 0; r < 16; ++r) ps += p1[r];
    { auto rr = __builtin_amdgcn_permlane32_swap(__float_as_uint(ps), __float_as_uint(ps), false, false);
      ps = __uint_as_float(rr[0]) + __uint_as_float(rr[1]); }
    l_reg = l_reg * alpha + ps;
#define PK4(P, B_, OUT) do { unsigned a0 = cvtpk(P[B_+0], P[B_+1]), a1 = cvtpk(P[B_+2], P[B_+3]);                          \
        unsigned b0 = cvtpk(P[B_+4], P[B_+5]), b1 = cvtpk(P[B_+6], P[B_+7]);                                             \
        auto r0 = __builtin_amdgcn_permlane32_swap(a0, b0, false, false); auto r1 = __builtin_amdgcn_permlane32_swap(a1, b1, false, false); \
        u32x4 w = {r0[0], r1[0], r0[1], r1[1]}; OUT = *reinterpret_cast<bf16x8*>(&w); } while (0)
    PK4(p0, 0, pa0); PK4(p0, 8, pa1); PK4(p1, 0, pa2); PK4(p1, 8, pa3);
#undef PK4
}
template <int KB>
__device__ __forceinline__ void qkt(f32x16& p0, f32x16& p1, const char* K_lds, int r32, int hi, const bf16x8* qr, bf16x8 kx0, bf16x8 kx1, bf16x8 qx) {
    p0 = __builtin_amdgcn_mfma_f32_32x32x16_bf16(kx0, qx, f32x16{}, 0, 0, 0);
    p1 = __builtin_amdgcn_mfma_f32_32x32x16_bf16(kx1, qx, f32x16{}, 0, 0, 0);
    const char* kb[4];
#pragma unroll
    for (int dd = 0; dd < 4; ++dd) kb[dd] = K_lds + KB * SHM_K + KSWZ(r32, (dd * 16 + hi * 8) * 2);
#pragma unroll
    for (int d0 = 0; d0 < 8; ++d0) { const char* a = kb[d0 & 3] + (d0 >> 2) * 128;
        bf16x8 b0 = *reinterpret_cast<const bf16x8*>(a);
        bf16x8 b1 = *reinterpret_cast<const bf16x8*>(a + 32 * 256);
        p0 = __builtin_amdgcn_mfma_f32_32x32x16_bf16(b0, qr[d0], p0, 0, 0, 0);
        p1 = __builtin_amdgcn_mfma_f32_32x32x16_bf16(b1, qr[d0], p1, 0, 0, 0); }
}
template <int VB>
__device__ __forceinline__ void pv_tile(f32x16* o, int vb0, bf16x8 pa0, bf16x8 pa1, bf16x8 pa2, bf16x8 pa3) {
#define TRRD(dst, off) asm volatile("ds_read_b64_tr_b16 %0, %1 offset:%2" : "=&v"(dst) : "v"(vb0), "i"(off) : "memory")
#define PV_D0(d0) do { s16x4 l0, l1, l2, l3, h0, h1, h2, h3; constexpr int b_ = VB * SHM_V + v_rd_off(d0, 0, 0);     \
        TRRD(l0, b_); TRRD(h0, b_ + 2048); TRRD(l1, b_ + 4096); TRRD(h1, b_ + 6144); TRRD(l2, b_ + 8192); TRRD(h2, b_ + 10240); TRRD(l3, b_ + 12288); TRRD(h3, b_ + 14336); \
        asm volatile("s_waitcnt lgkmcnt(0)" ::: "memory"); SBAR();                 \
        o[d0] = __builtin_amdgcn_mfma_f32_32x32x16_bf16(pa0, (bf16x8){l0[0], l0[1], l0[2], l0[3], h0[0], h0[1], h0[2], h0[3]}, o[d0], 0, 0, 0);   \
        o[d0] = __builtin_amdgcn_mfma_f32_32x32x16_bf16(pa1, (bf16x8){l1[0], l1[1], l1[2], l1[3], h1[0], h1[1], h1[2], h1[3]}, o[d0], 0, 0, 0);   \
        o[d0] = __builtin_amdgcn_mfma_f32_32x32x16_bf16(pa2, (bf16x8){l2[0], l2[1], l2[2], l2[3], h2[0], h2[1], h2[2], h2[3]}, o[d0], 0, 0, 0);   \
        o[d0] = __builtin_amdgcn_mfma_f32_32x32x16_bf16(pa3, (bf16x8){l3[0], l3[1], l3[2], l3[3], h3[0], h3[1], h3[2], h3[3]}, o[d0], 0, 0, 0); } while (0)
    PV_D0(0); PV_D0(1); PV_D0(2); PV_D0(3);
#undef PV_D0
#undef TRRD
}

struct BlockRef { const bf16* Q; const bf16* K; const bf16* V; bf16* O; const bf16* G; const float* CB; int P0, skv, qp, kp, jlo; };
struct Seam { bf16x8 qr[8]; bf16x8 st_v0, st_v1, st_k0, st_k1; float cb0, cb1; };
#define ROWP(p, k0, rr, pitch) ((p) + (size_t)(k0) * (pitch) + (unsigned)((rr) * (pitch) + sc))
#define VMW() asm volatile("s_waitcnt vmcnt(0)" ::: "memory")
#define VMWN(n) asm volatile("s_waitcnt vmcnt(%0)" :: "i"(n) : "memory")
#define SLOAD_H(Kp, Vp, Cp, k0, pitch) do { S.st_v0 = load8(ROWP(Vp, k0, sr, pitch)); S.st_v1 = load8(ROWP(Vp, k0, 32 + sr, pitch));              \
                         S.st_k0 = load8(ROWP(Kp, k0, sr, pitch)); S.st_k1 = load8(ROWP(Kp, k0, 32 + sr, pitch));                                    \
                         S.cb0 = (Cp) ? (Cp)[(k0) + r32] : 0.f; S.cb1 = (Cp) ? (Cp)[(k0) + 32 + r32] : 0.f; } while (0)
#define SWRITE_HK(bf) do { *(bf16x8*)(K_lds + (bf) * SHM_K + kws) = S.st_k0; *(bf16x8*)(K_lds + (bf) * SHM_K + kws + 32 * 256) = S.st_k1; } while (0)
#define SWRITE_HV(bf) do { *(bf16x8*)(V_lds + (bf) * SHM_V + vst0) = S.st_v0; *(bf16x8*)(V_lds + (bf) * SHM_V + vst1) = S.st_v1; } while (0)
#define SWRITE_H(bf) do { SWRITE_HV(bf); SWRITE_HK(bf); } while (0)
__device__ __forceinline__ void attn_prime(const BlockRef& cur, char* lds, Seam& S, const int wave_in) {
    const int tid = wave_in * 64 + lane_id_v(), wid = wave_in, lane = tid & 63, r32 = lane & 31, hi = lane >> 5;
    const int sr = tid >> 4, sc = (tid & 15) * 8, kws = KSWZ(sr, sc * 2); char* K_lds = lds + 2 * SHM_V;
#pragma unroll
    for (int d0 = 0; d0 < 8; ++d0) S.qr[d0] = load8(cur.Q + (size_t)(wid * QBLK + r32) * cur.qp + d0 * 16 + hi * 8);
    SLOAD_H(cur.K, cur.V, cur.CB, cur.jlo * KVBLK, cur.kp); VMW(); SWRITE_HK(0);
    __syncthreads();
}
__device__ __forceinline__ void attn_block(const BlockRef& cur, const BlockRef& nxt, char* lds, Seam& S, const int wave_in) {
    const int tid = wave_in * 64 + lane_id_v(), wid = wave_in, lane = tid & 63, r32 = lane & 31, hi = lane >> 5;
    constexpr int W = 1 << 30;
    int j_hi = (cur.P0 + QB - 1) / KVBLK + 1; if (j_hi > cur.skv / KVBLK) j_hi = cur.skv / KVBLK;
    const int j_lo = cur.jlo; const int NT = j_hi - j_lo;
    const int qlo = cur.P0 + wid * QBLK, qm = qlo + r32 - 4 * hi;
    char* V_lds = lds; char* K_lds = lds + 2 * SHM_V;
    float* ws = (float*)(lds + 2 * SHM_V + 2 * SHM_K) + wid * 64; float* li_l = ws, * al_l = ws + 32;
    float m_reg = -1e30f, l_reg = 0; f32x16 o[4] = {};
    const int sr = tid >> 4, sc = (tid & 15) * 8, vst0 = v_st(sr, sc), vst1 = v_st(32 + sr, sc), kws = KSWZ(sr, sc * 2);
    const int vb0 = (int)(uintptr_t)V_lds + v_rd_base(lane);
    const bf16* Kh = cur.K; const bf16* Vh = cur.V; const float* Ch = cur.CB; const int KP = cur.kp;
#define QX() ones_frag(hi_opaque())
#define RESC(a) do { if (__any((a) < 1.f)) { if (hi == 0) al_l[r32] = (a); asm volatile("s_waitcnt lgkmcnt(0)" ::: "memory");              \
                     for (int d_ = 0; d_ < 4; ++d_) for (int r = 0; r < 16; ++r) o[d_][r] *= al_l[crow(r, hi)]; } } while (0)
#define KBASE(t) ((j_lo + (t)) * KVBLK)
#define MASKT(P0_, P1_, t) do { const int kb_ = KBASE(t); if (kb_ + KVBLK - 1 > qlo) mask_tile(P0_, P1_, qm - kb_, (unsigned)W); } while (0)
#define SEAM_K0() do { VMWN(8); SWRITE_HK(0); SBAR(); } while (0)
    f32x16 pA0, pA1, pB0, pB1; float mnA, mnB, alA, alB; bf16x8 pa0, pa1, pa2, pa3; bf16x8 kx0, kx1;
    SWRITE_HV(0); SBAR();
    kx0 = cb_frag(S.cb0, hi); kx1 = cb_frag(S.cb1, hi);
    if (NT > 1) SLOAD_H(Kh, Vh, Ch, KBASE(1), KP);
    SBAR(); qkt<0>(pA0, pA1, K_lds, r32, hi, S.qr, kx0, kx1, QX());
    MASKT(pA0, pA1, 0); partialSM(pA0, pA1, m_reg, mnA, alA);
    if (NT > 1) { VMW(); SWRITE_H(1); }
    __syncthreads();
#define HALF_STEP(PX0, PX1, mnX, alX, PY0, PY1, alY, t, KB, VB, SB) do {                                                      \
        SBAR(); kx0 = cb_frag(S.cb0, hi); kx1 = cb_frag(S.cb1, hi);                                                           \
        qkt<KB>(PX0, PX1, K_lds, r32, hi, S.qr, kx0, kx1, QX());                                                                \
        finishSM(PY0, PY1, alY, l_reg, pa0, pa1, pa2, pa3); SBAR();                                                           \
        if ((t) + 1 < NT) { SLOAD_H(Kh, Vh, Ch, KBASE((t) + 1), KP); SBAR(); }                                                \
        pv_tile<VB>(o, vb0, pa0, pa1, pa2, pa3); MASKT(PX0, PX1, (t)); partialSM(PX0, PX1, m_reg, mnX, alX);                  \
        __syncthreads();                                                                                                      \
        if ((t) + 1 < NT) { VMW(); SWRITE_H(SB); }                                                                            \
        RESC(alX); __syncthreads(); } while (0)
    for (int t = 1; t + 1 < NT; t += 2) {
        HALF_STEP(pB0, pB1, mnB, alB, pA0, pA1, alA, t, 1, 0, 0);
        HALF_STEP(pA0, pA1, mnA, alA, pB0, pB1, alB, t + 1, 0, 1, 1);
    }
    const bool even = (NT & 1) == 0;
    if (even) { SBAR(); kx0 = cb_frag(S.cb0, hi); kx1 = cb_frag(S.cb1, hi); qkt<1>(pB0, pB1, K_lds, r32, hi, S.qr, kx0, kx1, QX()); SBAR(); }
    SLOAD_H(nxt.K, nxt.V, nxt.CB, nxt.jlo * KVBLK, nxt.kp); SBAR();
#pragma unroll
    for (int d0 = 0; d0 < 8; ++d0) S.qr[d0] = load8(nxt.Q + (size_t)(wid * QBLK + r32) * nxt.qp + d0 * 16 + hi * 8);
    SBAR();
    finishSM(pA0, pA1, alA, l_reg, pa0, pa1, pa2, pa3); SBAR();
    pv_tile<0>(o, vb0, pa0, pa1, pa2, pa3);
    if (even) { MASKT(pB0, pB1, NT - 1); partialSM(pB0, pB1, m_reg, mnB, alB); __syncthreads(); RESC(alB);
        finishSM(pB0, pB1, alB, l_reg, pa0, pa1, pa2, pa3); SBAR(); pv_tile<1>(o, vb0, pa0, pa1, pa2, pa3); }
    SBAR(); SEAM_K0();
    if (hi == 0) li_l[r32] = l_reg; asm volatile("s_waitcnt lgkmcnt(0)" ::: "memory");
    float rli[16];
#pragma unroll
    for (int r = 0; r < 16; ++r) rli[r] = __builtin_amdgcn_rcpf(li_l[crow(r, hi)]);
    bf16* Ow = cur.O + (size_t)(wid * QBLK) * OP;
    const bf16* Gw = cur.G ? cur.G + (size_t)(wid * QBLK) * cur.qp : nullptr; const int GP = cur.qp;
    char* stg = lds + LDS_BYTES + wid * (8 * EPI_PITCH);
    const int erow = lane >> 4, egrp = lane & 15;
    u32x4 gq[8];
    if (Gw) {
#pragma unroll
        for (int i = 0; i < 8; ++i) gq[i] = *(const u32x4*)(Gw + (size_t)(8 * (i >> 1) + 4 * (i & 1) + erow) * GP + egrp * 8); }
#pragma unroll
    for (int p = 0; p < 4; ++p) {
#pragma unroll
        for (int rr = 0; rr < 4; ++rr)
#pragma unroll
            for (int d0 = 0; d0 < 4; ++d0) *(float*)(stg + (rr + 4 * hi) * EPI_PITCH + (d0 * 32 + r32) * 4) = o[d0][4 * p + rr] * rli[4 * p + rr];
        asm volatile("s_waitcnt lgkmcnt(0)" ::: "memory");
#pragma unroll
        for (int i = 0; i < 2; ++i) { const int row = erow + 4 * i;
            f32x4 va = *(const f32x4*)(stg + row * EPI_PITCH + egrp * 32), vb = *(const f32x4*)(stg + row * EPI_PITCH + egrp * 32 + 16);
            if (Gw) { const u32x4 g = gq[2 * p + i];
#pragma unroll
                for (int j = 0; j < 4; ++j) { const unsigned gw_ = j == 0 ? g.x : j == 1 ? g.y : j == 2 ? g.z : g.w;
                    const float g0 = __uint_as_float(gw_ << 16), g1 = __uint_as_float(gw_ & 0xffff0000u);
                    const float s0 = __builtin_amdgcn_rcpf(1.0f + __builtin_amdgcn_exp2f(-1.4426950408889634f * g0)), s1 = __builtin_amdgcn_rcpf(1.0f + __builtin_amdgcn_exp2f(-1.4426950408889634f * g1));
                    if (j < 2) { va[2 * j] *= s0; va[2 * j + 1] *= s1; } else { vb[2 * j - 4] *= s0; vb[2 * j - 3] *= s1; } } }
            u32x4 w; w.x = cvtpk(va[0], va[1]); w.y = cvtpk(va[2], va[3]); w.z = cvtpk(vb[0], vb[1]); w.w = cvtpk(vb[2], vb[3]);
            *(u32x4*)(Ow + (size_t)(8 * p + row) * OP + egrp * 8) = w; }
    }
    __syncthreads();
#undef QX
#undef RESC
#undef KBASE
#undef MASKT
#undef SEAM_K0
#undef HALF_STEP
}
#undef ROWP
#undef VMW
#undef VMWN
#undef SLOAD_H
#undef SWRITE_HK
#undef SWRITE_HV
#undef SWRITE_H
#undef KSWZ
#undef SBAR
}

constexpr int NWAVES = 8;
#ifndef MK_PER_PHASE
#define MK_PER_PHASE 0
#endif
#ifndef MK_STOP_PC
#define MK_STOP_PC 1000
#endif
#ifndef REP_CVT
#define REP_CVT 1
#endif
#ifndef REP_MEMG
#define REP_MEMG 1
#endif
#ifndef REP_NORM
#define REP_NORM 1
#endif
#ifndef REP_KVG
#define REP_KVG 1
#endif
#ifndef REP_UP
#define REP_UP 1
#endif
#ifndef REP_DN
#define REP_DN 1
#endif
#ifndef REP_IN
#define REP_IN 1
#endif
#ifndef REP_PREP
#define REP_PREP 1
#endif
#ifndef REP_SCAN
#define REP_SCAN 1
#endif
#ifndef REP_ATT
#define REP_ATT 1
#endif
#ifndef REP_OUT
#define REP_OUT 1
#endif
#ifndef REP_POST
#define REP_POST 1
#endif
#ifndef REP_CUM
#define REP_CUM 1
#endif
#ifndef REP_HNFAKE
#define REP_HNFAKE 0
#endif
#ifndef UP_STAGGER_US
#define UP_STAGGER_US 0
#endif
#ifndef UP_ALIGN
#define UP_ALIGN true
#endif
#ifndef DN_STAGGER_US
#define DN_STAGGER_US 0
#endif
#ifndef GEMM_SP2
#define GEMM_SP2 true
#endif
#ifndef SEG_N
#define SEG_N 5
#endif
#ifndef SEG_LEN
#define SEG_LEN 13
#endif
#ifndef SCAN_WG
#define SCAN_WG 1
#endif
#ifndef FOX_SKIP
#define FOX_SKIP 1
#endif
#ifndef FFN_SPLIT
#define FFN_SPLIT 1
#endif
constexpr int NPH = 21 + 16 * FFN_SPLIT;

constexpr int BATCH = 8, SEQ = 4096, DM = 2048, M = BATCH * SEQ, FF = 5632, NUP = 2 * FF, DEPTH = 4;
constexpr int NA = 5376, NB = 3584, NKV = 3328, NMEMW = 4096;
constexpr int A_Q = 0, A_K = 768, A_V = 1536, A_G = 3072, A_QM = 4608, A_LR = 5120;
constexpr int B_Q = 0, B_G = 1536, B_QM = 3072;
constexpr int MEMT = 256, MROWS = BATCH * MEMT;
constexpr float EPS = 1e-6f;

constexpr size_t MiB = 1u << 20;
constexpr size_t WS_CTL = 0, CTL_ZERO_BYTES = 1 * MiB;
constexpr size_t WS_CB = 1 * MiB, WS_F = 3 * MiB, WS_ACH = 5 * MiB, WS_DSEG = 7 * MiB, WS_MEMB = 8 * MiB, WS_MKVF = 16 * MiB, WS_MK = 48 * MiB, WS_MV = 56 * MiB;
constexpr size_t WS_WUP = 64 * MiB, WS_WDN = 416 * MiB, WS_WAIN = 592 * MiB, WS_WBIN = 638 * MiB, WS_WOUT = 666 * MiB, WS_WKV = 698 * MiB, WS_WMEM = 711 * MiB;
constexpr size_t WS_HMIX = 728 * MiB, WS_ACT = 856 * MiB, WS_KDT = 1224 * MiB, WS_VT = 1272 * MiB, WS_OG = 1368 * MiB, WS_KSVS = 1224 * MiB, WS_FST = 1464 * MiB, WS_QF = 1528 * MiB, WS_XB2 = 1416 * MiB, WS_SS = 1576 * MiB, WS_END = 1580 * MiB;
constexpr size_t SS_BYTES = (size_t)13 * M * 8;
static_assert(WS_WUP + 8 * (size_t)NUP * DM * 2 <= WS_WDN && WS_WDN + 8 * (size_t)DM * FF * 2 <= WS_WAIN && WS_WAIN + 2 * (size_t)NA * DM * 2 <= WS_WBIN && WS_WBIN + 2 * (size_t)NB * DM * 2 <= WS_WOUT &&
              WS_WOUT + 4 * (size_t)DM * DM * 2 <= WS_WKV && WS_WKV + (size_t)NKV * DM * 2 <= WS_WMEM && WS_WMEM + (size_t)NMEMW * DM * 2 <= WS_HMIX && WS_HMIX + (size_t)M * DM * 2 <= WS_ACT &&
              WS_ACT + (size_t)M * NA * 2 <= WS_KDT && WS_KDT + (size_t)2048 * 192 * 64 * 2 <= WS_VT && WS_VT + (size_t)2048 * 384 * 64 * 2 <= WS_OG && WS_OG + (size_t)M * 1536 * 2 <= WS_FST && WS_FST + (size_t)384 * 7 * 24 * 64 * 16 <= WS_QF && WS_QF + (size_t)2048 * 192 * 64 * 2 <= WS_SS && WS_SS + SS_BYTES <= WS_END && WS_XB2 >= WS_KSVS + (size_t)M * 3072 * 2 && WS_XB2 + (size_t)M * DM * 2 <= WS_SS &&
              WS_KSVS + (size_t)M * 3072 * 2 <= WS_END && WS_MKVF + (size_t)MROWS * NMEMW * 4 <= WS_MK && WS_MEMB + (size_t)MROWS * DM * 2 <= WS_MKVF, "d_ws map");
constexpr int CW_TMO = 0, CW_BAR = 4096, CW_QUE = 16384  ;
constexpr int RING_BYTES = 131072, LDSCTL_OFF = RING_BYTES, MISC_OFF = LDSCTL_OFF + 320, RTAB_OFF = LDSCTL_OFF + 1024  , HNT_OFF = LDSCTL_OFF + 5120  , GAIN_OFF = LDSCTL_OFF + 13312  , LDS_BYTES = 147456;

#define GAS __attribute__((address_space(1)))
#define LAS __attribute__((address_space(3)))
typedef unsigned short bf16;
typedef unsigned v4u __attribute__((ext_vector_type(4)));
typedef float f32x4 __attribute__((ext_vector_type(4)));
typedef float f32x16 __attribute__((ext_vector_type(16)));
typedef short bf16x8 __attribute__((ext_vector_type(8)));
typedef GAS unsigned gu32;
#define RLX_AGENT __ATOMIC_RELAXED, __HIP_MEMORY_SCOPE_AGENT
#define LDS_WAIT() asm volatile("s_waitcnt lgkmcnt(0)" ::: "memory")
using pg8::pkbf;
__device__ __forceinline__ float bf_lo(unsigned w) { return __uint_as_float(w << 16); }
__device__ __forceinline__ float bf_hi(unsigned w) { return __uint_as_float(w & 0xffff0000u); }
__device__ __forceinline__ float bf2f(bf16 b) { return __uint_as_float(((unsigned)b) << 16); }
__device__ __forceinline__ float logsig(float x) { return fminf(x, 0.f) - 0.6931471805599453f * __builtin_amdgcn_logf(1.0f + __builtin_amdgcn_exp2f(-1.4426950408889634f * fabsf(x))); }
#define XCH1(v)  __uint_as_float((unsigned)__builtin_amdgcn_update_dpp(0, (int)__float_as_uint(v), 0xB1, 0xF, 0xF, true))
#define XCH2(v)  __uint_as_float((unsigned)__builtin_amdgcn_update_dpp(0, (int)__float_as_uint(v), 0x4E, 0xF, 0xF, true))
#define XCH4(v)  __uint_as_float((unsigned)__builtin_amdgcn_ds_swizzle((int)__float_as_uint(v), (4 << 10) | 0x1f))
#define XCH8(v)  __uint_as_float((unsigned)__builtin_amdgcn_ds_swizzle((int)__float_as_uint(v), (8 << 10) | 0x1f))
#define XCH16(v) __uint_as_float((unsigned)__builtin_amdgcn_ds_swizzle((int)__float_as_uint(v), (16 << 10) | 0x1f))
__device__ __forceinline__ float wave_sum(float v) {
    v += XCH1(v); v += XCH2(v); v += XCH4(v); v += XCH8(v); v += XCH16(v);
    const auto rr = __builtin_amdgcn_permlane32_swap(__float_as_uint(v), __float_as_uint(v), false, false);
    return __uint_as_float(rr[0]) + __uint_as_float(rr[1]);
}
__device__ __forceinline__ float wave_max(float v) {
    v = fmaxf(v, XCH1(v)); v = fmaxf(v, XCH2(v)); v = fmaxf(v, XCH4(v)); v = fmaxf(v, XCH8(v)); v = fmaxf(v, XCH16(v));
    const auto rr = __builtin_amdgcn_permlane32_swap(__float_as_uint(v), __float_as_uint(v), false, false);
    return fmaxf(__uint_as_float(rr[0]), __uint_as_float(rr[1]));
}
__device__ __forceinline__ int launder_s(int v) { asm volatile("" : "+s"(v)); return v; }

#define XB_TMO      128
#define XB_XCNT(j)  (256  + 64 * (j))
#define XB_XSUB(j)  (1280 + 64 * (j))
#define XB_XGEN(j)  (2304 + 64 * (j))
#define XB_TOP      3328
#define XB_TOPGEN   3392
#define XCD_BAR_WORDS 3456
#define XB_SPIN_CAP (1u << 18)
__device__ __forceinline__ unsigned xb_ld(unsigned* p)              { return __hip_atomic_load(p, __ATOMIC_RELAXED, __HIP_MEMORY_SCOPE_AGENT); }
__device__ __forceinline__ unsigned xb_add(unsigned* p, unsigned v) { return __hip_atomic_fetch_add(p, v, __ATOMIC_RELAXED, __HIP_MEMORY_SCOPE_AGENT); }
__device__ __forceinline__ unsigned xb_xcc_id() { return (unsigned)__builtin_amdgcn_s_getreg((3 << 11) | 20) & 0xFu; }
#define XB_SPIN(cond, bar) do { unsigned _sp = 0; while (cond) { __builtin_amdgcn_s_sleep(1); \
    if ((++_sp & 255u) == 0u) { if (xb_ld(&(bar)[XB_TMO])) break; if (_sp > XB_SPIN_CAP) { atomicAdd(&(bar)[XB_TMO], 1u); break; } } } } while (0)
struct XcdBarrier { unsigned* bar; unsigned x; volatile LAS unsigned* st; int wave; };
__device__ __forceinline__ XcdBarrier xcd_barrier_post(unsigned* bar, volatile LAS unsigned* st, int wave) {
    XcdBarrier b; b.bar = bar; b.x = xb_xcc_id(); b.st = st; b.wave = wave;
    if (threadIdx.x == 0) (void)xb_add(&bar[XB_XCNT(b.x)], 1u);
    return b;
}
__device__ __forceinline__ void xcd_barrier_complete(unsigned* bar, unsigned x, unsigned& nloc, unsigned& nx) {
    const unsigned G = gridDim.x * gridDim.y * gridDim.z;
    unsigned sum, cnt, mine, sp = 0u;
    for (;;) {
        sum = 0u; cnt = 0u; mine = 0u;
#pragma unroll
        for (unsigned j = 0; j < 16; ++j) { const unsigned c = xb_ld(&bar[XB_XCNT(j)]); sum += c; cnt += (c > 0u) ? 1u : 0u; mine = (j == x) ? c : mine; }
        if (sum == G) break;
        __builtin_amdgcn_s_sleep(1);
        if ((++sp & 255u) == 0u) { if (xb_ld(&bar[XB_TMO])) break; if (sp > XB_SPIN_CAP) { atomicAdd(&bar[XB_TMO], 1u); break; } }
    }
    nloc = mine > 0u ? mine : 1u; nx = cnt > 0u ? cnt : 1u;
}
__device__ __forceinline__ void xcd_barrier(const XcdBarrier& b) {
    asm volatile("s_waitcnt vmcnt(0)" ::: "memory");
    __syncthreads();
    if (b.wave == 0 && lane_id_v() == 0) {
        unsigned* bar = b.bar;
        __builtin_amdgcn_s_waitcnt(0);
        unsigned nloc = b.st[0], nx = b.st[1];
        if (nloc == 0u) { xcd_barrier_complete(bar, b.x, nloc, nx); b.st[0] = nloc; b.st[1] = nx; }
        const unsigned old = xb_add(&bar[XB_XSUB(b.x)], 1u);
        const unsigned gen = old / nloc;
        if (old + 1u == (gen + 1u) * nloc) {
            __builtin_amdgcn_fence(__ATOMIC_RELEASE, "agent");
            asm volatile("s_waitcnt vmcnt(0)" ::: "memory");
            const unsigned og = xb_add(&bar[XB_TOP], 1u);
            const unsigned tg = og / nx;
            if (og + 1u == (tg + 1u) * nx) xb_add(&bar[XB_TOPGEN], 1u);
            else XB_SPIN(xb_ld(&bar[XB_TOPGEN]) == tg, bar);
            __builtin_amdgcn_fence(__ATOMIC_ACQUIRE, "agent");
            xb_add(&bar[XB_XGEN(b.x)], 1u);
            asm volatile("s_waitcnt vmcnt(0)" ::: "memory");
        } else {
            XB_SPIN(xb_ld(&bar[XB_XGEN(b.x)]) == gen, bar);
            __builtin_amdgcn_fence(__ATOMIC_ACQUIRE, "agent");
            asm volatile("s_waitcnt vmcnt(0)" ::: "memory");
        }
    }
    __syncthreads();
}

__device__ __forceinline__ const float* ldp(volatile LAS unsigned* T, int k) { const unsigned lo = __builtin_amdgcn_readfirstlane(T[2 * k]), hi = __builtin_amdgcn_readfirstlane(T[2 * k + 1]); return (const float*)(const GAS float*)(((unsigned long long)hi << 32) | lo); }
__device__ __forceinline__ int launder(int v) { asm volatile("" : "+v"(v)); return v; }
__device__ __forceinline__ int lane_id() { return lane_id_v(); }
__device__ __forceinline__ void cvt_item(const float* W, int ldw, int srccol, const float* gain, float scale, bf16* Bt, int K, int dstrow, int k0, LAS float* scr, int lane) {
    float v[32], g[32];
    const float* src = W + (size_t)(k0 + (lane >> 5)) * ldw + srccol + (lane & 31);
#pragma unroll
    for (int i = 0; i < 32; ++i) v[i] = src[(size_t)(2 * i) * ldw];
#pragma unroll
    for (int i = 0; i < 32; ++i) g[i] = gain ? gain[k0 + 2 * i + (lane >> 5)] * scale : scale;
#pragma unroll
    for (int i = 0; i < 32; ++i) scr[(2 * i + (lane >> 5)) * 33 + (lane & 31)] = v[i] * g[i];
    LDS_WAIT();
    const int c = lane & 7;
#pragma unroll
    for (int j = 0; j < 4; ++j) { const int n = (lane >> 3) + 8 * j; const LAS float* s = scr + (8 * c) * 33 + n;
        v4u o; o.x = pkbf(s[0 * 33], s[1 * 33]); o.y = pkbf(s[2 * 33], s[3 * 33]); o.z = pkbf(s[4 * 33], s[5 * 33]); o.w = pkbf(s[6 * 33], s[7 * 33]);
        *(v4u*)(Bt + (size_t)(dstrow + n) * K + k0 + 8 * c) = o; }
    LDS_WAIT();
}
__device__ __forceinline__ void rms_row_to_bf16(const float* xrow, bf16* orow, int lane) {
    const f32x4* xr = (const f32x4*)xrow + lane;
    f32x4 v[8]; float s = 0.f;
#pragma unroll
    for (int j = 0; j < 8; ++j) { v[j] = xr[64 * j]; s += (v[j].x * v[j].x + v[j].y * v[j].y) + (v[j].z * v[j].z + v[j].w * v[j].w); }
    const float rinv = 1.0f / sqrtf(wave_sum(s) * (1.0f / DM) + EPS);
    unsigned long long* o8 = (unsigned long long*)orow + lane;
#pragma unroll
    for (int j = 0; j < 8; ++j) o8[64 * j] = (unsigned long long)pkbf(v[j].x * rinv, v[j].y * rinv) | ((unsigned long long)pkbf(v[j].z * rinv, v[j].w * rinv) << 32);
}
__device__ __forceinline__ void xb_row(const float* xrow, bf16* orow, float* ssrow, int lane) {
    const f32x4* xr = (const f32x4*)xrow + lane;
    f32x4 v[8]; float s = 0.f;
#pragma unroll
    for (int j = 0; j < 8; ++j) { v[j] = xr[64 * j]; s += (v[j].x * v[j].x + v[j].y * v[j].y) + (v[j].z * v[j].z + v[j].w * v[j].w); }
    s = wave_sum(s);
    if (lane == 0) *(unsigned long long*)ssrow = (unsigned long long)(s * 16777216.0f);
    unsigned long long* o8 = (unsigned long long*)orow + lane;
#pragma unroll
    for (int j = 0; j < 8; ++j) o8[64 * j] = (unsigned long long)pkbf(v[j].x, v[j].y) | ((unsigned long long)pkbf(v[j].z, v[j].w) << 32);
}
__device__ __forceinline__ void load_gains(LAS unsigned char* lds, const float* g0, const float* g1, int wave, int lane) {
    LAS float* G = (LAS float*)(lds + GAIN_OFF);
    if (wave < 2) { G[wave * 64 + lane] = g0[wave * 64 + lane]; G[128 + wave * 64 + lane] = g1[wave * 64 + lane]; }
    __syncthreads();
}
struct InPtrs { const float *x, *mem, *ffn_norm, *w1, *w3, *w2, *mix_norm, *mem_norm, *w_mem_kv, *mem_q_norm, *mem_k_norm, *w_out, *a_w_in, *a_w_gate_up, *a_b_gate, *a_out_norm, *b_w_in, *b_q_norm, *kv_norm, *w_kv, *b_f, *k_norm; };

__device__ __forceinline__ void convert_phase(volatile LAS unsigned* PT, unsigned char* ws, float* xout, LAS unsigned char* lds, int gw, int NGW, int lane, int wave) {
    InPtrs I;
    I.x = ldp(PT, 0); I.mem = ldp(PT, 1); I.ffn_norm = ldp(PT, 2); I.w1 = ldp(PT, 3); I.w3 = ldp(PT, 4); I.w2 = ldp(PT, 5); I.mix_norm = ldp(PT, 6); I.mem_norm = ldp(PT, 7);
    I.w_mem_kv = ldp(PT, 8); I.mem_q_norm = ldp(PT, 9); I.mem_k_norm = ldp(PT, 10); I.w_out = ldp(PT, 11); I.a_w_in = ldp(PT, 12); I.a_w_gate_up = ldp(PT, 13); I.a_b_gate = ldp(PT, 14);
    I.a_out_norm = ldp(PT, 15); I.b_w_in = ldp(PT, 16); I.b_q_norm = ldp(PT, 17); I.kv_norm = ldp(PT, 18); I.w_kv = ldp(PT, 19); I.b_f = ldp(PT, 20); I.k_norm = ldp(PT, 21);
    LAS float* scr = (LAS float*)(lds + wave * 16384);
    bf16* WUP = (bf16*)(ws + WS_WUP); bf16* WDN = (bf16*)(ws + WS_WDN); bf16* WAIN = (bf16*)(ws + WS_WAIN); bf16* WBIN = (bf16*)(ws + WS_WBIN);
    bf16* WOUT = (bf16*)(ws + WS_WOUT); bf16* WKV = (bf16*)(ws + WS_WKV); bf16* WMEM = (bf16*)(ws + WS_WMEM);
    constexpr int IT_W1 = 8 * 32 * 176, IT_W2 = 8 * 88 * 64, IT_A = 2 * 32 * 160, IT_B = 2 * 32 * 112, IT_O = 4 * 32 * 64, IT_KV = 32 * 96, IT_MEM = 4 * 32 * 32;
    constexpr int IT_TOTAL = 2 * IT_W1 + IT_W2 + IT_A + IT_B + IT_O + IT_KV + IT_MEM;
    for (int it = gw; it < IT_TOTAL; it += NGW) {
        int r = it;
        if (r < 2 * IT_W1) { const int which = r / IT_W1; r -= which * IT_W1; const int mat = r / (32 * 176); r -= mat * (32 * 176); const int kb = r / 176, nb = r % 176; const int j0 = 32 * nb;
            cvt_item((which ? I.w3 : I.w1) + (size_t)mat * DM * FF, FF, j0, I.ffn_norm + mat * DM, 1.f, WUP + (size_t)mat * NUP * DM, DM, 256 * (j0 / 128) + which * 128 + (j0 % 128), 64 * kb, scr, lane); continue; }
        r -= 2 * IT_W1;
        if (r < IT_W2) { const int mat = r / (88 * 64); r -= mat * (88 * 64); const int kb = r / 64, nb = r % 64;
            cvt_item(I.w2 + (size_t)mat * FF * DM, DM, 32 * nb, nullptr, 1.f, WDN + (size_t)mat * DM * FF, FF, 32 * nb, 64 * kb, scr, lane); continue; }
        r -= IT_W2;
        if (r < IT_A) { const int l = r / (32 * 160); r -= l * (32 * 160); const int kb = r / 160, nb = r % 160; const int n0 = 32 * nb;
            cvt_item(I.a_w_in + (size_t)l * DM * 5136, 5136, n0 < 3072 ? n0 : n0 + 16, I.mix_norm + l * DM, n0 < 768 ? 0.07216878364870322f : 1.f, WAIN + (size_t)l * NA * DM, DM, n0, 64 * kb, scr, lane); continue; }
        r -= IT_A;
        if (r < IT_B) { const int j = r / (32 * 112); r -= j * (32 * 112); const int kb = r / 112, nb = r % 112;
            cvt_item(I.b_w_in + (size_t)j * DM * NB, NB, 32 * nb, I.mix_norm + (2 + j) * DM, 1.f, WBIN + (size_t)j * NB * DM, DM, 32 * nb, 64 * kb, scr, lane); continue; }
        r -= IT_B;
        if (r < IT_O) { const int l = r / (32 * 64); r -= l * (32 * 64); const int kb = r / 64, nb = r % 64;
            cvt_item(I.w_out + (size_t)l * DM * DM, DM, 32 * nb, nullptr, 1.f, WOUT + (size_t)l * DM * DM, DM, 32 * nb, 64 * kb, scr, lane); continue; }
        r -= IT_O;
        if (r < IT_KV) { const int kb = r / 96, nb = r % 96;
            cvt_item(I.w_kv, 3084, 32 * nb, I.kv_norm, 1.f, WKV, DM, 32 * nb, 64 * kb, scr, lane); continue; }
        r -= IT_KV;
        { const int l = r / (32 * 32); r -= l * (32 * 32); const int kb = r / 32, nb = r % 32;
            cvt_item(I.w_mem_kv + (size_t)l * DM * 1024, 1024, 32 * nb, I.mem_norm + l * DM, 1.f, WMEM, DM, l * 1024 + 32 * nb, 64 * kb, scr, lane); }
    }
    const int gtid = gw * 64 + lane, NT = NGW * 64;
    for (int idx = gtid; idx < 2 * 256 * 256; idx += NT) { const int l = idx >> 16, n = (idx >> 8) & 255, k0 = (idx & 255) * 8;
        float a[8];
#pragma unroll
        for (int j = 0; j < 8; ++j) a[j] = (n < 16) ? I.a_w_in[(size_t)l * DM * 5136 + (size_t)(k0 + j) * 5136 + 3072 + n] * I.mix_norm[l * DM + k0 + j] : 0.f;
        v4u o; o.x = pkbf(a[0], a[1]); o.y = pkbf(a[2], a[3]); o.z = pkbf(a[4], a[5]); o.w = pkbf(a[6], a[7]);
        *(v4u*)(WAIN + (size_t)l * NA * DM + (size_t)(A_LR + n) * DM + k0) = o; }
    for (int idx = gtid; idx < 256 * 256; idx += NT) { const int n = idx >> 8, k0 = (idx & 255) * 8;
        float a[8];
#pragma unroll
        for (int j = 0; j < 8; ++j) a[j] = (n < 12) ? I.w_kv[(size_t)(k0 + j) * 3084 + 3072 + n] * I.kv_norm[k0 + j] : 0.f;
        v4u o; o.x = pkbf(a[0], a[1]); o.y = pkbf(a[2], a[3]); o.z = pkbf(a[4], a[5]); o.w = pkbf(a[6], a[7]);
        *(v4u*)(WKV + (size_t)(3072 + n) * DM + k0) = o; }
    for (int m = gw; m < MROWS; m += NGW) rms_row_to_bf16(I.mem + (size_t)m * DM, (bf16*)(ws + WS_MEMB) + (size_t)m * DM, lane);
    for (int m = gw; m < M; m += NGW) xb_row(I.x + (size_t)m * DM, (bf16*)xout + (size_t)m * DM, (float*)(ws + WS_SS) + 2 * (size_t)m, lane);
}
__device__ __forceinline__ void hn_pass(bf16* buf, int pitch, int col0, int nheads, const float* gain, int gw, int NGW, int lane) {
    const int l16 = lane & 15; const int ntask4 = M * nheads / 4;
    f32x4 g0 = *(const f32x4*)(gain + 8 * l16), g1 = *(const f32x4*)(gain + 8 * l16 + 4);
    for (int t4 = gw; t4 < ntask4; t4 += NGW) { const int t = t4 * 4 + (lane >> 4); const int row = t / nheads, hh = t - row * nheads;
        bf16* p = buf + (size_t)row * pitch + col0 + hh * 128 + 8 * l16;
        const v4u w = *(const v4u*)p;
        float x[8] = {bf_lo(w.x), bf_hi(w.x), bf_lo(w.y), bf_hi(w.y), bf_lo(w.z), bf_hi(w.z), bf_lo(w.w), bf_hi(w.w)};
        float ss = 0.f;
#pragma unroll
        for (int e = 0; e < 8; ++e) ss += x[e] * x[e];
        ss += XCH1(ss); ss += XCH2(ss); ss += XCH4(ss); ss += XCH8(ss);
        const float rinv = 1.0f / sqrtf(ss * (1.0f / 128.f) + EPS);
        v4u o; o.x = pkbf(x[0] * rinv * g0[0], x[1] * rinv * g0[1]); o.y = pkbf(x[2] * rinv * g0[2], x[3] * rinv * g0[3]);
        o.z = pkbf(x[4] * rinv * g1[0], x[5] * rinv * g1[1]); o.w = pkbf(x[6] * rinv * g1[2], x[7] * rinv * g1[3]);
        *(v4u*)p = o; }
}
__device__ __forceinline__ void mkmv_pass(const float* MKVF, bf16* MK, bf16* MV, const float* mem_k_norm, int gw, int NGW, int lane) {
    const int l16 = lane & 15;
    for (int t4 = gw; t4 < MROWS * 32 / 4; t4 += NGW) { const int t = t4 * 4 + (lane >> 4); const int row = t >> 5, rem = t & 31; const int l = rem >> 3, kv = (rem >> 2) & 1, hh = rem & 3;
        const float* src = MKVF + (size_t)row * NMEMW + l * 1024 + kv * 512 + hh * 128 + 8 * l16;
        const f32x4 a = *(const f32x4*)src, b = *(const f32x4*)(src + 4);
        float ss = (a.x * a.x + a.y * a.y) + (a.z * a.z + a.w * a.w) + (b.x * b.x + b.y * b.y) + (b.z * b.z + b.w * b.w);
        ss += XCH1(ss); ss += XCH2(ss); ss += XCH4(ss); ss += XCH8(ss);
        const float rinv = kv ? 1.0f : 1.0f / sqrtf(ss * (1.0f / 128.f) + EPS);
        f32x4 g0 = {1.f, 1.f, 1.f, 1.f}, g1 = {1.f, 1.f, 1.f, 1.f};
        if (!kv) { g0 = *(const f32x4*)(mem_k_norm + l * 128 + 8 * l16); g1 = *(const f32x4*)(mem_k_norm + l * 128 + 8 * l16 + 4); }
        v4u o; o.x = pkbf(a.x * rinv * g0[0], a.y * rinv * g0[1]); o.y = pkbf(a.z * rinv * g0[2], a.w * rinv * g0[3]);
        o.z = pkbf(b.x * rinv * g1[0], b.y * rinv * g1[1]); o.w = pkbf(b.z * rinv * g1[2], b.w * rinv * g1[3]);
        *(v4u*)((kv ? MV : MK) + ((size_t)l * MROWS + row) * 512 + hh * 128 + 8 * l16) = o; }
}
__device__ __forceinline__ void gla_prep(const bf16* PROJ, const float* b_gate  , const float* w_up  , bf16* KDT, bf16* VT, bf16* QF, float* ACH, int gw, int NGW, int lane) {
    const int r = lane & 31, hi = lane >> 5;
    for (int t = gw; t < 2048; t += NGW) {
        const int b = t >> 8, c = (t >> 2) & 63, h = t & 3; const int ci = (b * 4 + h) * 64 + c;
        const bf16* P = PROJ + ((size_t)b * SEQ + c * 64) * NA;
        if (lane < 48) { const int d0 = 4 * lane;
            const f32x4 bias = *(const f32x4*)(b_gate + h * 192 + d0);
            const bf16* plr = P + A_LR; const bf16* pk = P + A_K + h * 192 + d0;
            f32x4 wg[16];
#pragma unroll
            for (int rr = 0; rr < 16; ++rr) wg[rr] = *(const f32x4*)(w_up + rr * 768 + h * 192 + d0);
#define GATE4(gp, j) do { const v4u L0 = *(const v4u*)(plr + (size_t)(j) * NA), L1 = *(const v4u*)(plr + (size_t)(j) * NA + 8); gp = bias;  \
                gp = gp + wg[0] * bf_lo(L0.x) + wg[1] * bf_hi(L0.x) + wg[2] * bf_lo(L0.y) + wg[3] * bf_hi(L0.y) + wg[4] * bf_lo(L0.z) + wg[5] * bf_hi(L0.z) + wg[6] * bf_lo(L0.w) + wg[7] * bf_hi(L0.w);  \
                gp = gp + wg[8] * bf_lo(L1.x) + wg[9] * bf_hi(L1.x) + wg[10] * bf_lo(L1.y) + wg[11] * bf_hi(L1.y) + wg[12] * bf_lo(L1.z) + wg[13] * bf_hi(L1.z) + wg[14] * bf_lo(L1.w) + wg[15] * bf_hi(L1.w); } while (0)
            f32x4 tot = {0.f, 0.f, 0.f, 0.f};
#pragma unroll 8
            for (int j = 0; j < 64; ++j) { f32x4 gp; GATE4(gp, j);
                tot[0] += logsig(gp[0]); tot[1] += logsig(gp[1]); tot[2] += logsig(gp[2]); tot[3] += logsig(gp[3]); }
            tot = tot * (1.0f / 16.0f);
            *(f32x4*)(ACH + ci * 192 + d0) = (f32x4){__expf(tot[0]), __expf(tot[1]), __expf(tot[2]), __expf(tot[3])};
            bf16* dst = KDT + ((size_t)(ci * 6 + (d0 >> 5)) * 4 * 64 + (d0 & 31)) * 8;
            f32x4 run = {0.f, 0.f, 0.f, 0.f};
#pragma unroll
            for (int j8 = 0; j8 < 8; ++j8) { float kd[4][8];
#pragma unroll
                for (int e8 = 0; e8 < 8; ++e8) { const int j = 8 * j8 + e8; const uint2 kw = *(const uint2*)(pk + (size_t)j * NA); f32x4 gp; GATE4(gp, j);
                    run[0] += logsig(gp[0]) * (1.0f / 16.0f); run[1] += logsig(gp[1]) * (1.0f / 16.0f); run[2] += logsig(gp[2]) * (1.0f / 16.0f); run[3] += logsig(gp[3]) * (1.0f / 16.0f);
                    kd[0][e8] = bf_lo(kw.x) * __expf(tot[0] - run[0]); kd[1][e8] = bf_hi(kw.x) * __expf(tot[1] - run[1]); kd[2][e8] = bf_lo(kw.y) * __expf(tot[2] - run[2]); kd[3][e8] = bf_hi(kw.y) * __expf(tot[3] - run[3]); }
#pragma unroll
                for (int e = 0; e < 4; ++e) { v4u o; o.x = pkbf(kd[e][0], kd[e][1]); o.y = pkbf(kd[e][2], kd[e][3]); o.z = pkbf(kd[e][4], kd[e][5]); o.w = pkbf(kd[e][6], kd[e][7]);
                    *(v4u*)(dst + ((size_t)((j8 >> 1) * 64 + (j8 & 1) * 32 + e)) * 8) = o; } }
#undef GATE4
            }
        if (lane < 48) { const int dv0 = 8 * lane; const bf16* pv = P + A_V + h * 384 + dv0;
            bf16* dst = VT + ((size_t)(ci * 12 + (dv0 >> 5)) * 4 * 64 + (dv0 & 31)) * 8;
#pragma unroll
            for (int j8 = 0; j8 < 8; ++j8) { v4u w[8];
#pragma unroll
                for (int e8 = 0; e8 < 8; ++e8) w[e8] = *(const v4u*)(pv + (size_t)(8 * j8 + e8) * NA);
#pragma unroll
                for (int e = 0; e < 8; ++e) { v4u o;
#define VSEL(k) ((e & 1) ? (((e >> 1) == 0 ? w[k].x : (e >> 1) == 1 ? w[k].y : (e >> 1) == 2 ? w[k].z : w[k].w) >> 16) : (((e >> 1) == 0 ? w[k].x : (e >> 1) == 1 ? w[k].y : (e >> 1) == 2 ? w[k].z : w[k].w) & 0xffffu))
                    o.x = VSEL(0) | (VSEL(1) << 16); o.y = VSEL(2) | (VSEL(3) << 16); o.z = VSEL(4) | (VSEL(5) << 16); o.w = VSEL(6) | (VSEL(7) << 16);
#undef VSEL
                    *(v4u*)(dst + ((size_t)((j8 >> 1) * 64 + (j8 & 1) * 32 + e)) * 8) = o; } } }
        { const bf16* pq = P + (size_t)r * NA + A_Q + h * 192 + 4 * hi; bf16* dst = QF + ((size_t)ci * 24 * 64 + lane) * 8;
#pragma unroll
            for (int tt = 0; tt < 2; ++tt)
#pragma unroll
                for (int mt = 0; mt < 6; ++mt)
#pragma unroll
                    for (int s2 = 0; s2 < 2; ++s2) { const bf16* p = pq + (size_t)tt * 32 * NA + 32 * mt + 16 * s2;
                        const uint2 a = *(const uint2*)p, c2 = *(const uint2*)(p + 8);
                        v4u o = {a.x, a.y, c2.x, c2.y};
                        *(v4u*)(dst + (size_t)((tt * 6 + mt) * 2 + s2) * 64 * 8) = o; } }
    }
}
__device__ __forceinline__ void gla_update(f32x16 (&S)[6], const bf16* kd, const bf16* vt, const float* ac, int lane, int hi) {
    const unsigned lo16 = (unsigned)lane * 16u;
    bf16x8 vb[4];
#pragma unroll
    for (int s = 0; s < 4; ++s) vb[s] = *(const bf16x8*)((const char*)(vt + s * 512) + lo16);
#pragma unroll
    for (int half = 0; half < 2; ++half) {
        bf16x8 ka[3][4]; f32x4 a4[3][4];
#pragma unroll
        for (int m3 = 0; m3 < 3; ++m3)
#pragma unroll
            for (int s = 0; s < 4; ++s) ka[m3][s] = *(const bf16x8*)((const char*)(kd + ((3 * half + m3) * 4 + s) * 512) + lo16);
#pragma unroll
        for (int m3 = 0; m3 < 3; ++m3)
#pragma unroll
            for (int i4 = 0; i4 < 4; ++i4) a4[m3][i4] = *(const f32x4*)((const char*)(ac + 32 * (3 * half + m3) + 8 * i4) + (unsigned)hi * 16u);
        __builtin_amdgcn_sched_barrier(0);
#pragma unroll
        for (int m3 = 0; m3 < 3; ++m3) { const int mt = 3 * half + m3;
#pragma unroll
            for (int i4 = 0; i4 < 4; ++i4)
#pragma unroll
                for (int e = 0; e < 4; ++e) S[mt][4 * i4 + e] *= a4[m3][i4][e];
#pragma unroll
            for (int s = 0; s < 4; ++s) S[mt] = __builtin_amdgcn_mfma_f32_32x32x16_bf16(ka[m3][s], vb[s], S[mt], 0, 0, 0); }
        __builtin_amdgcn_sched_barrier(0);
    }
}
__device__ __forceinline__ void gla_output(const f32x16 (&S)[6], const bf16* qf, bf16* og_u  , int lane, int r, int hi) {
    const unsigned lo16 = (unsigned)lane * 16u;
    f32x16 o0, o1;
#pragma unroll
    for (int i = 0; i < 16; ++i) { o0[i] = 0.f; o1[i] = 0.f; }
#pragma unroll
    for (int half = 0; half < 2; ++half) {
        bf16x8 qa[3][2][2];
#pragma unroll
        for (int m3 = 0; m3 < 3; ++m3)
#pragma unroll
            for (int s = 0; s < 2; ++s) { qa[m3][s][0] = *(const bf16x8*)((const char*)(qf + ((0 * 6 + 3 * half + m3) * 2 + s) * 512) + lo16); qa[m3][s][1] = *(const bf16x8*)((const char*)(qf + ((1 * 6 + 3 * half + m3) * 2 + s) * 512) + lo16); }
        __builtin_amdgcn_sched_barrier(0);
#pragma unroll
        for (int m3 = 0; m3 < 3; ++m3) { const int mt = 3 * half + m3;
#pragma unroll
            for (int s = 0; s < 2; ++s) {
                v4u xw; xw.x = pkbf(S[mt][8 * s + 0], S[mt][8 * s + 1]); xw.y = pkbf(S[mt][8 * s + 2], S[mt][8 * s + 3]); xw.z = pkbf(S[mt][8 * s + 4], S[mt][8 * s + 5]); xw.w = pkbf(S[mt][8 * s + 6], S[mt][8 * s + 7]);
                const bf16x8 xs = __builtin_bit_cast(bf16x8, xw);
                o0 = __builtin_amdgcn_mfma_f32_32x32x16_bf16(qa[m3][s][0], xs, o0, 0, 0, 0);
                o1 = __builtin_amdgcn_mfma_f32_32x32x16_bf16(qa[m3][s][1], xs, o1, 0, 0, 0); } }
        __builtin_amdgcn_sched_barrier(0);
    }
    const unsigned so = (unsigned)(4 * hi * 1536 + r) * 2u;
#pragma unroll
    for (int i = 0; i < 16; ++i) { const int rowc = (i & 3) + 8 * (i >> 2);
        const float v0 = o0[i], v1 = o1[i]; const float n0 = XCH1(v0), n1 = XCH1(v1);
        if ((r & 1) == 0) { *(unsigned*)((char*)(og_u + (size_t)rowc * 1536) + so) = pkbf(v0, n0); *(unsigned*)((char*)(og_u + (size_t)(32 + rowc) * 1536) + so) = pkbf(v1, n1); } }
}
__device__ __forceinline__ void gla_seg_states(const bf16* KDT, const bf16* VT, const float* ACH, float* FST, float* DSEG, int gw, int NGW, int lane) {
    const int r = lane & 31, hi = lane >> 5;
    static_assert(SEG_N * SEG_LEN >= 64 && (SEG_N - 1) * SEG_LEN < 64 && SEG_N <= 8, "segments must cover the 64 chunks (FST holds up to 7 segment states per unit)");
    for (int idx = gw * 64 + lane; idx < 32 * SEG_N * 192; idx += NGW * 64) { const int bh = idx / (SEG_N * 192), rem = idx - bh * (SEG_N * 192), g = rem / 192, k = rem - g * 192;
        float d = 1.f;
#pragma unroll
        for (int c = g * SEG_LEN; c < g * SEG_LEN + SEG_LEN && c < 64; ++c) d *= ACH[(size_t)(bh * 64 + c) * 192 + k];
        DSEG[idx] = d; }
    for (int t = gw; t < 384 * (SEG_N - 1); t += NGW) { const int g = t / 384, u = t - g * 384; const int bh = u / 12, n32 = u - bh * 12;
        f32x16 S[6];
#pragma unroll
        for (int mt = 0; mt < 6; ++mt)
#pragma unroll
            for (int i = 0; i < 16; ++i) S[mt][i] = 0.f;
        for (int c = g * SEG_LEN; c < g * SEG_LEN + SEG_LEN; ++c) { const int ci = bh * 64 + c;
            gla_update(S, KDT + (size_t)ci * 192 * 64, VT + ((size_t)ci * 12 + n32) * 4 * 64 * 8, ACH + (size_t)ci * 192, lane, hi); }
        f32x4* dst = (f32x4*)FST + (size_t)(u * 7 + g) * 24 * 64 + lane;
#pragma unroll
        for (int mt = 0; mt < 6; ++mt)
#pragma unroll
            for (int i4 = 0; i4 < 4; ++i4) dst[(mt * 4 + i4) * 64] = (f32x4){S[mt][4 * i4], S[mt][4 * i4 + 1], S[mt][4 * i4 + 2], S[mt][4 * i4 + 3]}; }
}
__device__ __forceinline__ void gla_seg_outputs(const bf16* QF, const bf16* KDT, const bf16* VT, const float* ACH, const float* FST, const float* DSEG, bf16* OG, int gw, int NGW, int lane) {
    const int r = lane & 31, hi = lane >> 5;
    for (int t = gw; t < 384 * SEG_N; t += NGW) { const int g = t / 384, u = t - g * 384; const int bh = u / 12, n32 = u - bh * 12, b = bh >> 2, h = bh & 3;
        f32x16 S[6];
#pragma unroll
        for (int mt = 0; mt < 6; ++mt)
#pragma unroll
            for (int i = 0; i < 16; ++i) S[mt][i] = 0.f;
        for (int gp = 0; gp < g; ++gp) {
            const float* fs = FST + (size_t)(u * 7 + gp) * 24 * 64 * 4; const float* ds = DSEG + (size_t)(bh * SEG_N + gp) * 192; const unsigned lo16 = (unsigned)lane * 16u, hi16 = (unsigned)hi * 16u;
#pragma unroll
            for (int half = 0; half < 2; ++half) { f32x4 f4[3][4], d4[3][4];
#pragma unroll
                for (int m3 = 0; m3 < 3; ++m3)
#pragma unroll
                    for (int i4 = 0; i4 < 4; ++i4) { f4[m3][i4] = *(const f32x4*)((const char*)(fs + ((3 * half + m3) * 4 + i4) * 256) + lo16); d4[m3][i4] = *(const f32x4*)((const char*)(ds + 32 * (3 * half + m3) + 8 * i4) + hi16); }
                __builtin_amdgcn_sched_barrier(0);
#pragma unroll
                for (int m3 = 0; m3 < 3; ++m3)
#pragma unroll
                    for (int i4 = 0; i4 < 4; ++i4)
#pragma unroll
                        for (int e = 0; e < 4; ++e) S[3 * half + m3][4 * i4 + e] = S[3 * half + m3][4 * i4 + e] * d4[m3][i4][e] + f4[m3][i4][e];
                __builtin_amdgcn_sched_barrier(0); } }
        for (int c = g * SEG_LEN; c < g * SEG_LEN + SEG_LEN && c < 64; ++c) { const int ci = bh * 64 + c; const size_t t0 = (size_t)b * SEQ + c * 64;
            gla_update(S, KDT + (size_t)ci * 192 * 64, VT + ((size_t)ci * 12 + n32) * 4 * 64 * 8, ACH + (size_t)ci * 192, lane, hi);
            gla_output(S, QF + (size_t)ci * 192 * 64, OG + t0 * 1536 + h * 384 + n32 * 32, lane, r, hi); }
    }
}
constexpr int SC_BUF = 50176, SC_K = 0, SC_Q = 24576, SC_A = 49152;
struct ScanStage { v4u k[3], q[3], a; };
template <bool WITHQ> __device__ __forceinline__ void scan_stage_issue(ScanStage& st, const bf16* KDT, const bf16* QF, const float* ACH, int ci, int tid) {
    const unsigned to = (unsigned)tid * 16u;
    const char* kb = (const char*)(KDT + (size_t)ci * 192 * 64);
#pragma unroll
    for (int i = 0; i < 3; ++i) st.k[i] = *(const v4u*)(kb + i * 8192 + to);
    if (WITHQ) { const char* qb = (const char*)(QF + (size_t)ci * 192 * 64);
#pragma unroll
        for (int i = 0; i < 3; ++i) st.q[i] = *(const v4u*)(qb + i * 8192 + to); }
    if (tid < 48) st.a = *(const v4u*)((const char*)(ACH + (size_t)ci * 192) + to);
}
template <bool WITHQ> __device__ __forceinline__ void scan_stage_commit(const ScanStage& st, LAS unsigned char* buf, int tid) {
    const unsigned to = (unsigned)tid * 16u;
#pragma unroll
    for (int i = 0; i < 3; ++i) *(LAS v4u*)(buf + SC_K + i * 8192 + to) = st.k[i];
    if (WITHQ) {
#pragma unroll
        for (int i = 0; i < 3; ++i) *(LAS v4u*)(buf + SC_Q + i * 8192 + to) = st.q[i]; }
    if (tid < 48) *(LAS v4u*)(buf + SC_A + to) = st.a;
}
__device__ __forceinline__ void scan_load_vb(bf16x8 (&vb)[4], const bf16* VT, int ci, int n32, int lane) {
    const bf16* vt = VT + ((size_t)ci * 12 + n32) * 4 * 64 * 8;
#pragma unroll
    for (int s = 0; s < 4; ++s) vb[s] = *(const bf16x8*)((const char*)(vt + s * 512) + (unsigned)lane * 16u);
}
__device__ __forceinline__ void gla_update_lds(f32x16 (&S)[6], LAS const unsigned char* buf, const bf16x8 (&vb)[4], int lane, int hi) {
    const unsigned lo16 = (unsigned)lane * 16u;
#pragma unroll
    for (int mt = 0; mt < 6; ++mt) {
        bf16x8 ka[4]; f32x4 a4[4];
#pragma unroll
        for (int s = 0; s < 4; ++s) ka[s] = *(LAS const bf16x8*)(buf + SC_K + (mt * 4 + s) * 1024 + lo16);
#pragma unroll
        for (int i4 = 0; i4 < 4; ++i4) a4[i4] = *(LAS const f32x4*)(buf + SC_A + (32 * mt + 8 * i4) * 4 + (unsigned)hi * 16u);
#pragma unroll
        for (int i4 = 0; i4 < 4; ++i4)
#pragma unroll
            for (int e = 0; e < 4; ++e) S[mt][4 * i4 + e] *= a4[i4][e];
#pragma unroll
        for (int s = 0; s < 4; ++s) S[mt] = __builtin_amdgcn_mfma_f32_32x32x16_bf16(ka[s], vb[s], S[mt], 0, 0, 0); }
}
__device__ __forceinline__ void gla_output_lds(const f32x16 (&S)[6], LAS const unsigned char* buf, bf16* og_u, int lane, int r, int hi) {
    const unsigned lo16 = (unsigned)lane * 16u;
    f32x16 o0, o1;
#pragma unroll
    for (int i = 0; i < 16; ++i) { o0[i] = 0.f; o1[i] = 0.f; }
#pragma unroll
    for (int mt = 0; mt < 6; ++mt) {
        bf16x8 qa[2][2];
#pragma unroll
        for (int s = 0; s < 2; ++s) { qa[s][0] = *(LAS const bf16x8*)(buf + SC_Q + ((0 * 6 + mt) * 2 + s) * 1024 + lo16); qa[s][1] = *(LAS const bf16x8*)(buf + SC_Q + ((1 * 6 + mt) * 2 + s) * 1024 + lo16); }
#pragma unroll
        for (int s = 0; s < 2; ++s) {
            v4u xw; xw.x = pkbf(S[mt][8 * s + 0], S[mt][8 * s + 1]); xw.y = pkbf(S[mt][8 * s + 2], S[mt][8 * s + 3]); xw.z = pkbf(S[mt][8 * s + 4], S[mt][8 * s + 5]); xw.w = pkbf(S[mt][8 * s + 6], S[mt][8 * s + 7]);
            const bf16x8 xs = __builtin_bit_cast(bf16x8, xw);
            o0 = __builtin_amdgcn_mfma_f32_32x32x16_bf16(qa[s][0], xs, o0, 0, 0, 0);
            o1 = __builtin_amdgcn_mfma_f32_32x32x16_bf16(qa[s][1], xs, o1, 0, 0, 0); } }
    const unsigned so = (unsigned)(4 * hi * 1536 + r) * 2u;
#pragma unroll
    for (int i = 0; i < 16; ++i) { const int rowc = (i & 3) + 8 * (i >> 2);
        const float v0 = o0[i], v1 = o1[i]; const float n0 = XCH1(v0), n1 = XCH1(v1);
        if ((r & 1) == 0) { *(unsigned*)((char*)(og_u + (size_t)rowc * 1536) + so) = pkbf(v0, n0); *(unsigned*)((char*)(og_u + (size_t)(32 + rowc) * 1536) + so) = pkbf(v1, n1); } }
}
constexpr int WSEG_N = 4, WSEG_LEN = 16;
__device__ __forceinline__ void gla_seg_states_wg(const bf16* KDT, const bf16* VT, const float* ACH, float* FST, float* DSEG, LAS unsigned char* lds, int vcu, int G, int wave, int lane, int gw, int NGW) {
    const int hi = lane >> 5, tid = wave * 64 + lane;
    for (int idx = gw * 64 + lane; idx < 32 * WSEG_N * 192; idx += NGW * 64) { const int bh = idx / (WSEG_N * 192), rem = idx - bh * (WSEG_N * 192), g = rem / 192, k = rem - g * 192;
        float d = 1.f;
        for (int c = g * WSEG_LEN; c < g * WSEG_LEN + WSEG_LEN; ++c) d *= ACH[(size_t)(bh * 64 + c) * 192 + k];
        DSEG[idx] = d; }
    for (int wt = vcu; wt < 32 * WSEG_N * 2; wt += G) { const int bh = wt / (WSEG_N * 2), rem = wt - bh * (WSEG_N * 2), g = rem >> 1, half = rem & 1;
        if (g == WSEG_N - 1) continue;
        const bool act = wave < 6; const int n32 = half * 6 + (act ? wave : 0), u = bh * 12 + n32;
        f32x16 S[6];
#pragma unroll
        for (int mt = 0; mt < 6; ++mt)
#pragma unroll
            for (int i = 0; i < 16; ++i) S[mt][i] = 0.f;
        const int c0 = g * WSEG_LEN, c1 = c0 + WSEG_LEN;
        ScanStage st; bf16x8 vb[4], vbn[4];
        scan_stage_issue<false>(st, KDT, nullptr, ACH, bh * 64 + c0, tid); if (act) scan_load_vb(vb, VT, bh * 64 + c0, n32, lane);
        scan_stage_commit<false>(st, lds, tid);
        __syncthreads();
        for (int c = c0; c < c1; ++c) { LAS unsigned char* buf = lds + ((c - c0) & 1) * SC_BUF; LAS unsigned char* nbuf = lds + (((c - c0) & 1) ^ 1) * SC_BUF; const bool more = c + 1 < c1;
            if (more) { scan_stage_issue<false>(st, KDT, nullptr, ACH, bh * 64 + c + 1, tid); if (act) scan_load_vb(vbn, VT, bh * 64 + c + 1, n32, lane); }
            if (act) gla_update_lds(S, buf, vb, lane, hi);
            if (more) { scan_stage_commit<false>(st, nbuf, tid);
#pragma unroll
                for (int s = 0; s < 4; ++s) vb[s] = vbn[s]; }
            __syncthreads(); }
        if (act) { char* dst = (char*)(FST + (size_t)(u * 7 + g) * 24 * 64 * 4); const unsigned lo16 = (unsigned)lane * 16u;
#pragma unroll
            for (int mt = 0; mt < 6; ++mt)
#pragma unroll
                for (int i4 = 0; i4 < 4; ++i4) *(f32x4*)(dst + (mt * 4 + i4) * 1024 + lo16) = (f32x4){S[mt][4 * i4], S[mt][4 * i4 + 1], S[mt][4 * i4 + 2], S[mt][4 * i4 + 3]}; }
    }
}
__device__ __forceinline__ void gla_seg_outputs_wg(const bf16* QF, const bf16* KDT, const bf16* VT, const float* ACH, const float* FST, const float* DSEG, bf16* OG, LAS unsigned char* lds, int vcu, int G, int wave, int lane) {
    const int r = lane & 31, hi = lane >> 5, tid = wave * 64 + lane;
    for (int wt = vcu; wt < 32 * WSEG_N * 2; wt += G) { const int bh = wt / (WSEG_N * 2), rem = wt - bh * (WSEG_N * 2), g = rem >> 1, half = rem & 1, b = bh >> 2, h = bh & 3;
        const bool act = wave < 6; const int n32 = half * 6 + (act ? wave : 0), u = bh * 12 + n32;
        f32x16 S[6];
#pragma unroll
        for (int mt = 0; mt < 6; ++mt)
#pragma unroll
            for (int i = 0; i < 16; ++i) S[mt][i] = 0.f;
        const int c0 = g * WSEG_LEN, c1 = c0 + WSEG_LEN;
        ScanStage st; bf16x8 vb[4], vbn[4];
        scan_stage_issue<true>(st, KDT, QF, ACH, bh * 64 + c0, tid); if (act) scan_load_vb(vb, VT, bh * 64 + c0, n32, lane);
        if (act) for (int gp = 0; gp < g; ++gp) {
            const float* fs = FST + (size_t)(u * 7 + gp) * 24 * 64 * 4; const float* ds = DSEG + (size_t)(bh * WSEG_N + gp) * 192; const int lq = launder(lane); const unsigned lo16 = (unsigned)lq * 16u, hi16 = (unsigned)(lq >> 5) * 16u;
#pragma unroll
            for (int m2 = 0; m2 < 3; ++m2) { f32x4 f4[2][4], d4[2][4];
#pragma unroll
                for (int mm = 0; mm < 2; ++mm)
#pragma unroll
                    for (int i4 = 0; i4 < 4; ++i4) { f4[mm][i4] = *(const f32x4*)((const char*)(fs + ((2 * m2 + mm) * 4 + i4) * 256) + lo16); d4[mm][i4] = *(const f32x4*)((const char*)(ds + 32 * (2 * m2 + mm) + 8 * i4) + hi16); }
                __builtin_amdgcn_sched_barrier(0);
#pragma unroll
                for (int mm = 0; mm < 2; ++mm)
#pragma unroll
                    for (int i4 = 0; i4 < 4; ++i4)
#pragma unroll
                        for (int e = 0; e < 4; ++e) S[2 * m2 + mm][4 * i4 + e] = S[2 * m2 + mm][4 * i4 + e] * d4[mm][i4][e] + f4[mm][i4][e];
                __builtin_amdgcn_sched_barrier(0); } }
        scan_stage_commit<true>(st, lds, tid);
        __syncthreads();
        for (int c = c0; c < c1; ++c) { LAS unsigned char* buf = lds + ((c - c0) & 1) * SC_BUF; LAS unsigned char* nbuf = lds + (((c - c0) & 1) ^ 1) * SC_BUF; const bool more = c + 1 < c1;
            if (more) { scan_stage_issue<true>(st, KDT, QF, ACH, bh * 64 + c + 1, tid); if (act) scan_load_vb(vbn, VT, bh * 64 + c + 1, n32, lane); }
            if (act) { gla_update_lds(S, buf, vb, lane, hi);
                gla_output_lds(S, buf, OG + ((size_t)b * SEQ + c * 64) * 1536 + h * 384 + n32 * 32, lane, r, hi); }
            if (more) { scan_stage_commit<true>(st, nbuf, tid);
#pragma unroll
                for (int s = 0; s < 4; ++s) vb[s] = vbn[s]; }
            __syncthreads(); }
    }
}
__device__ __forceinline__ void gla_post(const bf16* OG, const bf16* PROJ, const float* onorm  , bf16* MIX, int gw, int NGW, int lane) {
    const int la = lane < 48 ? lane : 0;
    const f32x4 g0 = *(const f32x4*)(onorm + 8 * la), g1 = *(const f32x4*)(onorm + 8 * la + 4);
    for (int t = gw; t < M * 4; t += NGW) { const int row = t >> 2, h = t & 3;
        v4u w = {0u, 0u, 0u, 0u}, gw4 = {0u, 0u, 0u, 0u};
        if (lane < 48) { w = *(const v4u*)(OG + (size_t)row * 1536 + h * 384 + 8 * lane); gw4 = *(const v4u*)(PROJ + (size_t)row * NA + A_G + h * 384 + 8 * lane); }
        float x[8] = {bf_lo(w.x), bf_hi(w.x), bf_lo(w.y), bf_hi(w.y), bf_lo(w.z), bf_hi(w.z), bf_lo(w.w), bf_hi(w.w)};
        float g[8] = {bf_lo(gw4.x), bf_hi(gw4.x), bf_lo(gw4.y), bf_hi(gw4.y), bf_lo(gw4.z), bf_hi(gw4.z), bf_lo(gw4.w), bf_hi(gw4.w)};
        float ss = 0.f;
#pragma unroll
        for (int e = 0; e < 8; ++e) ss += x[e] * x[e];
        const float rinv = 1.0f / sqrtf(wave_sum(ss) * (1.0f / 384.f) + EPS);
        float y[8];
#pragma unroll
        for (int e = 0; e < 8; ++e) y[e] = x[e] * rinv * (e < 4 ? g0[e] : g1[e - 4]) * pg8::silu_f(g[e]);
        if (lane < 48) { v4u o; o.x = pkbf(y[0], y[1]); o.y = pkbf(y[2], y[3]); o.z = pkbf(y[4], y[5]); o.w = pkbf(y[6], y[7]);
            *(v4u*)(MIX + (size_t)row * DM + h * 384 + 8 * lane) = o; } }
}
__device__ __forceinline__ void fox_cumsum(const float* F, const float* b_f, float* CB, int gw, int NGW, int lane) {
    for (int t = gw; t < BATCH * 12; t += NGW) { const int b = t / 12, h = t - b * 12; const float bf = b_f[h];
        const float* src = F + ((size_t)b * SEQ + lane * 64) * 16 + h;
        float v[64]; float run = 0.f;
#pragma unroll
        for (int j = 0; j < 64; ++j) v[j] = src[(size_t)j * 16];
        asm volatile("s_waitcnt vmcnt(0)" ::: "memory");
#pragma unroll
        for (int j = 0; j < 64; ++j) { run += logsig(v[j] + bf); v[j] = run; }
        float incl = run;
#pragma unroll
        for (int o = 1; o < 64; o <<= 1) { const float y = __uint_as_float((unsigned)__builtin_amdgcn_ds_bpermute((lane - o) << 2, (int)__float_as_uint(incl))); if (lane >= o) incl += y; }
        const float excl = incl - run;
        float* dst = CB + (size_t)t * SEQ + lane * 64;
#pragma unroll
        for (int j = 0; j < 64; ++j) dst[j] = -(excl + v[j]) * 11.313708498984761f; }
}
struct AttCfg { const bf16* PROJ; const bf16* KSVS; const float* CB; const bf16* MK; const bf16* MV; bf16* MIX; const float* BF; unsigned* que; volatile LAS unsigned* qs; int np, qmcol, fox, vcu, G, q, nq; float skip_th; };
__device__ __forceinline__ fa::BlockRef att_item(const AttCfg& c, int j, int half, int nF) {
    fa::BlockRef r; const int nb = 8 / c.nq;
    if (j < nF) { const int p = j / (8 * nb), rem = j - p * (8 * nb), bl = rem >> 3, x = rem & 7; const int b = c.q + c.nq * bl; const int qb = half ? 15 - x : x;
        const int ln = lane_id_v(); const float mine = c.BF[ln < 12 ? ln : 11]; int rank = 0;
#pragma unroll
        for (int k = 0; k < 12; ++k) { const float o = __uint_as_float((unsigned)__builtin_amdgcn_readlane((int)__float_as_uint(mine), k)); rank += (o > mine || (o == mine && k < ln)) ? 1 : 0; }
        const unsigned long long hm = __ballot(ln < 12 && rank == p); const int h = hm ? (int)__builtin_ctzll(hm) : 0; const int bh = b * 12 + h;
        const size_t row0 = (size_t)b * SEQ + qb * 256;
        r.Q = c.PROJ + row0 * c.np + B_Q + h * 128; r.G = c.PROJ + row0 * c.np + B_G + h * 128; r.K = c.KSVS + (size_t)b * SEQ * 3072 + h * 128; r.V = r.K + 1536; r.O = c.MIX + row0 * DM + h * 128;
        r.CB = c.CB + (size_t)bh * SEQ; r.P0 = qb * 256; r.skv = SEQ; r.qp = c.np; r.kp = 3072;
        { const float cb0 = r.CB[qb * 256], cbe = r.CB[64 * ln + 63];
          const unsigned long long mk = __ballot(cb0 - cbe <= c.skip_th); r.jlo = mk ? (int)__builtin_ctzll(mk) : 0; } }
    else { const int jm = j - nF; const int bl = jm >> 6, rbl = (jm & 63) >> 2, mh = jm & 3; const int b = c.q + c.nq * bl; const int rb = b * 16 + rbl; const size_t row0 = (size_t)rb * 256;
        r.Q = c.PROJ + row0 * c.np + c.qmcol + mh * 128; r.G = nullptr; r.K = c.MK + (size_t)b * MEMT * 512 + mh * 128; r.V = c.MV + (size_t)b * MEMT * 512 + mh * 128; r.O = c.MIX + row0 * DM + 1536 + mh * 128;
        r.CB = nullptr; r.P0 = 256; r.skv = MEMT; r.qp = c.np; r.kp = 512; r.jlo = 0; }
    return r;
}
__device__ __forceinline__ int att_fetch(const AttCfg& c, int wave, int GQ) {
    if (wave == 0 && lane_id_v() == 0) c.qs[0] = __hip_atomic_fetch_add(c.que, 1u, RLX_AGENT);
    __syncthreads();
    return __builtin_amdgcn_readfirstlane(GQ + (int)c.qs[0]);
}
__device__ __forceinline__ void att_phase(const AttCfg& c, char* lds, int wave) {
    const int nb = 8 / c.nq, nF = c.fox ? 96 * nb : 0, T = nF + 64 * nb, GQ = c.G / c.nq;
    int j = c.vcu - c.q * GQ, half = 0;
    if (j >= T) return;
    fa::BlockRef cur = att_item(c, j, 0, nF); fa::Seam S;
    fa::attn_prime(cur, lds, S, wave);
    for (;;) {
        int nj = j, nh = 1;
        if (!(j < nF && half == 0)) { nj = att_fetch(c, wave, GQ); nh = 0; }
        const bool has = nj < T;
        const fa::BlockRef nxt = has ? att_item(c, nj, nh, nF) : cur;
        fa::attn_block(cur, nxt, lds, S, wave);
        if (!has) break;
        cur = nxt; j = nj; half = nh;
    }
}

struct Args { const float* in[22]; float* out; unsigned char* ws; int lo, hi; };
constexpr int PT_OUT = 22, PT_WS = 23;
#define PTR(k) ldp(PT, (k))
__global__ void __launch_bounds__(NWAVES * 64, 2) mega_fwd(Args args) {
    extern __shared__ __attribute__((aligned(16))) unsigned char lds_raw[];
    LAS unsigned char* lds = (LAS unsigned char*)lds_raw;
    volatile LAS unsigned* MISC = (volatile LAS unsigned*)(lds + MISC_OFF);
    volatile LAS unsigned* PT = (volatile LAS unsigned*)(lds + MISC_OFF + 128);
    const int wave = __builtin_amdgcn_readfirstlane((int)threadIdx.x >> 6);
    const int G = gridDim.x; const int bx = blockIdx.x; const int vcu = (G % 8 == 0) ? (bx % 8) * (G / 8) + bx / 8 : bx;
    const int gw = vcu * NWAVES + wave, NGW = G * NWAVES;
    for (int u = threadIdx.x; u < (LDS_BYTES - LDSCTL_OFF) / 4; u += NWAVES * 64) ((LAS unsigned*)(lds + LDSCTL_OFF))[u] = 0u;
    __syncthreads();
    if (threadIdx.x == 0) {
#pragma unroll
        for (int k = 0; k < 22; ++k) { const unsigned long long p = (unsigned long long)args.in[k]; PT[2 * k] = (unsigned)p; PT[2 * k + 1] = (unsigned)(p >> 32); }
        { const unsigned long long p = (unsigned long long)args.out; PT[2 * PT_OUT] = (unsigned)p; PT[2 * PT_OUT + 1] = (unsigned)(p >> 32); }
        { const unsigned long long p = (unsigned long long)args.ws; PT[2 * PT_WS] = (unsigned)p; PT[2 * PT_WS + 1] = (unsigned)(p >> 32); }
    }
    __syncthreads();
    const int lo = args.lo, hi = args.hi < MK_STOP_PC ? args.hi : MK_STOP_PC;
    const bool use_bar = (args.hi - args.lo) > 1;
    XcdBarrier bar; bar.bar = (unsigned*)((unsigned char*)PTR(PT_WS) + WS_CTL) + CW_BAR; bar.x = 0; bar.st = MISC + 8; bar.wave = wave;
    if (use_bar) bar = xcd_barrier_post(bar.bar, MISC + 8, wave);

    int pc = 0;
#define PH_ON (pc >= lo && pc < hi)
#define PH_END do { if (use_bar && pc >= lo && pc + 1 < hi) { XcdBarrier bb; bb.bar = (unsigned*)((unsigned char*)PTR(PT_WS) + WS_CTL) + CW_BAR; bb.x = bar.x; bb.st = MISC + 8; bb.wave = wave; xcd_barrier(bb); } ++pc; } while (0)
#define WSP ((unsigned char*)PTR(PT_WS))
#define PH_BEGIN if (PH_ON) { const int lane = lane_id(); const int gwp = launder_s(gw), vcup = launder_s(vcu), bxp = launder_s(bx), wavep = launder_s(wave); unsigned char* ws = WSP; (void)lane; (void)gwp; (void)vcup; (void)bxp; (void)wavep;
#define XOUT ((float*)PTR(PT_OUT))

    PH_BEGIN
#ifndef DBG_NO_CVT
        for (int rep = 0; rep < REP_CVT; ++rep) convert_phase(PT, ws, XOUT, lds, gwp, NGW, lane, wavep);
#endif
    }
    PH_END;
#ifdef EXTRA_BARRIERS
    if (use_bar) for (int eb = 0; eb < EXTRA_BARRIERS; ++eb) { XcdBarrier bb; bb.bar = (unsigned*)((unsigned char*)PTR(PT_WS) + WS_CTL) + CW_BAR; bb.x = bar.x; bb.st = MISC + 8; bb.wave = wave; xcd_barrier(bb); }
#endif

#ifdef EXTRA_UP_PHASES
    for (int ex = 0; ex < EXTRA_UP_PHASES; ++ex) {
        if (pc >= lo && pc < hi) { unsigned char* ws = WSP; const int bxp = launder_s(bx), wavep = launder_s(wave);
            pg8::Gemm g{(const bf16*)XOUT, (const bf16*)(ws + WS_WUP) + (size_t)(7 - (ex & 3)) * NUP * DM, M, NUP, DM}; pg8::StaticOrder S; S.init(M, NUP, G, bxp);
            pg8::EpiNull E{(float*)(ws + WS_DSEG)};
            pg8::gemm_phase<pg8::EpiNull, pg8::StaticOrder, true, true>(lds, g, S, E, wavep); }
        if (use_bar && pc >= lo) { XcdBarrier bb; bb.bar = (unsigned*)((unsigned char*)PTR(PT_WS) + WS_CTL) + CW_BAR; bb.x = bar.x; bb.st = MISC + 8; bb.wave = wave; xcd_barrier(bb); }
    }
#endif
    for (int l = 0; l < DEPTH; ++l) {
        for (int sub = 0; sub < 2; ++sub) {
            const int mat = l * 2 + sub;
            if (l == 2 && sub == 0) {
                PH_BEGIN load_gains(lds, PTR(21), PTR(21), wavep, lane);
                    pg8::Gemm g{(const bf16*)XOUT, (const bf16*)(ws + WS_WKV), M, NKV, DM}; pg8::StaticOrder S; S.init(M, NKV, G, bxp);
                    pg8::EpiKV E{(bf16*)(ws + WS_KSVS), 3072, (float*)(ws + WS_F), pg8::RinvCache{(const float*)(ws + WS_SS) + (size_t)6 * M * 2, (LAS float*)(lds + RTAB_OFF), -1}, (LAS float*)(lds + HNT_OFF), (LAS const float*)(lds + GAIN_OFF)};
                    for (int rep = 0; rep < REP_KVG; ++rep) pg8::gemm_phase<pg8::EpiKV, pg8::StaticOrder, true, GEMM_SP2>(lds, g, S, E, wavep); }
                PH_END;
                PH_BEGIN
#ifndef DBG_NO_CUM
                    for (int rep = 0; rep < REP_CUM; ++rep) fox_cumsum((const float*)(ws + WS_F), PTR(20), (float*)(ws + WS_CB), gwp, NGW, lane);
#endif
                    }
                PH_END;
            }
            for (int part = 0; part < FFN_SPLIT; ++part) {
            constexpr int MP = M / FFN_SPLIT; const size_t r0 = (size_t)part * MP;
            PH_BEGIN
                if (UP_STAGGER_US > 0 && ((bxp >> 3) & 1)) { const unsigned long long t0 = __builtin_amdgcn_s_memrealtime(); while (__builtin_amdgcn_s_memrealtime() - t0 < (unsigned long long)UP_STAGGER_US * 100ull) __builtin_amdgcn_s_sleep(16); }
                const bf16* resA = (l == DEPTH - 1 && sub == 1) ? (const bf16*)(ws + WS_XB2) : (const bf16*)XOUT;
                pg8::Gemm g{resA + r0 * DM, (const bf16*)(ws + WS_WUP) + (size_t)mat * NUP * DM, MP, NUP, DM}; pg8::StaticOrder S; S.init(MP, NUP, G, bxp);
                pg8::EpiSwiGLU E{(bf16*)(ws + WS_ACT) + r0 * FF, FF, pg8::RinvCache{(const float*)(ws + WS_SS) + ((size_t)(3 * l + 2 * sub) * M + r0) * 2, (LAS float*)(lds + RTAB_OFF), -1}};
                pg8::gemm_phase<pg8::EpiSwiGLU, pg8::StaticOrder, UP_ALIGN, GEMM_SP2>(lds, g, S, E, wavep);
#if REP_UP > 1
#ifdef REP_UP_CHEAP
                for (int rep = 1; rep < REP_UP; ++rep) { pg8::EpiNull E2{(float*)(ws + WS_DSEG)}; pg8::gemm_phase<pg8::EpiNull, pg8::StaticOrder, true, GEMM_SP2>(lds, g, S, E2, wavep); }
#else
                for (int rep = 1; rep < REP_UP; ++rep) pg8::gemm_phase<pg8::EpiSwiGLU, pg8::StaticOrder, UP_ALIGN, GEMM_SP2>(lds, g, S, E, wavep);
#endif
#endif
                }
            PH_END;
            PH_BEGIN pg8::Gemm g{(const bf16*)(ws + WS_ACT) + r0 * FF, (const bf16*)(ws + WS_WDN) + (size_t)mat * DM * FF, MP, DM, FF}; pg8::StaticOrder S; S.init(MP, DM, G, bxp);
                const int ssid = sub ? 3 * (l + 1) : 3 * l + 1;
                if (DN_STAGGER_US > 0 && ((bxp >> 3) & 1)) { const unsigned long long t0 = __builtin_amdgcn_s_memrealtime(); while (__builtin_amdgcn_s_memrealtime() - t0 < (unsigned long long)DN_STAGGER_US * 100ull) __builtin_amdgcn_s_sleep(8); }
                if (l == DEPTH - 1 && sub == 1) {
                    pg8::EpiRes<true> E{PT, PT_OUT, PT_WS, WS_XB2, 0, WS_SS + (size_t)12 * M * 8, 1, 0, 0.5f, (int)r0};
                    pg8::gemm_phase<pg8::EpiRes<true>, pg8::StaticOrder, true, GEMM_SP2>(lds, g, S, E, wavep);
                } else {
                    pg8::EpiRes<false> E{PT, PT_OUT, PT_WS, 0, 0, WS_SS + (size_t)ssid * M * 8, 0, 0, 0.5f, (int)r0};
                    pg8::gemm_phase<pg8::EpiRes<false>, pg8::StaticOrder, true, GEMM_SP2>(lds, g, S, E, wavep); }
#if REP_DN > 1
                for (int rep = 1; rep < REP_DN; ++rep) { pg8::EpiDummy E{(bf16*)(ws + WS_HMIX) + r0 * DM, DM}; pg8::gemm_phase<pg8::EpiDummy, pg8::StaticOrder, true, GEMM_SP2>(lds, g, S, E, wavep); }
#endif
                }
            PH_END;
            }
            if (sub == 0) {
                const int np = l < 2 ? NA : NB;
                PH_BEGIN load_gains(lds, l < 2 ? PTR(9) + l * 128 : PTR(17) + (l - 2) * 128, PTR(9) + l * 128, wavep, lane);
                    const bf16* wt = l < 2 ? (const bf16*)(ws + WS_WAIN) + (size_t)l * NA * DM : (const bf16*)(ws + WS_WBIN) + (size_t)(l - 2) * NB * DM;
                    pg8::Gemm g{(const bf16*)XOUT, wt, M, np, DM}; pg8::StaticOrder S; S.init(M, np, G, bxp);
                    pg8::EpiB16 E{(bf16*)(ws + WS_ACT), np, pg8::RinvCache{(const float*)(ws + WS_SS) + (size_t)(3 * l + 1) * M * 2, (LAS float*)(lds + RTAB_OFF), -1}, (LAS float*)(lds + HNT_OFF), (LAS const float*)(lds + GAIN_OFF),
                        l < 2 ? A_QM / 256 : 0, l < 2 ? A_QM / 256 + 2 : 6, l < 2 ? 0 : B_QM / 256, l < 2 ? 0 : B_QM / 256 + 2};
                    for (int rep = 0; rep < REP_IN; ++rep) pg8::gemm_phase<pg8::EpiB16, pg8::StaticOrder, true, GEMM_SP2>(lds, g, S, E, wavep);
                    if (l == 0 && bxp >= G / 2) { pg8::Gemm g2{(const bf16*)(ws + WS_MEMB), (const bf16*)(ws + WS_WMEM), MROWS, NMEMW, DM}; pg8::StaticOrder S2; S2.init(MROWS, NMEMW, G - G / 2, bxp - G / 2);
                        pg8::EpiF32 E2{(float*)(ws + WS_MKVF), NMEMW};
                        pg8::gemm_phase<pg8::EpiF32, pg8::StaticOrder, true, GEMM_SP2>(lds, g2, S2, E2, wavep); } }
                PH_END;
                if (l < 2) {
                    PH_BEGIN if (l == 0) mkmv_pass((const float*)(ws + WS_MKVF), (bf16*)(ws + WS_MK), (bf16*)(ws + WS_MV), PTR(10), gwp, NGW, lane);
#ifndef DBG_NO_PREP
                        for (int rep = 0; rep < REP_PREP; ++rep) gla_prep((const bf16*)(ws + WS_ACT), PTR(14) + l * 768, PTR(13) + l * 16 * 768, (bf16*)(ws + WS_KDT), (bf16*)(ws + WS_VT), (bf16*)(ws + WS_QF), (float*)(ws + WS_ACH), gwp, NGW, lane);
#endif
                        }
                    PH_END;
                    PH_BEGIN
#if SCAN_WG
                        for (int rep = 0; rep < REP_SCAN; ++rep) gla_seg_states_wg((const bf16*)(ws + WS_KDT), (const bf16*)(ws + WS_VT), (const float*)(ws + WS_ACH), (float*)(ws + WS_FST), (float*)(ws + WS_DSEG), lds, vcup, G, wavep, lane, gwp, NGW);
#else
                        for (int rep = 0; rep < REP_SCAN; ++rep) gla_seg_states((const bf16*)(ws + WS_KDT), (const bf16*)(ws + WS_VT), (const float*)(ws + WS_ACH), (float*)(ws + WS_FST), (float*)(ws + WS_DSEG), gwp, NGW, lane);
#endif
                    }
                    PH_END;
                    PH_BEGIN
#if SCAN_WG
                        for (int rep = 0; rep < REP_SCAN; ++rep) gla_seg_outputs_wg((const bf16*)(ws + WS_QF), (const bf16*)(ws + WS_KDT), (const bf16*)(ws + WS_VT), (const float*)(ws + WS_ACH), (const float*)(ws + WS_FST), (const float*)(ws + WS_DSEG), (bf16*)(ws + WS_OG), lds, vcup, G, wavep, lane);
#else
                        for (int rep = 0; rep < REP_SCAN; ++rep) gla_seg_outputs((const bf16*)(ws + WS_QF), (const bf16*)(ws + WS_KDT), (const bf16*)(ws + WS_VT), (const float*)(ws + WS_ACH), (const float*)(ws + WS_FST), (const float*)(ws + WS_DSEG), (bf16*)(ws + WS_OG), gwp, NGW, lane);
#endif
                    }
                    PH_END;
                }
                PH_BEGIN
                    if (l < 2) for (int rep = 0; rep < REP_POST; ++rep) gla_post((const bf16*)(ws + WS_OG), (const bf16*)(ws + WS_ACT), PTR(15) + l * 384, (bf16*)(ws + WS_HMIX), gwp, NGW, lane);
                    AttCfg c; c.PROJ = (const bf16*)(ws + WS_ACT); c.KSVS = (const bf16*)(ws + WS_KSVS); c.CB = (const float*)(ws + WS_CB); c.MK = (const bf16*)(ws + WS_MK) + (size_t)l * MROWS * 512; c.MV = (const bf16*)(ws + WS_MV) + (size_t)l * MROWS * 512;
                    c.MIX = (bf16*)(ws + WS_HMIX); c.np = np; c.qmcol = l < 2 ? A_QM : B_QM; c.fox = l >= 2; c.vcu = vcup; c.G = G; c.skip_th = 0.f;
                    c.nq = (G % 8 == 0) ? 8 : 1; c.q = vcup / (G / c.nq); c.BF = PTR(20); c.qs = MISC + 16; c.que = (unsigned*)(ws + WS_CTL) + CW_QUE + (l * 8 + c.q) * 16;
                    if (l >= 2) {
                        const float* gq = PTR(17) + (l - 2) * 128; const float* gk = PTR(21);
                        float mq = fmaxf(fabsf(gq[lane]), fabsf(gq[64 + lane])), mkk = fmaxf(fabsf(gk[lane]), fabsf(gk[64 + lane]));
                        mq = wave_max(mq); mkk = wave_max(mkk);
                        c.skip_th = FOX_SKIP ? 1270.5f + 2.0f * 128.0f * 1.02f * mq * mkk : 3.0e38f; }
                    __syncthreads();
#ifndef DBG_NO_ATT
                    for (int rep = 0; rep < REP_ATT; ++rep) att_phase(c, (char*)lds_raw, wavep);
#endif
                    }
                PH_END;
                PH_BEGIN pg8::Gemm g{(const bf16*)(ws + WS_HMIX), (const bf16*)(ws + WS_WOUT) + (size_t)l * DM * DM, M, DM, DM}; pg8::StaticOrder S; S.init(M, DM, G, bxp);
                    { pg8::EpiRes<false> E{PT, PT_OUT, PT_WS, 0, WS_XB2, WS_SS + (size_t)(3 * l + 2) * M * 8, 0, l == DEPTH - 1 ? 1 : 0, 1.0f, 0};
                      pg8::gemm_phase<pg8::EpiRes<false>, pg8::StaticOrder, true, GEMM_SP2>(lds, g, S, E, wavep); }
#if REP_OUT > 1
                    for (int rep = 1; rep < REP_OUT; ++rep) { pg8::EpiDummy E{(bf16*)(ws + WS_ACT), DM}; pg8::gemm_phase<pg8::EpiDummy, pg8::StaticOrder, true, GEMM_SP2>(lds, g, S, E, wavep); }
#endif
                    }
                PH_END;
            }
        }
    }
#undef PH_ON
#undef PH_END
#undef WSP
#undef PH_BEGIN
#undef XOUT
}

extern "C" void kernel_launch(void* const* d_in, const int* in_sizes, int n_in, void* d_out, int out_size, void* d_ws, size_t ws_size, hipStream_t stream) {
    static int grid = 0;
    if (grid == 0) {
        if (n_in != 22 || in_sizes[0] != M * DM || out_size != M * DM || ws_size < WS_END) { fprintf(stderr, "kernel_launch: unexpected shapes (n_in %d, in0 %d, out %d, ws %zu < %zu); nothing launched\n", n_in, n_in > 0 ? in_sizes[0] : -1, out_size, ws_size, (size_t)WS_END); grid = -1; return; }
        int dev = 0, cus = 0, per_cu = 0;
        if (hipGetDevice(&dev) != hipSuccess || hipDeviceGetAttribute(&cus, hipDeviceAttributeMultiprocessorCount, dev) != hipSuccess) { fprintf(stderr, "kernel_launch: device query failed\n"); grid = -1; return; }
        if (hipFuncSetAttribute((const void*)mega_fwd, hipFuncAttributeMaxDynamicSharedMemorySize, LDS_BYTES) != hipSuccess) { fprintf(stderr, "kernel_launch: hipFuncSetAttribute failed\n"); grid = -1; return; }
        if (hipOccupancyMaxActiveBlocksPerMultiprocessor(&per_cu, (const void*)mega_fwd, NWAVES * 64, LDS_BYTES) != hipSuccess || per_cu < 1)
            fprintf(stderr, "kernel_launch: note: occupancy query reports %d workgroups per CU\n", per_cu);
        (void)hipGetLastError();
        grid = cus;
    }
    if (grid < 0) return;
    (void)hipMemsetAsync((char*)d_ws + WS_CTL, 0, CTL_ZERO_BYTES, stream);
    (void)hipMemsetAsync((char*)d_ws + WS_SS, 0, SS_BYTES, stream);
    Args a{};
    for (int i = 0; i < 22; ++i) a.in[i] = (const float*)d_in[i];
    a.out = (float*)d_out; a.ws = (unsigned char*)d_ws;
#if MK_PER_PHASE
    for (int p = 0; p < NPH && p < MK_STOP_PC; ++p) { a.lo = p; a.hi = p + 1; hipLaunchKernelGGL(mega_fwd, dim3(grid), dim3(NWAVES * 64), LDS_BYTES, stream, a); }
#else
    a.lo = 0; a.hi = NPH; hipLaunchKernelGGL(mega_fwd, dim3(grid), dim3(NWAVES * 64), LDS_BYTES, stream, a);
#endif
}
```

```cpp
#ifndef PG8_WGM
#define PG8_WGM 8
#endif
#include <hip/hip_runtime.h>
#include <cstdio>
#include <cstdint>
__device__ __forceinline__ int lane_id_v() { int l; asm volatile("v_mbcnt_lo_u32_b32 %0, -1, 0\n\tv_mbcnt_hi_u32_b32 %0, -1, %0" : "=v"(l)); return l; }
namespace pg8 {
#define PG8_LAS __attribute__((address_space(3)))
typedef unsigned short bf16_t;
typedef short bf16x8 __attribute__((ext_vector_type(8)));
typedef float f32x4 __attribute__((ext_vector_type(4)));
typedef unsigned u32x4 __attribute__((ext_vector_type(4)));
constexpr int BM = 256, BK = 64, HALF = 128, HTB = HALF * BK * 2  , STAGE_BYTES = 8 * HTB, NXCD = 8, WGM = PG8_WGM;

__host__ __device__ __forceinline__ int lds_byte(int r, int c) { const int st = (r >> 4) * 2 + (c >> 5), rr = r & 15, cc = c & 31, ob = rr * 64 + cc * 2; return st * 1024 + (ob ^ (((ob >> 9) & 1) << 5)); }
__host__ __device__ __forceinline__ void stage_rc(int b, int& R, int& C) { const int st = b / 1024, sb = b % 1024, swz = sb ^ (((sb >> 9) & 1) << 5); R = (st >> 1) * 16 + swz / 64; C = (st & 1) * 32 + (swz % 64) / 2; }
__host__ __device__ __forceinline__ int perm32(int rho) { const int n = rho >> 4, i = rho & 15; return 8 * (i >> 2) + 4 * n + (i & 3); }

struct Unit { int pm, pn; };
struct Gemm { const bf16_t* A; const bf16_t* Bt; int M, N, K; };

struct StaticOrder {
    int nM, nN, nwg, G, c;
    __host__ __device__ void init(int M, int N, int G_, int c_) { nM = M / BM; nN = N / BM; nwg = nM * nN; G = G_; c = c_; }
    __host__ __device__ bool next(int i, Unit& u) const {
        const long L = (long)i * G + c; if (L >= nwg) return false;
        int wgid = (int)L; { const int q = nwg / NXCD, r = nwg % NXCD, xcd = wgid % NXCD, off = wgid / NXCD; wgid = (xcd < r ? xcd * (q + 1) : r * (q + 1) + (xcd - r) * q) + off; }
        const int nig = WGM * nN, gid = wgid / nig, fm = gid * WGM, gsz = (nM - fm) < WGM ? (nM - fm) : WGM;
        u.pm = fm + ((wgid % nig) % gsz); u.pn = (wgid % nig) / gsz; return true;
    }
    __device__ __forceinline__ void a_ready(const Unit&) const {}
    __device__ __forceinline__ void done(const Unit&) const {}
};

__device__ __forceinline__ unsigned cvt_pk_bf16(float lo, float hi) { unsigned r; asm volatile("v_cvt_pk_bf16_f32 %0, %1, %2" : "=v"(r) : "v"(lo), "v"(hi)); return r; }
typedef float f32x2 __attribute__((ext_vector_type(2)));
__device__ __forceinline__ f32x2 gelu_pk(f32x2 v) {
    const f32x2 av = __builtin_elementwise_abs(v), d = av * 0.2316418882f + 1.0f;
    f32x2 t; t.x = __builtin_amdgcn_rcpf(d.x); t.y = __builtin_amdgcn_rcpf(d.y);
    f32x2 q = t * 0.5307027145f + (-0.7265760135f); q = q * t + 0.7107068705f; q = q * t + (-0.142248368f); q = q * t + 0.127414796f; q = q * t;
    const f32x2 s = (v * v) * (-0.72134752044f);
    f32x2 e; e.x = __builtin_amdgcn_exp2f(s.x); e.y = __builtin_amdgcn_exp2f(s.y);
    const f32x2 m = v * (q * e), r = v - m;
    f32x2 o; o.x = v.x < 0.f ? m.x : r.x; o.y = v.y < 0.f ? m.y : r.y; return o;
}

template <int ACT  > struct EpiBf16 {
    static constexpr bool PERM = true, AFTER_DRAIN = false; static_assert(ACT == 0 || ACT == 1, "EpiBf16: ACT is 0 (none) or 1 (gelu_pk)");
    bf16_t* O; int ldc; const float* bias; int split_cols; size_t split_stride; float scale0;
    __device__ __forceinline__ void operator()(const f32x4 (&acc)[2][2][4][2], const Unit& u, int wr, int wc, int fr, int fq) const {
        const int row0 = u.pm * BM + wr * 64 + fr; int colt = u.pn * BM; bf16_t* base = O;
        float sc = 1.f; if (split_cols) { const int t = colt / split_cols; base += (size_t)t * split_stride; colt -= t * split_cols; if (t == 0) sc = scale0; }
        const int col0 = colt + wc * 32 + 8 * fq, bcol0 = u.pn * BM + wc * 32 + 8 * fq;
        f32x4 bv[2][2];
#pragma unroll
        for (int bj = 0; bj < 2; ++bj)
#pragma unroll
            for (int n = 0; n < 2; ++n) bv[bj][n] = bias ? *(const f32x4*)(bias + bcol0 + bj * HALF + 4 * n) : (f32x4){0.f, 0.f, 0.f, 0.f};
#pragma unroll
        for (int ai = 0; ai < 2; ++ai)
#pragma unroll
            for (int m = 0; m < 4; ++m) { bf16_t* rowp = base + (size_t)(row0 + ai * HALF + m * 16) * ldc + col0;
#pragma unroll
                for (int bj = 0; bj < 2; ++bj) { f32x4 v0 = acc[ai][bj][m][0] + bv[bj][0], v1 = acc[ai][bj][m][1] + bv[bj][1];
                    if (ACT == 1) { f32x2 a = gelu_pk((f32x2){v0[0], v0[1]}), b = gelu_pk((f32x2){v0[2], v0[3]}), c = gelu_pk((f32x2){v1[0], v1[1]}), d = gelu_pk((f32x2){v1[2], v1[3]});
                        v0 = (f32x4){a.x, a.y, b.x, b.y}; v1 = (f32x4){c.x, c.y, d.x, d.y}; }
                    v0 = v0 * sc; v1 = v1 * sc; u32x4 w; w.x = cvt_pk_bf16(v0[0], v0[1]); w.y = cvt_pk_bf16(v0[2], v0[3]); w.z = cvt_pk_bf16(v1[0], v1[1]); w.w = cvt_pk_bf16(v1[2], v1[3]);
                    *(u32x4*)(rowp + bj * HALF) = w; } }
    }
};

__device__ __forceinline__ unsigned pkbf(float lo, float hi) {
    typedef __bf16 bf2_t __attribute__((ext_vector_type(2))); typedef float fl2_t __attribute__((ext_vector_type(2)));
    fl2_t v = {lo, hi}; bf2_t r = __builtin_convertvector(v, bf2_t); return __builtin_bit_cast(unsigned, r);
}
__device__ __forceinline__ float silu_f(float x) { return x * __builtin_amdgcn_rcpf(1.0f + __builtin_amdgcn_exp2f(-1.4426950408889634f * x)); }

__device__ __forceinline__ float rinv_of(const float* ss, int row) { const float s = (float)((const unsigned long long*)ss)[row] * (1.0f / 16777216.0f); return 1.0f / sqrtf(s * (1.0f / 2048.f) + 1e-6f); }
struct RinvCache {
    const float* ss; PG8_LAS float* tab; mutable int pm_cached;
    __device__ __forceinline__ void get(float (&ri)[2][4], const Unit& u, int wr, int wc, int fr) const {
        PG8_LAS float* t = tab + (wr * 4 + wc) * 128;
        if (u.pm != pm_cached) { pm_cached = u.pm; const int l = lane_id_v();
            t[l] = rinv_of(ss, u.pm * BM + wr * 64 + l); t[64 + l] = rinv_of(ss, u.pm * BM + HALF + wr * 64 + l);
            asm volatile("s_waitcnt lgkmcnt(0)" ::: "memory"); }
#pragma unroll
        for (int ai = 0; ai < 2; ++ai)
#pragma unroll
            for (int m = 0; m < 4; ++m) ri[ai][m] = t[ai * 64 + m * 16 + fr];
    }
};
struct EpiSwiGLU {
    static constexpr bool PERM = true, AFTER_DRAIN = false;
    bf16_t* O; int ldc; RinvCache rc;
    __device__ __forceinline__ void operator()(const f32x4 (&acc)[2][2][4][2], const Unit& u, int wr, int wc, int fr, int fq) const {
        const int row0 = u.pm * BM + wr * 64 + fr, col0 = u.pn * HALF + wc * 32 + 8 * fq;
        float rit[2][4]; rc.get(rit, u, wr, wc, fr);
#pragma unroll
        for (int ai = 0; ai < 2; ++ai)
#pragma unroll
            for (int m = 0; m < 4; ++m) { bf16_t* rowp = O + (size_t)(row0 + ai * HALF + m * 16) * ldc + col0;
                const float ri = rit[ai][m]; const float ce = -1.4426950408889634f * ri, kk = __builtin_amdgcn_rcpf(ri * ri);
                const f32x4 ag0 = acc[ai][0][m][0], ag1 = acc[ai][0][m][1], au0 = acc[ai][1][m][0], au1 = acc[ai][1][m][1];
                const f32x4 t0 = ag0 * ce, t1 = ag1 * ce; f32x4 e0, e1;
#pragma unroll
                for (int j = 0; j < 4; ++j) { e0[j] = __builtin_amdgcn_exp2f(t0[j]); e1[j] = __builtin_amdgcn_exp2f(t1[j]); }
                const f32x4 d0 = e0 * kk + kk, d1 = e1 * kk + kk; f32x4 r0, r1;
#pragma unroll
                for (int j = 0; j < 4; ++j) { r0[j] = __builtin_amdgcn_rcpf(d0[j]); r1[j] = __builtin_amdgcn_rcpf(d1[j]); }
                const f32x4 o0 = (ag0 * au0) * r0, o1 = (ag1 * au1) * r1;
                u32x4 w;
                w.x = pkbf(o0[0], o0[1]); w.y = pkbf(o0[2], o0[3]); w.z = pkbf(o1[0], o1[1]); w.w = pkbf(o1[2], o1[3]);
                __builtin_nontemporal_store(w, (u32x4*)rowp); }
    }
};
typedef unsigned u32x2 __attribute__((ext_vector_type(2)));
template <bool FINAL> struct EpiRes {
    static constexpr bool PERM = true, AFTER_DRAIN = false;
    volatile PG8_LAS unsigned* PT; int slot_out, slot_ws; size_t base_off, out_off, ss_off; int base_in_ws, out_in_ws; float scale; int row_base;
    __device__ __forceinline__ void operator()(const f32x4 (&acc)[2][2][4][2], const Unit& u, int wr, int wc, int fr, int fq) const {
        typedef __attribute__((address_space(1))) unsigned char gchar;
        unsigned char* dout = (unsigned char*)(gchar*)(((unsigned long long)__builtin_amdgcn_readfirstlane(PT[2 * slot_out + 1]) << 32) | (unsigned)__builtin_amdgcn_readfirstlane(PT[2 * slot_out]));
        unsigned char* ws = (unsigned char*)(gchar*)(((unsigned long long)__builtin_amdgcn_readfirstlane(PT[2 * slot_ws + 1]) << 32) | (unsigned)__builtin_amdgcn_readfirstlane(PT[2 * slot_ws]));
        const bf16_t* base = (const bf16_t*)(base_in_ws ? ws + base_off : dout); bf16_t* outb = (bf16_t*)(out_in_ws ? ws + out_off : dout); float* outf = (float*)dout; float* ss = (float*)(ws + ss_off);
        constexpr int ldc = 2048;
        const int row0 = row_base + u.pm * BM + wr * 64 + fr, col0 = u.pn * BM + wc * 32 + 8 * fq;
        u32x4 b[2][4][2];
#pragma unroll
        for (int ai = 0; ai < 2; ++ai)
#pragma unroll
            for (int m = 0; m < 4; ++m) { const size_t off = (size_t)(row0 + ai * HALF + m * 16) * ldc + col0;
#pragma unroll
                for (int bj = 0; bj < 2; ++bj) b[ai][m][bj] = *(const u32x4*)(base + off + bj * HALF); }
#pragma unroll
        for (int ai = 0; ai < 2; ++ai) {
#pragma unroll
            for (int m = 0; m < 4; ++m) { const size_t off = (size_t)(row0 + ai * HALF + m * 16) * ldc + col0; float q = 0.f;
#pragma unroll
                for (int bj = 0; bj < 2; ++bj) { const u32x4 r = b[ai][m][bj];
                    f32x4 x0 = {__uint_as_float(r.x << 16), __uint_as_float(r.x & 0xffff0000u), __uint_as_float(r.y << 16), __uint_as_float(r.y & 0xffff0000u)};
                    f32x4 x1 = {__uint_as_float(r.z << 16), __uint_as_float(r.z & 0xffff0000u), __uint_as_float(r.w << 16), __uint_as_float(r.w & 0xffff0000u)};
                    x0 = x0 + acc[ai][bj][m][0] * scale; x1 = x1 + acc[ai][bj][m][1] * scale;
                    if (FINAL) { *(f32x4*)(outf + off + bj * HALF) = x0; *(f32x4*)(outf + off + bj * HALF + 4) = x1; }
                    else { q += ((x0[0] * x0[0] + x0[1] * x0[1]) + (x0[2] * x0[2] + x0[3] * x0[3])) + ((x1[0] * x1[0] + x1[1] * x1[1]) + (x1[2] * x1[2] + x1[3] * x1[3]));
                        u32x4 w; w.x = pkbf(x0[0], x0[1]); w.y = pkbf(x0[2], x0[3]); w.z = pkbf(x1[0], x1[1]); w.w = pkbf(x1[2], x1[3]); *(u32x4*)(outb + off + bj * HALF) = w; } }
                if (!FINAL) {
                    q += __uint_as_float((unsigned)__builtin_amdgcn_ds_swizzle((int)__float_as_uint(q), (16 << 10) | 0x1f));
                    const auto rr = __builtin_amdgcn_permlane32_swap(__float_as_uint(q), __float_as_uint(q), false, false);
                    q = __uint_as_float(rr[0]) + __uint_as_float(rr[1]);
                    if (fq == 0) atomicAdd((unsigned long long*)ss + row0 + ai * HALF + m * 16, (unsigned long long)(q * 16777216.0f)); } }
            asm volatile("" ::: "memory"); }
    }
};
struct EpiF32 {
    static constexpr bool PERM = false, AFTER_DRAIN = false;
    float* C; int ldc;
    __device__ __forceinline__ void operator()(const f32x4 (&acc)[2][2][4][2], const Unit& u, int wr, int wc, int fr, int fq) const {
        const int row0 = u.pm * BM + wr * 64 + fr, col0 = u.pn * BM + wc * 32 + 4 * fq;
#pragma unroll
        for (int ai = 0; ai < 2; ++ai)
#pragma unroll
            for (int m = 0; m < 4; ++m) { float* rowp = C + (size_t)(row0 + ai * HALF + m * 16) * ldc + col0;
#pragma unroll
                for (int bj = 0; bj < 2; ++bj)
#pragma unroll
                    for (int n = 0; n < 2; ++n) *(f32x4*)(rowp + bj * HALF + n * 16) = acc[ai][bj][m][n]; }
    }
};
struct HeadNorm { PG8_LAS float* hnt; PG8_LAS const float* gain; };
__device__ __forceinline__ void store_b16_tile(const f32x4 (&acc)[2][2][4][2], bf16_t* O, int ldc, int row0, int col0, const float (&rit)[2][4], const HeadNorm hn, int wr, int wc, int fr, int fq) {
    if (hn.gain) {
#pragma unroll
        for (int ai = 0; ai < 2; ++ai)
#pragma unroll
            for (int m = 0; m < 4; ++m) { const float ri = rit[ai][m];
#pragma unroll
                for (int bj = 0; bj < 2; ++bj) { const f32x4 v0 = acc[ai][bj][m][0] * ri, v1 = acc[ai][bj][m][1] * ri;
                    float q = ((v0[0] * v0[0] + v0[1] * v0[1]) + (v0[2] * v0[2] + v0[3] * v0[3])) + ((v1[0] * v1[0] + v1[1] * v1[1]) + (v1[2] * v1[2] + v1[3] * v1[3]));
                    q += __uint_as_float((unsigned)__builtin_amdgcn_ds_swizzle((int)__float_as_uint(q), (16 << 10) | 0x1f));
                    const auto rr = __builtin_amdgcn_permlane32_swap(__float_as_uint(q), __float_as_uint(q), false, false);
                    q = __uint_as_float(rr[0]) + __uint_as_float(rr[1]);
                    if (fq == 0) hn.hnt[((ai * HALF + wr * 64 + m * 16 + fr) * 2 + bj) * 4 + wc] = q; } }
        asm volatile("s_waitcnt lgkmcnt(0)" ::: "memory"); __builtin_amdgcn_s_barrier(); asm volatile("" ::: "memory");
        const f32x4 g0 = *(PG8_LAS const f32x4*)(hn.gain + wc * 32 + 8 * fq), g1 = *(PG8_LAS const f32x4*)(hn.gain + wc * 32 + 8 * fq + 4);
#pragma unroll
        for (int ai = 0; ai < 2; ++ai)
#pragma unroll
            for (int m = 0; m < 4; ++m) { bf16_t* rowp = O + (size_t)(row0 + ai * HALF + m * 16) * ldc + col0; const float ri = rit[ai][m];
#pragma unroll
                for (int bj = 0; bj < 2; ++bj) { const f32x4 p4 = *(PG8_LAS const f32x4*)(hn.hnt + ((ai * HALF + wr * 64 + m * 16 + fr) * 2 + bj) * 4);
                    const float rh = ri / sqrtf(((p4[0] + p4[1]) + (p4[2] + p4[3])) * (1.0f / 128.f) + 1e-6f);
                    const f32x4 v0 = acc[ai][bj][m][0] * rh * g0, v1 = acc[ai][bj][m][1] * rh * g1;
                    u32x4 w; w.x = pkbf(v0[0], v0[1]); w.y = pkbf(v0[2], v0[3]); w.z = pkbf(v1[0], v1[1]); w.w = pkbf(v1[2], v1[3]);
                    *(u32x4*)(rowp + bj * HALF) = w; } }
    } else {
#pragma unroll
        for (int ai = 0; ai < 2; ++ai)
#pragma unroll
            for (int m = 0; m < 4; ++m) { bf16_t* rowp = O + (size_t)(row0 + ai * HALF + m * 16) * ldc + col0; const float ri = rit[ai][m];
#pragma unroll
                for (int bj = 0; bj < 2; ++bj) { const f32x4 v0 = acc[ai][bj][m][0] * ri, v1 = acc[ai][bj][m][1] * ri;
                    u32x4 w; w.x = pkbf(v0[0], v0[1]); w.y = pkbf(v0[2], v0[3]); w.z = pkbf(v1[0], v1[1]); w.w = pkbf(v1[2], v1[3]);
                    *(u32x4*)(rowp + bj * HALF) = w; } }
    }
}
struct EpiB16 {
    static constexpr bool PERM = true, AFTER_DRAIN = false;
    bf16_t* O; int ldc; RinvCache rc; PG8_LAS float* hnt; PG8_LAS const float* gains; int t0lo, t0hi, t1lo, t1hi;
    __device__ __forceinline__ void operator()(const f32x4 (&acc)[2][2][4][2], const Unit& u, int wr, int wc, int fr, int fq) const {
        const int row0 = u.pm * BM + wr * 64 + fr, col0 = u.pn * BM + wc * 32 + 8 * fq;
        float rit[2][4]; rc.get(rit, u, wr, wc, fr);
        HeadNorm hn{hnt, nullptr};
        if (u.pn >= t0lo && u.pn < t0hi) hn.gain = gains; else if (u.pn >= t1lo && u.pn < t1hi) hn.gain = gains + 128;
        store_b16_tile(acc, O, ldc, row0, col0, rit, hn, wr, wc, fr, fq);
    }
};
struct EpiKV {
    static constexpr bool PERM = true, AFTER_DRAIN = false;
    bf16_t* O; int ldc; float* F; RinvCache rc; PG8_LAS float* hnt; PG8_LAS const float* gains;
    __device__ __forceinline__ void operator()(const f32x4 (&acc)[2][2][4][2], const Unit& u, int wr, int wc, int fr, int fq) const {
        const int row0 = u.pm * BM + wr * 64 + fr;
        float rit[2][4]; rc.get(rit, u, wr, wc, fr);
        if (u.pn < 12) {
            HeadNorm hn{hnt, u.pn < 6 ? gains : nullptr};
            store_b16_tile(acc, O, ldc, row0, u.pn * BM + wc * 32 + 8 * fq, rit, hn, wr, wc, fr, fq);
        } else if (wc == 0 && fq < 2) {
#pragma unroll
            for (int ai = 0; ai < 2; ++ai)
#pragma unroll
                for (int m = 0; m < 4; ++m) { float* rowp = F + (size_t)(row0 + ai * HALF + m * 16) * 16 + 8 * fq; const float ri = rit[ai][m];
                    *(f32x4*)(rowp) = acc[ai][0][m][0] * ri; *(f32x4*)(rowp + 4) = acc[ai][0][m][1] * ri; }
        }
    }
};
struct EpiDummy {
    static constexpr bool PERM = true, AFTER_DRAIN = false;
    bf16_t* O; int ldc;
    __device__ __forceinline__ void operator()(const f32x4 (&acc)[2][2][4][2], const Unit& u, int wr, int wc, int fr, int fq) const {
        const int row0 = u.pm * BM + wr * 64 + fr, col0 = u.pn * BM + wc * 32 + 8 * fq;
#pragma unroll
        for (int ai = 0; ai < 2; ++ai)
#pragma unroll
            for (int m = 0; m < 4; ++m) { bf16_t* rowp = O + (size_t)(row0 + ai * HALF + m * 16) * ldc + col0;
#pragma unroll
                for (int bj = 0; bj < 2; ++bj) { const f32x4 v0 = acc[ai][bj][m][0], v1 = acc[ai][bj][m][1];
                    u32x4 w; w.x = pkbf(v0[0], v0[1]); w.y = pkbf(v0[2], v0[3]); w.z = pkbf(v1[0], v1[1]); w.w = pkbf(v1[2], v1[3]);
                    *(u32x4*)(rowp + bj * HALF) = w; } }
    }
};

struct EpiNull {
    static constexpr bool PERM = true, AFTER_DRAIN = false;
    float* sink;
    __device__ __forceinline__ void operator()(const f32x4 (&acc)[2][2][4][2], const Unit& u, int wr, int wc, int fr, int fq) const {
        f32x4 t = {0.f, 0.f, 0.f, 0.f};
#pragma unroll
        for (int ai = 0; ai < 2; ++ai)
#pragma unroll
            for (int bj = 0; bj < 2; ++bj)
#pragma unroll
                for (int m = 0; m < 4; ++m) { t = t + acc[ai][bj][m][0]; t = t + acc[ai][bj][m][1]; }
        if ((t[0] + t[1]) + (t[2] + t[3]) == 1.2345678e33f) sink[0] = t[0];
    }
};
template <class Epi, class Sched, bool ALIGN_EPI = false, bool SP2 = false>
__device__ __forceinline__ void gemm_phase(PG8_LAS unsigned char* lds, const Gemm g, const Sched& S, const Epi E, const int wave_in) {
    const int tid_l = wave_in * 64 + lane_id_v();
    const int tid = tid_l, wid = wave_in, lane = tid & 63, wr = wid >> 2, wc = wid & 3, fr = lane & 15, fq = lane >> 4;
    const int K = g.K, nt = K / BK;
    unsigned voffA[2], voffB[2];
#pragma unroll
    for (int i = 0; i < 2; ++i) { int R, C; stage_rc(tid * 16 + i * 8192, R, C); const int Rb = Epi::PERM ? ((R & ~31) + perm32(R & 31)) : R;
        voffA[i] = (unsigned)(R * K + C) * 2u; voffB[i] = (unsigned)(Rb * K + C) * 2u; }
    const size_t kstep = (size_t)(BK * 2);
    const size_t hstep = (size_t)HALF * K * 2;
    const size_t tstep = 2 * hstep;
    const unsigned ldsw = (unsigned)wid * 1024u;
    const int aoff = lds_byte(wr * 64 + fr, fq * 8), boff = lds_byte(wc * 32 + fr, fq * 8);
#define PG8_SA(b, h) (((b) * 2 + (h)) * HTB)
#define PG8_SB(b, h) ((4 + (b) * 2 + (h)) * HTB)
#define PG8_STAGE(bufoff, gbase, voff) do { _Pragma("unroll") for (int _i = 0; _i < 2; ++_i) \
        __builtin_amdgcn_global_load_lds((const unsigned*)((const char*)(gbase) + (voff)[_i]), (PG8_LAS unsigned*)(lds + (bufoff) + ldsw + _i * 8192), 16, 0, 0); } while (0)
#define PG8_LDA(dst, b, h) do { _Pragma("unroll") for (int m = 0; m < 4; ++m) _Pragma("unroll") for (int k = 0; k < 2; ++k) dst[m][k] = *(const PG8_LAS bf16x8*)(lds + PG8_SA(b, h) + aoff + m * 2048 + k * 1024); } while (0)
#define PG8_LDB(dst, b, h) do { _Pragma("unroll") for (int n = 0; n < 2; ++n) _Pragma("unroll") for (int k = 0; k < 2; ++k) dst[n][k] = *(const PG8_LAS bf16x8*)(lds + PG8_SB(b, h) + boff + n * 2048 + k * 1024); } while (0)
#define PG8_MMA(ai, bj, At, Bt) do { __builtin_amdgcn_s_setprio(1); _Pragma("unroll") for (int m = 0; m < 4; ++m) _Pragma("unroll") for (int n = 0; n < 2; ++n) _Pragma("unroll") for (int k = 0; k < 2; ++k) \
        acc[ai][bj][m][n] = __builtin_amdgcn_mfma_f32_16x16x32_bf16(Bt[n][k], At[m][k], acc[ai][bj][m][n], 0, 0, 0); __builtin_amdgcn_s_setprio(0); } while (0)
#define PG8_WAIT_V(n) asm volatile("s_waitcnt vmcnt(" #n ")" ::: "memory")
#define PG8_WAIT_L(n) asm volatile("s_waitcnt lgkmcnt(" #n ")" ::: "memory")
#define PG8_BAR __builtin_amdgcn_s_barrier()
#define PG8_SCHED __builtin_amdgcn_sched_barrier(0)
    Unit cur, nxt; int ui = 0;
    if (!S.next(0, cur)) return;
    f32x4 acc[2][2][4][2];
#pragma unroll
    for (int a = 0; a < 2; ++a)
#pragma unroll
        for (int b = 0; b < 2; ++b)
#pragma unroll
            for (int m = 0; m < 4; ++m)
#pragma unroll
                for (int n = 0; n < 2; ++n) acc[a][b][m][n] = (f32x4){0.f, 0.f, 0.f, 0.f};
    bf16x8 At[4][2], B0[2][2], B1[2][2];
    const char* cA = (const char*)g.A + (size_t)cur.pm * tstep; const char* cB = (const char*)g.Bt + (size_t)cur.pn * tstep;
    S.a_ready(cur);
    if constexpr (SP2) {
        PG8_STAGE(PG8_SB(0, 0), cB, voffB); PG8_STAGE(PG8_SB(0, 1), cB + hstep, voffB); PG8_STAGE(PG8_SA(0, 0), cA, voffA); PG8_STAGE(PG8_SA(0, 1), cA + hstep, voffA);
        if (wr == 1) PG8_BAR;
        PG8_WAIT_V(2); PG8_BAR;
        PG8_STAGE(PG8_SB(1, 0), cB + kstep, voffB); PG8_STAGE(PG8_SA(1, 0), cA + kstep, voffA); PG8_STAGE(PG8_SB(1, 1), cB + hstep + kstep, voffB);
        PG8_WAIT_V(6); PG8_BAR;
    } else {
        PG8_STAGE(PG8_SB(0, 0), cB, voffB); PG8_STAGE(PG8_SA(0, 0), cA, voffA); PG8_STAGE(PG8_SB(0, 1), cB + hstep, voffB); PG8_STAGE(PG8_SA(0, 1), cA + hstep, voffA);
        if (wr == 1) PG8_BAR;
        PG8_WAIT_V(4); PG8_BAR;
        PG8_STAGE(PG8_SB(1, 0), cB + kstep, voffB); PG8_STAGE(PG8_SA(1, 0), cA + kstep, voffA); PG8_STAGE(PG8_SB(1, 1), cB + hstep + kstep, voffB);
        PG8_WAIT_V(6); PG8_BAR;
    }
    for (;;) {
        const bool has_next = S.next(ui + 1, nxt);
        const char* nA = has_next ? (const char*)g.A + (size_t)nxt.pm * tstep : cA; const char* nB = has_next ? (const char*)g.Bt + (size_t)nxt.pn * tstep : cB;
        for (int t = 0; t < nt; t += 2) {
            const bool last = (t == nt - 2);
            const char* a1 = cA + (size_t)(t + 1) * kstep;
            const char* a2 = last ? nA : cA + (size_t)(t + 2) * kstep; const char* b2 = last ? nB : cB + (size_t)(t + 2) * kstep;
            const char* a3 = a2 + kstep; const char* b3 = b2 + kstep;
            if (last && has_next) S.a_ready(nxt);
            if constexpr (SP2) {
            PG8_LDB(B0, 0, 0); PG8_LDB(B1, 0, 1); PG8_SCHED; PG8_LDA(At, 0, 0); PG8_STAGE(PG8_SA(1, 1), a1 + hstep, voffA);
            PG8_WAIT_V(8); PG8_WAIT_L(0); PG8_BAR; PG8_MMA(0, 0, At, B0); PG8_MMA(0, 1, At, B1); PG8_BAR; PG8_SCHED;
            PG8_LDA(At, 0, 1); PG8_STAGE(PG8_SB(0, 0), b2, voffB); PG8_STAGE(PG8_SB(0, 1), b2 + hstep, voffB); PG8_STAGE(PG8_SA(0, 0), a2, voffA);
            PG8_WAIT_V(8); PG8_WAIT_L(0); PG8_BAR; PG8_MMA(1, 0, At, B0); PG8_MMA(1, 1, At, B1); PG8_BAR; PG8_SCHED;
            PG8_LDB(B0, 1, 0); PG8_LDB(B1, 1, 1); PG8_SCHED; PG8_LDA(At, 1, 0); PG8_STAGE(PG8_SA(0, 1), a2 + hstep, voffA);
            PG8_WAIT_V(8); PG8_WAIT_L(0); PG8_BAR; PG8_MMA(0, 0, At, B0); PG8_MMA(0, 1, At, B1); PG8_BAR; PG8_SCHED;
            PG8_LDA(At, 1, 1); PG8_STAGE(PG8_SB(1, 0), b3, voffB); PG8_STAGE(PG8_SB(1, 1), b3 + hstep, voffB); PG8_STAGE(PG8_SA(1, 0), a3, voffA);
            PG8_WAIT_V(8); PG8_WAIT_L(0); PG8_BAR; PG8_MMA(1, 0, At, B0); PG8_MMA(1, 1, At, B1); PG8_BAR; PG8_SCHED;
            } else {
            PG8_LDB(B0, 0, 0); PG8_SCHED; PG8_LDA(At, 0, 0); PG8_STAGE(PG8_SA(1, 1), a1 + hstep, voffA);
            PG8_WAIT_L(8); PG8_BAR; PG8_WAIT_L(0); PG8_MMA(0, 0, At, B0); PG8_BAR; PG8_SCHED;
            PG8_LDB(B1, 0, 1); PG8_STAGE(PG8_SB(0, 0), b2, voffB);
            PG8_BAR; PG8_WAIT_L(0); PG8_MMA(0, 1, At, B1); PG8_BAR;
            PG8_LDA(At, 0, 1); PG8_STAGE(PG8_SA(0, 0), a2, voffA);
            PG8_BAR; PG8_WAIT_L(0); PG8_MMA(1, 0, At, B0); PG8_BAR; PG8_SCHED;
            PG8_STAGE(PG8_SB(0, 1), b2 + hstep, voffB);
            PG8_WAIT_V(6); PG8_BAR; PG8_MMA(1, 1, At, B1); PG8_BAR;
            PG8_LDB(B0, 1, 0); PG8_SCHED; PG8_LDA(At, 1, 0); PG8_STAGE(PG8_SA(0, 1), a2 + hstep, voffA);
            PG8_WAIT_L(8); PG8_BAR; PG8_WAIT_L(0); PG8_MMA(0, 0, At, B0); PG8_BAR; PG8_SCHED;
            PG8_LDB(B1, 1, 1); PG8_STAGE(PG8_SB(1, 0), b3, voffB);
            PG8_BAR; PG8_WAIT_L(0); PG8_MMA(0, 1, At, B1); PG8_BAR;
            PG8_LDA(At, 1, 1); PG8_STAGE(PG8_SA(1, 0), a3, voffA);
            PG8_BAR; PG8_WAIT_L(0); PG8_MMA(1, 0, At, B0); PG8_BAR; PG8_SCHED;
            PG8_STAGE(PG8_SB(1, 1), b3 + hstep, voffB);
            PG8_WAIT_V(6); PG8_BAR; PG8_MMA(1, 1, At, B1); PG8_BAR;
            }
        }
        if constexpr (ALIGN_EPI) { if (wr == 0) PG8_BAR; }
        if constexpr (!Epi::AFTER_DRAIN) { E(acc, cur, wr, wc, fr, fq); S.done(cur); }
        if (!has_next) break;
#pragma unroll
        for (int a = 0; a < 2; ++a)
#pragma unroll
            for (int b = 0; b < 2; ++b)
#pragma unroll
                for (int m = 0; m < 4; ++m)
#pragma unroll
                    for (int n = 0; n < 2; ++n) acc[a][b][m][n] = (f32x4){0.f, 0.f, 0.f, 0.f};
        cur = nxt; cA = nA; cB = nB; ++ui;
        if constexpr (ALIGN_EPI) { if (wr == 1) PG8_BAR; }
    }
    PG8_WAIT_V(0);
    if constexpr (!ALIGN_EPI) { if (wr == 0) PG8_BAR; }
    PG8_BAR;
    if constexpr (Epi::AFTER_DRAIN) { E.fused(acc, cur, wr, wc, fr, fq, lds, wid, lane); S.done(cur); }
#undef PG8_SA
#undef PG8_SB
#undef PG8_STAGE
#undef PG8_LDA
#undef PG8_LDB
#undef PG8_MMA
#undef PG8_WAIT_V
#undef PG8_WAIT_L
#undef PG8_BAR
#undef PG8_SCHED
}
}

namespace fa {
constexpr float SCALE = 0.08838834764831845f;
constexpr int D = 128, NW = 8, QBLK = 32, KVBLK = 64, QB = NW * QBLK;
constexpr int SHM_V = KVBLK * D * 2, SHM_K = KVBLK * D * 2;
constexpr int LDS_BYTES = 2 * SHM_V + 2 * SHM_K + NW * 64 * 4;
constexpr float THR = 8.f;
constexpr int EPI_PITCH = 528;
constexpr int OP = 2048;
typedef unsigned short bf16;
typedef short bf16x8 __attribute__((ext_vector_type(8)));
typedef short s16x4 __attribute__((ext_vector_type(4)));
typedef float f32x16 __attribute__((ext_vector_type(16)));
typedef float f32x4 __attribute__((ext_vector_type(4)));
typedef unsigned u32x4 __attribute__((ext_vector_type(4)));

#define KSWZ(row, colB) ((row) * 256 + ((colB) ^ (((row) & 7) << 4)))
#define SBAR() __builtin_amdgcn_sched_barrier(0)
__device__ __forceinline__ int v_st(int k, int c) { const int kk = (k & ~0xC) | ((k & 4) << 1) | ((k & 8) >> 1); return ((kk >> 3) * 4 + (c >> 5)) * 512 + ((kk & 7) * 32 + (c & 31)) * 2; }
__device__ __forceinline__ int v_rd_base(int lane) { return ((lane & 3) << 3) | (((lane >> 2) & 3) << 6) | (((lane >> 4) & 1) << 5) | (((lane >> 5) & 1) << 8); }
constexpr int v_rd_off(int d0, int ks, int half) { return d0 * 512 + ks * 4096 + half * 2048; }
__device__ __forceinline__ int crow(int r, int hi) { return (r & 3) + 8 * (r >> 2) + 4 * hi; }
__device__ __forceinline__ unsigned cvtpk(float lo, float hi) {
    unsigned r; asm volatile("v_cvt_pk_bf16_f32 %0, %1, %2" : "=v"(r) : "v"(lo), "v"(hi)); return r;
}
__device__ __forceinline__ bf16x8 load8(const bf16* p) { return *reinterpret_cast<const bf16x8*>(p); }
__device__ __forceinline__ bf16x8 cb_frag(float c, int hi) {
    const unsigned u1 = __float_as_uint(c) & 0xffff0000u; const float r1 = c - __uint_as_float(u1);
    const unsigned v1 = __float_as_uint(r1) & 0xffff0000u; const float r2 = r1 - __uint_as_float(v1);
    const unsigned w1 = __float_as_uint(r2) & 0xffff0000u;
    u32x4 w = {hi ? 0u : ((u1 >> 16) | v1), hi ? 0u : (w1 >> 16), 0u, 0u};
    return *reinterpret_cast<bf16x8*>(&w);
}
__device__ __forceinline__ int hi_opaque() { return lane_id_v() >> 5; }
__device__ __forceinline__ bf16x8 ones_frag(int hi) { u32x4 w = {hi ? 0u : 0x3F803F80u, hi ? 0u : 0x00003F80u, 0u, 0u}; return *reinterpret_cast<bf16x8*>(&w); }
__device__ __forceinline__ void mask_tile(f32x16& p0, f32x16& p1, int dq, unsigned W) {
    const float NEG = -__builtin_inff();
#pragma unroll
    for (int r = 0; r < 16; ++r) {
        const int c = (r & 3) + 8 * (r >> 2);
        if ((unsigned)(dq - c) >= W) p0[r] = NEG;
        if ((unsigned)(dq - c - 32) >= W) p1[r] = NEG;
    }
}
__device__ __forceinline__ void partialSM(f32x16& p0, f32x16& p1, float& m_reg, float& mn, float& alpha) {
    float pmax = p0[0]; for (int r = 1; r < 16; ++r) pmax = fmaxf(pmax, p0[r]); for (int r = 0; r < 16; ++r) pmax = fmaxf(pmax, p1[r]);
    { auto rr = __builtin_amdgcn_permlane32_swap(__float_as_uint(pmax), __float_as_uint(pmax), false, false);
      pmax = fmaxf(__uint_as_float(rr[0]), __uint_as_float(rr[1])); }
    constexpr float C2 = 1.4426950408889634f * SCALE;
    if (__builtin_expect(__all((pmax - m_reg) * SCALE <= THR), 1)) { mn = m_reg; alpha = 1.f; }
    else { mn = fmaxf(m_reg, pmax); alpha = __builtin_amdgcn_exp2f((m_reg - mn) * C2); m_reg = mn; }
    const float mnL = -mn * C2;
    for (int r = 0; r < 16; ++r) p0[r] = fmaf(p0[r], C2, mnL); for (int r = 0; r < 16; ++r) p1[r] = fmaf(p1[r], C2, mnL);
    for (int r = 0; r < 16; ++r) p0[r] = __builtin_amdgcn_exp2f(p0[r]);
}
__device__ __forceinline__ void finishSM(f32x16& p0, f32x16& p1, float alpha, float& l_reg, bf16x8& pa0, bf16x8& pa1, bf16x8& pa2, bf16x8& pa3) {
    for (int r = 0; r < 16; ++r) p1[r] = __builtin_amdgcn_exp2f(p1[r]);
    float ps = 0; for (int r = 0; r < 16; ++r) ps += p0[r]; for (int r = 0; r < 16; ++r) ps += p1[r];
    { auto rr = __builtin_amdgcn_permlane32_swap(__float_as_uint(ps), __float_as_uint(ps), false, false);
      ps = __uint_as_float(rr[0]) + __uint_as_float(rr[1]); }
    l_reg = l_reg * alpha + ps;
#define PK4(P, B_, OUT) do { unsigned a0 = cvtpk(P[B_+0], P[B_+1]), a1 = cvtpk(P[B_+2], P[B_+3]);                          \
        unsigned b0 = cvtpk(P[B_+4], P[B_+5]), b1 = cvtpk(P[B_+6], P[B_+7]);                                             \
        auto r0 = __builtin_amdgcn_permlane32_swap(a0, b0, false, false); auto r1 = __builtin_amdgcn_permlane32_swap(a1, b1, false, false); \
        u32x4 w = {r0[0], r1[0], r0[1], r1[1]}; OUT = *reinterpret_cast<bf16x8*>(&w); } while (0)
    PK4(p0, 0, pa0); PK4(p0, 8, pa1); PK4(p1, 0, pa2); PK4(p1, 8, pa3);
#undef PK4
}
template <int KB>
__device__ __forceinline__ void qkt(f32x16& p0, f32x16& p1, const char* K_lds, int r32, int hi, const bf16x8* qr, bf16x8 kx0, bf16x8 kx1, bf16x8 qx) {
    p0 = __builtin_amdgcn_mfma_f32_32x32x16_bf16(kx0, qx, f32x16{}, 0, 0, 0);
    p1 = __builtin_amdgcn_mfma_f32_32x32x16_bf16(kx1, qx, f32x16{}, 0, 0, 0);
    const char* kb[4];
#pragma unroll
    for (int dd = 0; dd < 4; ++dd) kb[dd] = K_lds + KB * SHM_K + KSWZ(r32, (dd * 16 + hi * 8) * 2);
#pragma unroll
    for (int d0 = 0; d0 < 8; ++d0) { const char* a = kb[d0 & 3] + (d0 >> 2) * 128;
        bf16x8 b0 = *reinterpret_cast<const bf16x8*>(a);
        bf16x8 b1 = *reinterpret_cast<const bf16x8*>(a + 32 * 256);
        p0 = __builtin_amdgcn_mfma_f32_32x32x16_bf16(b0, qr[d0], p0, 0, 0, 0);
        p1 = __builtin_amdgcn_mfma_f32_32x32x16_bf16(b1, qr[d0], p1, 0, 0, 0); }
}
template <int VB>
__device__ __forceinline__ void pv_tile(f32x16* o, int vb0, bf16x8 pa0, bf16x8 pa1, bf16x8 pa2, bf16x8 pa3) {
#define TRRD(dst, off) asm volatile("ds_read_b64_tr_b16 %0, %1 offset:%2" : "=&v"(dst) : "v"(vb0), "i"(off) : "memory")
#define PV_D0(d0) do { s16x4 l0, l1, l2, l3, h0, h1, h2, h3; constexpr int b_ = VB * SHM_V + v_rd_off(d0, 0, 0);     \
        TRRD(l0, b_); TRRD(h0, b_ + 2048); TRRD(l1, b_ + 4096); TRRD(h1, b_ + 6144); TRRD(l2, b_ + 8192); TRRD(h2, b_ + 10240); TRRD(l3, b_ + 12288); TRRD(h3, b_ + 14336); \
        asm volatile("s_waitcnt lgkmcnt(0)" ::: "memory"); SBAR();                 \
        o[d0] = __builtin_amdgcn_mfma_f32_32x32x16_bf16(pa0, (bf16x8){l0[0], l0[1], l0[2], l0[3], h0[0], h0[1], h0[2], h0[3]}, o[d0], 0, 0, 0);   \
        o[d0] = __builtin_amdgcn_mfma_f32_32x32x16_bf16(pa1, (bf16x8){l1[0], l1[1], l1[2], l1[3], h1[0], h1[1], h1[2], h1[3]}, o[d0], 0, 0, 0);   \
        o[d0] = __builtin_amdgcn_mfma_f32_32x32x16_bf16(pa2, (bf16x8){l2[0], l2[1], l2[2], l2[3], h2[0], h2[1], h2[2], h2[3]}, o[d0], 0, 0, 0);   \
        o[d0] = __builtin_amdgcn_mfma_f32_32x32x16_bf16(pa3, (bf16x8){l3[0], l3[1], l3[2], l3[3], h3[0], h3[1], h3[2], h3[3]}, o[d0], 0, 0, 0); } while (0)
    PV_D0(0); PV_D0(1); PV_D0(2); PV_D0(3);
#undef PV_D0
#undef TRRD
}

struct BlockRef { const bf16* Q; const bf16* K; const bf16* V; bf16* O; const bf16* G; const float* CB; int P0, skv, qp, kp, jlo; };
struct Seam { bf16x8 qr[8]; bf16x8 st_v0, st_v1, st_k0, st_k1; float cb0, cb1; };
#define ROWP(p, k0, rr, pitch) ((p) + (size_t)(k0) * (pitch) + (unsigned)((rr) * (pitch) + sc))
#define VMW() asm volatile("s_waitcnt vmcnt(0)" ::: "memory")
#define VMWN(n) asm volatile("s_waitcnt vmcnt(%0)" :: "i"(n) : "memory")
#define SLOAD_H(Kp, Vp, Cp, k0, pitch) do { S.st_v0 = load8(ROWP(Vp, k0, sr, pitch)); S.st_v1 = load8(ROWP(Vp, k0, 32 + sr, pitch));              \
                         S.st_k0 = load8(ROWP(Kp, k0, sr, pitch)); S.st_k1 = load8(ROWP(Kp, k0, 32 + sr, pitch));                                    \
                         S.cb0 = (Cp) ? (Cp)[(k0) + r32] : 0.f; S.cb1 = (Cp) ? (Cp)[(k0) + 32 + r32] : 0.f; } while (0)
#define SWRITE_HK(bf) do { *(bf16x8*)(K_lds + (bf) * SHM_K + kws) = S.st_k0; *(bf16x8*)(K_lds + (bf) * SHM_K + kws + 32 * 256) = S.st_k1; } while (0)
#define SWRITE_HV(bf) do { *(bf16x8*)(V_lds + (bf) * SHM_V + vst0) = S.st_v0; *(bf16x8*)(V_lds + (bf) * SHM_V + vst1) = S.st_v1; } while (0)
#define SWRITE_H(bf) do { SWRITE_HV(bf); SWRITE_HK(bf); } while (0)
__device__ __forceinline__ void attn_prime(const BlockRef& cur, char* lds, Seam& S, const int wave_in) {
    const int tid = wave_in * 64 + lane_id_v(), wid = wave_in, lane = tid & 63, r32 = lane & 31, hi = lane >> 5;
    const int sr = tid >> 4, sc = (tid & 15) * 8, kws = KSWZ(sr, sc * 2); char* K_lds = lds + 2 * SHM_V;
#pragma unroll
    for (int d0 = 0; d0 < 8; ++d0) S.qr[d0] = load8(cur.Q + (size_t)(wid * QBLK + r32) * cur.qp + d0 * 16 + hi * 8);
    SLOAD_H(cur.K, cur.V, cur.CB, cur.jlo * KVBLK, cur.kp); VMW(); SWRITE_HK(0);
    __syncthreads();
}
__device__ __forceinline__ void attn_block(const BlockRef& cur, const BlockRef& nxt, char* lds, Seam& S, const int wave_in) {
    const int tid = wave_in * 64 + lane_id_v(), wid = wave_in, lane = tid & 63, r32 = lane & 31, hi = lane >> 5;
    constexpr int W = 1 << 30;
    int j_hi = (cur.P0 + QB - 1) / KVBLK + 1; if (j_hi > cur.skv / KVBLK) j_hi = cur.skv / KVBLK;
    const int j_lo = cur.jlo; const int NT = j_hi - j_lo;
    const int qlo = cur.P0 + wid * QBLK, qm = qlo + r32 - 4 * hi;
    char* V_lds = lds; char* K_lds = lds + 2 * SHM_V;
    float* ws = (float*)(lds + 2 * SHM_V + 2 * SHM_K) + wid * 64; float* li_l = ws, * al_l = ws + 32;
    float m_reg = -1e30f, l_reg = 0; f32x16 o[4] = {};
    const int sr = tid >> 4, sc = (tid & 15) * 8, vst0 = v_st(sr, sc), vst1 = v_st(32 + sr, sc), kws = KSWZ(sr, sc * 2);
    const int vb0 = (int)(uintptr_t)V_lds + v_rd_base(lane);
    const bf16* Kh = cur.K; const bf16* Vh = cur.V; const float* Ch = cur.CB; const int KP = cur.kp;
#define QX() ones_frag(hi_opaque())
#define RESC(a) do { if (__any((a) < 1.f)) { if (hi == 0) al_l[r32] = (a); asm volatile("s_waitcnt lgkmcnt(0)" ::: "memory");              \
                     for (int d_ = 0; d_ < 4; ++d_) for (int r = 0; r < 16; ++r) o[d_][r] *= al_l[crow(r, hi)]; } } while (0)
#define KBASE(t) ((j_lo + (t)) * KVBLK)
#define MASKT(P0_, P1_, t) do { const int kb_ = KBASE(t); if (kb_ + KVBLK - 1 > qlo) mask_tile(P0_, P1_, qm - kb_, (unsigned)W); } while (0)
#define SEAM_K0() do { VMWN(8); SWRITE_HK(0); SBAR(); } while (0)
    f32x16 pA0, pA1, pB0, pB1; float mnA, mnB, alA, alB; bf16x8 pa0, pa1, pa2, pa3; bf16x8 kx0, kx1;
    SWRITE_HV(0); SBAR();
    kx0 = cb_frag(S.cb0, hi); kx1 = cb_frag(S.cb1, hi);
    if (NT > 1) SLOAD_H(Kh, Vh, Ch, KBASE(1), KP);
    SBAR(); qkt<0>(pA0, pA1, K_lds, r32, hi, S.qr, kx0, kx1, QX());
    MASKT(pA0, pA1, 0); partialSM(pA0, pA1, m_reg, mnA, alA);
    if (NT > 1) { VMW(); SWRITE_H(1); }
    __syncthreads();
#define HALF_STEP(PX0, PX1, mnX, alX, PY0, PY1, alY, t, KB, VB, SB) do {                                                      \
        SBAR(); kx0 = cb_frag(S.cb0, hi); kx1 = cb_frag(S.cb1, hi);                                                           \
        qkt<KB>(PX0, PX1, K_lds, r32, hi, S.qr, kx0, kx1, QX());                                                                \
        finishSM(PY0, PY1, alY, l_reg, pa0, pa1, pa2, pa3); SBAR();                                                           \
        if ((t) + 1 < NT) { SLOAD_H(Kh, Vh, Ch, KBASE((t) + 1), KP); SBAR(); }                                                \
        pv_tile<VB>(o, vb0, pa0, pa1, pa2, pa3); MASKT(PX0, PX1, (t)); partialSM(PX0, PX1, m_reg, mnX, alX);                  \
        __syncthreads();                                                                                                      \
        if ((t) + 1 < NT) { VMW(); SWRITE_H(SB); }                                                                            \
        RESC(alX); __syncthreads(); } while (0)
    for (int t = 1; t + 1 < NT; t += 2) {
        HALF_STEP(pB0, pB1, mnB, alB, pA0, pA1, alA, t, 1, 0, 0);
        HALF_STEP(pA0, pA1, mnA, alA, pB0, pB1, alB, t + 1, 0, 1, 1);
    }
    const bool even = (NT & 1) == 0;
    if (even) { SBAR(); kx0 = cb_frag(S.cb0, hi); kx1 = cb_frag(S.cb1, hi); qkt<1>(pB0, pB1, K_lds, r32, hi, S.qr, kx0, kx1, QX()); SBAR(); }
    SLOAD_H(nxt.K, nxt.V, nxt.CB, nxt.jlo * KVBLK, nxt.kp); SBAR();
#pragma unroll
    for (int d0 = 0; d0 < 8; ++d0) S.qr[d0] = load8(nxt.Q + (size_t)(wid * QBLK + r32) * nxt.qp + d0 * 16 + hi * 8);
    SBAR();
    finishSM(pA0, pA1, alA, l_reg, pa0, pa1, pa2, pa3); SBAR();
    pv_tile<0>(o, vb0, pa0, pa1, pa2, pa3);
    if (even) { MASKT(pB0, pB1, NT - 1); partialSM(pB0, pB1, m_reg, mnB, alB); __syncthreads(); RESC(alB);
        finishSM(pB0, pB1, alB, l_reg, pa0, pa1, pa2, pa3); SBAR(); pv_tile<1>(o, vb0, pa0, pa1, pa2, pa3); }
    SBAR(); SEAM_K0();
    if (hi == 0) li_l[r32] = l_reg; asm volatile("s_waitcnt lgkmcnt(0)" ::: "memory");
    float rli[16];
#pragma unroll
    for (int r = 0; r < 16; ++r) rli[r] = __builtin_amdgcn_rcpf(li_l[crow(r, hi)]);
    bf16* Ow = cur.O + (size_t)(wid * QBLK) * OP;
    const bf16* Gw = cur.G ? cur.G + (size_t)(wid * QBLK) * cur.qp : nullptr; const int GP = cur.qp;
    char* stg = lds + LDS_BYTES + wid * (8 * EPI_PITCH);
    const int erow = lane >> 4, egrp = lane & 15;
    u32x4 gq[8];
    if (Gw) {
#pragma unroll
        for (int i = 0; i < 8; ++i) gq[i] = *(const u32x4*)(Gw + (size_t)(8 * (i >> 1) + 4 * (i & 1) + erow) * GP + egrp * 8); }
#pragma unroll
    for (int p = 0; p < 4; ++p) {
#pragma unroll
        for (int rr = 0; rr < 4; ++rr)
#pragma unroll
            for (int d0 = 0; d0 < 4; ++d0) *(float*)(stg + (rr + 4 * hi) * EPI_PITCH + (d0 * 32 + r32) * 4) = o[d0][4 * p + rr] * rli[4 * p + rr];
        asm volatile("s_waitcnt lgkmcnt(0)" ::: "memory");
#pragma unroll
        for (int i = 0; i < 2; ++i) { const int row = erow + 4 * i;
            f32x4 va = *(const f32x4*)(stg + row * EPI_PITCH + egrp * 32), vb = *(const f32x4*)(stg + row * EPI_PITCH + egrp * 32 + 16);
            if (Gw) { const u32x4 g = gq[2 * p + i];
#pragma unroll
                for (int j = 0; j < 4; ++j) { const unsigned gw_ = j == 0 ? g.x : j == 1 ? g.y : j == 2 ? g.z : g.w;
                    const float g0 = __uint_as_float(gw_ << 16), g1 = __uint_as_float(gw_ & 0xffff0000u);
                    const float s0 = __builtin_amdgcn_rcpf(1.0f + __builtin_amdgcn_exp2f(-1.4426950408889634f * g0)), s1 = __builtin_amdgcn_rcpf(1.0f + __builtin_amdgcn_exp2f(-1.4426950408889634f * g1));
                    if (j < 2) { va[2 * j] *= s0; va[2 * j + 1] *= s1; } else { vb[2 * j - 4] *= s0; vb[2 * j - 3] *= s1; } } }
            u32x4 w; w.x = cvtpk(va[0], va[1]); w.y = cvtpk(va[2], va[3]); w.z = cvtpk(vb[0], vb[1]); w.w = cvtpk(vb[2], vb[3]);
            *(u32x4*)(Ow + (size_t)(8 * p + row) * OP + egrp * 8) = w; }
    }
    __syncthreads();
#undef QX
#undef RESC
#undef KBASE
#undef MASKT
#undef SEAM_K0
#undef HALF_STEP
}
#undef ROWP
#undef VMW
#undef VMWN
#undef SLOAD_H
#undef SWRITE_HK
#undef SWRITE_HV
#undef SWRITE_H
#undef KSWZ
#undef SBAR
}

constexpr int NWAVES = 8;
#ifndef MK_PER_PHASE
#define MK_PER_PHASE 0
#endif
#ifndef MK_STOP_PC
#define MK_STOP_PC 1000
#endif
#ifndef REP_CVT
#define REP_CVT 1
#endif
#ifndef REP_MEMG
#define REP_MEMG 1
#endif
#ifndef REP_NORM
#define REP_NORM 1
#endif
#ifndef REP_KVG
#define REP_KVG 1
#endif
#ifndef REP_UP
#define REP_UP 1
#endif
#ifndef REP_DN
#define REP_DN 1
#endif
#ifndef REP_IN
#define REP_IN 1
#endif
#ifndef REP_PREP
#define REP_PREP 1
#endif
#ifndef REP_SCAN
#define REP_SCAN 1
#endif
#ifndef REP_ATT
#define REP_ATT 1
#endif
#ifndef REP_OUT
#define REP_OUT 1
#endif
#ifndef REP_POST
#define REP_POST 1
#endif
#ifndef REP_CUM
#define REP_CUM 1
#endif
#ifndef REP_HNFAKE
#define REP_HNFAKE 0
#endif
#ifndef UP_STAGGER_US
#define UP_STAGGER_US 0
#endif
#ifndef UP_ALIGN
#define UP_ALIGN true
#endif
#ifndef DN_STAGGER_US
#define DN_STAGGER_US 0
#endif
#ifndef GEMM_SP2
#define GEMM_SP2 true
#endif
#ifndef SEG_N
#define SEG_N 5
#endif
#ifndef SEG_LEN
#define SEG_LEN 13
#endif
#ifndef SCAN_WG
#define SCAN_WG 1
#endif
#ifndef FOX_SKIP
#define FOX_SKIP 1
#endif
#ifndef FFN_SPLIT
#define FFN_SPLIT 1
#endif
constexpr int NPH = 21 + 16 * FFN_SPLIT;

constexpr int BATCH = 8, SEQ = 4096, DM = 2048, M = BATCH * SEQ, FF = 5632, NUP = 2 * FF, DEPTH = 4;
constexpr int NA = 5376, NB = 3584, NKV = 3328, NMEMW = 4096;
constexpr int A_Q = 0, A_K = 768, A_V = 1536, A_G = 3072, A_QM = 4608, A_LR = 5120;
constexpr int B_Q = 0, B_G = 1536, B_QM = 3072;
constexpr int MEMT = 256, MROWS = BATCH * MEMT;
constexpr float EPS = 1e-6f;

constexpr size_t MiB = 1u << 20;
constexpr size_t WS_CTL = 0, CTL_ZERO_BYTES = 1 * MiB;
constexpr size_t WS_CB = 1 * MiB, WS_F = 3 * MiB, WS_ACH = 5 * MiB, WS_DSEG = 7 * MiB, WS_MEMB = 8 * MiB, WS_MKVF = 16 * MiB, WS_MK = 48 * MiB, WS_MV = 56 * MiB;
constexpr size_t WS_WUP = 64 * MiB, WS_WDN = 416 * MiB, WS_WAIN = 592 * MiB, WS_WBIN = 638 * MiB, WS_WOUT = 666 * MiB, WS_WKV = 698 * MiB, WS_WMEM = 711 * MiB;
constexpr size_t WS_HMIX = 728 * MiB, WS_ACT = 856 * MiB, WS_KDT = 1224 * MiB, WS_VT = 1272 * MiB, WS_OG = 1368 * MiB, WS_KSVS = 1224 * MiB, WS_FST = 1464 * MiB, WS_QF = 1528 * MiB, WS_XB2 = 1416 * MiB, WS_SS = 1576 * MiB, WS_END = 1580 * MiB;
constexpr size_t SS_BYTES = (size_t)13 * M * 8;
static_assert(WS_WUP + 8 * (size_t)NUP * DM * 2 <= WS_WDN && WS_WDN + 8 * (size_t)DM * FF * 2 <= WS_WAIN && WS_WAIN + 2 * (size_t)NA * DM * 2 <= WS_WBIN && WS_WBIN + 2 * (size_t)NB * DM * 2 <= WS_WOUT &&
              WS_WOUT + 4 * (size_t)DM * DM * 2 <= WS_WKV && WS_WKV + (size_t)NKV * DM * 2 <= WS_WMEM && WS_WMEM + (size_t)NMEMW * DM * 2 <= WS_HMIX && WS_HMIX + (size_t)M * DM * 2 <= WS_ACT &&
              WS_ACT + (size_t)M * NA * 2 <= WS_KDT && WS_KDT + (size_t)2048 * 192 * 64 * 2 <= WS_VT && WS_VT + (size_t)2048 * 384 * 64 * 2 <= WS_OG && WS_OG + (size_t)M * 1536 * 2 <= WS_FST && WS_FST + (size_t)384 * 7 * 24 * 64 * 16 <= WS_QF && WS_QF + (size_t)2048 * 192 * 64 * 2 <= WS_SS && WS_SS + SS_BYTES <= WS_END && WS_XB2 >= WS_KSVS + (size_t)M * 3072 * 2 && WS_XB2 + (size_t)M * DM * 2 <= WS_SS &&
              WS_KSVS + (size_t)M * 3072 * 2 <= WS_END && WS_MKVF + (size_t)MROWS * NMEMW * 4 <= WS_MK && WS_MEMB + (size_t)MROWS * DM * 2 <= WS_MKVF, "d_ws map");
constexpr int CW_TMO = 0, CW_BAR = 4096, CW_QUE = 16384  ;
constexpr int RING_BYTES = 131072, LDSCTL_OFF = RING_BYTES, MISC_OFF = LDSCTL_OFF + 320, RTAB_OFF = LDSCTL_OFF + 1024  , HNT_OFF = LDSCTL_OFF + 5120  , GAIN_OFF = LDSCTL_OFF + 13312  , LDS_BYTES = 147456;

#define GAS __attribute__((address_space(1)))
#define LAS __attribute__((address_space(3)))
typedef unsigned short bf16;
typedef unsigned v4u __attribute__((ext_vector_type(4)));
typedef float f32x4 __attribute__((ext_vector_type(4)));
typedef float f32x16 __attribute__((ext_vector_type(16)));
typedef short bf16x8 __attribute__((ext_vector_type(8)));
typedef GAS unsigned gu32;
#define RLX_AGENT __ATOMIC_RELAXED, __HIP_MEMORY_SCOPE_AGENT
#define LDS_WAIT() asm volatile("s_waitcnt lgkmcnt(0)" ::: "memory")
using pg8::pkbf;
__device__ __forceinline__ float bf_lo(unsigned w) { return __uint_as_float(w << 16); }
__device__ __forceinline__ float bf_hi(unsigned w) { return __uint_as_float(w & 0xffff0000u); }
__device__ __forceinline__ float bf2f(bf16 b) { return __uint_as_float(((unsigned)b) << 16); }
__device__ __forceinline__ float logsig(float x) { return fminf(x, 0.f) - 0.6931471805599453f * __builtin_amdgcn_logf(1.0f + __builtin_amdgcn_exp2f(-1.4426950408889634f * fabsf(x))); }
#define XCH1(v)  __uint_as_float((unsigned)__builtin_amdgcn_update_dpp(0, (int)__float_as_uint(v), 0xB1, 0xF, 0xF, true))
#define XCH2(v)  __uint_as_float((unsigned)__builtin_amdgcn_update_dpp(0, (int)__float_as_uint(v), 0x4E, 0xF, 0xF, true))
#define XCH4(v)  __uint_as_float((unsigned)__builtin_amdgcn_ds_swizzle((int)__float_as_uint(v), (4 << 10) | 0x1f))
#define XCH8(v)  __uint_as_float((unsigned)__builtin_amdgcn_ds_swizzle((int)__float_as_uint(v), (8 << 10) | 0x1f))
#define XCH16(v) __uint_as_float((unsigned)__builtin_amdgcn_ds_swizzle((int)__float_as_uint(v), (16 << 10) | 0x1f))
__device__ __forceinline__ float wave_sum(float v) {
    v += XCH1(v); v += XCH2(v); v += XCH4(v); v += XCH8(v); v += XCH16(v);
    const auto rr = __builtin_amdgcn_permlane32_swap(__float_as_uint(v), __float_as_uint(v), false, false);
    return __uint_as_float(rr[0]) + __uint_as_float(rr[1]);
}
__device__ __forceinline__ float wave_max(float v) {
    v = fmaxf(v, XCH1(v)); v = fmaxf(v, XCH2(v)); v = fmaxf(v, XCH4(v)); v = fmaxf(v, XCH8(v)); v = fmaxf(v, XCH16(v));
    const auto rr = __builtin_amdgcn_permlane32_swap(__float_as_uint(v), __float_as_uint(v), false, false);
    return fmaxf(__uint_as_float(rr[0]), __uint_as_float(rr[1]));
}
__device__ __forceinline__ int launder_s(int v) { asm volatile("" : "+s"(v)); return v; }

#define XB_TMO      128
#define XB_XCNT(j)  (256  + 64 * (j))
#define XB_XSUB(j)  (1280 + 64 * (j))
#define XB_XGEN(j)  (2304 + 64 * (j))
#define XB_TOP      3328
#define XB_TOPGEN   3392
#define XCD_BAR_WORDS 3456
#define XB_SPIN_CAP (1u << 18)
__device__ __forceinline__ unsigned xb_ld(unsigned* p)              { return __hip_atomic_load(p, __ATOMIC_RELAXED, __HIP_MEMORY_SCOPE_AGENT); }
__device__ __forceinline__ unsigned xb_add(unsigned* p, unsigned v) { return __hip_atomic_fetch_add(p, v, __ATOMIC_RELAXED, __HIP_MEMORY_SCOPE_AGENT); }
__device__ __forceinline__ unsigned xb_xcc_id() { return (unsigned)__builtin_amdgcn_s_getreg((3 << 11) | 20) & 0xFu; }
#define XB_SPIN(cond, bar) do { unsigned _sp = 0; while (cond) { __builtin_amdgcn_s_sleep(1); \
    if ((++_sp & 255u) == 0u) { if (xb_ld(&(bar)[XB_TMO])) break; if (_sp > XB_SPIN_CAP) { atomicAdd(&(bar)[XB_TMO], 1u); break; } } } } while (0)
struct XcdBarrier { unsigned* bar; unsigned x; volatile LAS unsigned* st; int wave; };
__device__ __forceinline__ XcdBarrier xcd_barrier_post(unsigned* bar, volatile LAS unsigned* st, int wave) {
    XcdBarrier b; b.bar = bar; b.x = xb_xcc_id(); b.st = st; b.wave = wave;
    if (threadIdx.x == 0) (void)xb_add(&bar[XB_XCNT(b.x)], 1u);
    return b;
}
__device__ __forceinline__ void xcd_barrier_complete(unsigned* bar, unsigned x, unsigned& nloc, unsigned& nx) {
    const unsigned G = gridDim.x * gridDim.y * gridDim.z;
    unsigned sum, cnt, mine, sp = 0u;
    for (;;) {
        sum = 0u; cnt = 0u; mine = 0u;
#pragma unroll
        for (unsigned j = 0; j < 16; ++j) { const unsigned c = xb_ld(&bar[XB_XCNT(j)]); sum += c; cnt += (c > 0u) ? 1u : 0u; mine = (j == x) ? c : mine; }
        if (sum == G) break;
        __builtin_amdgcn_s_sleep(1);
        if ((++sp & 255u) == 0u) { if (xb_ld(&bar[XB_TMO])) break; if (sp > XB_SPIN_CAP) { atomicAdd(&bar[XB_TMO], 1u); break; } }
    }
    nloc = mine > 0u ? mine : 1u; nx = cnt > 0u ? cnt : 1u;
}
__device__ __forceinline__ void xcd_barrier(const XcdBarrier& b) {
    asm volatile("s_waitcnt vmcnt(0)" ::: "memory");
    __syncthreads();
    if (b.wave == 0 && lane_id_v() == 0) {
        unsigned* bar = b.bar;
        __builtin_amdgcn_s_waitcnt(0);
        unsigned nloc = b.st[0], nx = b.st[1];
        if (nloc == 0u) { xcd_barrier_complete(bar, b.x, nloc, nx); b.st[0] = nloc; b.st[1] = nx; }
        const unsigned old = xb_add(&bar[XB_XSUB(b.x)], 1u);
        const unsigned gen = old / nloc;
        if (old + 1u == (gen + 1u) * nloc) {
            __builtin_amdgcn_fence(__ATOMIC_RELEASE, "agent");
            asm volatile("s_waitcnt vmcnt(0)" ::: "memory");
            const unsigned og = xb_add(&bar[XB_TOP], 1u);
            const unsigned tg = og / nx;
            if (og + 1u == (tg + 1u) * nx) xb_add(&bar[XB_TOPGEN], 1u);
            else XB_SPIN(xb_ld(&bar[XB_TOPGEN]) == tg, bar);
            __builtin_amdgcn_fence(__ATOMIC_ACQUIRE, "agent");
            xb_add(&bar[XB_XGEN(b.x)], 1u);
            asm volatile("s_waitcnt vmcnt(0)" ::: "memory");
        } else {
            XB_SPIN(xb_ld(&bar[XB_XGEN(b.x)]) == gen, bar);
            __builtin_amdgcn_fence(__ATOMIC_ACQUIRE, "agent");
            asm volatile("s_waitcnt vmcnt(0)" ::: "memory");
        }
    }
    __syncthreads();
}

__device__ __forceinline__ const float* ldp(volatile LAS unsigned* T, int k) { const unsigned lo = __builtin_amdgcn_readfirstlane(T[2 * k]), hi = __builtin_amdgcn_readfirstlane(T[2 * k + 1]); return (const float*)(const GAS float*)(((unsigned long long)hi << 32) | lo); }
__device__ __forceinline__ int launder(int v) { asm volatile("" : "+v"(v)); return v; }
__device__ __forceinline__ int lane_id() { return lane_id_v(); }
__device__ __forceinline__ void cvt_item(const float* W, int ldw, int srccol, const float* gain, float scale, bf16* Bt, int K, int dstrow, int k0, LAS float* scr, int lane) {
    float v[32], g[32];
    const float* src = W + (size_t)(k0 + (lane >> 5)) * ldw + srccol + (lane & 31);
#pragma unroll
    for (int i = 0; i < 32; ++i) v[i] = src[(size_t)(2 * i) * ldw];
#pragma unroll
    for (int i = 0; i < 32; ++i) g[i] = gain ? gain[k0 + 2 * i + (lane >> 5)] * scale : scale;
#pragma unroll
    for (int i = 0; i < 32; ++i) scr[(2 * i + (lane >> 5)) * 33 + (lane & 31)] = v[i] * g[i];
    LDS_WAIT();
    const int c = lane & 7;
#pragma unroll
    for (int j = 0; j < 4; ++j) { const int n = (lane >> 3) + 8 * j; const LAS float* s = scr + (8 * c) * 33 + n;
        v4u o; o.x = pkbf(s[0 * 33], s[1 * 33]); o.y = pkbf(s[2 * 33], s[3 * 33]); o.z = pkbf(s[4 * 33], s[5 * 33]); o.w = pkbf(s[6 * 33], s[7 * 33]);
        *(v4u*)(Bt + (size_t)(dstrow + n) * K + k0 + 8 * c) = o; }
    LDS_WAIT();
}
__device__ __forceinline__ void rms_row_to_bf16(const float* xrow, bf16* orow, int lane) {
    const f32x4* xr = (const f32x4*)xrow + lane;
    f32x4 v[8]; float s = 0.f;
#pragma unroll
    for (int j = 0; j < 8; ++j) { v[j] = xr[64 * j]; s += (v[j].x * v[j].x + v[j].y * v[j].y) + (v[j].z * v[j].z + v[j].w * v[j].w); }
    const float rinv = 1.0f / sqrtf(wave_sum(s) * (1.0f / DM) + EPS);
    unsigned long long* o8 = (unsigned long long*)orow + lane;
#pragma unroll
    for (int j = 0; j < 8; ++j) o8[64 * j] = (unsigned long long)pkbf(v[j].x * rinv, v[j].y * rinv) | ((unsigned long long)pkbf(v[j].z * rinv, v[j].w * rinv) << 32);
}
__device__ __forceinline__ void xb_row(const float* xrow, bf16* orow, float* ssrow, int lane) {
    const f32x4* xr = (const f32x4*)xrow + lane;
    f32x4 v[8]; float s = 0.f;
#pragma unroll
    for (int j = 0; j < 8; ++j) { v[j] = xr[64 * j]; s += (v[j].x * v[j].x + v[j].y * v[j].y) + (v[j].z * v[j].z + v[j].w * v[j].w); }
    s = wave_sum(s);
    if (lane == 0) *(unsigned long long*)ssrow = (unsigned long long)(s * 16777216.0f);
    unsigned long long* o8 = (unsigned long long*)orow + lane;
#pragma unroll
    for (int j = 0; j < 8; ++j) o8[64 * j] = (unsigned long long)pkbf(v[j].x, v[j].y) | ((unsigned long long)pkbf(v[j].z, v[j].w) << 32);
}
__device__ __forceinline__ void load_gains(LAS unsigned char* lds, const float* g0, const float* g1, int wave, int lane) {
    LAS float* G = (LAS float*)(lds + GAIN_OFF);
    if (wave < 2) { G[wave * 64 + lane] = g0[wave * 64 + lane]; G[128 + wave * 64 + lane] = g1[wave * 64 + lane]; }
    __syncthreads();
}
struct InPtrs { const float *x, *mem, *ffn_norm, *w1, *w3, *w2, *mix_norm, *mem_norm, *w_mem_kv, *mem_q_norm, *mem_k_norm, *w_out, *a_w_in, *a_w_gate_up, *a_b_gate, *a_out_norm, *b_w_in, *b_q_norm, *kv_norm, *w_kv, *b_f, *k_norm; };

__device__ __forceinline__ void convert_phase(volatile LAS unsigned* PT, unsigned char* ws, float* xout, LAS unsigned char* lds, int gw, int NGW, int lane, int wave) {
    InPtrs I;
    I.x = ldp(PT, 0); I.mem = ldp(PT, 1); I.ffn_norm = ldp(PT, 2); I.w1 = ldp(PT, 3); I.w3 = ldp(PT, 4); I.w2 = ldp(PT, 5); I.mix_norm = ldp(PT, 6); I.mem_norm = ldp(PT, 7);
    I.w_mem_kv = ldp(PT, 8); I.mem_q_norm = ldp(PT, 9); I.mem_k_norm = ldp(PT, 10); I.w_out = ldp(PT, 11); I.a_w_in = ldp(PT, 12); I.a_w_gate_up = ldp(PT, 13); I.a_b_gate = ldp(PT, 14);
    I.a_out_norm = ldp(PT, 15); I.b_w_in = ldp(PT, 16); I.b_q_norm = ldp(PT, 17); I.kv_norm = ldp(PT, 18); I.w_kv = ldp(PT, 19); I.b_f = ldp(PT, 20); I.k_norm = ldp(PT, 21);
    LAS float* scr = (LAS float*)(lds + wave * 16384);
    bf16* WUP = (bf16*)(ws + WS_WUP); bf16* WDN = (bf16*)(ws + WS_WDN); bf16* WAIN = (bf16*)(ws + WS_WAIN); bf16* WBIN = (bf16*)(ws + WS_WBIN);
    bf16* WOUT = (bf16*)(ws + WS_WOUT); bf16* WKV = (bf16*)(ws + WS_WKV); bf16* WMEM = (bf16*)(ws + WS_WMEM);
    constexpr int IT_W1 = 8 * 32 * 176, IT_W2 = 8 * 88 * 64, IT_A = 2 * 32 * 160, IT_B = 2 * 32 * 112, IT_O = 4 * 32 * 64, IT_KV = 32 * 96, IT_MEM = 4 * 32 * 32;
    constexpr int IT_TOTAL = 2 * IT_W1 + IT_W2 + IT_A + IT_B + IT_O + IT_KV + IT_MEM;
    for (int it = gw; it < IT_TOTAL; it += NGW) {
        int r = it;
        if (r < 2 * IT_W1) { const int which = r / IT_W1; r -= which * IT_W1; const int mat = r / (32 * 176); r -= mat * (32 * 176); const int kb = r / 176, nb = r % 176; const int j0 = 32 * nb;
            cvt_item((which ? I.w3 : I.w1) + (size_t)mat * DM * FF, FF, j0, I.ffn_norm + mat * DM, 1.f, WUP + (size_t)mat * NUP * DM, DM, 256 * (j0 / 128) + which * 128 + (j0 % 128), 64 * kb, scr, lane); continue; }
        r -= 2 * IT_W1;
        if (r < IT_W2) { const int mat = r / (88 * 64); r -= mat * (88 * 64); const int kb = r / 64, nb = r % 64;
            cvt_item(I.w2 + (size_t)mat * FF * DM, DM, 32 * nb, nullptr, 1.f, WDN + (size_t)mat * DM * FF, FF, 32 * nb, 64 * kb, scr, lane); continue; }
        r -= IT_W2;
        if (r < IT_A) { const int l = r / (32 * 160); r -= l * (32 * 160); const int kb = r / 160, nb = r % 160; const int n0 = 32 * nb;
            cvt_item(I.a_w_in + (size_t)l * DM * 5136, 5136, n0 < 3072 ? n0 : n0 + 16, I.mix_norm + l * DM, n0 < 768 ? 0.07216878364870322f : 1.f, WAIN + (size_t)l * NA * DM, DM, n0, 64 * kb, scr, lane); continue; }
        r -= IT_A;
        if (r < IT_B) { const int j = r / (32 * 112); r -= j * (32 * 112); const int kb = r / 112, nb = r % 112;
            cvt_item(I.b_w_in + (size_t)j * DM * NB, NB, 32 * nb, I.mix_norm + (2 + j) * DM, 1.f, WBIN + (size_t)j * NB * DM, DM, 32 * nb, 64 * kb, scr, lane); continue; }
        r -= IT_B;
        if (r < IT_O) { const int l = r / (32 * 64); r -= l * (32 * 64); const int kb = r / 64, nb = r % 64;
            cvt_item(I.w_out + (size_t)l * DM * DM, DM, 32 * nb, nullptr, 1.f, WOUT + (size_t)l * DM * DM, DM, 32 * nb, 64 * kb, scr, lane); continue; }
        r -= IT_O;
        if (r < IT_KV) { const int kb = r / 96, nb = r % 96;
            cvt_item(I.w_kv, 3084, 32 * nb, I.kv_norm, 1.f, WKV, DM, 32 * nb, 64 * kb, scr, lane); continue; }
        r -= IT_KV;
        { const int l = r / (32 * 32); r -= l * (32 * 32); const int kb = r / 32, nb = r % 32;
            cvt_item(I.w_mem_kv + (size_t)l * DM * 1024, 1024, 32 * nb, I.mem_norm + l * DM, 1.f, WMEM, DM, l * 1024 + 32 * nb, 64 * kb, scr, lane); }
    }
    const int gtid = gw * 64 + lane, NT = NGW * 64;
    for (int idx = gtid; idx < 2 * 256 * 256; idx += NT) { const int l = idx >> 16, n = (idx >> 8) & 255, k0 = (idx & 255) * 8;
        float a[8] = {0.f, 0.f, 0.f, 0.f, 0.f, 0.f, 0.f, 0.f};
        if (n < 16) { float w8[8]; const f32x4 ga = *(const f32x4*)(I.mix_norm + l * DM + k0), gb = *(const f32x4*)(I.mix_norm + l * DM + k0 + 4);
#pragma unroll
            for (int j = 0; j < 8; ++j) w8[j] = I.a_w_in[(size_t)l * DM * 5136 + (size_t)(k0 + j) * 5136 + 3072 + n];
#pragma unroll
            for (int j = 0; j < 8; ++j) a[j] = w8[j] * (j < 4 ? ga[j] : gb[j - 4]); }
        v4u o; o.x = pkbf(a[0], a[1]); o.y = pkbf(a[2], a[3]); o.z = pkbf(a[4], a[5]); o.w = pkbf(a[6], a[7]);
        *(v4u*)(WAIN + (size_t)l * NA * DM + (size_t)(A_LR + n) * DM + k0) = o; }
    for (int idx = gtid; idx < 256 * 256; idx += NT) { const int n = idx >> 8, k0 = (idx & 255) * 8;
        float a[8] = {0.f, 0.f, 0.f, 0.f, 0.f, 0.f, 0.f, 0.f};
        if (n < 12) { float w8[8]; const f32x4 ga = *(const f32x4*)(I.kv_norm + k0), gb = *(const f32x4*)(I.kv_norm + k0 + 4);
#pragma unroll
            for (int j = 0; j < 8; ++j) w8[j] = I.w_kv[(size_t)(k0 + j) * 3084 + 3072 + n];
#pragma unroll
            for (int j = 0; j < 8; ++j) a[j] = w8[j] * (j < 4 ? ga[j] : gb[j - 4]); }
        v4u o; o.x = pkbf(a[0], a[1]); o.y = pkbf(a[2], a[3]); o.z = pkbf(a[4], a[5]); o.w = pkbf(a[6], a[7]);
        *(v4u*)(WKV + (size_t)(3072 + n) * DM + k0) = o; }
    for (int m = gw; m < MROWS; m += NGW) rms_row_to_bf16(I.mem + (size_t)m * DM, (bf16*)(ws + WS_MEMB) + (size_t)m * DM, lane);
    for (int m = gw; m < M; m += NGW) xb_row(I.x + (size_t)m * DM, (bf16*)xout + (size_t)m * DM, (float*)(ws + WS_SS) + 2 * (size_t)m, lane);
}
__device__ __forceinline__ void hn_pass(bf16* buf, int pitch, int col0, int nheads, const float* gain, int gw, int NGW, int lane) {
    const int l16 = lane & 15; const int ntask4 = M * nheads / 4;
    f32x4 g0 = *(const f32x4*)(gain + 8 * l16), g1 = *(const f32x4*)(gain + 8 * l16 + 4);
    for (int t4 = gw; t4 < ntask4; t4 += NGW) { const int t = t4 * 4 + (lane >> 4); const int row = t / nheads, hh = t - row * nheads;
        bf16* p = buf + (size_t)row * pitch + col0 + hh * 128 + 8 * l16;
        const v4u w = *(const v4u*)p;
        float x[8] = {bf_lo(w.x), bf_hi(w.x), bf_lo(w.y), bf_hi(w.y), bf_lo(w.z), bf_hi(w.z), bf_lo(w.w), bf_hi(w.w)};
        float ss = 0.f;
#pragma unroll
        for (int e = 0; e < 8; ++e) ss += x[e] * x[e];
        ss += XCH1(ss); ss += XCH2(ss); ss += XCH4(ss); ss += XCH8(ss);
        const float rinv = 1.0f / sqrtf(ss * (1.0f / 128.f) + EPS);
        v4u o; o.x = pkbf(x[0] * rinv * g0[0], x[1] * rinv * g0[1]); o.y = pkbf(x[2] * rinv * g0[2], x[3] * rinv * g0[3]);
        o.z = pkbf(x[4] * rinv * g1[0], x[5] * rinv * g1[1]); o.w = pkbf(x[6] * rinv * g1[2], x[7] * rinv * g1[3]);
        *(v4u*)p = o; }
}
__device__ __forceinline__ void mkmv_pass(const float* MKVF, bf16* MK, bf16* MV, const float* mem_k_norm, int gw, int NGW, int lane) {
    const int l16 = lane & 15;
    for (int t4 = gw; t4 < MROWS * 32 / 4; t4 += NGW) { const int t = t4 * 4 + (lane >> 4); const int row = t >> 5, rem = t & 31; const int l = rem >> 3, kv = (rem >> 2) & 1, hh = rem & 3;
        const float* src = MKVF + (size_t)row * NMEMW + l * 1024 + kv * 512 + hh * 128 + 8 * l16;
        const f32x4 a = *(const f32x4*)src, b = *(const f32x4*)(src + 4);
        float ss = (a.x * a.x + a.y * a.y) + (a.z * a.z + a.w * a.w) + (b.x * b.x + b.y * b.y) + (b.z * b.z + b.w * b.w);
        ss += XCH1(ss); ss += XCH2(ss); ss += XCH4(ss); ss += XCH8(ss);
        const float rinv = kv ? 1.0f : 1.0f / sqrtf(ss * (1.0f / 128.f) + EPS);
        f32x4 g0 = {1.f, 1.f, 1.f, 1.f}, g1 = {1.f, 1.f, 1.f, 1.f};
        if (!kv) { g0 = *(const f32x4*)(mem_k_norm + l * 128 + 8 * l16); g1 = *(const f32x4*)(mem_k_norm + l * 128 + 8 * l16 + 4); }
        v4u o; o.x = pkbf(a.x * rinv * g0[0], a.y * rinv * g0[1]); o.y = pkbf(a.z * rinv * g0[2], a.w * rinv * g0[3]);
        o.z = pkbf(b.x * rinv * g1[0], b.y * rinv * g1[1]); o.w = pkbf(b.z * rinv * g1[2], b.w * rinv * g1[3]);
        *(v4u*)((kv ? MV : MK) + ((size_t)l * MROWS + row) * 512 + hh * 128 + 8 * l16) = o; }
}
__device__ __forceinline__ void gla_prep(const bf16* PROJ, const float* b_gate  , const float* w_up  , bf16* KDT, bf16* VT, bf16* QF, float* ACH, int gw, int NGW, int lane) {
    const int r = lane & 31, hi = lane >> 5;
    for (int t = gw; t < 2048; t += NGW) {
        const int b = t >> 8, c = (t >> 2) & 63, h = t & 3; const int ci = (b * 4 + h) * 64 + c;
        const bf16* P = PROJ + ((size_t)b * SEQ + c * 64) * NA;
        if (lane < 48) { const int d0 = 4 * lane;
            const f32x4 bias = *(const f32x4*)(b_gate + h * 192 + d0);
            const bf16* plr = P + A_LR; const bf16* pk = P + A_K + h * 192 + d0;
            f32x4 wg[16];
#pragma unroll
            for (int rr = 0; rr < 16; ++rr) wg[rr] = *(const f32x4*)(w_up + rr * 768 + h * 192 + d0);
#define GATE4(gp, j) do { const v4u L0 = *(const v4u*)(plr + (size_t)(j) * NA), L1 = *(const v4u*)(plr + (size_t)(j) * NA + 8); gp = bias;  \
                gp = gp + wg[0] * bf_lo(L0.x) + wg[1] * bf_hi(L0.x) + wg[2] * bf_lo(L0.y) + wg[3] * bf_hi(L0.y) + wg[4] * bf_lo(L0.z) + wg[5] * bf_hi(L0.z) + wg[6] * bf_lo(L0.w) + wg[7] * bf_hi(L0.w);  \
                gp = gp + wg[8] * bf_lo(L1.x) + wg[9] * bf_hi(L1.x) + wg[10] * bf_lo(L1.y) + wg[11] * bf_hi(L1.y) + wg[12] * bf_lo(L1.z) + wg[13] * bf_hi(L1.z) + wg[14] * bf_lo(L1.w) + wg[15] * bf_hi(L1.w); } while (0)
            f32x4 tot = {0.f, 0.f, 0.f, 0.f};
#pragma unroll 8
            for (int j = 0; j < 64; ++j) { f32x4 gp; GATE4(gp, j);
                tot[0] += logsig(gp[0]); tot[1] += logsig(gp[1]); tot[2] += logsig(gp[2]); tot[3] += logsig(gp[3]); }
            tot = tot * (1.0f / 16.0f);
            *(f32x4*)(ACH + ci * 192 + d0) = (f32x4){__expf(tot[0]), __expf(tot[1]), __expf(tot[2]), __expf(tot[3])};
            bf16* dst = KDT + ((size_t)(ci * 6 + (d0 >> 5)) * 4 * 64 + (d0 & 31)) * 8;
            f32x4 run = {0.f, 0.f, 0.f, 0.f};
#pragma unroll
            for (int j8 = 0; j8 < 8; ++j8) { float kd[4][8];
#pragma unroll
                for (int e8 = 0; e8 < 8; ++e8) { const int j = 8 * j8 + e8; const uint2 kw = *(const uint2*)(pk + (size_t)j * NA); f32x4 gp; GATE4(gp, j);
                    run[0] += logsig(gp[0]) * (1.0f / 16.0f); run[1] += logsig(gp[1]) * (1.0f / 16.0f); run[2] += logsig(gp[2]) * (1.0f / 16.0f); run[3] += logsig(gp[3]) * (1.0f / 16.0f);
                    kd[0][e8] = bf_lo(kw.x) * __expf(tot[0] - run[0]); kd[1][e8] = bf_hi(kw.x) * __expf(tot[1] - run[1]); kd[2][e8] = bf_lo(kw.y) * __expf(tot[2] - run[2]); kd[3][e8] = bf_hi(kw.y) * __expf(tot[3] - run[3]); }
#pragma unroll
                for (int e = 0; e < 4; ++e) { v4u o; o.x = pkbf(kd[e][0], kd[e][1]); o.y = pkbf(kd[e][2], kd[e][3]); o.z = pkbf(kd[e][4], kd[e][5]); o.w = pkbf(kd[e][6], kd[e][7]);
                    *(v4u*)(dst + ((size_t)((j8 >> 1) * 64 + (j8 & 1) * 32 + e)) * 8) = o; } }
#undef GATE4
            }
        if (lane < 48) { const int dv0 = 8 * lane; const bf16* pv = P + A_V + h * 384 + dv0;
            bf16* dst = VT + ((size_t)(ci * 12 + (dv0 >> 5)) * 4 * 64 + (dv0 & 31)) * 8;
#pragma unroll
            for (int j8 = 0; j8 < 8; ++j8) { v4u w[8];
#pragma unroll
                for (int e8 = 0; e8 < 8; ++e8) w[e8] = *(const v4u*)(pv + (size_t)(8 * j8 + e8) * NA);
#pragma unroll
                for (int e = 0; e < 8; ++e) { v4u o;
#define VSEL(k) ((e & 1) ? (((e >> 1) == 0 ? w[k].x : (e >> 1) == 1 ? w[k].y : (e >> 1) == 2 ? w[k].z : w[k].w) >> 16) : (((e >> 1) == 0 ? w[k].x : (e >> 1) == 1 ? w[k].y : (e >> 1) == 2 ? w[k].z : w[k].w) & 0xffffu))
                    o.x = VSEL(0) | (VSEL(1) << 16); o.y = VSEL(2) | (VSEL(3) << 16); o.z = VSEL(4) | (VSEL(5) << 16); o.w = VSEL(6) | (VSEL(7) << 16);
#undef VSEL
                    *(v4u*)(dst + ((size_t)((j8 >> 1) * 64 + (j8 & 1) * 32 + e)) * 8) = o; } } }
        { const bf16* pq = P + (size_t)r * NA + A_Q + h * 192 + 4 * hi; bf16* dst = QF + ((size_t)ci * 24 * 64 + lane) * 8;
#pragma unroll
            for (int tt = 0; tt < 2; ++tt) { uint2 qa[12], qc[12];
#pragma unroll
                for (int i = 0; i < 12; ++i) { const bf16* p = pq + (size_t)tt * 32 * NA + 32 * (i >> 1) + 16 * (i & 1); qa[i] = *(const uint2*)p; qc[i] = *(const uint2*)(p + 8); }
#pragma unroll
                for (int i = 0; i < 12; ++i) { v4u o = {qa[i].x, qa[i].y, qc[i].x, qc[i].y};
                    *(v4u*)(dst + (size_t)(tt * 12 + i) * 64 * 8) = o; } } }
    }
}
__device__ __forceinline__ void gla_update(f32x16 (&S)[6], const bf16* kd, const bf16* vt, const float* ac, int lane, int hi) {
    const unsigned lo16 = (unsigned)lane * 16u;
    bf16x8 vb[4];
#pragma unroll
    for (int s = 0; s < 4; ++s) vb[s] = *(const bf16x8*)((const char*)(vt + s * 512) + lo16);
#pragma unroll
    for (int half = 0; half < 2; ++half) {
        bf16x8 ka[3][4]; f32x4 a4[3][4];
#pragma unroll
        for (int m3 = 0; m3 < 3; ++m3)
#pragma unroll
            for (int s = 0; s < 4; ++s) ka[m3][s] = *(const bf16x8*)((const char*)(kd + ((3 * half + m3) * 4 + s) * 512) + lo16);
#pragma unroll
        for (int m3 = 0; m3 < 3; ++m3)
#pragma unroll
            for (int i4 = 0; i4 < 4; ++i4) a4[m3][i4] = *(const f32x4*)((const char*)(ac + 32 * (3 * half + m3) + 8 * i4) + (unsigned)hi * 16u);
        __builtin_amdgcn_sched_barrier(0);
#pragma unroll
        for (int m3 = 0; m3 < 3; ++m3) { const int mt = 3 * half + m3;
#pragma unroll
            for (int i4 = 0; i4 < 4; ++i4)
#pragma unroll
                for (int e = 0; e < 4; ++e) S[mt][4 * i4 + e] *= a4[m3][i4][e];
#pragma unroll
            for (int s = 0; s < 4; ++s) S[mt] = __builtin_amdgcn_mfma_f32_32x32x16_bf16(ka[m3][s], vb[s], S[mt], 0, 0, 0); }
        __builtin_amdgcn_sched_barrier(0);
    }
}
__device__ __forceinline__ void gla_output(const f32x16 (&S)[6], const bf16* qf, bf16* og_u  , int lane, int r, int hi) {
    const unsigned lo16 = (unsigned)lane * 16u;
    f32x16 o0, o1;
#pragma unroll
    for (int i = 0; i < 16; ++i) { o0[i] = 0.f; o1[i] = 0.f; }
#pragma unroll
    for (int half = 0; half < 2; ++half) {
        bf16x8 qa[3][2][2];
#pragma unroll
        for (int m3 = 0; m3 < 3; ++m3)
#pragma unroll
            for (int s = 0; s < 2; ++s) { qa[m3][s][0] = *(const bf16x8*)((const char*)(qf + ((0 * 6 + 3 * half + m3) * 2 + s) * 512) + lo16); qa[m3][s][1] = *(const bf16x8*)((const char*)(qf + ((1 * 6 + 3 * half + m3) * 2 + s) * 512) + lo16); }
        __builtin_amdgcn_sched_barrier(0);
#pragma unroll
        for (int m3 = 0; m3 < 3; ++m3) { const int mt = 3 * half + m3;
#pragma unroll
            for (int s = 0; s < 2; ++s) {
                v4u xw; xw.x = pkbf(S[mt][8 * s + 0], S[mt][8 * s + 1]); xw.y = pkbf(S[mt][8 * s + 2], S[mt][8 * s + 3]); xw.z = pkbf(S[mt][8 * s + 4], S[mt][8 * s + 5]); xw.w = pkbf(S[mt][8 * s + 6], S[mt][8 * s + 7]);
                const bf16x8 xs = __builtin_bit_cast(bf16x8, xw);
                o0 = __builtin_amdgcn_mfma_f32_32x32x16_bf16(qa[m3][s][0], xs, o0, 0, 0, 0);
                o1 = __builtin_amdgcn_mfma_f32_32x32x16_bf16(qa[m3][s][1], xs, o1, 0, 0, 0); } }
        __builtin_amdgcn_sched_barrier(0);
    }
    const unsigned so = (unsigned)(4 * hi * 1536 + r) * 2u;
#pragma unroll
    for (int i = 0; i < 16; ++i) { const int rowc = (i & 3) + 8 * (i >> 2);
        const float v0 = o0[i], v1 = o1[i]; const float n0 = XCH1(v0), n1 = XCH1(v1);
        if ((r & 1) == 0) { *(unsigned*)((char*)(og_u + (size_t)rowc * 1536) + so) = pkbf(v0, n0); *(unsigned*)((char*)(og_u + (size_t)(32 + rowc) * 1536) + so) = pkbf(v1, n1); } }
}
__device__ __forceinline__ void gla_seg_states(const bf16* KDT, const bf16* VT, const float* ACH, float* FST, float* DSEG, int gw, int NGW, int lane) {
    const int r = lane & 31, hi = lane >> 5;
    static_assert(SEG_N * SEG_LEN >= 64 && (SEG_N - 1) * SEG_LEN < 64 && SEG_N <= 8, "segments must cover the 64 chunks (FST holds up to 7 segment states per unit)");
    for (int idx = gw * 64 + lane; idx < 32 * SEG_N * 192; idx += NGW * 64) { const int bh = idx / (SEG_N * 192), rem = idx - bh * (SEG_N * 192), g = rem / 192, k = rem - g * 192;
        float d = 1.f;
#pragma unroll
        for (int c = g * SEG_LEN; c < g * SEG_LEN + SEG_LEN && c < 64; ++c) d *= ACH[(size_t)(bh * 64 + c) * 192 + k];
        DSEG[idx] = d; }
    for (int t = gw; t < 384 * (SEG_N - 1); t += NGW) { const int g = t / 384, u = t - g * 384; const int bh = u / 12, n32 = u - bh * 12;
        f32x16 S[6];
#pragma unroll
        for (int mt = 0; mt < 6; ++mt)
#pragma unroll
            for (int i = 0; i < 16; ++i) S[mt][i] = 0.f;
        for (int c = g * SEG_LEN; c < g * SEG_LEN + SEG_LEN; ++c) { const int ci = bh * 64 + c;
            gla_update(S, KDT + (size_t)ci * 192 * 64, VT + ((size_t)ci * 12 + n32) * 4 * 64 * 8, ACH + (size_t)ci * 192, lane, hi); }
        f32x4* dst = (f32x4*)FST + (size_t)(u * 7 + g) * 24 * 64 + lane;
#pragma unroll
        for (int mt = 0; mt < 6; ++mt)
#pragma unroll
            for (int i4 = 0; i4 < 4; ++i4) dst[(mt * 4 + i4) * 64] = (f32x4){S[mt][4 * i4], S[mt][4 * i4 + 1], S[mt][4 * i4 + 2], S[mt][4 * i4 + 3]}; }
}
__device__ __forceinline__ void gla_seg_outputs(const bf16* QF, const bf16* KDT, const bf16* VT, const float* ACH, const float* FST, const float* DSEG, bf16* OG, int gw, int NGW, int lane) {
    const int r = lane & 31, hi = lane >> 5;
    for (int t = gw; t < 384 * SEG_N; t += NGW) { const int g = t / 384, u = t - g * 384; const int bh = u / 12, n32 = u - bh * 12, b = bh >> 2, h = bh & 3;
        f32x16 S[6];
#pragma unroll
        for (int mt = 0; mt < 6; ++mt)
#pragma unroll
            for (int i = 0; i < 16; ++i) S[mt][i] = 0.f;
        for (int gp = 0; gp < g; ++gp) {
            const float* fs = FST + (size_t)(u * 7 + gp) * 24 * 64 * 4; const float* ds = DSEG + (size_t)(bh * SEG_N + gp) * 192; const unsigned lo16 = (unsigned)lane * 16u, hi16 = (unsigned)hi * 16u;
#pragma unroll
            for (int half = 0; half < 2; ++half) { f32x4 f4[3][4], d4[3][4];
#pragma unroll
                for (int m3 = 0; m3 < 3; ++m3)
#pragma unroll
                    for (int i4 = 0; i4 < 4; ++i4) { f4[m3][i4] = *(const f32x4*)((const char*)(fs + ((3 * half + m3) * 4 + i4) * 256) + lo16); d4[m3][i4] = *(const f32x4*)((const char*)(ds + 32 * (3 * half + m3) + 8 * i4) + hi16); }
                __builtin_amdgcn_sched_barrier(0);
#pragma unroll
                for (int m3 = 0; m3 < 3; ++m3)
#pragma unroll
                    for (int i4 = 0; i4 < 4; ++i4)
#pragma unroll
                        for (int e = 0; e < 4; ++e) S[3 * half + m3][4 * i4 + e] = S[3 * half + m3][4 * i4 + e] * d4[m3][i4][e] + f4[m3][i4][e];
                __builtin_amdgcn_sched_barrier(0); } }
        for (int c = g * SEG_LEN; c < g * SEG_LEN + SEG_LEN && c < 64; ++c) { const int ci = bh * 64 + c; const size_t t0 = (size_t)b * SEQ + c * 64;
            gla_update(S, KDT + (size_t)ci * 192 * 64, VT + ((size_t)ci * 12 + n32) * 4 * 64 * 8, ACH + (size_t)ci * 192, lane, hi);
            gla_output(S, QF + (size_t)ci * 192 * 64, OG + t0 * 1536 + h * 384 + n32 * 32, lane, r, hi); }
    }
}
constexpr int SC_BUF = 50176, SC_K = 0, SC_Q = 24576, SC_A = 49152;
struct ScanStage { v4u k[3], q[3], a; };
template <bool WITHQ> __device__ __forceinline__ void scan_stage_issue(ScanStage& st, const bf16* KDT, const bf16* QF, const float* ACH, int ci, int tid) {
    const unsigned to = (unsigned)tid * 16u;
    const char* kb = (const char*)(KDT + (size_t)ci * 192 * 64);
#pragma unroll
    for (int i = 0; i < 3; ++i) st.k[i] = *(const v4u*)(kb + i * 8192 + to);
    if (WITHQ) { const char* qb = (const char*)(QF + (size_t)ci * 192 * 64);
#pragma unroll
        for (int i = 0; i < 3; ++i) st.q[i] = *(const v4u*)(qb + i * 8192 + to); }
    if (tid < 48) st.a = *(const v4u*)((const char*)(ACH + (size_t)ci * 192) + to);
}
template <bool WITHQ> __device__ __forceinline__ void scan_stage_commit(const ScanStage& st, LAS unsigned char* buf, int tid) {
    const unsigned to = (unsigned)tid * 16u;
#pragma unroll
    for (int i = 0; i < 3; ++i) *(LAS v4u*)(buf + SC_K + i * 8192 + to) = st.k[i];
    if (WITHQ) {
#pragma unroll
        for (int i = 0; i < 3; ++i) *(LAS v4u*)(buf + SC_Q + i * 8192 + to) = st.q[i]; }
    if (tid < 48) *(LAS v4u*)(buf + SC_A + to) = st.a;
}
__device__ __forceinline__ void scan_load_vb(bf16x8 (&vb)[4], const bf16* VT, int ci, int n32, int lane) {
    const bf16* vt = VT + ((size_t)ci * 12 + n32) * 4 * 64 * 8;
#pragma unroll
    for (int s = 0; s < 4; ++s) vb[s] = *(const bf16x8*)((const char*)(vt + s * 512) + (unsigned)lane * 16u);
}
__device__ __forceinline__ void gla_update_lds(f32x16 (&S)[6], LAS const unsigned char* buf, const bf16x8 (&vb)[4], int lane, int hi) {
    const unsigned lo16 = (unsigned)lane * 16u;
#pragma unroll
    for (int mt = 0; mt < 6; ++mt) {
        bf16x8 ka[4]; f32x4 a4[4];
#pragma unroll
        for (int s = 0; s < 4; ++s) ka[s] = *(LAS const bf16x8*)(buf + SC_K + (mt * 4 + s) * 1024 + lo16);
#pragma unroll
        for (int i4 = 0; i4 < 4; ++i4) a4[i4] = *(LAS const f32x4*)(buf + SC_A + (32 * mt + 8 * i4) * 4 + (unsigned)hi * 16u);
#pragma unroll
        for (int i4 = 0; i4 < 4; ++i4)
#pragma unroll
            for (int e = 0; e < 4; ++e) S[mt][4 * i4 + e] *= a4[i4][e];
#pragma unroll
        for (int s = 0; s < 4; ++s) S[mt] = __builtin_amdgcn_mfma_f32_32x32x16_bf16(ka[s], vb[s], S[mt], 0, 0, 0); }
}
__device__ __forceinline__ void gla_output_lds(const f32x16 (&S)[6], LAS const unsigned char* buf, bf16* og_u, int lane, int r, int hi) {
    const unsigned lo16 = (unsigned)lane * 16u;
    f32x16 o0, o1;
#pragma unroll
    for (int i = 0; i < 16; ++i) { o0[i] = 0.f; o1[i] = 0.f; }
#pragma unroll
    for (int mt = 0; mt < 6; ++mt) {
        bf16x8 qa[2][2];
#pragma unroll
        for (int s = 0; s < 2; ++s) { qa[s][0] = *(LAS const bf16x8*)(buf + SC_Q + ((0 * 6 + mt) * 2 + s) * 1024 + lo16); qa[s][1] = *(LAS const bf16x8*)(buf + SC_Q + ((1 * 6 + mt) * 2 + s) * 1024 + lo16); }
#pragma unroll
        for (int s = 0; s < 2; ++s) {
            v4u xw; xw.x = pkbf(S[mt][8 * s + 0], S[mt][8 * s + 1]); xw.y = pkbf(S[mt][8 * s + 2], S[mt][8 * s + 3]); xw.z = pkbf(S[mt][8 * s + 4], S[mt][8 * s + 5]); xw.w = pkbf(S[mt][8 * s + 6], S[mt][8 * s + 7]);
            const bf16x8 xs = __builtin_bit_cast(bf16x8, xw);
            o0 = __builtin_amdgcn_mfma_f32_32x32x16_bf16(qa[s][0], xs, o0, 0, 0, 0);
            o1 = __builtin_amdgcn_mfma_f32_32x32x16_bf16(qa[s][1], xs, o1, 0, 0, 0); } }
    const unsigned so = (unsigned)(4 * hi * 1536 + r) * 2u;
#pragma unroll
    for (int i = 0; i < 16; ++i) { const int rowc = (i & 3) + 8 * (i >> 2);
        const float v0 = o0[i], v1 = o1[i]; const float n0 = XCH1(v0), n1 = XCH1(v1);
        if ((r & 1) == 0) { *(unsigned*)((char*)(og_u + (size_t)rowc * 1536) + so) = pkbf(v0, n0); *(unsigned*)((char*)(og_u + (size_t)(32 + rowc) * 1536) + so) = pkbf(v1, n1); } }
}
constexpr int WSEG_N = 4, WSEG_LEN = 16;
__device__ __forceinline__ void gla_seg_states_wg(const bf16* KDT, const bf16* VT, const float* ACH, float* FST, float* DSEG, LAS unsigned char* lds, int vcu, int G, int wave, int lane, int gw, int NGW) {
    const int hi = lane >> 5, tid = wave * 64 + lane;
    for (int idx = gw * 64 + lane; idx < 32 * WSEG_N * 192; idx += NGW * 64) { const int bh = idx / (WSEG_N * 192), rem = idx - bh * (WSEG_N * 192), g = rem / 192, k = rem - g * 192;
        float d = 1.f;
        for (int c = g * WSEG_LEN; c < g * WSEG_LEN + WSEG_LEN; ++c) d *= ACH[(size_t)(bh * 64 + c) * 192 + k];
        DSEG[idx] = d; }
    for (int wt = vcu; wt < 32 * WSEG_N * 2; wt += G) { const int bh = wt / (WSEG_N * 2), rem = wt - bh * (WSEG_N * 2), g = rem >> 1, half = rem & 1;
        if (g == WSEG_N - 1) continue;
        const bool act = wave < 6; const int n32 = half * 6 + (act ? wave : 0), u = bh * 12 + n32;
        f32x16 S[6];
#pragma unroll
        for (int mt = 0; mt < 6; ++mt)
#pragma unroll
            for (int i = 0; i < 16; ++i) S[mt][i] = 0.f;
        const int c0 = g * WSEG_LEN, c1 = c0 + WSEG_LEN;
        ScanStage st; bf16x8 vb[4], vbn[4];
        scan_stage_issue<false>(st, KDT, nullptr, ACH, bh * 64 + c0, tid); if (act) scan_load_vb(vb, VT, bh * 64 + c0, n32, lane);
        scan_stage_commit<false>(st, lds, tid);
        __syncthreads();
        for (int c = c0; c < c1; ++c) { LAS unsigned char* buf = lds + ((c - c0) & 1) * SC_BUF; LAS unsigned char* nbuf = lds + (((c - c0) & 1) ^ 1) * SC_BUF; const bool more = c + 1 < c1;
            if (more) { scan_stage_issue<false>(st, KDT, nullptr, ACH, bh * 64 + c + 1, tid); if (act) scan_load_vb(vbn, VT, bh * 64 + c + 1, n32, lane); }
            if (act) gla_update_lds(S, buf, vb, lane, hi);
            if (more) { scan_stage_commit<false>(st, nbuf, tid);
#pragma unroll
                for (int s = 0; s < 4; ++s) vb[s] = vbn[s]; }
            __syncthreads(); }
        if (act) { char* dst = (char*)(FST + (size_t)(u * 7 + g) * 24 * 64 * 4); const unsigned lo16 = (unsigned)lane * 16u;
#pragma unroll
            for (int mt = 0; mt < 6; ++mt)
#pragma unroll
                for (int i4 = 0; i4 < 4; ++i4) *(f32x4*)(dst + (mt * 4 + i4) * 1024 + lo16) = (f32x4){S[mt][4 * i4], S[mt][4 * i4 + 1], S[mt][4 * i4 + 2], S[mt][4 * i4 + 3]}; }
    }
}
__device__ __forceinline__ void gla_seg_outputs_wg(const bf16* QF, const bf16* KDT, const bf16* VT, const float* ACH, const float* FST, const float* DSEG, bf16* OG, LAS unsigned char* lds, int vcu, int G, int wave, int lane) {
    const int r = lane & 31, hi = lane >> 5, tid = wave * 64 + lane;
    for (int wt = vcu; wt < 32 * WSEG_N * 2; wt += G) { const int bh = wt / (WSEG_N * 2), rem = wt - bh * (WSEG_N * 2), g = rem >> 1, half = rem & 1, b = bh >> 2, h = bh & 3;
        const bool act = wave < 6; const int n32 = half * 6 + (act ? wave : 0), u = bh * 12 + n32;
        f32x16 S[6];
#pragma unroll
        for (int mt = 0; mt < 6; ++mt)
#pragma unroll
            for (int i = 0; i < 16; ++i) S[mt][i] = 0.f;
        const int c0 = g * WSEG_LEN, c1 = c0 + WSEG_LEN;
        ScanStage st; bf16x8 vb[4], vbn[4];
        scan_stage_issue<true>(st, KDT, QF, ACH, bh * 64 + c0, tid); if (act) scan_load_vb(vb, VT, bh * 64 + c0, n32, lane);
        if (act) for (int gp = 0; gp < g; ++gp) {
            const float* fs = FST + (size_t)(u * 7 + gp) * 24 * 64 * 4; const float* ds = DSEG + (size_t)(bh * WSEG_N + gp) * 192; const int lq = launder(lane); const unsigned lo16 = (unsigned)lq * 16u, hi16 = (unsigned)(lq >> 5) * 16u;
#pragma unroll
            for (int m2 = 0; m2 < 3; ++m2) { f32x4 f4[2][4], d4[2][4];
#pragma unroll
                for (int mm = 0; mm < 2; ++mm)
#pragma unroll
                    for (int i4 = 0; i4 < 4; ++i4) { f4[mm][i4] = *(const f32x4*)((const char*)(fs + ((2 * m2 + mm) * 4 + i4) * 256) + lo16); d4[mm][i4] = *(const f32x4*)((const char*)(ds + 32 * (2 * m2 + mm) + 8 * i4) + hi16); }
                __builtin_amdgcn_sched_barrier(0);
#pragma unroll
                for (int mm = 0; mm < 2; ++mm)
#pragma unroll
                    for (int i4 = 0; i4 < 4; ++i4)
#pragma unroll
                        for (int e = 0; e < 4; ++e) S[2 * m2 + mm][4 * i4 + e] = S[2 * m2 + mm][4 * i4 + e] * d4[mm][i4][e] + f4[mm][i4][e];
                __builtin_amdgcn_sched_barrier(0); } }
        scan_stage_commit<true>(st, lds, tid);
        __syncthreads();
        for (int c = c0; c < c1; ++c) { LAS unsigned char* buf = lds + ((c - c0) & 1) * SC_BUF; LAS unsigned char* nbuf = lds + (((c - c0) & 1) ^ 1) * SC_BUF; const bool more = c + 1 < c1;
            if (more) { scan_stage_issue<true>(st, KDT, QF, ACH, bh * 64 + c + 1, tid); if (act) scan_load_vb(vbn, VT, bh * 64 + c + 1, n32, lane); }
            if (act) { gla_update_lds(S, buf, vb, lane, hi);
                gla_output_lds(S, buf, OG + ((size_t)b * SEQ + c * 64) * 1536 + h * 384 + n32 * 32, lane, r, hi); }
            if (more) { scan_stage_commit<true>(st, nbuf, tid);
#pragma unroll
                for (int s = 0; s < 4; ++s) vb[s] = vbn[s]; }
            __syncthreads(); }
    }
}
__device__ __forceinline__ void gla_post(const bf16* OG, const bf16* PROJ, const float* onorm  , bf16* MIX, int gw, int NGW, int lane) {
    const int la = lane < 48 ? lane : 0;
    const f32x4 g0 = *(const f32x4*)(onorm + 8 * la), g1 = *(const f32x4*)(onorm + 8 * la + 4);
    for (int t = gw; t < M * 4; t += NGW) { const int row = t >> 2, h = t & 3;
        v4u w = {0u, 0u, 0u, 0u}, gw4 = {0u, 0u, 0u, 0u};
        if (lane < 48) { w = *(const v4u*)(OG + (size_t)row * 1536 + h * 384 + 8 * lane); gw4 = *(const v4u*)(PROJ + (size_t)row * NA + A_G + h * 384 + 8 * lane); }
        float x[8] = {bf_lo(w.x), bf_hi(w.x), bf_lo(w.y), bf_hi(w.y), bf_lo(w.z), bf_hi(w.z), bf_lo(w.w), bf_hi(w.w)};
        float g[8] = {bf_lo(gw4.x), bf_hi(gw4.x), bf_lo(gw4.y), bf_hi(gw4.y), bf_lo(gw4.z), bf_hi(gw4.z), bf_lo(gw4.w), bf_hi(gw4.w)};
        float ss = 0.f;
#pragma unroll
        for (int e = 0; e < 8; ++e) ss += x[e] * x[e];
        const float rinv = 1.0f / sqrtf(wave_sum(ss) * (1.0f / 384.f) + EPS);
        float y[8];
#pragma unroll
        for (int e = 0; e < 8; ++e) y[e] = x[e] * rinv * (e < 4 ? g0[e] : g1[e - 4]) * pg8::silu_f(g[e]);
        if (lane < 48) { v4u o; o.x = pkbf(y[0], y[1]); o.y = pkbf(y[2], y[3]); o.z = pkbf(y[4], y[5]); o.w = pkbf(y[6], y[7]);
            *(v4u*)(MIX + (size_t)row * DM + h * 384 + 8 * lane) = o; } }
}
__device__ __forceinline__ void fox_cumsum(const float* F, const float* b_f, float* CB, int gw, int NGW, int lane) {
    for (int t = gw; t < BATCH * 12; t += NGW) { const int b = t / 12, h = t - b * 12; const float bf = b_f[h];
        const float* src = F + ((size_t)b * SEQ + lane * 64) * 16 + h;
        float v[64]; float run = 0.f;
#pragma unroll
        for (int j = 0; j < 64; ++j) v[j] = src[(size_t)j * 16];
        asm volatile("s_waitcnt vmcnt(0)" ::: "memory");
#pragma unroll
        for (int j = 0; j < 64; ++j) { run += logsig(v[j] + bf); v[j] = run; }
        float incl = run;
#pragma unroll
        for (int o = 1; o < 64; o <<= 1) { const float y = __uint_as_float((unsigned)__builtin_amdgcn_ds_bpermute((lane - o) << 2, (int)__float_as_uint(incl))); if (lane >= o) incl += y; }
        const float excl = incl - run;
        float* dst = CB + (size_t)t * SEQ + lane * 64;
#pragma unroll
        for (int j = 0; j < 64; ++j) dst[j] = -(excl + v[j]) * 11.313708498984761f; }
}
struct AttCfg { const bf16* PROJ; const bf16* KSVS; const float* CB; const bf16* MK; const bf16* MV; bf16* MIX; const float* BF; unsigned* que; volatile LAS unsigned* qs; int np, qmcol, fox, vcu, G, q, nq; float skip_th; };
__device__ __forceinline__ fa::BlockRef att_item(const AttCfg& c, int j, int half, int nF) {
    fa::BlockRef r; const int nb = 8 / c.nq;
    if (j < nF) { const int p = j / (8 * nb), rem = j - p * (8 * nb), bl = rem >> 3, x = rem & 7; const int b = c.q + c.nq * bl; const int qb = half ? 15 - x : x;
        const int ln = lane_id_v(); const float mine = c.BF[ln < 12 ? ln : 11]; int rank = 0;
#pragma unroll
        for (int k = 0; k < 12; ++k) { const float o = __uint_as_float((unsigned)__builtin_amdgcn_readlane((int)__float_as_uint(mine), k)); rank += (o > mine || (o == mine && k < ln)) ? 1 : 0; }
        const unsigned long long hm = __ballot(ln < 12 && rank == p); const int h = hm ? (int)__builtin_ctzll(hm) : 0; const int bh = b * 12 + h;
        const size_t row0 = (size_t)b * SEQ + qb * 256;
        r.Q = c.PROJ + row0 * c.np + B_Q + h * 128; r.G = c.PROJ + row0 * c.np + B_G + h * 128; r.K = c.KSVS + (size_t)b * SEQ * 3072 + h * 128; r.V = r.K + 1536; r.O = c.MIX + row0 * DM + h * 128;
        r.CB = c.CB + (size_t)bh * SEQ; r.P0 = qb * 256; r.skv = SEQ; r.qp = c.np; r.kp = 3072;
        { const float cb0 = r.CB[qb * 256], cbe = r.CB[64 * ln + 63];
          const unsigned long long mk = __ballot(cb0 - cbe <= c.skip_th); r.jlo = mk ? (int)__builtin_ctzll(mk) : 0; } }
    else { const int jm = j - nF; const int bl = jm >> 6, rbl = (jm & 63) >> 2, mh = jm & 3; const int b = c.q + c.nq * bl; const int rb = b * 16 + rbl; const size_t row0 = (size_t)rb * 256;
        r.Q = c.PROJ + row0 * c.np + c.qmcol + mh * 128; r.G = nullptr; r.K = c.MK + (size_t)b * MEMT * 512 + mh * 128; r.V = c.MV + (size_t)b * MEMT * 512 + mh * 128; r.O = c.MIX + row0 * DM + 1536 + mh * 128;
        r.CB = nullptr; r.P0 = 256; r.skv = MEMT; r.qp = c.np; r.kp = 512; r.jlo = 0; }
    return r;
}
__device__ __forceinline__ int att_fetch(const AttCfg& c, int wave, int GQ) {
    if (wave == 0 && lane_id_v() == 0) c.qs[0] = __hip_atomic_fetch_add(c.que, 1u, RLX_AGENT);
    __syncthreads();
    return __builtin_amdgcn_readfirstlane(GQ + (int)c.qs[0]);
}
__device__ __forceinline__ void att_phase(const AttCfg& c, char* lds, int wave) {
    const int nb = 8 / c.nq, nF = c.fox ? 96 * nb : 0, T = nF + 64 * nb, GQ = c.G / c.nq;
    int j = c.vcu - c.q * GQ, half = 0;
    if (j >= T) return;
    fa::BlockRef cur = att_item(c, j, 0, nF); fa::Seam S;
    fa::attn_prime(cur, lds, S, wave);
    for (;;) {
        int nj = j, nh = 1;
        if (!(j < nF && half == 0)) { nj = att_fetch(c, wave, GQ); nh = 0; }
        const bool has = nj < T;
        const fa::BlockRef nxt = has ? att_item(c, nj, nh, nF) : cur;
        fa::attn_block(cur, nxt, lds, S, wave);
        if (!has) break;
        cur = nxt; j = nj; half = nh;
    }
}

struct Args { const float* in[22]; float* out; unsigned char* ws; int lo, hi; };
constexpr int PT_OUT = 22, PT_WS = 23;
#define PTR(k) ldp(PT, (k))
__global__ void __launch_bounds__(NWAVES * 64, 2) mega_fwd(Args args) {
    extern __shared__ __attribute__((aligned(16))) unsigned char lds_raw[];
    LAS unsigned char* lds = (LAS unsigned char*)lds_raw;
    volatile LAS unsigned* MISC = (volatile LAS unsigned*)(lds + MISC_OFF);
    volatile LAS unsigned* PT = (volatile LAS unsigned*)(lds + MISC_OFF + 128);
    const int wave = __builtin_amdgcn_readfirstlane((int)threadIdx.x >> 6);
    const int G = gridDim.x; const int bx = blockIdx.x; const int vcu = (G % 8 == 0) ? (bx % 8) * (G / 8) + bx / 8 : bx;
    const int gw = vcu * NWAVES + wave, NGW = G * NWAVES;
    for (int u = threadIdx.x; u < (LDS_BYTES - LDSCTL_OFF) / 4; u += NWAVES * 64) ((LAS unsigned*)(lds + LDSCTL_OFF))[u] = 0u;
    __syncthreads();
    if (threadIdx.x == 0) {
#pragma unroll
        for (int k = 0; k < 22; ++k) { const unsigned long long p = (unsigned long long)args.in[k]; PT[2 * k] = (unsigned)p; PT[2 * k + 1] = (unsigned)(p >> 32); }
        { const unsigned long long p = (unsigned long long)args.out; PT[2 * PT_OUT] = (unsigned)p; PT[2 * PT_OUT + 1] = (unsigned)(p >> 32); }
        { const unsigned long long p = (unsigned long long)args.ws; PT[2 * PT_WS] = (unsigned)p; PT[2 * PT_WS + 1] = (unsigned)(p >> 32); }
    }
    __syncthreads();
    const int lo = args.lo, hi = args.hi < MK_STOP_PC ? args.hi : MK_STOP_PC;
    const bool use_bar = (args.hi - args.lo) > 1;
    XcdBarrier bar; bar.bar = (unsigned*)((unsigned char*)PTR(PT_WS) + WS_CTL) + CW_BAR; bar.x = 0; bar.st = MISC + 8; bar.wave = wave;
    if (use_bar) bar = xcd_barrier_post(bar.bar, MISC + 8, wave);

    int pc = 0;
#define PH_ON (pc >= lo && pc < hi)
#define PH_END do { if (use_bar && pc >= lo && pc + 1 < hi) { XcdBarrier bb; bb.bar = (unsigned*)((unsigned char*)PTR(PT_WS) + WS_CTL) + CW_BAR; bb.x = bar.x; bb.st = MISC + 8; bb.wave = wave; xcd_barrier(bb); } ++pc; } while (0)
#define WSP ((unsigned char*)PTR(PT_WS))
#define PH_BEGIN if (PH_ON) { const int lane = lane_id(); const int gwp = launder_s(gw), vcup = launder_s(vcu), bxp = launder_s(bx), wavep = launder_s(wave); unsigned char* ws = WSP; (void)lane; (void)gwp; (void)vcup; (void)bxp; (void)wavep;
#define XOUT ((float*)PTR(PT_OUT))

    PH_BEGIN
#ifndef DBG_NO_CVT
        for (int rep = 0; rep < REP_CVT; ++rep) convert_phase(PT, ws, XOUT, lds, gwp, NGW, lane, wavep);
#endif
    }
    PH_END;
#ifdef EXTRA_BARRIERS
    if (use_bar) for (int eb = 0; eb < EXTRA_BARRIERS; ++eb) { XcdBarrier bb; bb.bar = (unsigned*)((unsigned char*)PTR(PT_WS) + WS_CTL) + CW_BAR; bb.x = bar.x; bb.st = MISC + 8; bb.wave = wave; xcd_barrier(bb); }
#endif

#ifdef EXTRA_UP_PHASES
    for (int ex = 0; ex < EXTRA_UP_PHASES; ++ex) {
        if (pc >= lo && pc < hi) { unsigned char* ws = WSP; const int bxp = launder_s(bx), wavep = launder_s(wave);
            pg8::Gemm g{(const bf16*)XOUT, (const bf16*)(ws + WS_WUP) + (size_t)(7 - (ex & 3)) * NUP * DM, M, NUP, DM}; pg8::StaticOrder S; S.init(M, NUP, G, bxp);
            pg8::EpiNull E{(float*)(ws + WS_DSEG)};
            pg8::gemm_phase<pg8::EpiNull, pg8::StaticOrder, true, true>(lds, g, S, E, wavep); }
        if (use_bar && pc >= lo) { XcdBarrier bb; bb.bar = (unsigned*)((unsigned char*)PTR(PT_WS) + WS_CTL) + CW_BAR; bb.x = bar.x; bb.st = MISC + 8; bb.wave = wave; xcd_barrier(bb); }
    }
#endif
    for (int l = 0; l < DEPTH; ++l) {
        for (int sub = 0; sub < 2; ++sub) {
            const int mat = l * 2 + sub;
            if (l == 2 && sub == 0) {
                PH_BEGIN load_gains(lds, PTR(21), PTR(21), wavep, lane);
                    pg8::Gemm g{(const bf16*)XOUT, (const bf16*)(ws + WS_WKV), M, NKV, DM}; pg8::StaticOrder S; S.init(M, NKV, G, bxp);
                    pg8::EpiKV E{(bf16*)(ws + WS_KSVS), 3072, (float*)(ws + WS_F), pg8::RinvCache{(const float*)(ws + WS_SS) + (size_t)6 * M * 2, (LAS float*)(lds + RTAB_OFF), -1}, (LAS float*)(lds + HNT_OFF), (LAS const float*)(lds + GAIN_OFF)};
                    for (int rep = 0; rep < REP_KVG; ++rep) pg8::gemm_phase<pg8::EpiKV, pg8::StaticOrder, true, GEMM_SP2>(lds, g, S, E, wavep); }
                PH_END;
                PH_BEGIN
#ifndef DBG_NO_CUM
                    for (int rep = 0; rep < REP_CUM; ++rep) fox_cumsum((const float*)(ws + WS_F), PTR(20), (float*)(ws + WS_CB), gwp, NGW, lane);
#endif
                    }
                PH_END;
            }
            for (int part = 0; part < FFN_SPLIT; ++part) {
            constexpr int MP = M / FFN_SPLIT; const size_t r0 = (size_t)part * MP;
            PH_BEGIN
                if (UP_STAGGER_US > 0 && ((bxp >> 3) & 1)) { const unsigned long long t0 = __builtin_amdgcn_s_memrealtime(); while (__builtin_amdgcn_s_memrealtime() - t0 < (unsigned long long)UP_STAGGER_US * 100ull) __builtin_amdgcn_s_sleep(16); }
                const bf16* resA = (l == DEPTH - 1 && sub == 1) ? (const bf16*)(ws + WS_XB2) : (const bf16*)XOUT;
                pg8::Gemm g{resA + r0 * DM, (const bf16*)(ws + WS_WUP) + (size_t)mat * NUP * DM, MP, NUP, DM}; pg8::StaticOrder S; S.init(MP, NUP, G, bxp);
                pg8::EpiSwiGLU E{(bf16*)(ws + WS_ACT) + r0 * FF, FF, pg8::RinvCache{(const float*)(ws + WS_SS) + ((size_t)(3 * l + 2 * sub) * M + r0) * 2, (LAS float*)(lds + RTAB_OFF), -1}};
                pg8::gemm_phase<pg8::EpiSwiGLU, pg8::StaticOrder, UP_ALIGN, GEMM_SP2>(lds, g, S, E, wavep);
#if REP_UP > 1
#ifdef REP_UP_CHEAP
                for (int rep = 1; rep < REP_UP; ++rep) { pg8::EpiNull E2{(float*)(ws + WS_DSEG)}; pg8::gemm_phase<pg8::EpiNull, pg8::StaticOrder, true, GEMM_SP2>(lds, g, S, E2, wavep); }
#else
                for (int rep = 1; rep < REP_UP; ++rep) pg8::gemm_phase<pg8::EpiSwiGLU, pg8::StaticOrder, UP_ALIGN, GEMM_SP2>(lds, g, S, E, wavep);
#endif
#endif
                }
            PH_END;
            PH_BEGIN pg8::Gemm g{(const bf16*)(ws + WS_ACT) + r0 * FF, (const bf16*)(ws + WS_WDN) + (size_t)mat * DM * FF, MP, DM, FF}; pg8::StaticOrder S; S.init(MP, DM, G, bxp);
                const int ssid = sub ? 3 * (l + 1) : 3 * l + 1;
                if (DN_STAGGER_US > 0 && ((bxp >> 3) & 1)) { const unsigned long long t0 = __builtin_amdgcn_s_memrealtime(); while (__builtin_amdgcn_s_memrealtime() - t0 < (unsigned long long)DN_STAGGER_US * 100ull) __builtin_amdgcn_s_sleep(8); }
                if (l == DEPTH - 1 && sub == 1) {
                    pg8::EpiRes<true> E{PT, PT_OUT, PT_WS, WS_XB2, 0, WS_SS + (size_t)12 * M * 8, 1, 0, 0.5f, (int)r0};
                    pg8::gemm_phase<pg8::EpiRes<true>, pg8::StaticOrder, true, GEMM_SP2>(lds, g, S, E, wavep);
                } else {
                    pg8::EpiRes<false> E{PT, PT_OUT, PT_WS, 0, 0, WS_SS + (size_t)ssid * M * 8, 0, 0, 0.5f, (int)r0};
                    pg8::gemm_phase<pg8::EpiRes<false>, pg8::StaticOrder, true, GEMM_SP2>(lds, g, S, E, wavep); }
#if REP_DN > 1
                for (int rep = 1; rep < REP_DN; ++rep) { pg8::EpiDummy E{(bf16*)(ws + WS_HMIX) + r0 * DM, DM}; pg8::gemm_phase<pg8::EpiDummy, pg8::StaticOrder, true, GEMM_SP2>(lds, g, S, E, wavep); }
#endif
                }
            PH_END;
            }
            if (sub == 0) {
                const int np = l < 2 ? NA : NB;
                PH_BEGIN load_gains(lds, l < 2 ? PTR(9) + l * 128 : PTR(17) + (l - 2) * 128, PTR(9) + l * 128, wavep, lane);
                    const bf16* wt = l < 2 ? (const bf16*)(ws + WS_WAIN) + (size_t)l * NA * DM : (const bf16*)(ws + WS_WBIN) + (size_t)(l - 2) * NB * DM;
                    pg8::Gemm g{(const bf16*)XOUT, wt, M, np, DM}; pg8::StaticOrder S; S.init(M, np, G, bxp);
                    pg8::EpiB16 E{(bf16*)(ws + WS_ACT), np, pg8::RinvCache{(const float*)(ws + WS_SS) + (size_t)(3 * l + 1) * M * 2, (LAS float*)(lds + RTAB_OFF), -1}, (LAS float*)(lds + HNT_OFF), (LAS const float*)(lds + GAIN_OFF),
                        l < 2 ? A_QM / 256 : 0, l < 2 ? A_QM / 256 + 2 : 6, l < 2 ? 0 : B_QM / 256, l < 2 ? 0 : B_QM / 256 + 2};
                    for (int rep = 0; rep < REP_IN; ++rep) pg8::gemm_phase<pg8::EpiB16, pg8::StaticOrder, true, GEMM_SP2>(lds, g, S, E, wavep);
                    if (l == 0 && bxp >= G / 2) { pg8::Gemm g2{(const bf16*)(ws + WS_MEMB), (const bf16*)(ws + WS_WMEM), MROWS, NMEMW, DM}; pg8::StaticOrder S2; S2.init(MROWS, NMEMW, G - G / 2, bxp - G / 2);
                        pg8::EpiF32 E2{(float*)(ws + WS_MKVF), NMEMW};
                        pg8::gemm_phase<pg8::EpiF32, pg8::StaticOrder, true, GEMM_SP2>(lds, g2, S2, E2, wavep); } }
                PH_END;
                if (l < 2) {
                    PH_BEGIN if (l == 0) mkmv_pass((const float*)(ws + WS_MKVF), (bf16*)(ws + WS_MK), (bf16*)(ws + WS_MV), PTR(10), gwp, NGW, lane);
#ifndef DBG_NO_PREP
                        for (int rep = 0; rep < REP_PREP; ++rep) gla_prep((const bf16*)(ws + WS_ACT), PTR(14) + l * 768, PTR(13) + l * 16 * 768, (bf16*)(ws + WS_KDT), (bf16*)(ws + WS_VT), (bf16*)(ws + WS_QF), (float*)(ws + WS_ACH), gwp, NGW, lane);
#endif
                        }
                    PH_END;
                    PH_BEGIN
#if SCAN_WG
                        for (int rep = 0; rep < REP_SCAN; ++rep) gla_seg_states_wg((const bf16*)(ws + WS_KDT), (const bf16*)(ws + WS_VT), (const float*)(ws + WS_ACH), (float*)(ws + WS_FST), (float*)(ws + WS_DSEG), lds, vcup, G, wavep, lane, gwp, NGW);
#else
                        for (int rep = 0; rep < REP_SCAN; ++rep) gla_seg_states((const bf16*)(ws + WS_KDT), (const bf16*)(ws + WS_VT), (const float*)(ws + WS_ACH), (float*)(ws + WS_FST), (float*)(ws + WS_DSEG), gwp, NGW, lane);
#endif
                    }
                    PH_END;
                    PH_BEGIN
#if SCAN_WG
                        for (int rep = 0; rep < REP_SCAN; ++rep) gla_seg_outputs_wg((const bf16*)(ws + WS_QF), (const bf16*)(ws + WS_KDT), (const bf16*)(ws + WS_VT), (const float*)(ws + WS_ACH), (const float*)(ws + WS_FST), (const float*)(ws + WS_DSEG), (bf16*)(ws + WS_OG), lds, vcup, G, wavep, lane);
#else
                        for (int rep = 0; rep < REP_SCAN; ++rep) gla_seg_outputs((const bf16*)(ws + WS_QF), (const bf16*)(ws + WS_KDT), (const bf16*)(ws + WS_VT), (const float*)(ws + WS_ACH), (const float*)(ws + WS_FST), (const float*)(ws + WS_DSEG), (bf16*)(ws + WS_OG), gwp, NGW, lane);
#endif
                    }
                    PH_END;
                }
                PH_BEGIN
                    if (l < 2) for (int rep = 0; rep < REP_POST; ++rep) gla_post((const bf16*)(ws + WS_OG), (const bf16*)(ws + WS_ACT), PTR(15) + l * 384, (bf16*)(ws + WS_HMIX), gwp, NGW, lane);
                    AttCfg c; c.PROJ = (const bf16*)(ws + WS_ACT); c.KSVS = (const bf16*)(ws + WS_KSVS); c.CB = (const float*)(ws + WS_CB); c.MK = (const bf16*)(ws + WS_MK) + (size_t)l * MROWS * 512; c.MV = (const bf16*)(ws + WS_MV) + (size_t)l * MROWS * 512;
                    c.MIX = (bf16*)(ws + WS_HMIX); c.np = np; c.qmcol = l < 2 ? A_QM : B_QM; c.fox = l >= 2; c.vcu = vcup; c.G = G; c.skip_th = 0.f;
                    c.nq = (G % 8 == 0) ? 8 : 1; c.q = vcup / (G / c.nq); c.BF = PTR(20); c.qs = MISC + 16; c.que = (unsigned*)(ws + WS_CTL) + CW_QUE + (l * 8 + c.q) * 16;
                    if (l >= 2) {
                        const float* gq = PTR(17) + (l - 2) * 128; const float* gk = PTR(21);
                        float mq = fmaxf(fabsf(gq[lane]), fabsf(gq[64 + lane])), mkk = fmaxf(fabsf(gk[lane]), fabsf(gk[64 + lane]));
                        mq = wave_max(mq); mkk = wave_max(mkk);
                        c.skip_th = FOX_SKIP ? 1270.5f + 2.0f * 128.0f * 1.02f * mq * mkk : 3.0e38f; }
                    __syncthreads();
#ifndef DBG_NO_ATT
                    for (int rep = 0; rep < REP_ATT; ++rep) att_phase(c, (char*)lds_raw, wavep);
#endif
                    }
                PH_END;
                PH_BEGIN pg8::Gemm g{(const bf16*)(ws + WS_HMIX), (const bf16*)(ws + WS_WOUT) + (size_t)l * DM * DM, M, DM, DM}; pg8::StaticOrder S; S.init(M, DM, G, bxp);
                    { pg8::EpiRes<false> E{PT, PT_OUT, PT_WS, 0, WS_XB2, WS_SS + (size_t)(3 * l + 2) * M * 8, 0, l == DEPTH - 1 ? 1 : 0, 1.0f, 0};
                      pg8::gemm_phase<pg8::EpiRes<false>, pg8::StaticOrder, true, GEMM_SP2>(lds, g, S, E, wavep); }
#if REP_OUT > 1
                    for (int rep = 1; rep < REP_OUT; ++rep) { pg8::EpiDummy E{(bf16*)(ws + WS_ACT), DM}; pg8::gemm_phase<pg8::EpiDummy, pg8::StaticOrder, true, GEMM_SP2>(lds, g, S, E, wavep); }
#endif
                    }
                PH_END;
            }
        }
    }
#undef PH_ON
#undef PH_END
#undef WSP
#undef PH_BEGIN
#undef XOUT
}

extern "C" void kernel_launch(void* const* d_in, const int* in_sizes, int n_in, void* d_out, int out_size, void* d_ws, size_t ws_size, hipStream_t stream) {
    static int grid = 0;
    if (grid == 0) {
        if (n_in != 22 || in_sizes[0] != M * DM || out_size != M * DM || ws_size < WS_END) { fprintf(stderr, "kernel_launch: unexpected shapes (n_in %d, in0 %d, out %d, ws %zu < %zu); nothing launched\n", n_in, n_in > 0 ? in_sizes[0] : -1, out_size, ws_size, (size_t)WS_END); grid = -1; return; }
        int dev = 0, cus = 0, per_cu = 0;
        if (hipGetDevice(&dev) != hipSuccess || hipDeviceGetAttribute(&cus, hipDeviceAttributeMultiprocessorCount, dev) != hipSuccess) { fprintf(stderr, "kernel_launch: device query failed\n"); grid = -1; return; }
        if (hipFuncSetAttribute((const void*)mega_fwd, hipFuncAttributeMaxDynamicSharedMemorySize, LDS_BYTES) != hipSuccess) { fprintf(stderr, "kernel_launch: hipFuncSetAttribute failed\n"); grid = -1; return; }
        if (hipOccupancyMaxActiveBlocksPerMultiprocessor(&per_cu, (const void*)mega_fwd, NWAVES * 64, LDS_BYTES) != hipSuccess || per_cu < 1)
            fprintf(stderr, "kernel_launch: note: occupancy query reports %d workgroups per CU\n", per_cu);
        (void)hipGetLastError();
        grid = cus;
    }
    if (grid < 0) return;
    (void)hipMemsetAsync((char*)d_ws + WS_CTL, 0, CTL_ZERO_BYTES, stream);
    (void)hipMemsetAsync((char*)d_ws + WS_SS, 0, SS_BYTES, stream);
    Args a{};
    for (int i = 0; i < 22; ++i) a.in[i] = (const float*)d_in[i];
    a.out = (float*)d_out; a.ws = (unsigned char*)d_ws;
#if MK_PER_PHASE
    for (int p = 0; p < NPH && p < MK_STOP_PC; ++p) { a.lo = p; a.hi = p + 1; hipLaunchKernelGGL(mega_fwd, dim3(grid), dim3(NWAVES * 64), LDS_BYTES, stream, a); }
#else
    a.lo = 0; a.hi = NPH; hipLaunchKernelGGL(mega_fwd, dim3(grid), dim3(NWAVES * 64), LDS_BYTES, stream, a);
#endif
}
```
